# Optimizing an MI355X kernel written in HIP

```python
import math
import numpy as np
import jax
import jax.numpy as jnp
from jax import lax

D_MODEL = 1024
BATCH = 8
SEQ = 4096
DEPTH = 4

GRID_W = 64
CTX_LEN = 256

BR_W = D_MODEL // 2
N_BRANCH = 4

SSD_HEADDIM = 64
SSD_HEADS = BR_W // SSD_HEADDIM
SSD_GROUPS = 2
SSD_STATE = 128
SSD_CHUNK = 128
SSD_CONV = 3
SSD_XBC = BR_W + 2 * SSD_GROUPS * SSD_STATE
SSD_COLS = BR_W + SSD_XBC + SSD_HEADS

RWKV_HEADDIM = 64
RWKV_HEADS = BR_W // RWKV_HEADDIM
RWKV_W_LORA = 64
RWKV_A_LORA = 64
RWKV_G_LORA = 128
RWKV_COLS = 3 * BR_W + 2 * RWKV_W_LORA + 2 * RWKV_A_LORA + RWKV_G_LORA
RWKV_LNX_EPS = 64e-5

DIFF_HEADDIM = 64
DIFF_HEADS = BR_W // (2 * DIFF_HEADDIM)
DIFF_COLS = 3 * BR_W
ATTN_QBLOCK = 128
ROPE_BASE = 10000.0
ROPE_PAIRS = DIFF_HEADDIM // 4

GLA_HEADS = 4
GLA_DK = BR_W // (2 * GLA_HEADS)
GLA_DV = BR_W // GLA_HEADS
GLA_GATE_LORA = 16
GLA_TAU = 16.0
GLA_CHUNK = 64
GLA_COLS = 2 * GLA_HEADS * GLA_DK + BR_W + 2 * GLA_GATE_LORA + BR_W

MERGE_COLS = N_BRANCH * D_MODEL
IN_SPLITS = (SSD_COLS, RWKV_COLS, DIFF_COLS, GLA_COLS, MERGE_COLS)
IN_COLS = sum(IN_SPLITS)

MOE_GROUPS = 4
MOE_PER_GROUP = 8
MOE_EXPERTS = MOE_GROUPS * MOE_PER_GROUP
MOE_TOPK = 2
MOE_FF = D_MODEL // 2
MOE_BLOCK = 256

DN_ALPHA = (2 * DEPTH) ** 0.25
DN_BETA = (8 * DEPTH) ** -0.25
LN_EPS = 1e-5
NORM_EPS = 1e-5

kernel_name = 'hybrid_ssd_rwkv_diffattn_gla_hmoe_trunk'


def _split(u, sizes):
    cuts = [int(s) for s in np.cumsum(sizes)[:-1]]
    return jnp.split(u, cuts, axis=-1)


def _flip(t):
    return jnp.flip(t, axis=1)


def _two_dirs(t):
    return jnp.stack([t, _flip(t)], axis=0)


def _dir_stack(t):
    return jnp.stack([t[:, :, 0], _flip(t[:, :, 1])], axis=0)


def _layernorm(x, g, b, eps=LN_EPS):
    xf = x.astype(jnp.float32)
    mu = jnp.mean(xf, -1, keepdims=True)
    var = jnp.mean(jnp.square(xf - mu), -1, keepdims=True)
    return ((xf - mu) * lax.rsqrt(var + eps)).astype(x.dtype) * g + b


def _rmsnorm(x, g, eps=NORM_EPS):
    xf = x.astype(jnp.float32)
    return (xf * lax.rsqrt(jnp.mean(xf * xf, -1, keepdims=True) + eps)).astype(x.dtype) * g


def _shift_centred(u):
    prev = jnp.pad(u, ((0, 0), (1, 0), (0, 0)))[:, :-1]
    nxt = jnp.pad(u, ((0, 0), (0, 1), (0, 0)))[:, 1:]
    return 0.5 * (prev + nxt)


def _dwconv_centred(u, w, bias):
    k, ch = w.shape
    out = lax.conv_general_dilated(u, w[:, None, :], window_strides=(1,), padding=[(k // 2, k // 2)],
                                   dimension_numbers=('NWC', 'WIO', 'NWC'), feature_group_count=ch)
    return out + bias


def _rope_tables(n_tokens):
    rows = n_tokens // GRID_W
    r_idx, c_idx = jnp.meshgrid(jnp.arange(rows), jnp.arange(GRID_W), indexing='ij')
    inv = ROPE_BASE ** (-jnp.arange(ROPE_PAIRS, dtype=jnp.float32) / ROPE_PAIRS)
    ang = jnp.stack([r_idx.reshape(-1)[:, None] * inv, c_idx.reshape(-1)[:, None] * inv], axis=1)
    return jnp.cos(ang), jnp.sin(ang)


def _rope_2d(t, cos, sin):
    b, n = t.shape[:2]
    mid = t.shape[2:-1]
    tt = t.reshape((b, n) + mid + (2, 2, ROPE_PAIRS))
    shp = (n,) + (1,) * len(mid) + (2, ROPE_PAIRS)
    c = cos.reshape(shp).astype(t.dtype)
    s = sin.reshape(shp).astype(t.dtype)
    x1, x2 = tt[..., 0, :], tt[..., 1, :]
    return jnp.stack([x1 * c - x2 * s, x2 * c + x1 * s], axis=-2).reshape(t.shape)


def _ssd_scan(x, dt, a, bm, cm, h0):
    b, n, H, P = x.shape
    G, N = bm.shape[2], bm.shape[3]
    Q = SSD_CHUNK
    nc = n // Q
    bh = jnp.repeat(bm, H // G, axis=2).reshape(b, nc, Q, H, N)
    ch = jnp.repeat(cm, H // G, axis=2).reshape(b, nc, Q, H, N)
    xc = x.reshape(b, nc, Q, H, P)
    dtc = dt.reshape(b, nc, Q, H)
    acs = jnp.cumsum(dtc * a, axis=2)
    mask = jnp.tril(jnp.ones((Q, Q), bool))[:, :, None]
    seg = acs[:, :, :, None, :] - acs[:, :, None, :, :]
    decay = jnp.exp(jnp.where(mask, seg, -jnp.inf))
    xdt = xc * dtc[..., None]
    scores = jnp.einsum('bcihn,bcjhn->bcijh', ch, bh) * decay
    y_diag = jnp.einsum('bcijh,bcjhp->bcihp', scores, xdt)
    to_end = jnp.exp(acs[:, :, -1:, :] - acs)
    states = jnp.einsum('bcjhn,bcjhp->bchpn', bh * to_end[..., None], xdt)
    chunk_decay = jnp.exp(acs[:, :, -1, :])

    def step(h, inp):
        st, dec = inp
        return h * dec[:, :, None, None] + st, h

    h_last, h_start = lax.scan(step, h0, (jnp.moveaxis(states, 1, 0), jnp.moveaxis(chunk_decay, 1, 0)))
    h_start = jnp.moveaxis(h_start, 0, 1)
    y_off = jnp.einsum('bcihn,bchpn->bcihp', ch * jnp.exp(acs)[..., None], h_start)
    return (y_diag + y_off).reshape(b, n, H, P), h_last


def _ssd_branch(u_lat, u_ctx, conv_w, conv_b, a_log, dt_bias, d_skip, norm_g):
    a = -jnp.exp(a_log)

    def run(u, h0):
        b, n = u.shape[:2]
        z, xbc, dt = _split(u, (BR_W, SSD_XBC, SSD_HEADS))
        xbc = jax.nn.silu(_dwconv_centred(xbc, conv_w, conv_b))
        xs, bm, cm = _split(xbc, (BR_W, SSD_GROUPS * SSD_STATE, SSD_GROUPS * SSD_STATE))
        xs = xs.reshape(b, n, SSD_HEADS, SSD_HEADDIM)
        bm = bm.reshape(b, n, SSD_GROUPS, SSD_STATE)
        cm = cm.reshape(b, n, SSD_GROUPS, SSD_STATE)
        dt2 = jax.nn.softplus(_two_dirs(dt) + dt_bias[:, None, None, :])
        y2, h_last = jax.vmap(_ssd_scan)(_two_dirs(xs), dt2, a, _two_dirs(bm), _two_dirs(cm), h0)
        y = y2[0] + _flip(y2[1]) + xs * d_skip[:, None]
        y = (y.reshape(b, n, BR_W) * jax.nn.silu(z)).reshape(b, n, SSD_GROUPS, BR_W // SSD_GROUPS)
        y = _rmsnorm(y, norm_g.reshape(SSD_GROUPS, BR_W // SSD_GROUPS)).reshape(b, n, BR_W)
        return y, h_last

    h0 = jnp.zeros((2, u_ctx.shape[0], SSD_HEADS, SSD_HEADDIM, SSD_STATE), u_ctx.dtype)
    y_ctx, h_ctx = run(u_ctx, h0)
    y_lat, _ = run(u_lat, h_ctx)
    return y_lat, y_ctx


def _rwkv_branch(u_lat, u_ctx, shift_mu, w0, w_up, a0, a_up, g_up, k_k, k_a, r_k, lnx_g, lnx_b):
    H, dh = RWKV_HEADS, RWKV_HEADDIM

    def step(S, inp):
        r, w, k, v, kk, a = inp
        sa = jnp.einsum('dbhvk,dbhk->dbhv', S, -kk)
        S = S * w[..., None, :] + sa[..., None] * (kk * a)[..., None, :] + v[..., None] * k[..., None, :]
        return S, jnp.einsum('dbhvk,dbhk->dbhv', S, r)

    def run(u, s0):
        b, n = u.shape[:2]
        u = u + shift_mu * (_shift_centred(u) - u)
        r, k, v, wd, ad, gd = _split(u, (BR_W, BR_W, BR_W, 2 * RWKV_W_LORA, 2 * RWKV_A_LORA, RWKV_G_LORA))
        wd = jnp.tanh(wd.reshape(b, n, 2, RWKV_W_LORA))
        w_log = -jax.nn.softplus(-(w0 + jnp.einsum('bldr,drc->bldc', wd, w_up))) - 0.5
        decay = jnp.exp(-jnp.exp(w_log))
        a = jax.nn.sigmoid(a0 + jnp.einsum('bldr,drc->bldc', ad.reshape(b, n, 2, RWKV_A_LORA), a_up))
        g = jax.nn.sigmoid(gd) @ g_up
        kk = (k * k_k).reshape(b, n, H, dh).astype(jnp.float32)
        kk = (kk * lax.rsqrt(jnp.sum(kk * kk, -1, keepdims=True) + 1e-12)).astype(u.dtype)
        kd = k[:, :, None, :] * (1 + (a - 1) * k_a)
        rh = r.reshape(b, n, H, dh)
        vh = v.reshape(b, n, H, dh)
        kdh = kd.reshape(b, n, 2, H, dh)
        xs = (_two_dirs(rh), _dir_stack(decay.reshape(b, n, 2, H, dh)), _dir_stack(kdh),
              _two_dirs(vh), _two_dirs(kk), _dir_stack(a.reshape(b, n, 2, H, dh)))
        xs = tuple(jnp.moveaxis(t, 2, 0) for t in xs)
        s_last, ys = lax.scan(step, s0, xs)
        ys = jnp.moveaxis(ys, 0, 2)
        y = _layernorm(ys[0] + _flip(ys[1]), lnx_g.reshape(H, dh), lnx_b.reshape(H, dh), RWKV_LNX_EPS)
        bonus = jnp.sum(rh * kdh.sum(2) * r_k, -1, keepdims=True) * vh
        return (y + bonus).reshape(b, n, BR_W) * g, s_last

    s0 = jnp.zeros((2, u_ctx.shape[0], H, dh, dh), u_ctx.dtype)
    y_ctx, s_ctx = run(u_ctx, s0)
    y_lat, _ = run(u_lat, s_ctx)
    return y_lat, y_ctx


def _diff_attn_branch(u_lat, u_ctx, lam_q1, lam_k1, lam_q2, lam_k2, subln_g, lam_init, need_ctx):
    H, d = DIFF_HEADS, DIFF_HEADDIM
    scale = d ** -0.5

    def heads(u):
        b, n = u.shape[:2]
        q, k, v = _split(u, (BR_W, BR_W, BR_W))
        return q.reshape(b, n, H, 2, d) * scale, k.reshape(b, n, H, 2, d), v.reshape(b, n, H, 2 * d)

    lam = (jnp.exp(jnp.sum(lam_q1 * lam_k1).astype(jnp.float32))
           - jnp.exp(jnp.sum(lam_q2 * lam_k2).astype(jnp.float32)) + lam_init)

    def attend(q, k, v):
        s = jnp.einsum('bqhmd,bkhmd->bhmqk', q, k).astype(jnp.float32)
        p = jax.nn.softmax(s, axis=-1)
        pd = (p[:, :, 0] - lam * p[:, :, 1]).astype(v.dtype)
        return jnp.einsum('bhqk,bkhe->bqhe', pd, v)

    def finish(o):
        b, n = o.shape[:2]
        return (_rmsnorm(o, subln_g) * (1.0 - lam_init)).reshape(b, n, BR_W)

    q_l, k_l, v_l = heads(u_lat)
    q_c, k_c, v_c = heads(u_ctx)
    b, n = u_lat.shape[:2]
    cos, sin = _rope_tables(n)
    q_l = _rope_2d(q_l, cos, sin)
    k_l = _rope_2d(k_l, cos, sin)
    k_all = jnp.concatenate([k_c, k_l], axis=1)
    v_all = jnp.concatenate([v_c, v_l], axis=1)
    nb = n // ATTN_QBLOCK
    qb = jnp.moveaxis(q_l.reshape(b, nb, ATTN_QBLOCK, H, 2, d), 1, 0)
    o_l = lax.map(lambda qblk: attend(qblk, k_all, v_all), qb)
    y_lat = finish(jnp.moveaxis(o_l, 0, 1).reshape(b, n, H, 2 * d))
    y_ctx = finish(attend(q_c, k_c, v_c)) if need_ctx else None
    return y_lat, y_ctx


def _gla_scan(q, k, v, logg, h0):
    b, n, H, dk = q.shape
    dv = v.shape[-1]
    Q = GLA_CHUNK
    nc = n // Q
    q = q.reshape(b, nc, Q, H, dk)
    k = k.reshape(b, nc, Q, H, dk)
    v = v.reshape(b, nc, Q, H, dv)
    gc = jnp.cumsum(logg.reshape(b, nc, Q, H, dk), axis=2)
    ref = gc[:, :, Q // 2:Q // 2 + 1]
    mask = jnp.tril(jnp.ones((Q, Q), bool))
    att = jnp.einsum('bcihd,bcjhd->bchij', q * jnp.exp(gc - ref), k * jnp.exp(ref - gc))
    att = jnp.where(mask, att, 0.0)
    o_intra = jnp.einsum('bchij,bcjhv->bcihv', att, v)
    g_last = gc[:, :, -1]
    st = jnp.einsum('bcjhd,bcjhv->bchdv', k * jnp.exp(g_last[:, :, None] - gc), v)

    def step(h, inp):
        s, gl = inp
        return h * jnp.exp(gl)[..., None] + s, h

    h_last, h_start = lax.scan(step, h0, (jnp.moveaxis(st, 1, 0), jnp.moveaxis(g_last, 1, 0)))
    o_inter = jnp.einsum('bcihd,bchdv->bcihv', q * jnp.exp(gc), jnp.moveaxis(h_start, 0, 1))
    return (o_intra + o_inter).reshape(b, n, H, dv), h_last


def _gla_branch(u_lat, u_ctx, g_up, g_bias, norm_g):
    H, dk, dv = GLA_HEADS, GLA_DK, GLA_DV

    def run(u, h0):
        b, n = u.shape[:2]
        q, k, v, gd, og = _split(u, (H * dk, H * dk, BR_W, 2 * GLA_GATE_LORA, BR_W))
        q = q.reshape(b, n, H, dk) * (dk ** -0.5)
        k = k.reshape(b, n, H, dk)
        v = v.reshape(b, n, H, dv)
        gate = jnp.einsum('bldr,drc->bldc', gd.reshape(b, n, 2, GLA_GATE_LORA), g_up) + g_bias
        logg = (jax.nn.log_sigmoid(gate) / GLA_TAU).reshape(b, n, 2, H, dk)
        o2, h_last = jax.vmap(_gla_scan)(_two_dirs(q), _two_dirs(k), _two_dirs(v), _dir_stack(logg), h0)
        o = _rmsnorm(o2[0] + _flip(o2[1]), norm_g)
        return o.reshape(b, n, BR_W) * jax.nn.silu(og), h_last

    h0 = jnp.zeros((2, u_ctx.shape[0], H, dk, dv), u_ctx.dtype)
    y_ctx, h_ctx = run(u_ctx, h0)
    y_lat, _ = run(u_lat, h_ctx)
    return y_lat, y_ctx


def _merge(ys, gate_cols, w_branch, w_out):
    b, n = gate_cols.shape[:2]
    gates = jax.nn.sigmoid(gate_cols.reshape(b, n, N_BRANCH, D_MODEL))
    m = gates[:, :, 0] * (ys[0] @ w_branch[0])
    for i in range(1, N_BRANCH):
        m = m + gates[:, :, i] * (ys[i] @ w_branch[i])
    return m @ w_out


def _mixer_block(h, hc, need_ctx, lam_init, w_in, ssd_p, rwkv_p, diff_p, gla_p, w_branch, w_out):
    u = h @ w_in
    uc = hc @ (w_in if need_ctx else w_in[:, :IN_COLS - MERGE_COLS])
    u_ssd, u_rwkv, u_diff, u_gla, u_gate = _split(u, IN_SPLITS)
    uc_ssd, uc_rwkv, uc_diff, uc_gla, uc_gate = _split(uc, IN_SPLITS)
    ya, yac = _ssd_branch(u_ssd, uc_ssd, *ssd_p)
    yb, ybc = _rwkv_branch(u_rwkv, uc_rwkv, *rwkv_p)
    yc, ycc = _diff_attn_branch(u_diff, uc_diff, *diff_p, lam_init, need_ctx)
    yd, ydc = _gla_branch(u_gla, uc_gla, *gla_p)
    out = _merge((ya, yb, yc, yd), u_gate, w_branch, w_out)
    out_c = _merge((yac, ybc, ycc, ydc), uc_gate, w_branch, w_out) if need_ctx else None
    return out, out_c


def _expert_dispatch(xf, eid, wts, w_gate, w_up, w_down):
    T, D = xf.shape
    E = w_gate.shape[0]
    A = T * MOE_TOPK
    nb = -(-A // MOE_BLOCK) + E
    flat_e = eid.reshape(A)
    order = jnp.argsort(flat_e)
    e_sorted = flat_e[order]
    counts = jnp.zeros((E,), jnp.int32).at[flat_e].add(1)
    blocks_e = (counts + MOE_BLOCK - 1) // MOE_BLOCK
    blk_end = jnp.cumsum(blocks_e)
    blk_begin = blk_end - blocks_e
    seg_begin = jnp.cumsum(counts) - counts
    rank = jnp.arange(A, dtype=jnp.int32) - seg_begin[e_sorted]
    slot = blk_begin[e_sorted] * MOE_BLOCK + rank
    tok_slot = jnp.full((nb * MOE_BLOCK,), T, jnp.int32).at[slot].set((order // MOE_TOPK).astype(jnp.int32))
    w_slot = jnp.zeros((nb * MOE_BLOCK,), xf.dtype).at[slot].set(wts.reshape(A)[order])
    blk_expert = jnp.minimum(jnp.searchsorted(blk_end, jnp.arange(nb, dtype=jnp.int32), side='right'), E - 1)
    x_pad = jnp.concatenate([xf, jnp.zeros((1, D), xf.dtype)], axis=0)
    xb = x_pad[tok_slot].reshape(nb, MOE_BLOCK, D)

    def expert_block(args):
        xblk, e = args
        hid = jax.nn.silu(xblk @ w_gate[e]) * (xblk @ w_up[e])
        return hid @ w_down[e]

    yb = lax.map(expert_block, (xb, blk_expert))
    y = jnp.zeros((T + 1, D), xf.dtype).at[tok_slot].add(yb.reshape(-1, D) * w_slot[:, None])
    return y[:T]


def _hier_moe(hf, w_grp, b_grp, w_exp, b_exp, w_gate, w_up, w_down):
    T = hf.shape[0]
    gp = jax.nn.softmax((hf @ w_grp + b_grp).astype(jnp.float32), axis=-1)
    gp_top, g_idx = lax.top_k(gp, 1)
    el = (hf @ w_exp + b_exp).reshape(T, MOE_GROUPS, MOE_PER_GROUP)
    sel = jnp.broadcast_to(g_idx[:, :, None], (T, 1, MOE_PER_GROUP))
    el = jnp.take_along_axis(el, sel, axis=1)[:, 0]
    ep = jax.nn.softmax(el.astype(jnp.float32), axis=-1)
    ep_top, e_idx = lax.top_k(ep, MOE_TOPK)
    wts = (ep_top / jnp.sum(ep_top, -1, keepdims=True) * gp_top).astype(hf.dtype)
    eid = g_idx * MOE_PER_GROUP + e_idx
    return _expert_dispatch(hf, eid, wts, w_gate, w_up, w_down)


def setup_inputs(seed: int = 0) -> dict:
    key = jax.random.key(seed)
    ks = iter(jax.random.split(key, 64))
    f32 = jnp.float32

    def nrm(shape, scale):
        return jax.random.normal(next(ks), shape, f32) * scale

    def unif(shape, lo, hi):
        return jax.random.uniform(next(ks), shape, f32, lo, hi)

    dt0 = jnp.exp(unif((DEPTH, 2, SSD_HEADS), math.log(1e-3), math.log(1e-1)))
    E = MOE_EXPERTS
    return {
        'x': nrm((BATCH, SEQ, D_MODEL), 1.0),
        'c': nrm((BATCH, D_MODEL), 1.0),
        'ctx': nrm((BATCH, CTX_LEN, D_MODEL), 1.0),
        'c_ctx': nrm((D_MODEL,), 1.0),
        'ada_w': nrm((DEPTH, D_MODEL, 6 * D_MODEL), D_MODEL ** -0.5),
        'ada_b': nrm((DEPTH, 6 * D_MODEL), 0.02),
        'w_in': nrm((DEPTH, D_MODEL, IN_COLS), D_MODEL ** -0.5),
        'ssd_conv_w': nrm((DEPTH, SSD_CONV, SSD_XBC), SSD_CONV ** -0.5),
        'ssd_conv_b': nrm((DEPTH, SSD_XBC), 0.02),
        'ssd_a_log': jnp.log(unif((DEPTH, 2, SSD_HEADS), 1.0, 16.0)),
        'ssd_dt_bias': dt0 + jnp.log(-jnp.expm1(-dt0)),
        'ssd_d': 1.0 + nrm((DEPTH, SSD_HEADS), 0.1),
        'ssd_norm_g': 1.0 + nrm((DEPTH, BR_W), 0.02),
        'rwkv_shift_mu': unif((DEPTH, RWKV_COLS), 0.0, 1.0),
        'rwkv_w0': unif((DEPTH, 2, BR_W), -5.0, 0.0),
        'rwkv_w_up': nrm((DEPTH, 2, RWKV_W_LORA, BR_W), RWKV_W_LORA ** -0.5),
        'rwkv_a0': nrm((DEPTH, 2, BR_W), 0.5),
        'rwkv_a_up': nrm((DEPTH, 2, RWKV_A_LORA, BR_W), RWKV_A_LORA ** -0.5),
        'rwkv_g_up': nrm((DEPTH, RWKV_G_LORA, BR_W), RWKV_G_LORA ** -0.5),
        'rwkv_k_k': 0.85 + nrm((DEPTH, BR_W), 0.1),
        'rwkv_k_a': 1.0 + nrm((DEPTH, BR_W), 0.1),
        'rwkv_r_k': nrm((DEPTH, RWKV_HEADS, RWKV_HEADDIM), 0.1),
        'rwkv_lnx_g': 1.0 + nrm((DEPTH, BR_W), 0.02),
        'rwkv_lnx_b': nrm((DEPTH, BR_W), 0.02),
        'diff_lam_q1': nrm((DEPTH, DIFF_HEADDIM), 0.1),
        'diff_lam_k1': nrm((DEPTH, DIFF_HEADDIM), 0.1),
        'diff_lam_q2': nrm((DEPTH, DIFF_HEADDIM), 0.1),
        'diff_lam_k2': nrm((DEPTH, DIFF_HEADDIM), 0.1),
        'diff_subln_g': 1.0 + nrm((DEPTH, 2 * DIFF_HEADDIM), 0.02),
        'gla_g_up': nrm((DEPTH, 2, GLA_GATE_LORA, GLA_HEADS * GLA_DK), GLA_GATE_LORA ** -0.5),
        'gla_g_bias': nrm((DEPTH, 2, GLA_HEADS * GLA_DK), 0.1),
        'gla_norm_g': 1.0 + nrm((DEPTH, GLA_DV), 0.02),
        'w_branch': nrm((DEPTH, N_BRANCH, BR_W, D_MODEL), BR_W ** -0.5),
        'w_out': nrm((DEPTH, D_MODEL, D_MODEL), D_MODEL ** -0.5 * DN_BETA),
        'ln1_g': 1.0 + nrm((DEPTH, D_MODEL), 0.02),
        'ln1_b': nrm((DEPTH, D_MODEL), 0.02),
        'moe_w_group': nrm((DEPTH, D_MODEL, MOE_GROUPS), D_MODEL ** -0.5),
        'moe_b_group': nrm((DEPTH, MOE_GROUPS), 0.01),
        'moe_w_expert': nrm((DEPTH, D_MODEL, E), D_MODEL ** -0.5),
        'moe_b_expert': nrm((DEPTH, E), 0.01),
        'moe_w_gate': nrm((DEPTH, E, D_MODEL, MOE_FF), D_MODEL ** -0.5),
        'moe_w_up': nrm((DEPTH, E, D_MODEL, MOE_FF), D_MODEL ** -0.5),
        'moe_w_down': nrm((DEPTH, E, MOE_FF, D_MODEL), MOE_FF ** -0.5 * DN_BETA),
        'ln2_g': 1.0 + nrm((DEPTH, D_MODEL), 0.02),
        'ln2_b': nrm((DEPTH, D_MODEL), 0.02),
    }


def reference(x, c, ctx, c_ctx, ada_w, ada_b, w_in,
              ssd_conv_w, ssd_conv_b, ssd_a_log, ssd_dt_bias, ssd_d, ssd_norm_g,
              rwkv_shift_mu, rwkv_w0, rwkv_w_up, rwkv_a0, rwkv_a_up, rwkv_g_up, rwkv_k_k, rwkv_k_a,
              rwkv_r_k, rwkv_lnx_g, rwkv_lnx_b,
              diff_lam_q1, diff_lam_k1, diff_lam_q2, diff_lam_k2, diff_subln_g,
              gla_g_up, gla_g_bias, gla_norm_g,
              w_branch, w_out, ln1_g, ln1_b,
              moe_w_group, moe_b_group, moe_w_expert, moe_b_expert, moe_w_gate, moe_w_up, moe_w_down,
              ln2_g, ln2_b):
    lc = ctx.shape[1]
    for l in range(DEPTH):
        need_ctx = l < DEPTH - 1
        lam_init = 0.8 - 0.6 * math.exp(-0.3 * l)
        mod = jax.nn.silu(c) @ ada_w[l] + ada_b[l]
        mod_c = jax.nn.silu(c_ctx) @ ada_w[l] + ada_b[l]
        sh1, sc1, g1, sh2, sc2, g2 = jnp.split(mod[:, None, :], 6, axis=-1)
        sh1c, sc1c, g1c, sh2c, sc2c, g2c = jnp.split(mod_c, 6, axis=-1)

        h = x * (1 + sc1) + sh1
        hc = ctx * (1 + sc1c) + sh1c
        ssd_p = (ssd_conv_w[l], ssd_conv_b[l], ssd_a_log[l], ssd_dt_bias[l], ssd_d[l], ssd_norm_g[l])
        rwkv_p = (rwkv_shift_mu[l], rwkv_w0[l], rwkv_w_up[l], rwkv_a0[l], rwkv_a_up[l], rwkv_g_up[l],
                  rwkv_k_k[l], rwkv_k_a[l], rwkv_r_k[l], rwkv_lnx_g[l], rwkv_lnx_b[l])
        diff_p = (diff_lam_q1[l], diff_lam_k1[l], diff_lam_q2[l], diff_lam_k2[l], diff_subln_g[l])
        gla_p = (gla_g_up[l], gla_g_bias[l], gla_norm_g[l])
        y, yc = _mixer_block(h, hc, need_ctx, lam_init, w_in[l], ssd_p, rwkv_p, diff_p, gla_p,
                             w_branch[l], w_out[l])
        x = _layernorm(DN_ALPHA * x + g1 * y, ln1_g[l], ln1_b[l])

        h = x * (1 + sc2) + sh2
        moe_p = (moe_w_group[l], moe_b_group[l], moe_w_expert[l], moe_b_expert[l],
                 moe_w_gate[l], moe_w_up[l], moe_w_down[l])
        if need_ctx:
            ctx = _layernorm(DN_ALPHA * ctx + g1c * yc, ln1_g[l], ln1_b[l])
            hc = ctx * (1 + sc2c) + sh2c
            tok = jnp.concatenate([hc, h], axis=1)
            b, nt = tok.shape[:2]
            m = _hier_moe(tok.reshape(b * nt, D_MODEL), *moe_p).reshape(b, nt, D_MODEL)
            ctx = _layernorm(DN_ALPHA * ctx + g2c * m[:, :lc], ln2_g[l], ln2_b[l])
            m = m[:, lc:]
        else:
            b, n = h.shape[:2]
            m = _hier_moe(h.reshape(b * n, D_MODEL), *moe_p).reshape(b, n, D_MODEL)
        x = _layernorm(DN_ALPHA * x + g2 * m, ln2_g[l], ln2_b[l])
    return x
```

```cpp
#define MK_MULTI 0
#include <hip/hip_runtime.h>
#include <stdint.h>
#include <stdio.h>

#define LAS __attribute__((address_space(3)))
typedef unsigned short bf16_t;
typedef short bf16x8 __attribute__((ext_vector_type(8)));
typedef short s16x4 __attribute__((ext_vector_type(4)));
typedef float f32x2 __attribute__((ext_vector_type(2)));
typedef float f32x4 __attribute__((ext_vector_type(4)));
typedef float f32x16 __attribute__((ext_vector_type(16)));
typedef unsigned u32x2 __attribute__((ext_vector_type(2)));
typedef unsigned u32x4 __attribute__((ext_vector_type(4)));

constexpr int D = 1024, NBATCH = 8, LAT = 4096, LCTX = 256, TPB = 4352, NTOK = NBATCH * TPB, DEPTH = 4;
constexpr int NPANEL = NTOK / 256;
constexpr int UC = 6656;
constexpr int U_SSD_Z = 0, U_SSD_X = 512, U_SSD_B = 1024, U_SSD_C = 1280, U_RW_R = 1536, U_RW_K = 2048, U_RW_V = 2560, U_RW_WD = 3072, U_RW_AD = 3200,
              U_RW_GD = 3328, U_SSD_DT = 3456, U_GLA_GD = 3464, U_DF_Q = 3584, U_DF_K = 4096, U_DF_V = 4608, U_GLA_Q = 5120, U_GLA_K = 5376, U_GLA_V = 5632, U_GLA_OG = 6144;
constexpr int IN_COLS = 10664, GATE_COL0 = 6568;
constexpr int NEXP = 32, MOE_FF = 512, NSLOTBLK = 304, NSLOT = NSLOTBLK * 256;
constexpr float DN_ALPHA = 1.681792830507429f;
constexpr int NTHR = 512;
constexpr int LDS_BYTES = 159744;
constexpr int LDS_STAGE = 1024;
constexpr int LDS_TAB = LDS_STAGE + 131072;

enum { I_X = 0, I_C, I_CTX, I_CCTX, I_ADAW, I_ADAB, I_WIN, I_SSD_CW, I_SSD_CB, I_SSD_ALOG, I_SSD_DTB, I_SSD_D, I_SSD_NG, I_RW_MU, I_RW_W0, I_RW_WUP, I_RW_A0, I_RW_AUP,
       I_RW_GUP, I_RW_KK, I_RW_KA, I_RW_RK, I_RW_LNG, I_RW_LNB, I_DF_Q1, I_DF_K1, I_DF_Q2, I_DF_K2, I_DF_SG, I_GLA_GUP, I_GLA_GB, I_GLA_NG, I_WBR, I_WOUT, I_LN1G, I_LN1B,
       I_MOE_WG, I_MOE_BG, I_MOE_WE, I_MOE_BE, I_MOE_GATE, I_MOE_UP, I_MOE_DOWN, I_LN2G, I_LN2B, N_IN };

constexpr size_t al256(size_t x) { return (x + 255) & ~(size_t)255; }
constexpr size_t WS_CTL = 0;
constexpr size_t CTL_BYTES = 65536;
constexpr int CW_QUEUE = 4096, CW_CNT = 8192, CW_CUR = 12288;
constexpr size_t WS_MOD = WS_CTL + CTL_BYTES;
constexpr size_t WS_ROPE = al256(WS_MOD + (size_t)DEPTH * 9 * 6144 * 4);
constexpr size_t WS_XC = al256(WS_ROPE + (size_t)2 * 4096 * 32 * 4);
constexpr size_t WS_H = al256(WS_XC + (size_t)2048 * 1024 * 4);
constexpr size_t WS_U = al256(WS_H + (size_t)NTOK * 1024 * 2);
constexpr size_t U_BYTES = (size_t)NTOK * UC * 2;
constexpr size_t WS_GATES = WS_U;
constexpr size_t WS_M = al256(WS_GATES + (size_t)NTOK * 4096 * 2);
constexpr size_t WS_XB = WS_U;
constexpr size_t WS_HID = al256(WS_XB + (size_t)NSLOT * 1024 * 2);
constexpr size_t WS_YB = al256(WS_HID + (size_t)NSLOT * 512 * 2);
static_assert(WS_M + (size_t)NTOK * 1024 * 4 <= WS_U + U_BYTES, "M overlay");
static_assert(WS_YB + (size_t)NSLOT * 1024 * 2 <= WS_U + U_BYTES, "moe overlay");
constexpr size_t WS_Y = al256(WS_U + U_BYTES);
constexpr size_t WS_SSDY = al256(WS_Y + (size_t)NTOK * 2048 * 2);
constexpr size_t WS_RWY = al256(WS_SSDY + (size_t)2 * NTOK * 512 * 2);
constexpr size_t WS_RWG = al256(WS_RWY + (size_t)2 * NTOK * 512 * 2);
constexpr size_t WS_GLAO = al256(WS_RWG + (size_t)NTOK * 512 * 2);
constexpr size_t WS_RWBD = al256(WS_GLAO + (size_t)2 * NTOK * 512 * 2);
constexpr size_t WS_WIN = al256(WS_RWBD + (size_t)2 * NTOK * 8 * 4);
constexpr size_t WS_WG = al256(WS_WIN + (size_t)UC * 1024 * 2);
constexpr size_t WS_WB = al256(WS_WG + (size_t)4096 * 1024 * 2);
constexpr size_t WS_WO = al256(WS_WB + (size_t)4 * 1024 * 512 * 2);
constexpr size_t WS_GU = al256(WS_WO + (size_t)1024 * 1024 * 2);
constexpr size_t WS_DW = al256(WS_GU + (size_t)32 * 1024 * 1024 * 2);
constexpr size_t WS_EID = al256(WS_DW + (size_t)32 * 1024 * 512 * 2);
constexpr size_t WS_WTS = al256(WS_EID + (size_t)NTOK * 2 * 4);
constexpr size_t WS_SLOT = al256(WS_WTS + (size_t)NTOK * 2 * 4);
constexpr size_t WS_END = al256(WS_SLOT + (size_t)NTOK * 2 * 4);

struct Params { const float* in[N_IN]; float* out; char* ws; int ph_lo, ph_hi; };
typedef const __attribute__((address_space(4))) Params CParams;
#define PRM CParams&
__device__ __forceinline__ LAS unsigned char* olds(LAS unsigned char* q) { asm volatile("" : "+s"(q)); return q; }
__device__ __forceinline__ CParams* kparams() { CParams* q = (CParams*)__builtin_amdgcn_kernarg_segment_ptr(); asm volatile("" : "+s"(q)); return q; }
#ifndef PHASE_FN
#define PHASE_FN __device__ __forceinline__
#endif

__device__ __forceinline__ int olane() { unsigned z = 0u; asm volatile("" : "+v"(z)); return (int)__builtin_amdgcn_mbcnt_hi(~0u, __builtin_amdgcn_mbcnt_lo(~0u, z)); }
__device__ __forceinline__ int otid(int wv) { return (wv << 6) | olane(); }
#define TID (otid(wv))
#define LANE (olane())
#define WAVE (wv)
__device__ __forceinline__ int oblk() { int b = (int)blockIdx.x; asm volatile("" : "+s"(b)); return b; }
#define BLK (oblk())
__device__ __forceinline__ float bf2f(unsigned b) { return __uint_as_float(b << 16); }
typedef __bf16 bf16x2_t __attribute__((ext_vector_type(2)));
__device__ __forceinline__ unsigned cvt_pk_bf16(float lo, float hi) { const f32x2 v = {lo, hi}; return __builtin_bit_cast(unsigned, __builtin_convertvector(v, bf16x2_t)); }
__device__ __forceinline__ bf16_t f2bf(float f) { return (bf16_t)(cvt_pk_bf16(f, 0.f) & 0xffffu); }
__device__ __forceinline__ void unpack8(const u32x4 w, float (&f)[8]) {
    f[0] = __uint_as_float(w.x << 16); f[1] = __uint_as_float(w.x & 0xffff0000u); f[2] = __uint_as_float(w.y << 16); f[3] = __uint_as_float(w.y & 0xffff0000u);
    f[4] = __uint_as_float(w.z << 16); f[5] = __uint_as_float(w.z & 0xffff0000u); f[6] = __uint_as_float(w.w << 16); f[7] = __uint_as_float(w.w & 0xffff0000u); }
__device__ __forceinline__ u32x4 pack8(const float (&f)[8]) { u32x4 w; w.x = cvt_pk_bf16(f[0], f[1]); w.y = cvt_pk_bf16(f[2], f[3]); w.z = cvt_pk_bf16(f[4], f[5]); w.w = cvt_pk_bf16(f[6], f[7]); return w; }
template <int CTRL> __device__ __forceinline__ float dppf(float v) { return __int_as_float(__builtin_amdgcn_update_dpp(0, __float_as_int(v), CTRL, 0xf, 0xf, true)); }
__device__ __forceinline__ float sum4(float v)  { v += dppf<0xB1>(v); v += dppf<0x4E>(v); return v; }
__device__ __forceinline__ float sum8(float v)  { v = sum4(v); v += dppf<0x141>(v); return v; }
__device__ __forceinline__ float sum16(float v) { v = sum8(v); v += dppf<0x140>(v); return v; }
__device__ __forceinline__ float shflx(float v, int mask) { const int ln = olane(); return __int_as_float(__builtin_amdgcn_ds_bpermute(((ln ^ mask) & 63) << 2, __float_as_int(v))); }
__device__ __forceinline__ float sum32(float v) { v = sum16(v); v += shflx(v, 16); return v; }
__device__ __forceinline__ float sum64(float v) { v = sum16(v);
    return __int_as_float(__builtin_amdgcn_readlane(__float_as_int(v), 0)) + __int_as_float(__builtin_amdgcn_readlane(__float_as_int(v), 16))
         + __int_as_float(__builtin_amdgcn_readlane(__float_as_int(v), 32)) + __int_as_float(__builtin_amdgcn_readlane(__float_as_int(v), 48)); }
__device__ __forceinline__ float sigmoidf_(float x) { return 1.0f / (1.0f + __expf(-x)); }
__device__ __forceinline__ float siluf_(float x) { return x / (1.0f + __expf(-x)); }
__device__ __forceinline__ float softplusf_(float x) { return x > 20.f ? x : log1pf(__expf(x)); }

__device__ __forceinline__ float* xs_row(PRM p, int r) { const int b = r / TPB, t = r - b * TPB;
    return t < LCTX ? (float*)(p.ws + WS_XC) + ((size_t)b * LCTX + t) * D : p.out + ((size_t)b * LAT + (t - LCTX)) * D; }
__device__ __forceinline__ const float* xin_row(PRM p, int r) { const int b = r / TPB, t = r - b * TPB;
    return t < LCTX ? p.in[I_CTX] + ((size_t)b * LCTX + t) * D : p.in[I_X] + ((size_t)b * LAT + (t - LCTX)) * D; }
__device__ __forceinline__ int mod_row(int r) { const int b = r / TPB, t = r - b * TPB; return t < LCTX ? 8 : b; }
#define XB_TMO      128
#define XB_XCNT(j)  (256  + 64 * (j))
#define XB_XSUB(j)  (1280 + 64 * (j))
#define XB_XGEN(j)  (2304 + 64 * (j))
#define XB_TOP      3328
#define XB_TOPGEN   3392
#define XCD_BAR_WORDS 3456
#define XB_SPIN_CAP (1u << 18)

__device__ __forceinline__ unsigned xb_ld(unsigned* p)              { return __hip_atomic_load(p, __ATOMIC_RELAXED, __HIP_MEMORY_SCOPE_AGENT); }
__device__ __forceinline__ unsigned xb_add(unsigned* p, unsigned v) { return __hip_atomic_fetch_add(p, v, __ATOMIC_RELAXED, __HIP_MEMORY_SCOPE_AGENT); }
__device__ __forceinline__ unsigned xb_xcc_id() { return (unsigned)__builtin_amdgcn_s_getreg((3 << 11) | 20) & 0xFu; }
#define XB_SPIN(cond, bar) do { unsigned _sp = 0; while (cond) { __builtin_amdgcn_s_sleep(1); \
    if ((++_sp & 255u) == 0u) { if (xb_ld(&(bar)[XB_TMO])) break; if (_sp > XB_SPIN_CAP) { atomicAdd(&(bar)[XB_TMO], 1u); break; } } } } while (0)

struct XcdBarrier {
    unsigned* bar; unsigned x;
    volatile LAS unsigned* st;
};

__device__ __forceinline__ XcdBarrier xcd_barrier_post(unsigned* bar, volatile LAS unsigned* st) {
    XcdBarrier b; b.bar = bar; b.x = xb_xcc_id(); b.st = st;
    if (threadIdx.x == 0) (void)xb_add(&bar[XB_XCNT(b.x)], 1u);
    return b;
}
__device__ __forceinline__ void xcd_barrier_complete(unsigned* bar, unsigned x, unsigned& nloc, unsigned& nx) {
    const unsigned G = gridDim.x * gridDim.y * gridDim.z;
    unsigned sum, cnt, mine, sp = 0u;
    for (;;) {
        sum = 0u; cnt = 0u; mine = 0u;
#pragma unroll
        for (unsigned j = 0; j < 16; ++j) { const unsigned c = xb_ld(&bar[XB_XCNT(j)]); sum += c; cnt += (c > 0u) ? 1u : 0u; mine = (j == x) ? c : mine; }
        if (sum == G) break;
        __builtin_amdgcn_s_sleep(1);
        if ((++sp & 255u) == 0u) { if (xb_ld(&bar[XB_TMO])) break; if (sp > XB_SPIN_CAP) { atomicAdd(&bar[XB_TMO], 1u); break; } }
    }
    nloc = mine > 0u ? mine : 1u; nx = cnt > 0u ? cnt : 1u;
}

__device__ __forceinline__ void xcd_barrier(const XcdBarrier& b) {
    asm volatile("s_waitcnt vmcnt(0)" ::: "memory");
    __syncthreads();
    if (threadIdx.x == 0) {
        unsigned* bar = b.bar;
        __builtin_amdgcn_s_waitcnt(0);
        unsigned nloc = b.st[0], nx = b.st[1];
        if (nloc == 0u) { xcd_barrier_complete(bar, b.x, nloc, nx); b.st[0] = nloc; b.st[1] = nx; }
        const unsigned old = xb_add(&bar[XB_XSUB(b.x)], 1u);
        const unsigned gen = old / nloc;
        if (old + 1u == (gen + 1u) * nloc) {
            __builtin_amdgcn_fence(__ATOMIC_RELEASE, "agent");
            asm volatile("s_waitcnt vmcnt(0)" ::: "memory");
            const unsigned og = xb_add(&bar[XB_TOP], 1u);
            const unsigned tg = og / nx;
            if (og + 1u == (tg + 1u) * nx) xb_add(&bar[XB_TOPGEN], 1u);
            else XB_SPIN(xb_ld(&bar[XB_TOPGEN]) == tg, bar);
            __builtin_amdgcn_fence(__ATOMIC_ACQUIRE, "agent");
            xb_add(&bar[XB_XGEN(b.x)], 1u);
            asm volatile("s_waitcnt vmcnt(0)" ::: "memory");
        } else {
            XB_SPIN(xb_ld(&bar[XB_XGEN(b.x)]) == gen, bar);
            __builtin_amdgcn_fence(__ATOMIC_ACQUIRE, "agent");
            asm volatile("s_waitcnt vmcnt(0)" ::: "memory");
        }
    }
    __syncthreads();
}

namespace pg8 {
constexpr int BM = 256, BK = 64, HALF = 128, HTB = HALF * BK * 2, STAGE_BYTES = 8 * HTB, NXCD = 8, WGM = 8;
__host__ __device__ __forceinline__ int lds_byte(int r, int c) { const int st = (r >> 4) * 2 + (c >> 5), rr = r & 15, cc = c & 31, ob = rr * 64 + cc * 2; return st * 1024 + (ob ^ (((ob >> 9) & 1) << 5)); }
__host__ __device__ __forceinline__ void stage_rc(int b, int& R, int& C) { const int st = b / 1024, sb = b % 1024, swz = sb ^ (((sb >> 9) & 1) << 5); R = (st >> 1) * 16 + swz / 64; C = (st & 1) * 32 + (swz % 64) / 2; }
__host__ __device__ __forceinline__ int perm32(int rho) { const int n = rho >> 4, i = rho & 15; return 8 * (i >> 2) + 4 * n + (i & 3); }

struct Unit { int pm, pn, x; const char* a; const char* b; };
struct Gemm { int lda, ldb, K; };

__device__ __forceinline__ bool static_tile(int L, int nM, int nN, int& pm, int& pn) {
    const int nwg = nM * nN; if (L >= nwg) return false;
    int wgid = L; { const int q = nwg / NXCD, r = nwg % NXCD, xcd = wgid % NXCD, off = wgid / NXCD; wgid = (xcd < r ? xcd * (q + 1) : r * (q + 1) + (xcd - r) * q) + off; }
    const int nig = WGM * nN, gid = wgid / nig, fm = gid * WGM, gsz = (nM - fm) < WGM ? (nM - fm) : WGM;
    pm = fm + ((wgid % nig) % gsz); pn = (wgid % nig) / gsz; return true;
}

template <class Epi, class Sched>
__device__ __forceinline__ void gemm_phase(int wv, LAS unsigned char* lds, const Gemm g, const Sched& S, const Epi& E) {
    const int tid = otid(wv), wid = wv, lane = tid & 63, wr = wid >> 2, wc = wid & 3, fr = lane & 15, fq = lane >> 4;
    const int K = g.K, nt = K / BK;
    unsigned voffA[2], voffB[2];
#pragma unroll
    for (int i = 0; i < 2; ++i) { int R, C; stage_rc(tid * 16 + i * 8192, R, C); const int Rb = (R & ~31) + perm32(R & 31);
        voffA[i] = (unsigned)(R * g.lda + C) * 2u; voffB[i] = (unsigned)(Rb * g.ldb + C) * 2u; }
    const size_t kstep = (size_t)(BK * 2);
    const size_t hstepA = (size_t)HALF * g.lda * 2, hstepB = (size_t)HALF * g.ldb * 2;
    const unsigned ldsw = (unsigned)wid * 1024u;
    const int aoff = lds_byte(wr * 64 + fr, fq * 8), boff = lds_byte(wc * 32 + fr, fq * 8);
#define PG8_SA(b, h) (((b) * 2 + (h)) * HTB)
#define PG8_SB(b, h) ((4 + (b) * 2 + (h)) * HTB)
#define PG8_STAGE(bufoff, gbase, voff) do { _Pragma("unroll") for (int _i = 0; _i < 2; ++_i) \
        __builtin_amdgcn_global_load_lds((const unsigned*)((const char*)(gbase) + (voff)[_i]), (LAS unsigned*)(lds + (bufoff) + ldsw + _i * 8192), 16, 0, 0); } while (0)
#define PG8_LDA(dst, b, h) do { _Pragma("unroll") for (int m = 0; m < 4; ++m) _Pragma("unroll") for (int k = 0; k < 2; ++k) dst[m][k] = *(const LAS bf16x8*)(lds + PG8_SA(b, h) + aoff + m * 2048 + k * 1024); } while (0)
#define PG8_LDB(dst, b, h) do { _Pragma("unroll") for (int n = 0; n < 2; ++n) _Pragma("unroll") for (int k = 0; k < 2; ++k) dst[n][k] = *(const LAS bf16x8*)(lds + PG8_SB(b, h) + boff + n * 2048 + k * 1024); } while (0)
#define PG8_MMA(ai, bj, At, Bt) do { __builtin_amdgcn_s_setprio(1); _Pragma("unroll") for (int m = 0; m < 4; ++m) _Pragma("unroll") for (int n = 0; n < 2; ++n) _Pragma("unroll") for (int k = 0; k < 2; ++k) \
        acc[ai][bj][m][n] = __builtin_amdgcn_mfma_f32_16x16x32_bf16(Bt[n][k], At[m][k], acc[ai][bj][m][n], 0, 0, 0); __builtin_amdgcn_s_setprio(0); } while (0)
#define PG8_WAIT_V(n) asm volatile("s_waitcnt vmcnt(" #n ")" ::: "memory")
#define PG8_WAIT_L(n) asm volatile("s_waitcnt lgkmcnt(" #n ")" ::: "memory")
#define PG8_BAR __builtin_amdgcn_s_barrier()
#define PG8_SCHED __builtin_amdgcn_sched_barrier(0)
    Unit cur, nxt; int ui = 0;
    if (!S.next(0, cur)) return;
    f32x4 acc[2][2][4][2];
#pragma unroll
    for (int a = 0; a < 2; ++a)
#pragma unroll
        for (int b = 0; b < 2; ++b)
#pragma unroll
            for (int m = 0; m < 4; ++m)
#pragma unroll
                for (int n = 0; n < 2; ++n) acc[a][b][m][n] = (f32x4){0.f, 0.f, 0.f, 0.f};
    bf16x8 At[4][2], B0[2][2], B1[2][2];
    const char* cA = cur.a; const char* cB = cur.b;
    PG8_STAGE(PG8_SB(0, 0), cB, voffB); PG8_STAGE(PG8_SB(0, 1), cB + hstepB, voffB); PG8_STAGE(PG8_SA(0, 0), cA, voffA); PG8_STAGE(PG8_SA(0, 1), cA + hstepA, voffA);
    if (wr == 1) PG8_BAR;
    PG8_WAIT_V(2); PG8_BAR;
    PG8_STAGE(PG8_SB(1, 0), cB + kstep, voffB); PG8_STAGE(PG8_SA(1, 0), cA + kstep, voffA); PG8_STAGE(PG8_SB(1, 1), cB + hstepB + kstep, voffB);
    PG8_WAIT_V(6); PG8_BAR;
    for (;;) {
        const bool has_next = S.next(ui + 1, nxt);
        const char* nA = has_next ? nxt.a : cA; const char* nB = has_next ? nxt.b : cB;
        for (int t = 0; t < nt; t += 2) {
            const bool last = (t == nt - 2);
            const char* a1 = cA + (size_t)(t + 1) * kstep;
            const char* a2 = last ? nA : cA + (size_t)(t + 2) * kstep; const char* b2 = last ? nB : cB + (size_t)(t + 2) * kstep;
            const char* a3 = a2 + kstep; const char* b3 = b2 + kstep;
            PG8_LDB(B0, 0, 0); PG8_LDB(B1, 0, 1); PG8_SCHED; PG8_LDA(At, 0, 0); PG8_STAGE(PG8_SA(1, 1), a1 + hstepA, voffA);
            PG8_WAIT_V(8); PG8_WAIT_L(0); PG8_BAR; PG8_MMA(0, 0, At, B0); PG8_MMA(0, 1, At, B1); PG8_BAR; PG8_SCHED;
            PG8_LDA(At, 0, 1); PG8_STAGE(PG8_SB(0, 0), b2, voffB); PG8_STAGE(PG8_SB(0, 1), b2 + hstepB, voffB); PG8_STAGE(PG8_SA(0, 0), a2, voffA);
            PG8_WAIT_V(8); PG8_WAIT_L(0); PG8_BAR; PG8_MMA(1, 0, At, B0); PG8_MMA(1, 1, At, B1); PG8_BAR; PG8_SCHED;
            PG8_LDB(B0, 1, 0); PG8_LDB(B1, 1, 1); PG8_SCHED; PG8_LDA(At, 1, 0); PG8_STAGE(PG8_SA(0, 1), a2 + hstepA, voffA);
            PG8_WAIT_V(8); PG8_WAIT_L(0); PG8_BAR; PG8_MMA(0, 0, At, B0); PG8_MMA(0, 1, At, B1); PG8_BAR; PG8_SCHED;
            PG8_LDA(At, 1, 1); PG8_STAGE(PG8_SB(1, 0), b3, voffB); PG8_STAGE(PG8_SB(1, 1), b3 + hstepB, voffB); PG8_STAGE(PG8_SA(1, 0), a3, voffA);
            PG8_WAIT_V(8); PG8_WAIT_L(0); PG8_BAR; PG8_MMA(1, 0, At, B0); PG8_MMA(1, 1, At, B1); PG8_BAR; PG8_SCHED;
        }
        if (wr == 0) PG8_BAR;
        E(acc, cur, wr, wc, fr, fq);
        if (!has_next) break;
#pragma unroll
        for (int a = 0; a < 2; ++a)
#pragma unroll
            for (int b = 0; b < 2; ++b)
#pragma unroll
                for (int m = 0; m < 4; ++m)
#pragma unroll
                    for (int n = 0; n < 2; ++n) acc[a][b][m][n] = (f32x4){0.f, 0.f, 0.f, 0.f};
        cur = nxt; cA = nA; cB = nB; ++ui;
        if (wr == 1) PG8_BAR;
    }
    PG8_WAIT_V(0);
    PG8_BAR;
#undef PG8_SA
#undef PG8_SB
#undef PG8_STAGE
#undef PG8_LDA
#undef PG8_LDB
#undef PG8_MMA
#undef PG8_WAIT_V
#undef PG8_WAIT_L
#undef PG8_BAR
#undef PG8_SCHED
}
}
using pg8::Unit;
template <int ACT  > struct EpiStoreBf16 {
    bf16_t* O; int ldc;
    __device__ __forceinline__ void operator()(const f32x4 (&acc)[2][2][4][2], const Unit& u, int wr, int wc, int fr, int fq) const {
        const int row0 = u.pm * 256 + wr * 64 + fr, col0 = u.pn * 256 + wc * 32 + 8 * fq;
#pragma unroll
        for (int ai = 0; ai < 2; ++ai)
#pragma unroll
            for (int m = 0; m < 4; ++m) { bf16_t* rowp = O + (size_t)(row0 + ai * 128 + m * 16) * ldc + col0;
#pragma unroll
                for (int bj = 0; bj < 2; ++bj) { f32x4 v0 = acc[ai][bj][m][0], v1 = acc[ai][bj][m][1];
                    if (ACT == 1) {
#pragma unroll
                        for (int j = 0; j < 4; ++j) { v0[j] = __builtin_amdgcn_rcpf(1.0f + __expf(-v0[j])); v1[j] = __builtin_amdgcn_rcpf(1.0f + __expf(-v1[j])); } }
                    u32x4 w; w.x = cvt_pk_bf16(v0[0], v0[1]); w.y = cvt_pk_bf16(v0[2], v0[3]); w.z = cvt_pk_bf16(v1[0], v1[1]); w.w = cvt_pk_bf16(v1[2], v1[3]);
                    *(u32x4*)(rowp + bj * 128) = w; } }
    }
};
struct EpiMerge {
    const bf16_t* G; float* M; bf16_t* MB;
    __device__ __forceinline__ void operator()(const f32x4 (&acc)[2][2][4][2], const Unit& u, int wr, int wc, int fr, int fq) const {
        const int br = u.x; const int row0 = u.pm * 256 + wr * 64 + fr, col0 = u.pn * 256 + wc * 32 + 8 * fq;
#pragma unroll
        for (int ai = 0; ai < 2; ++ai)
#pragma unroll
            for (int m = 0; m < 4; ++m) { const size_t r = (size_t)(row0 + ai * 128 + m * 16);
#pragma unroll
                for (int bj = 0; bj < 2; ++bj) { const int c = col0 + bj * 128;
                    const u32x4 gw = *(const u32x4*)(G + r * 4096 + br * 1024 + c); float gs[8]; unpack8(gw, gs);
                    f32x4 v0 = acc[ai][bj][m][0], v1 = acc[ai][bj][m][1];
#pragma unroll
                    for (int j = 0; j < 4; ++j) { v0[j] *= gs[j]; v1[j] *= gs[4 + j]; }
                    float* mp = M + r * 1024 + c;
                    if (br > 0) { v0 += *(const f32x4*)mp; v1 += *(const f32x4*)(mp + 4); }
                    if (br < 3) { *(f32x4*)mp = v0; *(f32x4*)(mp + 4) = v1; }
                    else { u32x4 w; w.x = cvt_pk_bf16(v0[0], v0[1]); w.y = cvt_pk_bf16(v0[2], v0[3]); w.z = cvt_pk_bf16(v1[0], v1[1]); w.w = cvt_pk_bf16(v1[2], v1[3]);
                        *(u32x4*)(MB + r * 1024 + c) = w; } } }
    }
};
struct EpiResid {
    float* xc; float* out; const float* ctxin; const float* xin; int layer; const float* modl;
    __device__ __forceinline__ void operator()(const f32x4 (&acc)[2][2][4][2], const Unit& u, int wr, int wc, int fr, int fq) const {
        asm volatile("" : "+v"(fr), "+v"(fq));
        const int b = u.pm / 17, pr = u.pm - b * 17; const bool isctx = pr == 0; const int mb = isctx ? 8 : b;
        float* dst = isctx ? xc + (size_t)b * LCTX * D : out + ((size_t)b * LAT + (size_t)(pr - 1) * 256) * D;
        const float* src = layer == 0 ? (isctx ? ctxin + (size_t)b * LCTX * D : xin + ((size_t)b * LAT + (size_t)(pr - 1) * 256) * D) : dst;
        const int rr0 = wr * 64 + fr, col0 = u.pn * 256 + wc * 32 + 8 * fq;
        const float* g1 = modl + mb * 6144 + 2048 + col0;
        f32x4 gv[2][2];
#pragma unroll
        for (int bj = 0; bj < 2; ++bj) { gv[bj][0] = *(const f32x4*)(g1 + bj * 128); gv[bj][1] = *(const f32x4*)(g1 + bj * 128 + 4); }
#pragma unroll
        for (int ai = 0; ai < 2; ++ai)
#pragma unroll
            for (int m = 0; m < 4; ++m) { const size_t ro = (size_t)(rr0 + ai * 128 + m * 16) * D + col0;
#pragma unroll
                for (int bj = 0; bj < 2; ++bj) {
                    const f32x4 x0 = *(const f32x4*)(src + ro + bj * 128), x1 = *(const f32x4*)(src + ro + bj * 128 + 4);
                    *(f32x4*)(dst + ro + bj * 128) = x0 * DN_ALPHA + gv[bj][0] * acc[ai][bj][m][0];
                    *(f32x4*)(dst + ro + bj * 128 + 4) = x1 * DN_ALPHA + gv[bj][1] * acc[ai][bj][m][1]; }
                asm volatile("" ::: "memory"); }
    }
};
struct EpiSwiGLU {
    bf16_t* HID;
    __device__ __forceinline__ void operator()(const f32x4 (&acc)[2][2][4][2], const Unit& u, int wr, int wc, int fr, int fq) const {
        const int row0 = u.pm * 256 + wr * 64 + fr, col0 = u.pn * 128 + wc * 32 + 8 * fq;
#pragma unroll
        for (int ai = 0; ai < 2; ++ai)
#pragma unroll
            for (int m = 0; m < 4; ++m) { float h[8];
#pragma unroll
                for (int n = 0; n < 2; ++n)
#pragma unroll
                    for (int j = 0; j < 4; ++j) { const float g = acc[ai][0][m][n][j], up = acc[ai][1][m][n][j]; h[4 * n + j] = g * __builtin_amdgcn_rcpf(1.0f + __expf(-g)) * up; }
                *(u32x4*)(HID + (size_t)(row0 + ai * 128 + m * 16) * MOE_FF + col0) = pack8(h); }
    }
};
struct SchedDense {
    int nM, nN, G, c; const char* A; const char* B; size_t ta, tb;
    __device__ __forceinline__ bool next(int i, Unit& u) const { int pm, pn; if (!pg8::static_tile(i * G + c, nM, nN, pm, pn)) return false;
        u.pm = pm; u.pn = pn; u.x = 0; u.a = A + (size_t)pm * ta; u.b = B + (size_t)pn * tb; return true; }
};
struct SchedMerge {
    int G, c; const char* Y; const char* WB;
    __device__ __forceinline__ bool next(int i, Unit& u) const { int pm, pn; if (!pg8::static_tile((i >> 2) * G + c, NPANEL, 4, pm, pn)) return false; const int br = i & 3;
        u.pm = pm; u.pn = pn; u.x = br; u.a = Y + (size_t)pm * 256 * 2048 * 2 + (size_t)br * 512 * 2; u.b = WB + (size_t)br * 1024 * 512 * 2 + (size_t)pn * 256 * 512 * 2; return true; }
};
struct SchedMoe {
    int G, c; const LAS int* tab; const char* A; const char* B; size_t ta, be, bt;
    __device__ __forceinline__ bool next(int i, Unit& u) const { const int L = i * G + c; const int nblk = tab[0]; if (L >= nblk * 4) return false; const int blk = L >> 2, t = L & 3, e = tab[1 + blk];
        u.pm = blk; u.pn = t; u.x = e; u.a = A + (size_t)blk * ta; u.b = B + (size_t)e * be + (size_t)t * bt; return true; }
};

PHASE_FN void phase_mod(int wv, PRM p, LAS unsigned char* lds) {
    LAS float* s = (LAS float*)(lds + LDS_STAGE); LAS float* red = s + 9 * 1024;
    const int tid = TID;
    for (int i = tid; i < 9 * 1024; i += NTHR) { const int b = i >> 10, k = i & 1023; const float v = b < 8 ? p.in[I_C][b * 1024 + k] : p.in[I_CCTX][k]; s[i] = siluf_(v); }
    __syncthreads();
    float* MOD = (float*)(p.ws + WS_MOD);
    for (int task = BLK; task < DEPTH * 48; task += gridDim.x) {
        const int l = task / 48, j0 = (task % 48) * 128, cq = tid & 127, kq = tid >> 7;
        float acc[9];
#pragma unroll
        for (int b = 0; b < 9; ++b) acc[b] = 0.f;
        const float* w = p.in[I_ADAW] + ((size_t)l * 1024 + kq * 256) * 6144 + j0 + cq;
        for (int k = 0; k < 256; ++k) { const float wv = w[(size_t)k * 6144];
#pragma unroll
            for (int b = 0; b < 9; ++b) acc[b] += s[b * 1024 + kq * 256 + k] * wv; }
#pragma unroll
        for (int b = 0; b < 9; ++b) red[(kq * 9 + b) * 128 + cq] = acc[b];
        __syncthreads();
        for (int o = tid; o < 9 * 128; o += NTHR) { const int b = o >> 7, c2 = o & 127;
            const float v = red[(0 * 9 + b) * 128 + c2] + red[(1 * 9 + b) * 128 + c2] + red[(2 * 9 + b) * 128 + c2] + red[(3 * 9 + b) * 128 + c2] + p.in[I_ADAB][l * 6144 + j0 + c2];
            MOD[((size_t)l * 9 + b) * 6144 + j0 + c2] = v; }
        __syncthreads();
    }
}
PHASE_FN void phase_rope_table(int wv, PRM p) {
    float* COS = (float*)(p.ws + WS_ROPE); float* SIN = COS + 4096 * 32;
    for (int i = BLK * NTHR + TID; i < 4096 * 32; i += gridDim.x * NTHR) { const int n = i >> 5, a = (i >> 4) & 1, pp = i & 15;
        const float inv = powf(10000.0f, -(float)pp / 16.0f); const float ang = (float)(a == 0 ? (n >> 6) : (n & 63)) * inv;
        COS[i] = cosf(ang); SIN[i] = sinf(ang); }
}
PHASE_FN void phase_modulate0(int wv, PRM p) {
    const float* MOD = (const float*)(p.ws + WS_MOD); bf16_t* H = (bf16_t*)(p.ws + WS_H); const int lane = LANE;
    for (int r = BLK * 8 + WAVE; r < NTOK; r += gridDim.x * 8) {
        const float* x = xin_row(p, r); const float* md = MOD + (size_t)mod_row(r) * 6144;
#pragma unroll
        for (int j = 0; j < 4; ++j) { const int c = j * 256 + lane * 4; const f32x4 v = *(const f32x4*)(x + c), sh = *(const f32x4*)(md + c), sc = *(const f32x4*)(md + 1024 + c);
            const f32x4 h = v * (sc + 1.0f) + sh; u32x2 w; w.x = cvt_pk_bf16(h[0], h[1]); w.y = cvt_pk_bf16(h[2], h[3]); *(u32x2*)(H + (size_t)r * D + c) = w; }
    }
}
__device__ __forceinline__ int win_src_col(int j) {
    if (j < 1536) return j;
    if (j < 3456) return 1544 + (j - 1536);
    if (j < 3464) return 1536 + (j - 3456);
    if (j < 3496) return 6024 + (j - 3464);
    if (j < 3584) return -1;
    if (j < 5120) return 3464 + (j - 3584);
    if (j < 6144) return 5000 + (j - 5120);
    return 6056 + (j - 6144);
}
PHASE_FN void phase_convert(int wv, PRM p, int l, LAS unsigned char* lds) {
    LAS float* tile = (LAS float*)(lds + LDS_STAGE);
    const int tid = TID;
    constexpr int T0 = 104 * 16, T1 = T0 + 64 * 16, T2 = T1 + 4 * 16 * 8, T3 = T2 + 16 * 16, T4 = T3 + 32 * 16 * 16, T5 = T4 + 32 * 16 * 8;
    for (int task = BLK; task < T5; task += gridDim.x) {
        const float* src; int sld; bf16_t* dst; int dld; int n0, k0, kind = 0, cadd = 0;
        if (task < T0) { const int t = task; n0 = (t >> 4) * 64; k0 = (t & 15) * 64; src = p.in[I_WIN] + (size_t)l * 1024 * IN_COLS; sld = IN_COLS; dst = (bf16_t*)(p.ws + WS_WIN); dld = 1024; kind = 1; }
        else if (task < T1) { const int t = task - T0; n0 = (t >> 4) * 64; k0 = (t & 15) * 64; src = p.in[I_WIN] + (size_t)l * 1024 * IN_COLS; sld = IN_COLS; dst = (bf16_t*)(p.ws + WS_WG); dld = 1024; cadd = GATE_COL0; }
        else if (task < T2) { const int t = task - T1; const int br = t >> 7, tt = t & 127; n0 = (tt >> 3) * 64; k0 = (tt & 7) * 64; src = p.in[I_WBR] + ((size_t)l * 4 + br) * 512 * 1024; sld = 1024; dst = (bf16_t*)(p.ws + WS_WB) + (size_t)br * 1024 * 512; dld = 512; }
        else if (task < T3) { const int t = task - T2; n0 = (t >> 4) * 64; k0 = (t & 15) * 64; src = p.in[I_WOUT] + (size_t)l * 1024 * 1024; sld = 1024; dst = (bf16_t*)(p.ws + WS_WO); dld = 1024; }
        else if (task < T4) { const int t = task - T3; const int e = t >> 8, tt = t & 255; const int j0 = (tt >> 4) * 64; k0 = (tt & 15) * 64;
            const int q = j0 >> 8, rr = j0 & 255; src = (rr < 128 ? p.in[I_MOE_GATE] : p.in[I_MOE_UP]) + ((size_t)l * 32 + e) * 1024 * 512; sld = 512; cadd = 128 * q + (rr & 127) - j0; n0 = j0;
            dst = (bf16_t*)(p.ws + WS_GU) + (size_t)e * 1024 * 1024; dld = 1024; }
        else { const int t = task - T4; const int e = t >> 7, tt = t & 127; n0 = (tt >> 3) * 64; k0 = (tt & 7) * 64; src = p.in[I_MOE_DOWN] + ((size_t)l * 32 + e) * 512 * 1024; sld = 1024; dst = (bf16_t*)(p.ws + WS_DW) + (size_t)e * 1024 * 512; dld = 512; }
        { const int nx = tid & 63, ky = tid >> 6; const int j = n0 + nx; const int sc = kind == 1 ? win_src_col(j) : j + cadd;
#pragma unroll
            for (int i = 0; i < 8; ++i) { const int k = ky + 8 * i; tile[k * 65 + nx] = sc >= 0 ? src[(size_t)(k0 + k) * sld + sc] : 0.f; } }
        __syncthreads();
        { const int kx = tid & 31, ny = tid >> 5;
#pragma unroll
            for (int i = 0; i < 4; ++i) { const int j = ny + 16 * i; *(unsigned*)(dst + (size_t)(n0 + j) * dld + k0 + 2 * kx) = cvt_pk_bf16(tile[(2 * kx) * 65 + j], tile[(2 * kx + 1) * 65 + j]); } }
        __syncthreads();
    }
}
PHASE_FN void phase_ln1_router(int wv, PRM p, int l, LAS unsigned char* lds) {
    LAS float* Wl = (LAS float*)(lds + LDS_STAGE);
    LAS unsigned* hist = (LAS unsigned*)(lds + 64);
    const int tid = TID, lane = LANE;
    const float* wg = p.in[I_MOE_WG] + (size_t)l * 1024 * 4; const float* we = p.in[I_MOE_WE] + (size_t)l * 1024 * 32;
    for (int i = tid; i < 1024 * 36; i += NTHR) { const int k = i / 36, e = i - k * 36;
        const int j = k >> 8, ln = (k >> 2) & 63, q = k & 3; Wl[((j * 4 + q) * 64 + ln) * 36 + e] = e < 4 ? wg[k * 4 + e] : we[k * 32 + (e - 4)]; }
    if (tid < 32) hist[tid] = 0u;
    __syncthreads();
    const float* MOD = (const float*)(p.ws + WS_MOD) + (size_t)l * 9 * 6144; bf16_t* H = (bf16_t*)(p.ws + WS_H);
    const float* lg = p.in[I_LN1G] + l * 1024; const float* lb = p.in[I_LN1B] + l * 1024;
    const float* bg = p.in[I_MOE_BG] + l * 4; const float* be = p.in[I_MOE_BE] + l * 32;
    int* EID = (int*)(p.ws + WS_EID); float* WTS = (float*)(p.ws + WS_WTS);
    for (int g4 = BLK * 8 + WAVE; g4 < NTOK / 2; g4 += gridDim.x * 8) {
        float h[2][16];
#pragma unroll
        for (int r = 0; r < 2; ++r) { const int row = g4 * 2 + r; float* xr = xs_row(p, row); const float* md = MOD + (size_t)mod_row(row) * 6144;
            f32x4 v[4]; float s = 0.f;
#pragma unroll
            for (int j = 0; j < 4; ++j) { v[j] = *(const f32x4*)(xr + j * 256 + lane * 4); s += (v[j][0] + v[j][1]) + (v[j][2] + v[j][3]); }
            const float mean = sum64(s) * (1.0f / 1024.0f); float q = 0.f;
#pragma unroll
            for (int j = 0; j < 4; ++j) { const f32x4 d = v[j] - mean; q += (d[0] * d[0] + d[1] * d[1]) + (d[2] * d[2] + d[3] * d[3]); }
            const float rstd = rsqrtf(sum64(q) * (1.0f / 1024.0f) + 1e-5f);
#pragma unroll
            for (int j = 0; j < 4; ++j) { const int c = j * 256 + lane * 4; const f32x4 x = (v[j] - mean) * rstd * *(const f32x4*)(lg + c) + *(const f32x4*)(lb + c);
                *(f32x4*)(xr + c) = x; const f32x4 hh = x * (*(const f32x4*)(md + 4 * 1024 + c) + 1.0f) + *(const f32x4*)(md + 3 * 1024 + c);
                u32x2 w; w.x = cvt_pk_bf16(hh[0], hh[1]); w.y = cvt_pk_bf16(hh[2], hh[3]); *(u32x2*)(H + (size_t)row * D + c) = w;
                h[r][j * 4 + 0] = hh[0]; h[r][j * 4 + 1] = hh[1]; h[r][j * 4 + 2] = hh[2]; h[r][j * 4 + 3] = hh[3]; } }
        LAS float* LG = (LAS float*)(lds + LDS_STAGE + 147456) + WAVE * 144;
#pragma unroll 1
        for (int pass = 0; pass < 3; ++pass) {
            float acc[2][12];
#pragma unroll
            for (int r = 0; r < 2; ++r)
#pragma unroll
                for (int e = 0; e < 12; ++e) acc[r][e] = 0.f;
#pragma unroll
            for (int idx = 0; idx < 16; ++idx) { const LAS float* wr = Wl + (idx * 64 + lane) * 36 + pass * 12; float w[12];
#pragma unroll
                for (int e4 = 0; e4 < 3; ++e4) { const f32x4 t = *(const LAS f32x4*)(wr + 4 * e4); w[4 * e4] = t[0]; w[4 * e4 + 1] = t[1]; w[4 * e4 + 2] = t[2]; w[4 * e4 + 3] = t[3]; }
#pragma unroll
                for (int r = 0; r < 2; ++r)
#pragma unroll
                    for (int e = 0; e < 12; ++e) acc[r][e] += h[r][idx] * w[e]; }
#pragma unroll
            for (int r = 0; r < 2; ++r)
#pragma unroll
                for (int e = 0; e < 12; ++e) LG[r * 36 + pass * 12 + e] = sum64(acc[r][e]);
        }
        asm volatile("s_waitcnt lgkmcnt(0)" ::: "memory");
        if (lane < 2) { const int r = lane, row = g4 * 2 + r; const LAS float* lr = LG + r * 36;
            float gl[4];
#pragma unroll
            for (int g = 0; g < 4; ++g) gl[g] = lr[g] + bg[g];
            int gi = 0; float gm = gl[0];
#pragma unroll
            for (int g = 1; g < 4; ++g) if (gl[g] > gm) { gm = gl[g]; gi = g; }
            float gs = 0.f;
#pragma unroll
            for (int g = 0; g < 4; ++g) gs += __expf(gl[g] - gm);
            const float gp = 1.0f / gs;
            float el[8];
#pragma unroll
            for (int j = 0; j < 8; ++j) el[j] = lr[4 + gi * 8 + j] + be[gi * 8 + j];
            int i1 = 0; float m1 = el[0];
#pragma unroll
            for (int j = 1; j < 8; ++j) if (el[j] > m1) { m1 = el[j]; i1 = j; }
            int i2 = 0; float m2 = -3.0e38f;
#pragma unroll
            for (int j = 0; j < 8; ++j) if (j != i1 && el[j] > m2) { m2 = el[j]; i2 = j; }
            const float e2 = __expf(m2 - m1); const float w1 = gp / (1.0f + e2), w2 = gp * e2 / (1.0f + e2);
            const int ea = gi * 8 + i1, eb = gi * 8 + i2; EID[row * 2] = ea; EID[row * 2 + 1] = eb; WTS[row * 2] = w1; WTS[row * 2 + 1] = w2;
            __hip_atomic_fetch_add(&hist[ea], 1u, __ATOMIC_RELAXED, __HIP_MEMORY_SCOPE_WORKGROUP); __hip_atomic_fetch_add(&hist[eb], 1u, __ATOMIC_RELAXED, __HIP_MEMORY_SCOPE_WORKGROUP);
        }
        asm volatile("s_waitcnt lgkmcnt(0)" ::: "memory");
    }
    __syncthreads();
    if (tid < 32) { const unsigned c = hist[tid]; if (c) atomicAdd((unsigned*)(p.ws + WS_CTL) + CW_CNT + l * 64 + tid, c); }
    __syncthreads();
}
__device__ __forceinline__ void moe_tables(int wv, PRM p, int l, LAS int* tab, LAS int* beg) {
    if (TID == 0) { const unsigned* cnt = (const unsigned*)(p.ws + WS_CTL) + CW_CNT + l * 64; int nb = 0;
        for (int e = 0; e < NEXP; ++e) { const int c = (int)__hip_atomic_load(cnt + e, __ATOMIC_RELAXED, __HIP_MEMORY_SCOPE_AGENT); const int k = (c + 255) >> 8; beg[e] = nb; for (int j = 0; j < k; ++j) tab[1 + nb + j] = e; nb += k; }
        tab[0] = nb; }
    __syncthreads();
}
PHASE_FN void phase_moe_assign(int wv, PRM p, int l, LAS unsigned char* lds) {
    LAS int* tab = (LAS int*)(lds + LDS_TAB); LAS int* beg = tab + 320;
    moe_tables(wv, p, l, tab, beg);
    const int* EID = (const int*)(p.ws + WS_EID); int* SLOT = (int*)(p.ws + WS_SLOT); unsigned* cur = (unsigned*)(p.ws + WS_CTL) + CW_CUR + l * 64;
    const bf16_t* H = (const bf16_t*)(p.ws + WS_H); bf16_t* XB = (bf16_t*)(p.ws + WS_XB); const int lane = LANE;
    for (int a = BLK * 8 + WAVE; a < NTOK * 2; a += gridDim.x * 8) {
        const int e = EID[a]; int slot = 0;
        if (lane == 0) { const unsigned rank = atomicAdd(cur + e, 1u); slot = beg[e] * 256 + (int)rank; SLOT[a] = slot; }
        slot = __builtin_amdgcn_readfirstlane(slot);
        const u32x4* src = (const u32x4*)(H + (size_t)(a >> 1) * D); u32x4* dst = (u32x4*)(XB + (size_t)slot * D);
        dst[lane] = src[lane]; dst[lane + 64] = src[lane + 64];
    }
}
PHASE_FN void phase_ln2(int wv, PRM p, int l) {
    const float* MOD = (const float*)(p.ws + WS_MOD) + (size_t)l * 9 * 6144; const float* MODN = MOD + 9 * 6144; bf16_t* H = (bf16_t*)(p.ws + WS_H);
    const float* lg = p.in[I_LN2G] + l * 1024; const float* lb = p.in[I_LN2B] + l * 1024;
    const int* SLOT = (const int*)(p.ws + WS_SLOT); const float* WTS = (const float*)(p.ws + WS_WTS); const bf16_t* YB = (const bf16_t*)(p.ws + WS_YB); const int lane = LANE;
    for (int row = BLK * 8 + WAVE; row < NTOK; row += gridDim.x * 8) {
        float* xr = xs_row(p, row); const int mr = mod_row(row); const float* md = MOD + (size_t)mr * 6144;
        const int s0 = SLOT[row * 2], s1 = SLOT[row * 2 + 1]; const float w0 = WTS[row * 2], w1 = WTS[row * 2 + 1];
        f32x4 v[4]; float s = 0.f;
#pragma unroll
        for (int j = 0; j < 4; ++j) { const int c = j * 256 + lane * 4; const u32x2 a = *(const u32x2*)(YB + (size_t)s0 * D + c), b = *(const u32x2*)(YB + (size_t)s1 * D + c);
            f32x4 m; m[0] = w0 * bf2f(a.x & 0xffffu) + w1 * bf2f(b.x & 0xffffu); m[1] = w0 * bf2f(a.x >> 16) + w1 * bf2f(b.x >> 16);
            m[2] = w0 * bf2f(a.y & 0xffffu) + w1 * bf2f(b.y & 0xffffu); m[3] = w0 * bf2f(a.y >> 16) + w1 * bf2f(b.y >> 16);
            v[j] = *(const f32x4*)(xr + c) * DN_ALPHA + *(const f32x4*)(md + 5 * 1024 + c) * m; s += (v[j][0] + v[j][1]) + (v[j][2] + v[j][3]); }
        const float mean = sum64(s) * (1.0f / 1024.0f); float q = 0.f;
#pragma unroll
        for (int j = 0; j < 4; ++j) { const f32x4 d = v[j] - mean; q += (d[0] * d[0] + d[1] * d[1]) + (d[2] * d[2] + d[3] * d[3]); }
        const float rstd = rsqrtf(sum64(q) * (1.0f / 1024.0f) + 1e-5f);
#pragma unroll
        for (int j = 0; j < 4; ++j) { const int c = j * 256 + lane * 4; f32x4 x = (v[j] - mean) * rstd * *(const f32x4*)(lg + c) + *(const f32x4*)(lb + c);
#ifdef DBG_SANITIZE
            for (int i_ = 0; i_ < 4; ++i_) x[i_] = (x[i_] == x[i_] && fabsf(x[i_]) < 1e30f) ? x[i_] : 0.f;
#endif
            *(f32x4*)(xr + c) = x;
            if (l + 1 < DEPTH) { const float* mn = MODN + (size_t)mr * 6144; const f32x4 hh = x * (*(const f32x4*)(mn + 1024 + c) + 1.0f) + *(const f32x4*)(mn + c);
                u32x2 w; w.x = cvt_pk_bf16(hh[0], hh[1]); w.y = cvt_pk_bf16(hh[2], hh[3]); *(u32x2*)(H + (size_t)row * D + c) = w; } }
    }
}
constexpr float ATT_C2 = 0.125f * 1.4426950408889634f;
PHASE_FN void phase_prep(int wv, PRM p) {
    bf16_t* U = (bf16_t*)(p.ws + WS_U); const float* COS = (const float*)(p.ws + WS_ROPE); const float* SIN = COS + 4096 * 32; const int lane = LANE;
    for (int r = BLK * 8 + WAVE; r < NTOK; r += gridDim.x * 8) {
        const int t = r % TPB; const bool lat = t >= LCTX; const int n = t - LCTX;
        const int c0 = lane * 8, a = (c0 >> 5) & 1, jj = (c0 >> 4) & 1, pp0 = c0 & 15;
        float cs[8], sn[8];
#pragma unroll
        for (int i = 0; i < 8; ++i) { cs[i] = 1.f; sn[i] = 0.f; }
        if (lat) {
#pragma unroll
            for (int i = 0; i < 8; ++i) { cs[i] = COS[n * 32 + a * 16 + pp0 + i]; sn[i] = SIN[n * 32 + a * 16 + pp0 + i]; } }
#pragma unroll
        for (int which = 0; which < 2; ++which) {
            bf16_t* ptr = U + (size_t)r * UC + (which == 0 ? U_DF_Q : U_DF_K) + c0;
            float x[8]; unpack8(*(const u32x4*)ptr, x); float o[8];
#pragma unroll
            for (int i = 0; i < 8; ++i) { const float other = dppf<0x4E>(x[i]);
                o[i] = jj == 0 ? x[i] * cs[i] - other * sn[i] : x[i] * cs[i] + other * sn[i];
                if (which == 0) o[i] *= ATT_C2; }
            if (lat || which == 0) *(u32x4*)ptr = pack8(o);
        }
    }
}
PHASE_FN void phase_fin(int wv, PRM p, int l) {
    const bf16_t* U = (const bf16_t*)(p.ws + WS_U); bf16_t* Y = (bf16_t*)(p.ws + WS_Y); const int lane = LANE, c0 = lane * 8;
    const bf16_t* SSDY = (const bf16_t*)(p.ws + WS_SSDY); const bf16_t* RWY = (const bf16_t*)(p.ws + WS_RWY); const bf16_t* RWG = (const bf16_t*)(p.ws + WS_RWG);
    const bf16_t* GLAO = (const bf16_t*)(p.ws + WS_GLAO); const float* BD = (const float*)(p.ws + WS_RWBD);
    const float* ssd_ng = p.in[I_SSD_NG] + l * 512; const float* lnxg = p.in[I_RW_LNG] + l * 512; const float* lnxb = p.in[I_RW_LNB] + l * 512;
    const float* mu_v = p.in[I_RW_MU] + l * 1920 + 1024; const float* gla_ng = p.in[I_GLA_NG] + l * 128;
    for (int r = BLK * 8 + WAVE; r < NTOK; r += gridDim.x * 8) {
        const int t = r % TPB; const bool has_prev = (t != 0) && (t != LCTX), has_next = (t != LCTX - 1) && (t != TPB - 1);
        {
            float a[8], b[8], z[8]; unpack8(*(const u32x4*)(SSDY + (size_t)r * 512 + c0), a); unpack8(*(const u32x4*)(SSDY + ((size_t)NTOK + r) * 512 + c0), b); unpack8(*(const u32x4*)(U + (size_t)r * UC + U_SSD_Z + c0), z);
            float y[8], ss = 0.f;
#pragma unroll
            for (int i = 0; i < 8; ++i) { y[i] = (a[i] + b[i]) * siluf_(z[i]); ss += y[i] * y[i]; }
            const float rs = rsqrtf(sum32(ss) * (1.0f / 256.0f) + 1e-5f);
#pragma unroll
            for (int i = 0; i < 8; ++i) y[i] = y[i] * rs * ssd_ng[c0 + i];
            *(u32x4*)(Y + (size_t)r * 2048 + c0) = pack8(y); }
        {
            float a[8], b[8], g[8], vc[8], vp[8], vn[8]; unpack8(*(const u32x4*)(RWY + (size_t)r * 512 + c0), a); unpack8(*(const u32x4*)(RWY + ((size_t)NTOK + r) * 512 + c0), b);
            unpack8(*(const u32x4*)(RWG + (size_t)r * 512 + c0), g); unpack8(*(const u32x4*)(U + (size_t)r * UC + U_RW_V + c0), vc);
#pragma unroll
            for (int i = 0; i < 8; ++i) { vp[i] = 0.f; vn[i] = 0.f; }
            if (has_prev) unpack8(*(const u32x4*)(U + (size_t)(r - 1) * UC + U_RW_V + c0), vp);
            if (has_next) unpack8(*(const u32x4*)(U + (size_t)(r + 1) * UC + U_RW_V + c0), vn);
            const int head = lane >> 3; const float bd = BD[(size_t)r * 8 + head] + BD[((size_t)NTOK + r) * 8 + head];
            float y[8], s = 0.f;
#pragma unroll
            for (int i = 0; i < 8; ++i) { y[i] = a[i] + b[i]; s += y[i]; }
            const float mean = sum8(s) * (1.0f / 64.0f); float q = 0.f;
#pragma unroll
            for (int i = 0; i < 8; ++i) { y[i] -= mean; q += y[i] * y[i]; }
            const float rs = rsqrtf(sum8(q) * (1.0f / 64.0f) + 64e-5f);
#pragma unroll
            for (int i = 0; i < 8; ++i) { const float vm = vc[i] + mu_v[c0 + i] * (0.5f * (vp[i] + vn[i]) - vc[i]);
                y[i] = (y[i] * rs * lnxg[c0 + i] + lnxb[c0 + i] + bd * vm) * g[i]; }
            *(u32x4*)(Y + (size_t)r * 2048 + 512 + c0) = pack8(y); }
        {
            float a[8], b[8], og[8]; unpack8(*(const u32x4*)(GLAO + (size_t)r * 512 + c0), a); unpack8(*(const u32x4*)(GLAO + ((size_t)NTOK + r) * 512 + c0), b); unpack8(*(const u32x4*)(U + (size_t)r * UC + U_GLA_OG + c0), og);
            float y[8], ss = 0.f;
#pragma unroll
            for (int i = 0; i < 8; ++i) { y[i] = a[i] + b[i]; ss += y[i] * y[i]; }
            const float rs = rsqrtf(sum16(ss) * (1.0f / 128.0f) + 1e-5f);
#pragma unroll
            for (int i = 0; i < 8; ++i) y[i] = y[i] * rs * gla_ng[(c0 + i) & 127] * siluf_(og[i]);
            *(u32x4*)(Y + (size_t)r * 2048 + 1536 + c0) = pack8(y); }
    }
}
typedef short v4i16_t __attribute__((ext_vector_type(4)));
__device__ __forceinline__ s16x4 vtr(const LAS unsigned char* pp) { return __builtin_bit_cast(s16x4, __builtin_amdgcn_ds_read_tr16_b64_v4i16((LAS v4i16_t*)pp)); }
constexpr int AT_K0 = 0, AT_K1 = 9216, AT_V = 18432, AT_AL = 38912, AT_XO = 40960;
PHASE_FN void attn_unit(int wv, PRM p, LAS unsigned char* L, int qrow0, int krow0, int ntiles, int h, float lam, float outscale, const float* subg) {
    const int tid = TID, lane = tid & 63, wave = wv, m = wave >> 2, qs = wave & 3, r32 = lane & 31, hh = lane >> 5;
    const bf16_t* U = (const bf16_t*)(p.ws + WS_U); bf16_t* Y = (bf16_t*)(p.ws + WS_Y);
    const int kr = tid >> 3, kc = tid & 7;
    const bf16_t* gk = U + (size_t)(krow0 + kr) * UC + U_DF_K + h * 128 + kc * 8;
    const int vr0 = tid >> 4, vc = tid & 15;
    const bf16_t* gv = U + (size_t)(krow0 + vr0) * UC + U_DF_V + h * 128 + vc * 8;
    u32x4 rk0, rk1, rv0, rv1;
#define AT_LOAD(t) do { const size_t o_ = (size_t)(t) * 64 * UC; rk0 = *(const u32x4*)(gk + o_); rk1 = *(const u32x4*)(gk + o_ + 64); rv0 = *(const u32x4*)(gv + o_); rv1 = *(const u32x4*)(gv + o_ + (size_t)32 * UC); } while (0)
    AT_LOAD(0);
    bf16x8 qf[4];
    { const bf16_t* qp = U + (size_t)(qrow0 + qs * 32 + r32) * UC + U_DF_Q + h * 128 + m * 64 + hh * 8;
#pragma unroll
      for (int d0 = 0; d0 < 4; ++d0) qf[d0] = *(const bf16x8*)(qp + d0 * 16); }
    f32x16 o[4];
#pragma unroll
    for (int db = 0; db < 4; ++db) o[db] = (f32x16){0.f,0.f,0.f,0.f,0.f,0.f,0.f,0.f,0.f,0.f,0.f,0.f,0.f,0.f,0.f,0.f};
    float m_run = -INFINITY, l_run = 0.f;
    LAS float* AL = (LAS float*)(L + AT_AL) + wave * 32;
    const LAS unsigned char* Km = L + (m ? AT_K1 : AT_K0);
    const int i16 = lane & 15; const int vtr_off = (4 * hh + (i16 >> 2)) * 320 + (((lane >> 4) & 1) * 16 + (i16 & 3) * 4) * 2;
    for (int t = 0; t < ntiles; ++t) {
        __syncthreads();
        *(LAS u32x4*)(L + AT_K0 + (kr * 72 + kc * 8) * 2) = rk0; *(LAS u32x4*)(L + AT_K1 + (kr * 72 + kc * 8) * 2) = rk1;
        *(LAS u32x4*)(L + AT_V + vr0 * 320 + vc * 16) = rv0; *(LAS u32x4*)(L + AT_V + (vr0 + 32) * 320 + vc * 16) = rv1;
        __syncthreads();
        if (t + 1 < ntiles) AT_LOAD(t + 1);
        f32x16 p0 = (f32x16){0.f,0.f,0.f,0.f,0.f,0.f,0.f,0.f,0.f,0.f,0.f,0.f,0.f,0.f,0.f,0.f}, p1 = p0;
#pragma unroll
        for (int d0 = 0; d0 < 4; ++d0) {
            const bf16x8 k0 = *(const LAS bf16x8*)(Km + (r32 * 72 + d0 * 16 + hh * 8) * 2);
            const bf16x8 k1 = *(const LAS bf16x8*)(Km + ((r32 + 32) * 72 + d0 * 16 + hh * 8) * 2);
            p0 = __builtin_amdgcn_mfma_f32_32x32x16_bf16(k0, qf[d0], p0, 0, 0, 0);
            p1 = __builtin_amdgcn_mfma_f32_32x32x16_bf16(k1, qf[d0], p1, 0, 0, 0); }
        float mx = fmaxf(p0[0], p1[0]);
#pragma unroll
        for (int r = 1; r < 16; ++r) mx = fmaxf(mx, fmaxf(p0[r], p1[r]));
        mx = fmaxf(mx, shflx(mx, 32));
        const float m_new = fmaxf(m_run, mx); const float alpha = exp2f(m_run - m_new); m_run = m_new;
        float ps = 0.f;
#pragma unroll
        for (int r = 0; r < 16; ++r) { p0[r] = exp2f(p0[r] - m_new); p1[r] = exp2f(p1[r] - m_new); ps += p0[r] + p1[r]; }
        l_run = l_run * alpha + ps;
        if (__any(alpha != 1.0f)) {
            if (hh == 0) AL[r32] = alpha;
            asm volatile("s_waitcnt lgkmcnt(0)" ::: "memory");
#pragma unroll
            for (int g = 0; g < 4; ++g) { const f32x4 a4 = *(const LAS f32x4*)(AL + 8 * g + 4 * hh);
#pragma unroll
                for (int db = 0; db < 4; ++db) { o[db][4 * g] *= a4[0]; o[db][4 * g + 1] *= a4[1]; o[db][4 * g + 2] *= a4[2]; o[db][4 * g + 3] *= a4[3]; } }
            asm volatile("s_waitcnt lgkmcnt(0)" ::: "memory");
        }
        bf16x8 pa[4];
#pragma unroll
        for (int ks = 0; ks < 4; ++ks) { const int b0 = (ks & 1) * 8; u32x4 w;
            if (ks < 2) { w.x = cvt_pk_bf16(p0[b0], p0[b0 + 1]); w.y = cvt_pk_bf16(p0[b0 + 2], p0[b0 + 3]); w.z = cvt_pk_bf16(p0[b0 + 4], p0[b0 + 5]); w.w = cvt_pk_bf16(p0[b0 + 6], p0[b0 + 7]); }
            else { w.x = cvt_pk_bf16(p1[b0], p1[b0 + 1]); w.y = cvt_pk_bf16(p1[b0 + 2], p1[b0 + 3]); w.z = cvt_pk_bf16(p1[b0 + 4], p1[b0 + 5]); w.w = cvt_pk_bf16(p1[b0 + 6], p1[b0 + 7]); }
            pa[ks] = __builtin_bit_cast(bf16x8, w); }
#pragma unroll
        for (int db = 0; db < 4; ++db)
#pragma unroll
            for (int ks = 0; ks < 4; ++ks) { const LAS unsigned char* vb = L + AT_V + vtr_off + ks * 16 * 320 + db * 64;
                const s16x4 lo = vtr(vb), hi = vtr(vb + 8 * 320);
                const bf16x8 vf = (bf16x8){lo[0], lo[1], lo[2], lo[3], hi[0], hi[1], hi[2], hi[3]};
                o[db] = __builtin_amdgcn_mfma_f32_32x32x16_bf16(pa[ks], vf, o[db], 0, 0, 0); }
    }
#undef AT_LOAD
    const float ltot = l_run + shflx(l_run, 32);
    if (hh == 0) AL[r32] = (m ? lam : 1.0f) / ltot;
    asm volatile("s_waitcnt lgkmcnt(0)" ::: "memory");
    float sc[16];
#pragma unroll
    for (int g = 0; g < 4; ++g) { const f32x4 a4 = *(const LAS f32x4*)(AL + 8 * g + 4 * hh); sc[4 * g] = a4[0]; sc[4 * g + 1] = a4[1]; sc[4 * g + 2] = a4[2]; sc[4 * g + 3] = a4[3]; }
    LAS float* XO = (LAS float*)(L + AT_XO);
    if (m == 1) {
#pragma unroll
        for (int r = 0; r < 16; ++r) { const int q = qs * 32 + (r & 3) + 8 * (r >> 2) + 4 * hh;
#pragma unroll
            for (int db = 0; db < 4; ++db) XO[q * 128 + db * 32 + r32] = o[db][r] * sc[r]; } }
    __syncthreads();
    if (m == 0) {
#pragma unroll
        for (int r = 0; r < 16; ++r) { const int q = qs * 32 + (r & 3) + 8 * (r >> 2) + 4 * hh; float ss = 0.f;
#pragma unroll
            for (int db = 0; db < 4; ++db) { const float v = o[db][r] * sc[r] - XO[q * 128 + db * 32 + r32]; o[db][r] = v; ss += v * v; }
            const float rs = rsqrtf(sum32(ss) * (1.0f / 128.0f) + 1e-5f) * outscale;
            bf16_t* yp = Y + (size_t)(qrow0 + q) * 2048 + 1024 + h * 128 + r32;
#pragma unroll
            for (int db = 0; db < 4; ++db) yp[db * 32] = f2bf(o[db][r] * rs * subg[db * 32 + r32]); } }
}
struct ChunkPos { int rowbase, t_lo, seglen; };
__device__ __forceinline__ ChunkPos chunk_pos(int b, int d, int ci) { ChunkPos c; const bool isctx = ci < 8; const int cl = isctx ? ci : ci - 8; c.seglen = isctx ? LCTX : LAT;
    c.rowbase = b * TPB + (isctx ? 0 : LCTX); c.t_lo = d == 0 ? cl * 32 : c.seglen - 32 * (cl + 1); return c; }
constexpr int NCHUNK = TPB / 32;

PHASE_FN void rwkv_chain(int wv, PRM p, int l, LAS unsigned char* L, int d, int b, int h) {
    const int tid = TID, lane = tid & 63, wave = wv, r32 = lane & 31, hh = lane >> 5;
    LAS bf16_t* RAW = (LAS bf16_t*)(L + 0);
    LAS bf16_t* TW = (LAS bf16_t*)(L + 30464);
    LAS bf16_t* TA = (LAS bf16_t*)(L + 35072);
    LAS bf16_t* TG = (LAS bf16_t*)(L + 39680);
    LAS float* R_ = (LAS float*)(L + 49152); LAS float* KT = R_ + 2048; LAS float* V_ = KT + 2048; LAS float* W_ = V_ + 2048; LAS float* AA = W_ + 2048;
    LAS float* KK = AA + 2048; LAS float* KKA = KK + 2048; LAS float* KD = KKA + 2048; LAS float* YO = KD + 2048;
    LAS float* MU = YO + 2048;
    LAS float* CW0 = MU + 448; LAS float* CA0 = CW0 + 64; LAS float* CKK = CA0 + 64; LAS float* CKA = CKK + 64; LAS float* CRK = CKA + 64;
    const bf16_t* U = (const bf16_t*)(p.ws + WS_U);
    bf16_t* RWY = (bf16_t*)(p.ws + WS_RWY) + (size_t)d * NTOK * 512; bf16_t* RWG = (bf16_t*)(p.ws + WS_RWG); float* BD = (float*)(p.ws + WS_RWBD) + (size_t)d * NTOK * 8;
    __syncthreads();
    if (tid < 448) { const int cc = tid; int gc;
        if (cc < 192) gc = (cc >> 6) * 512 + h * 64 + (cc & 63); else if (cc < 256) gc = 1536 + d * 64 + (cc - 192); else if (cc < 320) gc = 1664 + d * 64 + (cc - 256); else gc = 1792 + (cc - 320);
        MU[cc] = p.in[I_RW_MU][l * 1920 + gc]; }
    if (tid < 64) { const int c = h * 64 + tid; CW0[tid] = p.in[I_RW_W0][(l * 2 + d) * 512 + c]; CA0[tid] = p.in[I_RW_A0][(l * 2 + d) * 512 + c];
        CKK[tid] = p.in[I_RW_KK][l * 512 + c]; CKA[tid] = p.in[I_RW_KA][l * 512 + c]; CRK[tid] = p.in[I_RW_RK][l * 512 + c]; }
    bf16x8 Bf[8];
    if (wave < 4) {
#pragma unroll
        for (int f = 0; f < 8; ++f) { float v[8];
#pragma unroll
            for (int j = 0; j < 8; ++j) { float x;
                if (wave < 2) { const int cb = f >> 2, ks = f & 3, k = ks * 16 + hh * 8 + j; const float* w = wave == 0 ? p.in[I_RW_WUP] : p.in[I_RW_AUP]; x = w[((size_t)(l * 2 + d) * 64 + k) * 512 + h * 64 + cb * 32 + r32]; }
                else { const int cb = wave - 2, k = f * 16 + hh * 8 + j; x = p.in[I_RW_GUP][((size_t)l * 128 + k) * 512 + h * 64 + cb * 32 + r32]; }
                v[j] = x; }
            Bf[f] = __builtin_bit_cast(bf16x8, pack8(v)); } }
    const int vl = lane >> 4, kq = lane & 15; float S[2][4];
#pragma unroll
    for (int i = 0; i < 2; ++i)
#pragma unroll
        for (int j = 0; j < 4; ++j) S[i][j] = 0.f;
    for (int ci = 0; ci < NCHUNK; ++ci) {
        const ChunkPos cp = chunk_pos(b, d, ci);
        __syncthreads();
        for (int idx = tid; idx < 34 * 56; idx += NTHR) { const int row = idx / 56, ch = idx - row * 56; const int t = cp.t_lo - 1 + row;
            int gcol; if (ch < 24) gcol = U_RW_R + (ch >> 3) * 512 + h * 64 + (ch & 7) * 8; else if (ch < 32) gcol = U_RW_WD + d * 64 + (ch - 24) * 8; else if (ch < 40) gcol = U_RW_AD + d * 64 + (ch - 32) * 8; else gcol = U_RW_GD + (ch - 40) * 8;
            u32x4 v = (u32x4){0u, 0u, 0u, 0u}; if (t >= 0 && t < cp.seglen) v = *(const u32x4*)(U + (size_t)(cp.rowbase + t) * UC + gcol);
            *(LAS u32x4*)(RAW + row * 448 + ch * 8) = v; }
        __syncthreads();
        if (tid < 448) { const int cc = tid; const float mu = MU[cc];
            for (int s = 0; s < 32; ++s) { const float c0 = bf2f(RAW[(s + 1) * 448 + cc]), pv = bf2f(RAW[s * 448 + cc]), nx = bf2f(RAW[(s + 2) * 448 + cc]);
                const float mx = c0 + mu * (0.5f * (pv + nx) - c0);
                if (cc < 64) R_[s * 64 + cc] = mx; else if (cc < 128) KT[s * 64 + cc - 64] = mx; else if (cc < 192) V_[s * 64 + cc - 128] = mx;
                else if (cc < 256) TW[s * 72 + cc - 192] = f2bf(tanhf(mx)); else if (cc < 320) TA[s * 72 + cc - 256] = f2bf(mx); else TG[s * 136 + cc - 320] = f2bf(sigmoidf_(mx)); } }
        __syncthreads();
        if (wave < 2) {
#pragma unroll
            for (int cb = 0; cb < 2; ++cb) { f32x16 acc = (f32x16){0.f,0.f,0.f,0.f,0.f,0.f,0.f,0.f,0.f,0.f,0.f,0.f,0.f,0.f,0.f,0.f};
#pragma unroll
                for (int ks = 0; ks < 4; ++ks) { const bf16x8 a = *(const LAS bf16x8*)((wave == 0 ? TW : TA) + r32 * 72 + ks * 16 + hh * 8); acc = __builtin_amdgcn_mfma_f32_32x32x16_bf16(a, Bf[cb * 4 + ks], acc, 0, 0, 0); }
                const int c = cb * 32 + r32;
#pragma unroll
                for (int r = 0; r < 16; ++r) { const int s = (r & 3) + 8 * (r >> 2) + 4 * hh;
                    if (wave == 0) { const float wl = -softplusf_(-(CW0[c] + acc[r])) - 0.5f; W_[s * 64 + c] = __expf(-__expf(wl)); }
                    else AA[s * 64 + c] = sigmoidf_(CA0[c] + acc[r]); } } }
        else if (wave < 4 && d == 0) { const int cb = wave - 2; f32x16 acc = (f32x16){0.f,0.f,0.f,0.f,0.f,0.f,0.f,0.f,0.f,0.f,0.f,0.f,0.f,0.f,0.f,0.f};
#pragma unroll
            for (int ks = 0; ks < 8; ++ks) { const bf16x8 a = *(const LAS bf16x8*)(TG + r32 * 136 + ks * 16 + hh * 8); acc = __builtin_amdgcn_mfma_f32_32x32x16_bf16(a, Bf[ks], acc, 0, 0, 0); }
#pragma unroll
            for (int r = 0; r < 16; ++r) { const int s = (r & 3) + 8 * (r >> 2) + 4 * hh; RWG[(size_t)(cp.rowbase + cp.t_lo + s) * 512 + h * 64 + cb * 32 + r32] = f2bf(acc[r]); } }
        __syncthreads();
        { const int s = tid >> 4, c4 = (tid & 15) * 4; float kkv[4], ssq = 0.f, bdp = 0.f, av[4], kt[4];
#pragma unroll
            for (int j = 0; j < 4; ++j) { const int c = c4 + j; kt[j] = KT[s * 64 + c]; av[j] = AA[s * 64 + c]; kkv[j] = kt[j] * CKK[c]; ssq += kkv[j] * kkv[j]; }
            const float inv = rsqrtf(sum16(ssq) + 1e-12f);
#pragma unroll
            for (int j = 0; j < 4; ++j) { const int c = c4 + j; const float kn = kkv[j] * inv; KK[s * 64 + c] = -kn; KKA[s * 64 + c] = kn * av[j];
                const float kd = kt[j] * (1.0f + (av[j] - 1.0f) * CKA[c]); KD[s * 64 + c] = kd; bdp += R_[s * 64 + c] * kd * CRK[c]; }
            bdp = sum16(bdp); if ((tid & 15) == 0) BD[(size_t)(cp.rowbase + cp.t_lo + s) * 8 + h] = bdp; }
        __syncthreads();
        for (int st = 0; st < 32; ++st) { const int sm = d ? 31 - st : st;
            const f32x4 w4 = *(const LAS f32x4*)(W_ + sm * 64 + 4 * kq), k4 = *(const LAS f32x4*)(KK + sm * 64 + 4 * kq), ka4 = *(const LAS f32x4*)(KKA + sm * 64 + 4 * kq),
                        kd4 = *(const LAS f32x4*)(KD + sm * 64 + 4 * kq), r4 = *(const LAS f32x4*)(R_ + sm * 64 + 4 * kq);
            const f32x2 v2 = *(const LAS f32x2*)(V_ + sm * 64 + 8 * wave + 2 * vl);
            float y[2];
#pragma unroll
            for (int i = 0; i < 2; ++i) { float sa = (S[i][0] * k4[0] + S[i][1] * k4[1]) + (S[i][2] * k4[2] + S[i][3] * k4[3]); sa = sum16(sa);
#pragma unroll
                for (int j = 0; j < 4; ++j) S[i][j] = S[i][j] * w4[j] + sa * ka4[j] + v2[i] * kd4[j];
                y[i] = sum16((S[i][0] * r4[0] + S[i][1] * r4[1]) + (S[i][2] * r4[2] + S[i][3] * r4[3])); }
            if (kq == 0) *(LAS f32x2*)(YO + sm * 64 + 8 * wave + 2 * vl) = (f32x2){y[0], y[1]}; }
        __syncthreads();
        { const int s = tid >> 4, v4 = (tid & 15) * 4; const f32x4 y = *(const LAS f32x4*)(YO + s * 64 + v4); u32x2 w; w.x = cvt_pk_bf16(y[0], y[1]); w.y = cvt_pk_bf16(y[2], y[3]);
            *(u32x2*)(RWY + (size_t)(cp.rowbase + cp.t_lo + s) * 512 + h * 64 + v4) = w; }
    }
}

PHASE_FN void ssd_chain(int wv, PRM p, int l, LAS unsigned char* L, int d, int b, int h) {
    const int tid = TID, lane = tid & 63, wave = wv, g = h >> 2;
    LAS bf16_t* RAW = (LAS bf16_t*)(L + 0);
    LAS float* DTR = (LAS float*)(L + 21760);
    LAS float* XS = (LAS float*)(L + 22016); LAS float* XDT = XS + 2048; LAS float* BC = XDT + 2048; LAS float* CC = BC + 4096; LAS float* DA = CC + 4096;
    LAS float* YP = DA + 64;
    LAS float* CWt = YP + 16384;
    LAS float* CBs = CWt + 960;
    const bf16_t* U = (const bf16_t*)(p.ws + WS_U); bf16_t* SSDY = (bf16_t*)(p.ws + WS_SSDY) + (size_t)d * NTOK * 512;
    __syncthreads();
    if (tid < 320) { const int cc = tid; const int ch = cc < 64 ? h * 64 + cc : (cc < 192 ? 512 + g * 128 + (cc - 64) : 768 + g * 128 + (cc - 192));
#pragma unroll
        for (int j = 0; j < 3; ++j) CWt[j * 320 + cc] = p.in[I_SSD_CW][((size_t)l * 3 + j) * 1024 + ch];
        CBs[cc] = p.in[I_SSD_CB][l * 1024 + ch]; }
    const float Aneg = -__expf(p.in[I_SSD_ALOG][(l * 2 + d) * 8 + h]), dtb = p.in[I_SSD_DTB][(l * 2 + d) * 8 + h], Dh = p.in[I_SSD_D][l * 8 + h];
    float hs[16];
#pragma unroll
    for (int j = 0; j < 16; ++j) hs[j] = 0.f;
    for (int ci = 0; ci < NCHUNK; ++ci) {
        const ChunkPos cp = chunk_pos(b, d, ci);
        __syncthreads();
        for (int idx = tid; idx < 34 * 40; idx += NTHR) { const int row = idx / 40, ch = idx - row * 40; const int t = cp.t_lo - 1 + row;
            const int gcol = ch < 8 ? U_SSD_X + h * 64 + ch * 8 : (ch < 24 ? U_SSD_B + g * 128 + (ch - 8) * 8 : U_SSD_C + g * 128 + (ch - 24) * 8);
            u32x4 v = (u32x4){0u, 0u, 0u, 0u}; if (t >= 0 && t < cp.seglen) v = *(const u32x4*)(U + (size_t)(cp.rowbase + t) * UC + gcol);
            *(LAS u32x4*)(RAW + row * 320 + ch * 8) = v; }
        if (tid < 32) { const float dtr = bf2f(U[(size_t)(cp.rowbase + cp.t_lo + tid) * UC + U_SSD_DT + h]); const float dtc = softplusf_(dtr + dtb); DTR[tid] = dtc; DA[tid] = __expf(dtc * Aneg); }
        __syncthreads();
        for (int idx = tid; idx < 32 * 320; idx += NTHR) { const int s = idx / 320, cc = idx - s * 320;
            const float a = CBs[cc] + CWt[cc] * bf2f(RAW[s * 320 + cc]) + CWt[320 + cc] * bf2f(RAW[(s + 1) * 320 + cc]) + CWt[640 + cc] * bf2f(RAW[(s + 2) * 320 + cc]);
            const float v = siluf_(a);
            if (cc < 64) { XS[s * 64 + cc] = v; XDT[s * 64 + cc] = v * DTR[s]; } else if (cc < 192) BC[s * 128 + cc - 64] = v; else CC[s * 128 + cc - 192] = v; }
        __syncthreads();
        for (int st = 0; st < 32; ++st) { const int sm = d ? 31 - st : st;
            const float xdt = XDT[sm * 64 + lane], da = DA[sm]; float yp = 0.f;
#pragma unroll
            for (int q = 0; q < 4; ++q) { const f32x4 b4 = *(const LAS f32x4*)(BC + sm * 128 + 16 * wave + 4 * q), c4 = *(const LAS f32x4*)(CC + sm * 128 + 16 * wave + 4 * q);
#pragma unroll
                for (int j = 0; j < 4; ++j) { hs[4 * q + j] = hs[4 * q + j] * da + xdt * b4[j]; yp += hs[4 * q + j] * c4[j]; } }
            YP[(wave * 32 + sm) * 64 + lane] = yp; }
        __syncthreads();
        { const int s = tid >> 4, p4 = (tid & 15) * 4; f32x4 y = (f32x4){0.f, 0.f, 0.f, 0.f};
#pragma unroll
            for (int w = 0; w < 8; ++w) y += *(const LAS f32x4*)(YP + (w * 32 + s) * 64 + p4);
            if (d == 0) y += *(const LAS f32x4*)(XS + s * 64 + p4) * Dh;
            u32x2 w2; w2.x = cvt_pk_bf16(y[0], y[1]); w2.y = cvt_pk_bf16(y[2], y[3]);
            *(u32x2*)(SSDY + (size_t)(cp.rowbase + cp.t_lo + s) * 512 + h * 64 + p4) = w2; }
    }
}

PHASE_FN void gla_chain(int wv, PRM p, int l, LAS unsigned char* L, int d, int b, int h) {
    const int tid = TID, lane = tid & 63, wave = wv, eh = wave & 1, kr = wave >> 1;
    LAS bf16_t* RAW = (LAS bf16_t*)(L + 0);
    LAS float* QF = (LAS float*)(L + 17408); LAS float* KF = QF + 2048; LAS float* GF = KF + 2048; LAS float* VF = GF + 2048;
    LAS float* OP = VF + 4096;
    LAS float* GUP = OP + 16384;
    LAS float* GB = GUP + 1024;
    const bf16_t* U = (const bf16_t*)(p.ws + WS_U); bf16_t* GLAO = (bf16_t*)(p.ws + WS_GLAO) + (size_t)d * NTOK * 512;
    __syncthreads();
    for (int i = tid; i < 1024; i += NTHR) GUP[i] = p.in[I_GLA_GUP][((size_t)(l * 2 + d) * 16 + (i >> 6)) * 256 + h * 64 + (i & 63)];
    if (tid < 64) GB[tid] = p.in[I_GLA_GB][(l * 2 + d) * 256 + h * 64 + tid];
    float S[16];
#pragma unroll
    for (int j = 0; j < 16; ++j) S[j] = 0.f;
    for (int ci = 0; ci < NCHUNK; ++ci) {
        const ChunkPos cp = chunk_pos(b, d, ci);
        __syncthreads();
        for (int idx = tid; idx < 32 * 34; idx += NTHR) { const int row = idx / 34, ch = idx - row * 34;
            const int gcol = ch < 8 ? U_GLA_Q + h * 64 + ch * 8 : (ch < 16 ? U_GLA_K + h * 64 + (ch - 8) * 8 : (ch < 32 ? U_GLA_V + h * 128 + (ch - 16) * 8 : U_GLA_GD + d * 16 + (ch - 32) * 8));
            *(LAS u32x4*)(RAW + row * 272 + ch * 8) = *(const u32x4*)(U + (size_t)(cp.rowbase + cp.t_lo + row) * UC + gcol); }
        __syncthreads();
        for (int idx = tid; idx < 32 * 64; idx += NTHR) { const int s = idx >> 6, k = idx & 63;
            QF[idx] = bf2f(RAW[s * 272 + k]) * 0.125f; KF[idx] = bf2f(RAW[s * 272 + 64 + k]);
            float gt = GB[k];
#pragma unroll
            for (int r = 0; r < 16; ++r) gt += bf2f(RAW[s * 272 + 256 + r]) * GUP[r * 64 + k];
            GF[idx] = __expf(-softplusf_(-gt) * (1.0f / 16.0f)); }
        for (int idx = tid; idx < 32 * 128; idx += NTHR) { const int s = idx >> 7, e = idx & 127; VF[idx] = bf2f(RAW[s * 272 + 128 + e]); }
        __syncthreads();
        for (int st = 0; st < 32; ++st) { const int sm = d ? 31 - st : st;
            const float v = VF[sm * 128 + 64 * eh + lane]; float op = 0.f;
#pragma unroll
            for (int q = 0; q < 4; ++q) { const f32x4 g4 = *(const LAS f32x4*)(GF + sm * 64 + 16 * kr + 4 * q), k4 = *(const LAS f32x4*)(KF + sm * 64 + 16 * kr + 4 * q), q4 = *(const LAS f32x4*)(QF + sm * 64 + 16 * kr + 4 * q);
#pragma unroll
                for (int j = 0; j < 4; ++j) { S[4 * q + j] = S[4 * q + j] * g4[j] + k4[j] * v; op += S[4 * q + j] * q4[j]; } }
            OP[(kr * 32 + sm) * 128 + 64 * eh + lane] = op; }
        __syncthreads();
        { const int s = tid >> 4, e8 = (tid & 15) * 8; float o[8];
#pragma unroll
            for (int i = 0; i < 8; ++i) o[i] = OP[(0 * 32 + s) * 128 + e8 + i] + OP[(1 * 32 + s) * 128 + e8 + i] + OP[(2 * 32 + s) * 128 + e8 + i] + OP[(3 * 32 + s) * 128 + e8 + i];
            *(u32x4*)(GLAO + (size_t)(cp.rowbase + cp.t_lo + s) * 512 + h * 128 + e8) = pack8(o); }
    }
}
PHASE_FN void phase_mix(int wv, PRM p, int l, LAS unsigned char* lds) {
    LAS int* slot = (LAS int*)(lds + 32);
    unsigned* q = (unsigned*)(p.ws + WS_CTL) + CW_QUEUE + l * 64;
    const float lam_init = 0.8f - 0.6f * expf(-0.3f * (float)l);
    float s1 = 0.f, s2 = 0.f;
    for (int i = 0; i < 64; ++i) { s1 += p.in[I_DF_Q1][l * 64 + i] * p.in[I_DF_K1][l * 64 + i]; s2 += p.in[I_DF_Q2][l * 64 + i] * p.in[I_DF_K2][l * 64 + i]; }
    const float lam = expf(s1) - expf(s2) + lam_init;
    const int n_ctx_att = (l < DEPTH - 1) ? 64 : 0, nitems = 320 + 1024 + n_ctx_att;
    for (;;) {
        if (TID == 0) *slot = (int)atomicAdd(q, 1u);
        __syncthreads();
        const int item = *slot;
        __syncthreads();
        if (item >= nitems) break;
        CParams& pp = *kparams(); LAS unsigned char* L = olds(lds) + LDS_STAGE;
        if (item < 128) rwkv_chain(wv, pp, l, L, item & 1, (item >> 1) & 7, item >> 4);
        else if (item < 256) { const int i = item - 128; ssd_chain(wv, pp, l, L, i & 1, (i >> 1) & 7, i >> 4); }
        else if (item < 320) { const int i = item - 256; gla_chain(wv, pp, l, L, i & 1, (i >> 1) & 7, i >> 4); }
        else if (item < 320 + 1024) { const int i = item - 320; const int b = i >> 7, h = (i >> 5) & 3, qb = i & 31; attn_unit(wv, pp, L, b * TPB + LCTX + qb * 128, b * TPB, TPB / 64, h, lam, 1.0f - lam_init, pp.in[I_DF_SG] + l * 128); }
        else { const int i = item - 1344; const int b = i >> 3, h = (i >> 1) & 3, qb = i & 1; attn_unit(wv, pp, L, b * TPB + qb * 128, b * TPB, LCTX / 64, h, lam, 1.0f - lam_init, pp.in[I_DF_SG] + l * 128); }
    }
}

PHASE_FN void phase_g1(int wv, PRM p, LAS unsigned char* lds) {
    const char* ws = p.ws; SchedDense S{NPANEL, UC / 256, (int)gridDim.x, BLK, ws + WS_H, ws + WS_WIN, (size_t)256 * 1024 * 2, (size_t)256 * 1024 * 2};
    EpiStoreBf16<0> E{(bf16_t*)(p.ws + WS_U), UC};
    pg8::gemm_phase(wv, lds + LDS_STAGE, pg8::Gemm{1024, 1024, 1024}, S, E); }
PHASE_FN void phase_g2(int wv, PRM p, LAS unsigned char* lds) {
    const char* ws = p.ws; SchedDense S{NPANEL, 16, (int)gridDim.x, BLK, ws + WS_H, ws + WS_WG, (size_t)256 * 1024 * 2, (size_t)256 * 1024 * 2};
    EpiStoreBf16<1> E{(bf16_t*)(p.ws + WS_GATES), 4096};
    pg8::gemm_phase(wv, lds + LDS_STAGE, pg8::Gemm{1024, 1024, 1024}, S, E); }
PHASE_FN void phase_g3(int wv, PRM p, LAS unsigned char* lds) {
    const char* ws = p.ws; SchedMerge S{(int)gridDim.x, BLK, ws + WS_Y, ws + WS_WB};
    EpiMerge E{(const bf16_t*)(ws + WS_GATES), (float*)(p.ws + WS_M), (bf16_t*)(p.ws + WS_H)};
    pg8::gemm_phase(wv, lds + LDS_STAGE, pg8::Gemm{2048, 512, 512}, S, E); }
PHASE_FN void phase_g4(int wv, PRM p, int l, LAS unsigned char* lds) {
    const char* ws = p.ws; SchedDense S{NPANEL, 4, (int)gridDim.x, BLK, ws + WS_H, ws + WS_WO, (size_t)256 * 1024 * 2, (size_t)256 * 1024 * 2};
    EpiResid E{(float*)(p.ws + WS_XC), p.out, p.in[I_CTX], p.in[I_X], l, (const float*)(ws + WS_MOD) + (size_t)l * 9 * 6144};
    pg8::gemm_phase(wv, lds + LDS_STAGE, pg8::Gemm{1024, 1024, 1024}, S, E); }
PHASE_FN void phase_g5(int wv, PRM p, int l, LAS unsigned char* lds) {
    const char* ws = p.ws; LAS int* tab = (LAS int*)(lds + LDS_TAB); moe_tables(wv, p, l, tab, tab + 320);
    SchedMoe S{(int)gridDim.x, BLK, tab, ws + WS_XB, ws + WS_GU, (size_t)256 * 1024 * 2, (size_t)1024 * 1024 * 2, (size_t)256 * 1024 * 2};
    EpiSwiGLU E{(bf16_t*)(p.ws + WS_HID)};
    pg8::gemm_phase(wv, lds + LDS_STAGE, pg8::Gemm{1024, 1024, 1024}, S, E); }
PHASE_FN void phase_g6(int wv, PRM p, int l, LAS unsigned char* lds) {
    const char* ws = p.ws; LAS int* tab = (LAS int*)(lds + LDS_TAB); moe_tables(wv, p, l, tab, tab + 320);
    SchedMoe S{(int)gridDim.x, BLK, tab, ws + WS_HID, ws + WS_DW, (size_t)256 * 512 * 2, (size_t)1024 * 512 * 2, (size_t)256 * 512 * 2};
    EpiStoreBf16<0> E{(bf16_t*)(p.ws + WS_YB), 1024};
    pg8::gemm_phase(wv, lds + LDS_STAGE, pg8::Gemm{512, 512, 512}, S, E); }

constexpr int PH_PER_LAYER = 13, N_PHASES = 1 + DEPTH * PH_PER_LAYER;
constexpr int LDS_PARAMS = 256;
#define LAYER_BODY(l) { if (PH_ON) { phase_convert(wv, *kparams(), l, olds(lds)); if (l == 0) phase_modulate0(wv, *kparams()); } PH_NEXT; if (PH_ON) phase_g1(wv, *kparams(), olds(lds)); PH_NEXT; if (PH_ON) phase_prep(wv, *kparams()); PH_NEXT; if (PH_ON) phase_mix(wv, *kparams(), l, olds(lds)); PH_NEXT; if (PH_ON) phase_fin(wv, *kparams(), l); PH_NEXT; if (PH_ON) phase_g2(wv, *kparams(), olds(lds)); PH_NEXT; if (PH_ON) phase_g3(wv, *kparams(), olds(lds)); PH_NEXT; if (PH_ON) phase_g4(wv, *kparams(), l, olds(lds)); PH_NEXT; if (PH_ON) phase_ln1_router(wv, *kparams(), l, olds(lds)); PH_NEXT; if (PH_ON) phase_moe_assign(wv, *kparams(), l, olds(lds)); PH_NEXT; if (PH_ON) phase_g5(wv, *kparams(), l, olds(lds)); PH_NEXT; if (PH_ON) phase_g6(wv, *kparams(), l, olds(lds)); PH_NEXT; if (PH_ON) phase_ln2(wv, *kparams(), l); PH_NEXT; }
__global__ void __launch_bounds__(NTHR, 2) fwd_kernel(Params p) {
    extern __shared__ __attribute__((aligned(16))) unsigned char shm[];
    LAS unsigned char* lds = (LAS unsigned char*)shm;
    const int ph_lo = p.ph_lo, ph_hi = p.ph_hi;
    const int wv = __builtin_amdgcn_readfirstlane((int)threadIdx.x >> 6);
    const bool single = (ph_hi - ph_lo) > 1;
    if (threadIdx.x == 0) *(LAS u32x4*)lds = (u32x4){0u, 0u, 0u, 0u};
    __syncthreads();
    XcdBarrier bar; bar.bar = (unsigned*)(p.ws + WS_CTL); bar.x = 0; bar.st = (volatile LAS unsigned*)lds;
    if (single) bar = xcd_barrier_post((unsigned*)(p.ws + WS_CTL), (volatile LAS unsigned*)lds);
    int gph = 0;
#define PH_ON (gph >= ph_lo && gph < ph_hi)
#define PH_NEXT do { ++gph; if (single) xcd_barrier(bar); } while (0)
    if (PH_ON) { phase_mod(wv, *kparams(), olds(lds)); phase_rope_table(wv, *kparams()); }
    PH_NEXT;
    LAYER_BODY(0) LAYER_BODY(1) LAYER_BODY(2) LAYER_BODY(3)
}
#ifndef MK_NO_HOST
#ifndef MK_MULTI
#define MK_MULTI 1
#endif
extern "C" void kernel_launch(void* const* d_in, const int* in_sizes, int n_in, void* d_out, int out_size, void* d_ws, size_t ws_size, hipStream_t stream) {
    static int grid = 0;
    if (grid == 0) {
        if (n_in != N_IN || ws_size < WS_END) { fprintf(stderr, "kernel_launch: unexpected n_in %d or ws_size %zu (< %zu)\n", n_in, ws_size, (size_t)WS_END); grid = -1; return; }
        int dev = 0, cus = 0, per_cu = 0;
        if (hipGetDevice(&dev) != hipSuccess || hipDeviceGetAttribute(&cus, hipDeviceAttributeMultiprocessorCount, dev) != hipSuccess) { grid = -1; return; }
        if (hipFuncSetAttribute((const void*)fwd_kernel, hipFuncAttributeMaxDynamicSharedMemorySize, LDS_BYTES) != hipSuccess) { fprintf(stderr, "kernel_launch: hipFuncSetAttribute failed\n"); grid = -1; return; }
        if (hipOccupancyMaxActiveBlocksPerMultiprocessor(&per_cu, fwd_kernel, NTHR, LDS_BYTES) != hipSuccess || per_cu < 1) { fprintf(stderr, "kernel_launch: occupancy query failed (%d)\n", per_cu); grid = -1; return; }
        grid = cus;
    }
    if (grid <= 0) return;
    (void)hipMemsetAsync((char*)d_ws + WS_CTL, 0, CTL_BYTES, stream);
    Params p{};
    for (int i = 0; i < N_IN; ++i) p.in[i] = (const float*)d_in[i];
    p.out = (float*)d_out; p.ws = (char*)d_ws;
#ifdef DBG_DET
    unsigned long long* cks = (unsigned long long*)((char*)d_ws + WS_END);
    (void)hipMemsetAsync(cks, 0, 2 * DBG_SLOTS * 8, stream);
    for (int run = 0; run < 2; ++run) {
        (void)hipMemsetAsync((char*)d_ws + WS_CTL, 0, CTL_BYTES, stream);
        for (int ph = 0; ph < N_PHASES; ++ph) { p.ph_lo = ph; p.ph_hi = ph + 1; hipLaunchKernelGGL(fwd_kernel, dim3(grid), dim3(NTHR), LDS_BYTES, stream, p);
            dbg_phase_ck(stream, (char*)d_ws, (float*)d_out, ph, cks + run * DBG_SLOTS + ph); }
    }
    hipLaunchKernelGGL(dbg_final, dim3(1024), dim3(256), 0, stream, cks, DBG_SLOTS, (float*)d_out, out_size);
#elif MK_MULTI
    for (int ph = 0; ph < N_PHASES; ++ph) { p.ph_lo = ph; p.ph_hi = ph + 1; hipLaunchKernelGGL(fwd_kernel, dim3(grid), dim3(NTHR), LDS_BYTES, stream, p); }
#else
    p.ph_lo = 0; p.ph_hi = N_PHASES;
    hipLaunchKernelGGL(fwd_kernel, dim3(grid), dim3(NTHR), LDS_BYTES, stream, p);
#endif
}
#endif
```

```cpp
#define MK_MULTI 0
#include <hip/hip_runtime.h>
#include <stdint.h>
#include <stdio.h>

#define LAS __attribute__((address_space(3)))
typedef unsigned short bf16_t;
typedef short bf16x8 __attribute__((ext_vector_type(8)));
typedef short s16x4 __attribute__((ext_vector_type(4)));
typedef float f32x2 __attribute__((ext_vector_type(2)));
typedef float f32x4 __attribute__((ext_vector_type(4)));
typedef float f32x16 __attribute__((ext_vector_type(16)));
typedef unsigned u32x2 __attribute__((ext_vector_type(2)));
typedef unsigned u32x4 __attribute__((ext_vector_type(4)));

constexpr int D = 1024, NBATCH = 8, LAT = 4096, LCTX = 256, TPB = 4352, NTOK = NBATCH * TPB, DEPTH = 4;
constexpr int NPANEL = NTOK / 256;
constexpr int UC = 6656;
constexpr int U_SSD_Z = 0, U_SSD_X = 512, U_SSD_B = 1024, U_SSD_C = 1280, U_RW_R = 1536, U_RW_K = 2048, U_RW_V = 2560, U_RW_WD = 3072, U_RW_AD = 3200,
              U_RW_GD = 3328, U_SSD_DT = 3456, U_GLA_GD = 3464, U_DF_Q = 3584, U_DF_K = 4096, U_DF_V = 4608, U_GLA_Q = 5120, U_GLA_K = 5376, U_GLA_V = 5632, U_GLA_OG = 6144;
constexpr int IN_COLS = 10664, GATE_COL0 = 6568;
constexpr int NEXP = 32, MOE_FF = 512, NSLOTBLK = 304, NSLOT = NSLOTBLK * 256;
constexpr float DN_ALPHA = 1.681792830507429f;
constexpr int NTHR = 512;
constexpr int LDS_BYTES = 159744;
constexpr int LDS_STAGE = 1024;
constexpr int LDS_TAB = LDS_STAGE + 131072;

enum { I_X = 0, I_C, I_CTX, I_CCTX, I_ADAW, I_ADAB, I_WIN, I_SSD_CW, I_SSD_CB, I_SSD_ALOG, I_SSD_DTB, I_SSD_D, I_SSD_NG, I_RW_MU, I_RW_W0, I_RW_WUP, I_RW_A0, I_RW_AUP,
       I_RW_GUP, I_RW_KK, I_RW_KA, I_RW_RK, I_RW_LNG, I_RW_LNB, I_DF_Q1, I_DF_K1, I_DF_Q2, I_DF_K2, I_DF_SG, I_GLA_GUP, I_GLA_GB, I_GLA_NG, I_WBR, I_WOUT, I_LN1G, I_LN1B,
       I_MOE_WG, I_MOE_BG, I_MOE_WE, I_MOE_BE, I_MOE_GATE, I_MOE_UP, I_MOE_DOWN, I_LN2G, I_LN2B, N_IN };

constexpr size_t al256(size_t x) { return (x + 255) & ~(size_t)255; }
constexpr size_t WS_CTL = 0;
constexpr size_t CTL_BYTES = 65536;
constexpr int CW_QUEUE = 4096, CW_CNT = 8192, CW_CUR = 12288;
constexpr size_t WS_MOD = WS_CTL + CTL_BYTES;
constexpr size_t WS_ROPE = al256(WS_MOD + (size_t)DEPTH * 9 * 6144 * 4);
constexpr size_t WS_XC = al256(WS_ROPE + (size_t)2 * 4096 * 32 * 4);
constexpr size_t WS_H = al256(WS_XC + (size_t)2048 * 1024 * 4);
constexpr size_t WS_U = al256(WS_H + (size_t)NTOK * 1024 * 2);
constexpr size_t U_BYTES = (size_t)NTOK * UC * 2;
constexpr size_t WS_GATES = WS_U;
constexpr size_t WS_M = al256(WS_GATES + (size_t)NTOK * 4096 * 2);
constexpr size_t WS_XB = WS_U;
constexpr size_t WS_HID = al256(WS_XB + (size_t)NSLOT * 1024 * 2);
constexpr size_t WS_YB = al256(WS_HID + (size_t)NSLOT * 512 * 2);
static_assert(WS_M + (size_t)NTOK * 1024 * 4 <= WS_U + U_BYTES, "M overlay");
static_assert(WS_YB + (size_t)NSLOT * 1024 * 2 <= WS_U + U_BYTES, "moe overlay");
constexpr size_t WS_Y = al256(WS_U + U_BYTES);
constexpr size_t WS_SSDY = al256(WS_Y + (size_t)NTOK * 2048 * 2);
constexpr size_t WS_RWY = al256(WS_SSDY + (size_t)2 * NTOK * 512 * 2);
constexpr size_t WS_RWG = al256(WS_RWY + (size_t)2 * NTOK * 512 * 2);
constexpr size_t WS_GLAO = al256(WS_RWG + (size_t)NTOK * 512 * 2);
constexpr size_t WS_RWBD = al256(WS_GLAO + (size_t)2 * NTOK * 512 * 2);
constexpr size_t WS_WIN = al256(WS_RWBD + (size_t)2 * NTOK * 8 * 4);
constexpr size_t WS_WG = al256(WS_WIN + (size_t)UC * 1024 * 2);
constexpr size_t WS_WB = al256(WS_WG + (size_t)4096 * 1024 * 2);
constexpr size_t WS_WO = al256(WS_WB + (size_t)4 * 1024 * 512 * 2);
constexpr size_t WS_GU = al256(WS_WO + (size_t)1024 * 1024 * 2);
constexpr size_t WS_DW = al256(WS_GU + (size_t)32 * 1024 * 1024 * 2);
constexpr size_t WS_EID = al256(WS_DW + (size_t)32 * 1024 * 512 * 2);
constexpr size_t WS_WTS = al256(WS_EID + (size_t)NTOK * 2 * 4);
constexpr size_t WS_SLOT = al256(WS_WTS + (size_t)NTOK * 2 * 4);
constexpr size_t WS_END = al256(WS_SLOT + (size_t)NTOK * 2 * 4);

struct Params { const float* in[N_IN]; float* out; char* ws; int ph_lo, ph_hi; };
typedef const __attribute__((address_space(4))) Params CParams;
#define PRM CParams&
__device__ __forceinline__ LAS unsigned char* olds(LAS unsigned char* q) { asm volatile("" : "+s"(q)); return q; }
__device__ __forceinline__ CParams* kparams() { CParams* q = (CParams*)__builtin_amdgcn_kernarg_segment_ptr(); asm volatile("" : "+s"(q)); return q; }
#ifndef PHASE_FN
#define PHASE_FN __device__ __forceinline__
#endif

__device__ __forceinline__ int olane() { unsigned z = 0u; asm volatile("" : "+v"(z)); return (int)__builtin_amdgcn_mbcnt_hi(~0u, __builtin_amdgcn_mbcnt_lo(~0u, z)); }
__device__ __forceinline__ int otid(int wv) { return (wv << 6) | olane(); }
#define TID (otid(wv))
#define LANE (olane())
#define WAVE (wv)
__device__ __forceinline__ int oblk() { int b = (int)blockIdx.x; asm volatile("" : "+s"(b)); return b; }
#define BLK (oblk())
__device__ __forceinline__ float bf2f(unsigned b) { return __uint_as_float(b << 16); }
typedef __bf16 bf16x2_t __attribute__((ext_vector_type(2)));
__device__ __forceinline__ unsigned cvt_pk_bf16(float lo, float hi) { const f32x2 v = {lo, hi}; return __builtin_bit_cast(unsigned, __builtin_convertvector(v, bf16x2_t)); }
__device__ __forceinline__ bf16_t f2bf(float f) { return (bf16_t)(cvt_pk_bf16(f, 0.f) & 0xffffu); }
__device__ __forceinline__ void unpack8(const u32x4 w, float (&f)[8]) {
    f[0] = __uint_as_float(w.x << 16); f[1] = __uint_as_float(w.x & 0xffff0000u); f[2] = __uint_as_float(w.y << 16); f[3] = __uint_as_float(w.y & 0xffff0000u);
    f[4] = __uint_as_float(w.z << 16); f[5] = __uint_as_float(w.z & 0xffff0000u); f[6] = __uint_as_float(w.w << 16); f[7] = __uint_as_float(w.w & 0xffff0000u); }
__device__ __forceinline__ u32x4 pack8(const float (&f)[8]) { u32x4 w; w.x = cvt_pk_bf16(f[0], f[1]); w.y = cvt_pk_bf16(f[2], f[3]); w.z = cvt_pk_bf16(f[4], f[5]); w.w = cvt_pk_bf16(f[6], f[7]); return w; }
template <int CTRL> __device__ __forceinline__ float dppf(float v) { return __int_as_float(__builtin_amdgcn_update_dpp(0, __float_as_int(v), CTRL, 0xf, 0xf, true)); }
__device__ __forceinline__ float sum4(float v)  { v += dppf<0xB1>(v); v += dppf<0x4E>(v); return v; }
__device__ __forceinline__ float sum8(float v)  { v = sum4(v); v += dppf<0x141>(v); return v; }
__device__ __forceinline__ float sum16(float v) { v = sum8(v); v += dppf<0x140>(v); return v; }
__device__ __forceinline__ float shflx(float v, int mask) { const int ln = olane(); return __int_as_float(__builtin_amdgcn_ds_bpermute(((ln ^ mask) & 63) << 2, __float_as_int(v))); }
__device__ __forceinline__ float sum32(float v) { v = sum16(v); v += shflx(v, 16); return v; }
__device__ __forceinline__ float sum64(float v) { v = sum16(v);
    return __int_as_float(__builtin_amdgcn_readlane(__float_as_int(v), 0)) + __int_as_float(__builtin_amdgcn_readlane(__float_as_int(v), 16))
         + __int_as_float(__builtin_amdgcn_readlane(__float_as_int(v), 32)) + __int_as_float(__builtin_amdgcn_readlane(__float_as_int(v), 48)); }
__device__ __forceinline__ float sigmoidf_(float x) { return 1.0f / (1.0f + __expf(-x)); }
__device__ __forceinline__ float siluf_(float x) { return x / (1.0f + __expf(-x)); }
__device__ __forceinline__ float softplusf_(float x) { return x > 20.f ? x : log1pf(__expf(x)); }
__device__ __forceinline__ float softplus_fast(float x) { return fmaxf(x, 0.f) + __logf(1.0f + __expf(-fabsf(x))); }
__device__ __forceinline__ float tanh_fast(float x) { return 1.0f - 2.0f * __builtin_amdgcn_rcpf(__expf(2.0f * x) + 1.0f); }

__device__ __forceinline__ float* xs_row(PRM p, int r) { const int b = r / TPB, t = r - b * TPB;
    return t < LCTX ? (float*)(p.ws + WS_XC) + ((size_t)b * LCTX + t) * D : p.out + ((size_t)b * LAT + (t - LCTX)) * D; }
__device__ __forceinline__ const float* xin_row(PRM p, int r) { const int b = r / TPB, t = r - b * TPB;
    return t < LCTX ? p.in[I_CTX] + ((size_t)b * LCTX + t) * D : p.in[I_X] + ((size_t)b * LAT + (t - LCTX)) * D; }
__device__ __forceinline__ int mod_row(int r) { const int b = r / TPB, t = r - b * TPB; return t < LCTX ? 8 : b; }
#define XB_TMO      128
#define XB_XCNT(j)  (256  + 64 * (j))
#define XB_XSUB(j)  (1280 + 64 * (j))
#define XB_XGEN(j)  (2304 + 64 * (j))
#define XB_TOP      3328
#define XB_TOPGEN   3392
#define XCD_BAR_WORDS 3456
#define XB_SPIN_CAP (1u << 18)

__device__ __forceinline__ unsigned xb_ld(unsigned* p)              { return __hip_atomic_load(p, __ATOMIC_RELAXED, __HIP_MEMORY_SCOPE_AGENT); }
__device__ __forceinline__ unsigned xb_add(unsigned* p, unsigned v) { return __hip_atomic_fetch_add(p, v, __ATOMIC_RELAXED, __HIP_MEMORY_SCOPE_AGENT); }
__device__ __forceinline__ unsigned xb_xcc_id() { return (unsigned)__builtin_amdgcn_s_getreg((3 << 11) | 20) & 0xFu; }
#define XB_SPIN(cond, bar) do { unsigned _sp = 0; while (cond) { __builtin_amdgcn_s_sleep(1); \
    if ((++_sp & 255u) == 0u) { if (xb_ld(&(bar)[XB_TMO])) break; if (_sp > XB_SPIN_CAP) { atomicAdd(&(bar)[XB_TMO], 1u); break; } } } } while (0)

struct XcdBarrier {
    unsigned* bar; unsigned x;
    volatile LAS unsigned* st;
};

__device__ __forceinline__ XcdBarrier xcd_barrier_post(unsigned* bar, volatile LAS unsigned* st) {
    XcdBarrier b; b.bar = bar; b.x = xb_xcc_id(); b.st = st;
    if (threadIdx.x == 0) (void)xb_add(&bar[XB_XCNT(b.x)], 1u);
    return b;
}
__device__ __forceinline__ void xcd_barrier_complete(unsigned* bar, unsigned x, unsigned& nloc, unsigned& nx) {
    const unsigned G = gridDim.x * gridDim.y * gridDim.z;
    unsigned sum, cnt, mine, sp = 0u;
    for (;;) {
        sum = 0u; cnt = 0u; mine = 0u;
#pragma unroll
        for (unsigned j = 0; j < 16; ++j) { const unsigned c = xb_ld(&bar[XB_XCNT(j)]); sum += c; cnt += (c > 0u) ? 1u : 0u; mine = (j == x) ? c : mine; }
        if (sum == G) break;
        __builtin_amdgcn_s_sleep(1);
        if ((++sp & 255u) == 0u) { if (xb_ld(&bar[XB_TMO])) break; if (sp > XB_SPIN_CAP) { atomicAdd(&bar[XB_TMO], 1u); break; } }
    }
    nloc = mine > 0u ? mine : 1u; nx = cnt > 0u ? cnt : 1u;
}

__device__ __forceinline__ void xcd_barrier(const XcdBarrier& b) {
    asm volatile("s_waitcnt vmcnt(0)" ::: "memory");
    __syncthreads();
    if (threadIdx.x == 0) {
        unsigned* bar = b.bar;
        __builtin_amdgcn_s_waitcnt(0);
        unsigned nloc = b.st[0], nx = b.st[1];
        if (nloc == 0u) { xcd_barrier_complete(bar, b.x, nloc, nx); b.st[0] = nloc; b.st[1] = nx; }
        const unsigned old = xb_add(&bar[XB_XSUB(b.x)], 1u);
        const unsigned gen = old / nloc;
        if (old + 1u == (gen + 1u) * nloc) {
            __builtin_amdgcn_fence(__ATOMIC_RELEASE, "agent");
            asm volatile("s_waitcnt vmcnt(0)" ::: "memory");
            const unsigned og = xb_add(&bar[XB_TOP], 1u);
            const unsigned tg = og / nx;
            if (og + 1u == (tg + 1u) * nx) xb_add(&bar[XB_TOPGEN], 1u);
            else XB_SPIN(xb_ld(&bar[XB_TOPGEN]) == tg, bar);
            __builtin_amdgcn_fence(__ATOMIC_ACQUIRE, "agent");
            xb_add(&bar[XB_XGEN(b.x)], 1u);
            asm volatile("s_waitcnt vmcnt(0)" ::: "memory");
        } else {
            XB_SPIN(xb_ld(&bar[XB_XGEN(b.x)]) == gen, bar);
            __builtin_amdgcn_fence(__ATOMIC_ACQUIRE, "agent");
            asm volatile("s_waitcnt vmcnt(0)" ::: "memory");
        }
    }
    __syncthreads();
}

namespace pg8 {
constexpr int BM = 256, BK = 64, HALF = 128, HTB = HALF * BK * 2, STAGE_BYTES = 8 * HTB, NXCD = 8, WGM = 8;
__host__ __device__ __forceinline__ int lds_byte(int r, int c) { const int st = (r >> 4) * 2 + (c >> 5), rr = r & 15, cc = c & 31, ob = rr * 64 + cc * 2; return st * 1024 + (ob ^ (((ob >> 9) & 1) << 5)); }
__host__ __device__ __forceinline__ void stage_rc(int b, int& R, int& C) { const int st = b / 1024, sb = b % 1024, swz = sb ^ (((sb >> 9) & 1) << 5); R = (st >> 1) * 16 + swz / 64; C = (st & 1) * 32 + (swz % 64) / 2; }
__host__ __device__ __forceinline__ int perm32(int rho) { const int n = rho >> 4, i = rho & 15; return 8 * (i >> 2) + 4 * n + (i & 3); }

struct Unit { int pm, pn, x; const char* a; const char* b; };
struct Gemm { int lda, ldb, K; };

__device__ __forceinline__ bool static_tile(int L, int nM, int nN, int& pm, int& pn) {
    const int nwg = nM * nN; if (L >= nwg) return false;
    int wgid = L; { const int q = nwg / NXCD, r = nwg % NXCD, xcd = wgid % NXCD, off = wgid / NXCD; wgid = (xcd < r ? xcd * (q + 1) : r * (q + 1) + (xcd - r) * q) + off; }
    const int nig = WGM * nN, gid = wgid / nig, fm = gid * WGM, gsz = (nM - fm) < WGM ? (nM - fm) : WGM;
    pm = fm + ((wgid % nig) % gsz); pn = (wgid % nig) / gsz; return true;
}

template <class Epi, class Sched>
__device__ __forceinline__ void gemm_phase(int wv, LAS unsigned char* lds, const Gemm g, const Sched& S, const Epi& E) {
    const int tid = otid(wv), wid = wv, lane = tid & 63, wr = wid >> 2, wc = wid & 3, fr = lane & 15, fq = lane >> 4;
    const int K = g.K, nt = K / BK;
    unsigned voffA[2], voffB[2];
#pragma unroll
    for (int i = 0; i < 2; ++i) { int R, C; stage_rc(tid * 16 + i * 8192, R, C); const int Rb = (R & ~31) + perm32(R & 31);
        voffA[i] = (unsigned)(R * g.lda + C) * 2u; voffB[i] = (unsigned)(Rb * g.ldb + C) * 2u; }
    const size_t kstep = (size_t)(BK * 2);
    const size_t hstepA = (size_t)HALF * g.lda * 2, hstepB = (size_t)HALF * g.ldb * 2;
    const unsigned ldsw = (unsigned)wid * 1024u;
    const int aoff = lds_byte(wr * 64 + fr, fq * 8), boff = lds_byte(wc * 32 + fr, fq * 8);
#define PG8_SA(b, h) (((b) * 2 + (h)) * HTB)
#define PG8_SB(b, h) ((4 + (b) * 2 + (h)) * HTB)
#define PG8_STAGE(bufoff, gbase, voff) do { _Pragma("unroll") for (int _i = 0; _i < 2; ++_i) \
        __builtin_amdgcn_global_load_lds((const unsigned*)((const char*)(gbase) + (voff)[_i]), (LAS unsigned*)(lds + (bufoff) + ldsw + _i * 8192), 16, 0, 0); } while (0)
#define PG8_LDA(dst, b, h) do { _Pragma("unroll") for (int m = 0; m < 4; ++m) _Pragma("unroll") for (int k = 0; k < 2; ++k) dst[m][k] = *(const LAS bf16x8*)(lds + PG8_SA(b, h) + aoff + m * 2048 + k * 1024); } while (0)
#define PG8_LDB(dst, b, h) do { _Pragma("unroll") for (int n = 0; n < 2; ++n) _Pragma("unroll") for (int k = 0; k < 2; ++k) dst[n][k] = *(const LAS bf16x8*)(lds + PG8_SB(b, h) + boff + n * 2048 + k * 1024); } while (0)
#define PG8_MMA(ai, bj, At, Bt) do { __builtin_amdgcn_s_setprio(1); _Pragma("unroll") for (int m = 0; m < 4; ++m) _Pragma("unroll") for (int n = 0; n < 2; ++n) _Pragma("unroll") for (int k = 0; k < 2; ++k) \
        acc[ai][bj][m][n] = __builtin_amdgcn_mfma_f32_16x16x32_bf16(Bt[n][k], At[m][k], acc[ai][bj][m][n], 0, 0, 0); __builtin_amdgcn_s_setprio(0); } while (0)
#define PG8_WAIT_V(n) asm volatile("s_waitcnt vmcnt(" #n ")" ::: "memory")
#define PG8_WAIT_L(n) asm volatile("s_waitcnt lgkmcnt(" #n ")" ::: "memory")
#define PG8_BAR __builtin_amdgcn_s_barrier()
#define PG8_SCHED __builtin_amdgcn_sched_barrier(0)
    Unit cur, nxt; int ui = 0;
    if (!S.next(0, cur)) return;
    f32x4 acc[2][2][4][2];
#pragma unroll
    for (int a = 0; a < 2; ++a)
#pragma unroll
        for (int b = 0; b < 2; ++b)
#pragma unroll
            for (int m = 0; m < 4; ++m)
#pragma unroll
                for (int n = 0; n < 2; ++n) acc[a][b][m][n] = (f32x4){0.f, 0.f, 0.f, 0.f};
    bf16x8 At[4][2], B0[2][2], B1[2][2];
    const char* cA = cur.a; const char* cB = cur.b;
    PG8_STAGE(PG8_SB(0, 0), cB, voffB); PG8_STAGE(PG8_SB(0, 1), cB + hstepB, voffB); PG8_STAGE(PG8_SA(0, 0), cA, voffA); PG8_STAGE(PG8_SA(0, 1), cA + hstepA, voffA);
    if (wr == 1) PG8_BAR;
    PG8_WAIT_V(2); PG8_BAR;
    PG8_STAGE(PG8_SB(1, 0), cB + kstep, voffB); PG8_STAGE(PG8_SA(1, 0), cA + kstep, voffA); PG8_STAGE(PG8_SB(1, 1), cB + hstepB + kstep, voffB);
    PG8_WAIT_V(6); PG8_BAR;
    for (;;) {
        const bool has_next = S.next(ui + 1, nxt);
        const char* nA = has_next ? nxt.a : cA; const char* nB = has_next ? nxt.b : cB;
        for (int t = 0; t < nt; t += 2) {
            const bool last = (t == nt - 2);
            const char* a1 = cA + (size_t)(t + 1) * kstep;
            const char* a2 = last ? nA : cA + (size_t)(t + 2) * kstep; const char* b2 = last ? nB : cB + (size_t)(t + 2) * kstep;
            const char* a3 = a2 + kstep; const char* b3 = b2 + kstep;
            PG8_LDB(B0, 0, 0); PG8_LDB(B1, 0, 1); PG8_SCHED; PG8_LDA(At, 0, 0); PG8_STAGE(PG8_SA(1, 1), a1 + hstepA, voffA);
            PG8_WAIT_V(8); PG8_WAIT_L(0); PG8_BAR; PG8_MMA(0, 0, At, B0); PG8_MMA(0, 1, At, B1); PG8_BAR; PG8_SCHED;
            PG8_LDA(At, 0, 1); PG8_STAGE(PG8_SB(0, 0), b2, voffB); PG8_STAGE(PG8_SB(0, 1), b2 + hstepB, voffB); PG8_STAGE(PG8_SA(0, 0), a2, voffA);
            PG8_WAIT_V(8); PG8_WAIT_L(0); PG8_BAR; PG8_MMA(1, 0, At, B0); PG8_MMA(1, 1, At, B1); PG8_BAR; PG8_SCHED;
            PG8_LDB(B0, 1, 0); PG8_LDB(B1, 1, 1); PG8_SCHED; PG8_LDA(At, 1, 0); PG8_STAGE(PG8_SA(0, 1), a2 + hstepA, voffA);
            PG8_WAIT_V(8); PG8_WAIT_L(0); PG8_BAR; PG8_MMA(0, 0, At, B0); PG8_MMA(0, 1, At, B1); PG8_BAR; PG8_SCHED;
            PG8_LDA(At, 1, 1); PG8_STAGE(PG8_SB(1, 0), b3, voffB); PG8_STAGE(PG8_SB(1, 1), b3 + hstepB, voffB); PG8_STAGE(PG8_SA(1, 0), a3, voffA);
            PG8_WAIT_V(8); PG8_WAIT_L(0); PG8_BAR; PG8_MMA(1, 0, At, B0); PG8_MMA(1, 1, At, B1); PG8_BAR; PG8_SCHED;
        }
        if (wr == 0) PG8_BAR;
        E(acc, cur, wr, wc, fr, fq);
        if (!has_next) break;
#pragma unroll
        for (int a = 0; a < 2; ++a)
#pragma unroll
            for (int b = 0; b < 2; ++b)
#pragma unroll
                for (int m = 0; m < 4; ++m)
#pragma unroll
                    for (int n = 0; n < 2; ++n) acc[a][b][m][n] = (f32x4){0.f, 0.f, 0.f, 0.f};
        cur = nxt; cA = nA; cB = nB; ++ui;
        if (wr == 1) PG8_BAR;
    }
    PG8_WAIT_V(0);
    PG8_BAR;
#undef PG8_SA
#undef PG8_SB
#undef PG8_STAGE
#undef PG8_LDA
#undef PG8_LDB
#undef PG8_MMA
#undef PG8_WAIT_V
#undef PG8_WAIT_L
#undef PG8_BAR
#undef PG8_SCHED
}
}
using pg8::Unit;
template <int ACT  > struct EpiStoreBf16 {
    bf16_t* O; int ldc;
    __device__ __forceinline__ void operator()(const f32x4 (&acc)[2][2][4][2], const Unit& u, int wr, int wc, int fr, int fq) const {
        const int row0 = u.pm * 256 + wr * 64 + fr, col0 = u.pn * 256 + wc * 32 + 8 * fq;
#pragma unroll
        for (int ai = 0; ai < 2; ++ai)
#pragma unroll
            for (int m = 0; m < 4; ++m) { bf16_t* rowp = O + (size_t)(row0 + ai * 128 + m * 16) * ldc + col0;
#pragma unroll
                for (int bj = 0; bj < 2; ++bj) { f32x4 v0 = acc[ai][bj][m][0], v1 = acc[ai][bj][m][1];
                    if (ACT == 1) {
#pragma unroll
                        for (int j = 0; j < 4; ++j) { v0[j] = __builtin_amdgcn_rcpf(1.0f + __expf(-v0[j])); v1[j] = __builtin_amdgcn_rcpf(1.0f + __expf(-v1[j])); } }
                    u32x4 w; w.x = cvt_pk_bf16(v0[0], v0[1]); w.y = cvt_pk_bf16(v0[2], v0[3]); w.z = cvt_pk_bf16(v1[0], v1[1]); w.w = cvt_pk_bf16(v1[2], v1[3]);
                    *(u32x4*)(rowp + bj * 128) = w; } }
    }
};
struct EpiMerge {
    const bf16_t* G; float* M; bf16_t* MB;
    __device__ __forceinline__ void operator()(const f32x4 (&acc)[2][2][4][2], const Unit& u, int wr, int wc, int fr, int fq) const {
        const int br = u.x; const int row0 = u.pm * 256 + wr * 64 + fr, col0 = u.pn * 256 + wc * 32 + 8 * fq;
#pragma unroll
        for (int ai = 0; ai < 2; ++ai)
#pragma unroll
            for (int m = 0; m < 4; ++m) { const size_t r = (size_t)(row0 + ai * 128 + m * 16);
#pragma unroll
                for (int bj = 0; bj < 2; ++bj) { const int c = col0 + bj * 128;
                    const u32x4 gw = *(const u32x4*)(G + r * 4096 + br * 1024 + c); float gs[8]; unpack8(gw, gs);
                    f32x4 v0 = acc[ai][bj][m][0], v1 = acc[ai][bj][m][1];
#pragma unroll
                    for (int j = 0; j < 4; ++j) { v0[j] *= gs[j]; v1[j] *= gs[4 + j]; }
                    float* mp = M + r * 1024 + c;
                    if (br > 0) { v0 += *(const f32x4*)mp; v1 += *(const f32x4*)(mp + 4); }
                    if (br < 3) { *(f32x4*)mp = v0; *(f32x4*)(mp + 4) = v1; }
                    else { u32x4 w; w.x = cvt_pk_bf16(v0[0], v0[1]); w.y = cvt_pk_bf16(v0[2], v0[3]); w.z = cvt_pk_bf16(v1[0], v1[1]); w.w = cvt_pk_bf16(v1[2], v1[3]);
                        *(u32x4*)(MB + r * 1024 + c) = w; } } }
    }
};
struct EpiResid {
    float* xc; float* out; const float* ctxin; const float* xin; int layer; const float* modl;
    __device__ __forceinline__ void operator()(const f32x4 (&acc)[2][2][4][2], const Unit& u, int wr, int wc, int fr, int fq) const {
        asm volatile("" : "+v"(fr), "+v"(fq));
        const int b = u.pm / 17, pr = u.pm - b * 17; const bool isctx = pr == 0; const int mb = isctx ? 8 : b;
        float* dst = isctx ? xc + (size_t)b * LCTX * D : out + ((size_t)b * LAT + (size_t)(pr - 1) * 256) * D;
        const float* src = layer == 0 ? (isctx ? ctxin + (size_t)b * LCTX * D : xin + ((size_t)b * LAT + (size_t)(pr - 1) * 256) * D) : dst;
        const int rr0 = wr * 64 + fr, col0 = u.pn * 256 + wc * 32 + 8 * fq;
        const float* g1 = modl + mb * 6144 + 2048 + col0;
        f32x4 gv[2][2];
#pragma unroll
        for (int bj = 0; bj < 2; ++bj) { gv[bj][0] = *(const f32x4*)(g1 + bj * 128); gv[bj][1] = *(const f32x4*)(g1 + bj * 128 + 4); }
#pragma unroll
        for (int ai = 0; ai < 2; ++ai)
#pragma unroll
            for (int m = 0; m < 4; ++m) { const size_t ro = (size_t)(rr0 + ai * 128 + m * 16) * D + col0;
#pragma unroll
                for (int bj = 0; bj < 2; ++bj) {
                    const f32x4 x0 = *(const f32x4*)(src + ro + bj * 128), x1 = *(const f32x4*)(src + ro + bj * 128 + 4);
                    *(f32x4*)(dst + ro + bj * 128) = x0 * DN_ALPHA + gv[bj][0] * acc[ai][bj][m][0];
                    *(f32x4*)(dst + ro + bj * 128 + 4) = x1 * DN_ALPHA + gv[bj][1] * acc[ai][bj][m][1]; }
                asm volatile("" ::: "memory"); }
    }
};
struct EpiSwiGLU {
    bf16_t* HID;
    __device__ __forceinline__ void operator()(const f32x4 (&acc)[2][2][4][2], const Unit& u, int wr, int wc, int fr, int fq) const {
        const int row0 = u.pm * 256 + wr * 64 + fr, col0 = u.pn * 128 + wc * 32 + 8 * fq;
#pragma unroll
        for (int ai = 0; ai < 2; ++ai)
#pragma unroll
            for (int m = 0; m < 4; ++m) { float h[8];
#pragma unroll
                for (int n = 0; n < 2; ++n)
#pragma unroll
                    for (int j = 0; j < 4; ++j) { const float g = acc[ai][0][m][n][j], up = acc[ai][1][m][n][j]; h[4 * n + j] = g * __builtin_amdgcn_rcpf(1.0f + __expf(-g)) * up; }
                *(u32x4*)(HID + (size_t)(row0 + ai * 128 + m * 16) * MOE_FF + col0) = pack8(h); }
    }
};
struct SchedDense {
    int nM, nN, G, c; const char* A; const char* B; size_t ta, tb;
    __device__ __forceinline__ bool next(int i, Unit& u) const { int pm, pn; if (!pg8::static_tile(i * G + c, nM, nN, pm, pn)) return false;
        u.pm = pm; u.pn = pn; u.x = 0; u.a = A + (size_t)pm * ta; u.b = B + (size_t)pn * tb; return true; }
};
struct SchedMerge {
    int G, c; const char* Y; const char* WB;
    __device__ __forceinline__ bool next(int i, Unit& u) const { int pm, pn; if (!pg8::static_tile((i >> 2) * G + c, NPANEL, 4, pm, pn)) return false; const int br = i & 3;
        u.pm = pm; u.pn = pn; u.x = br; u.a = Y + (size_t)pm * 256 * 2048 * 2 + (size_t)br * 512 * 2; u.b = WB + (size_t)br * 1024 * 512 * 2 + (size_t)pn * 256 * 512 * 2; return true; }
};
struct SchedMoe {
    int G, c; const LAS int* tab; const char* A; const char* B; size_t ta, be, bt;
    __device__ __forceinline__ bool next(int i, Unit& u) const { const int L = i * G + c; const int nblk = tab[0]; if (L >= nblk * 4) return false; const int blk = L >> 2, t = L & 3, e = tab[1 + blk];
        u.pm = blk; u.pn = t; u.x = e; u.a = A + (size_t)blk * ta; u.b = B + (size_t)e * be + (size_t)t * bt; return true; }
};

PHASE_FN void phase_mod(int wv, PRM p, LAS unsigned char* lds) {
    LAS float* s = (LAS float*)(lds + LDS_STAGE); LAS float* red = s + 9 * 1024;
    const int tid = TID;
    for (int i = tid; i < 9 * 1024; i += NTHR) { const int b = i >> 10, k = i & 1023; const float v = b < 8 ? p.in[I_C][b * 1024 + k] : p.in[I_CCTX][k]; s[i] = siluf_(v); }
    __syncthreads();
    float* MOD = (float*)(p.ws + WS_MOD);
    for (int task = BLK; task < DEPTH * 48; task += gridDim.x) {
        const int l = task / 48, j0 = (task % 48) * 128, cq = tid & 127, kq = tid >> 7;
        float acc[9];
#pragma unroll
        for (int b = 0; b < 9; ++b) acc[b] = 0.f;
        const float* w = p.in[I_ADAW] + ((size_t)l * 1024 + kq * 256) * 6144 + j0 + cq;
        for (int k = 0; k < 256; ++k) { const float wv = w[(size_t)k * 6144];
#pragma unroll
            for (int b = 0; b < 9; ++b) acc[b] += s[b * 1024 + kq * 256 + k] * wv; }
#pragma unroll
        for (int b = 0; b < 9; ++b) red[(kq * 9 + b) * 128 + cq] = acc[b];
        __syncthreads();
        for (int o = tid; o < 9 * 128; o += NTHR) { const int b = o >> 7, c2 = o & 127;
            const float v = red[(0 * 9 + b) * 128 + c2] + red[(1 * 9 + b) * 128 + c2] + red[(2 * 9 + b) * 128 + c2] + red[(3 * 9 + b) * 128 + c2] + p.in[I_ADAB][l * 6144 + j0 + c2];
            MOD[((size_t)l * 9 + b) * 6144 + j0 + c2] = v; }
        __syncthreads();
    }
}
PHASE_FN void phase_rope_table(int wv, PRM p) {
    float* COS = (float*)(p.ws + WS_ROPE); float* SIN = COS + 4096 * 32;
    for (int i = BLK * NTHR + TID; i < 4096 * 32; i += gridDim.x * NTHR) { const int n = i >> 5, a = (i >> 4) & 1, pp = i & 15;
        const float inv = powf(10000.0f, -(float)pp / 16.0f); const float ang = (float)(a == 0 ? (n >> 6) : (n & 63)) * inv;
        COS[i] = cosf(ang); SIN[i] = sinf(ang); }
}
PHASE_FN void phase_modulate0(int wv, PRM p) {
    const float* MOD = (const float*)(p.ws + WS_MOD); bf16_t* H = (bf16_t*)(p.ws + WS_H); const int lane = LANE;
    for (int r = BLK * 8 + WAVE; r < NTOK; r += gridDim.x * 8) {
        const float* x = xin_row(p, r); const float* md = MOD + (size_t)mod_row(r) * 6144;
#pragma unroll
        for (int j = 0; j < 4; ++j) { const int c = j * 256 + lane * 4; const f32x4 v = *(const f32x4*)(x + c), sh = *(const f32x4*)(md + c), sc = *(const f32x4*)(md + 1024 + c);
            const f32x4 h = v * (sc + 1.0f) + sh; u32x2 w; w.x = cvt_pk_bf16(h[0], h[1]); w.y = cvt_pk_bf16(h[2], h[3]); *(u32x2*)(H + (size_t)r * D + c) = w; }
    }
}
__device__ __forceinline__ int win_src_col(int j) {
    if (j < 1536) return j;
    if (j < 3456) return 1544 + (j - 1536);
    if (j < 3464) return 1536 + (j - 3456);
    if (j < 3496) return 6024 + (j - 3464);
    if (j < 3584) return -1;
    if (j < 5120) return 3464 + (j - 3584);
    if (j < 6144) return 5000 + (j - 5120);
    return 6056 + (j - 6144);
}
PHASE_FN void phase_convert(int wv, PRM p, int l, LAS unsigned char* lds) {
    LAS float* tile = (LAS float*)(lds + LDS_STAGE);
    const int tid = TID;
    constexpr int T0 = 104 * 16, T1 = T0 + 64 * 16, T2 = T1 + 4 * 16 * 8, T3 = T2 + 16 * 16, T4 = T3 + 32 * 16 * 16, T5 = T4 + 32 * 16 * 8;
    for (int task = BLK; task < T5; task += gridDim.x) {
        const float* src; int sld; bf16_t* dst; int dld; int n0, k0, kind = 0, cadd = 0;
        if (task < T0) { const int t = task; n0 = (t >> 4) * 64; k0 = (t & 15) * 64; src = p.in[I_WIN] + (size_t)l * 1024 * IN_COLS; sld = IN_COLS; dst = (bf16_t*)(p.ws + WS_WIN); dld = 1024; kind = 1; }
        else if (task < T1) { const int t = task - T0; n0 = (t >> 4) * 64; k0 = (t & 15) * 64; src = p.in[I_WIN] + (size_t)l * 1024 * IN_COLS; sld = IN_COLS; dst = (bf16_t*)(p.ws + WS_WG); dld = 1024; cadd = GATE_COL0; }
        else if (task < T2) { const int t = task - T1; const int br = t >> 7, tt = t & 127; n0 = (tt >> 3) * 64; k0 = (tt & 7) * 64; src = p.in[I_WBR] + ((size_t)l * 4 + br) * 512 * 1024; sld = 1024; dst = (bf16_t*)(p.ws + WS_WB) + (size_t)br * 1024 * 512; dld = 512; }
        else if (task < T3) { const int t = task - T2; n0 = (t >> 4) * 64; k0 = (t & 15) * 64; src = p.in[I_WOUT] + (size_t)l * 1024 * 1024; sld = 1024; dst = (bf16_t*)(p.ws + WS_WO); dld = 1024; }
        else if (task < T4) { const int t = task - T3; const int e = t >> 8, tt = t & 255; const int j0 = (tt >> 4) * 64; k0 = (tt & 15) * 64;
            const int q = j0 >> 8, rr = j0 & 255; src = (rr < 128 ? p.in[I_MOE_GATE] : p.in[I_MOE_UP]) + ((size_t)l * 32 + e) * 1024 * 512; sld = 512; cadd = 128 * q + (rr & 127) - j0; n0 = j0;
            dst = (bf16_t*)(p.ws + WS_GU) + (size_t)e * 1024 * 1024; dld = 1024; }
        else { const int t = task - T4; const int e = t >> 7, tt = t & 127; n0 = (tt >> 3) * 64; k0 = (tt & 7) * 64; src = p.in[I_MOE_DOWN] + ((size_t)l * 32 + e) * 512 * 1024; sld = 1024; dst = (bf16_t*)(p.ws + WS_DW) + (size_t)e * 1024 * 512; dld = 512; }
        { const int nx = tid & 63, ky = tid >> 6; const int j = n0 + nx; const int sc = kind == 1 ? win_src_col(j) : j + cadd;
#pragma unroll
            for (int i = 0; i < 8; ++i) { const int k = ky + 8 * i; tile[k * 65 + nx] = sc >= 0 ? src[(size_t)(k0 + k) * sld + sc] : 0.f; } }
        __syncthreads();
        { const int kx = tid & 31, ny = tid >> 5;
#pragma unroll
            for (int i = 0; i < 4; ++i) { const int j = ny + 16 * i; *(unsigned*)(dst + (size_t)(n0 + j) * dld + k0 + 2 * kx) = cvt_pk_bf16(tile[(2 * kx) * 65 + j], tile[(2 * kx + 1) * 65 + j]); } }
        __syncthreads();
    }
}
PHASE_FN void phase_ln1_router(int wv, PRM p, int l, LAS unsigned char* lds) {
    LAS float* Wl = (LAS float*)(lds + LDS_STAGE);
    LAS unsigned* hist = (LAS unsigned*)(lds + 64);
    const int tid = TID, lane = LANE;
    const float* wg = p.in[I_MOE_WG] + (size_t)l * 1024 * 4; const float* we = p.in[I_MOE_WE] + (size_t)l * 1024 * 32;
    for (int i = tid; i < 1024 * 36; i += NTHR) { const int k = i / 36, e = i - k * 36;
        const int j = k >> 8, ln = (k >> 2) & 63, q = k & 3; Wl[((j * 4 + q) * 64 + ln) * 36 + e] = e < 4 ? wg[k * 4 + e] : we[k * 32 + (e - 4)]; }
    if (tid < 32) hist[tid] = 0u;
    __syncthreads();
    const float* MOD = (const float*)(p.ws + WS_MOD) + (size_t)l * 9 * 6144; bf16_t* H = (bf16_t*)(p.ws + WS_H);
    const float* lg = p.in[I_LN1G] + l * 1024; const float* lb = p.in[I_LN1B] + l * 1024;
    const float* bg = p.in[I_MOE_BG] + l * 4; const float* be = p.in[I_MOE_BE] + l * 32;
    int* EID = (int*)(p.ws + WS_EID); float* WTS = (float*)(p.ws + WS_WTS);
    for (int g4 = BLK * 8 + WAVE; g4 < NTOK / 2; g4 += gridDim.x * 8) {
        float h[2][16];
#pragma unroll
        for (int r = 0; r < 2; ++r) { const int row = g4 * 2 + r; float* xr = xs_row(p, row); const float* md = MOD + (size_t)mod_row(row) * 6144;
            f32x4 v[4]; float s = 0.f;
#pragma unroll
            for (int j = 0; j < 4; ++j) { v[j] = *(const f32x4*)(xr + j * 256 + lane * 4); s += (v[j][0] + v[j][1]) + (v[j][2] + v[j][3]); }
            const float mean = sum64(s) * (1.0f / 1024.0f); float q = 0.f;
#pragma unroll
            for (int j = 0; j < 4; ++j) { const f32x4 d = v[j] - mean; q += (d[0] * d[0] + d[1] * d[1]) + (d[2] * d[2] + d[3] * d[3]); }
            const float rstd = rsqrtf(sum64(q) * (1.0f / 1024.0f) + 1e-5f);
#pragma unroll
            for (int j = 0; j < 4; ++j) { const int c = j * 256 + lane * 4; const f32x4 x = (v[j] - mean) * rstd * *(const f32x4*)(lg + c) + *(const f32x4*)(lb + c);
                *(f32x4*)(xr + c) = x; const f32x4 hh = x * (*(const f32x4*)(md + 4 * 1024 + c) + 1.0f) + *(const f32x4*)(md + 3 * 1024 + c);
                u32x2 w; w.x = cvt_pk_bf16(hh[0], hh[1]); w.y = cvt_pk_bf16(hh[2], hh[3]); *(u32x2*)(H + (size_t)row * D + c) = w;
                h[r][j * 4 + 0] = hh[0]; h[r][j * 4 + 1] = hh[1]; h[r][j * 4 + 2] = hh[2]; h[r][j * 4 + 3] = hh[3]; } }
        LAS float* LG = (LAS float*)(lds + LDS_STAGE + 147456) + WAVE * 144;
#pragma unroll 1
        for (int pass = 0; pass < 3; ++pass) {
            float acc[2][12];
#pragma unroll
            for (int r = 0; r < 2; ++r)
#pragma unroll
                for (int e = 0; e < 12; ++e) acc[r][e] = 0.f;
#pragma unroll
            for (int idx = 0; idx < 16; ++idx) { const LAS float* wr = Wl + (idx * 64 + lane) * 36 + pass * 12; float w[12];
#pragma unroll
                for (int e4 = 0; e4 < 3; ++e4) { const f32x4 t = *(const LAS f32x4*)(wr + 4 * e4); w[4 * e4] = t[0]; w[4 * e4 + 1] = t[1]; w[4 * e4 + 2] = t[2]; w[4 * e4 + 3] = t[3]; }
#pragma unroll
                for (int r = 0; r < 2; ++r)
#pragma unroll
                    for (int e = 0; e < 12; ++e) acc[r][e] += h[r][idx] * w[e]; }
#pragma unroll
            for (int r = 0; r < 2; ++r)
#pragma unroll
                for (int e = 0; e < 12; ++e) LG[r * 36 + pass * 12 + e] = sum64(acc[r][e]);
        }
        asm volatile("s_waitcnt lgkmcnt(0)" ::: "memory");
        if (lane < 2) { const int r = lane, row = g4 * 2 + r; const LAS float* lr = LG + r * 36;
            float gl[4];
#pragma unroll
            for (int g = 0; g < 4; ++g) gl[g] = lr[g] + bg[g];
            int gi = 0; float gm = gl[0];
#pragma unroll
            for (int g = 1; g < 4; ++g) if (gl[g] > gm) { gm = gl[g]; gi = g; }
            float gs = 0.f;
#pragma unroll
            for (int g = 0; g < 4; ++g) gs += __expf(gl[g] - gm);
            const float gp = 1.0f / gs;
            float el[8];
#pragma unroll
            for (int j = 0; j < 8; ++j) el[j] = lr[4 + gi * 8 + j] + be[gi * 8 + j];
            int i1 = 0; float m1 = el[0];
#pragma unroll
            for (int j = 1; j < 8; ++j) if (el[j] > m1) { m1 = el[j]; i1 = j; }
            int i2 = 0; float m2 = -3.0e38f;
#pragma unroll
            for (int j = 0; j < 8; ++j) if (j != i1 && el[j] > m2) { m2 = el[j]; i2 = j; }
            const float e2 = __expf(m2 - m1); const float w1 = gp / (1.0f + e2), w2 = gp * e2 / (1.0f + e2);
            const int ea = gi * 8 + i1, eb = gi * 8 + i2; EID[row * 2] = ea; EID[row * 2 + 1] = eb; WTS[row * 2] = w1; WTS[row * 2 + 1] = w2;
            __hip_atomic_fetch_add(&hist[ea], 1u, __ATOMIC_RELAXED, __HIP_MEMORY_SCOPE_WORKGROUP); __hip_atomic_fetch_add(&hist[eb], 1u, __ATOMIC_RELAXED, __HIP_MEMORY_SCOPE_WORKGROUP);
        }
        asm volatile("s_waitcnt lgkmcnt(0)" ::: "memory");
    }
    __syncthreads();
    if (tid < 32) { const unsigned c = hist[tid]; if (c) atomicAdd((unsigned*)(p.ws + WS_CTL) + CW_CNT + l * 64 + tid, c); }
    __syncthreads();
}
__device__ __forceinline__ void moe_tables(int wv, PRM p, int l, LAS int* tab, LAS int* beg) {
    if (TID == 0) { const unsigned* cnt = (const unsigned*)(p.ws + WS_CTL) + CW_CNT + l * 64; int nb = 0;
        for (int e = 0; e < NEXP; ++e) { const int c = (int)__hip_atomic_load(cnt + e, __ATOMIC_RELAXED, __HIP_MEMORY_SCOPE_AGENT); const int k = (c + 255) >> 8; beg[e] = nb; for (int j = 0; j < k; ++j) tab[1 + nb + j] = e; nb += k; }
        tab[0] = nb; }
    __syncthreads();
}
PHASE_FN void phase_moe_assign(int wv, PRM p, int l, LAS unsigned char* lds) {
    LAS int* tab = (LAS int*)(lds + LDS_TAB); LAS int* beg = tab + 320;
    moe_tables(wv, p, l, tab, beg);
    const int* EID = (const int*)(p.ws + WS_EID); int* SLOT = (int*)(p.ws + WS_SLOT); unsigned* cur = (unsigned*)(p.ws + WS_CTL) + CW_CUR + l * 64;
    const bf16_t* H = (const bf16_t*)(p.ws + WS_H); bf16_t* XB = (bf16_t*)(p.ws + WS_XB); const int lane = LANE;
    for (int a = BLK * 8 + WAVE; a < NTOK * 2; a += gridDim.x * 8) {
        const int e = EID[a]; int slot = 0;
        if (lane == 0) { const unsigned rank = atomicAdd(cur + e, 1u); slot = beg[e] * 256 + (int)rank; SLOT[a] = slot; }
        slot = __builtin_amdgcn_readfirstlane(slot);
        const u32x4* src = (const u32x4*)(H + (size_t)(a >> 1) * D); u32x4* dst = (u32x4*)(XB + (size_t)slot * D);
        dst[lane] = src[lane]; dst[lane + 64] = src[lane + 64];
    }
}
PHASE_FN void phase_ln2(int wv, PRM p, int l) {
    const float* MOD = (const float*)(p.ws + WS_MOD) + (size_t)l * 9 * 6144; const float* MODN = MOD + 9 * 6144; bf16_t* H = (bf16_t*)(p.ws + WS_H);
    const float* lg = p.in[I_LN2G] + l * 1024; const float* lb = p.in[I_LN2B] + l * 1024;
    const int* SLOT = (const int*)(p.ws + WS_SLOT); const float* WTS = (const float*)(p.ws + WS_WTS); const bf16_t* YB = (const bf16_t*)(p.ws + WS_YB); const int lane = LANE;
    for (int row = BLK * 8 + WAVE; row < NTOK; row += gridDim.x * 8) {
        float* xr = xs_row(p, row); const int mr = mod_row(row); const float* md = MOD + (size_t)mr * 6144;
        const int s0 = SLOT[row * 2], s1 = SLOT[row * 2 + 1]; const float w0 = WTS[row * 2], w1 = WTS[row * 2 + 1];
        f32x4 v[4]; float s = 0.f;
#pragma unroll
        for (int j = 0; j < 4; ++j) { const int c = j * 256 + lane * 4; const u32x2 a = *(const u32x2*)(YB + (size_t)s0 * D + c), b = *(const u32x2*)(YB + (size_t)s1 * D + c);
            f32x4 m; m[0] = w0 * bf2f(a.x & 0xffffu) + w1 * bf2f(b.x & 0xffffu); m[1] = w0 * bf2f(a.x >> 16) + w1 * bf2f(b.x >> 16);
            m[2] = w0 * bf2f(a.y & 0xffffu) + w1 * bf2f(b.y & 0xffffu); m[3] = w0 * bf2f(a.y >> 16) + w1 * bf2f(b.y >> 16);
            v[j] = *(const f32x4*)(xr + c) * DN_ALPHA + *(const f32x4*)(md + 5 * 1024 + c) * m; s += (v[j][0] + v[j][1]) + (v[j][2] + v[j][3]); }
        const float mean = sum64(s) * (1.0f / 1024.0f); float q = 0.f;
#pragma unroll
        for (int j = 0; j < 4; ++j) { const f32x4 d = v[j] - mean; q += (d[0] * d[0] + d[1] * d[1]) + (d[2] * d[2] + d[3] * d[3]); }
        const float rstd = rsqrtf(sum64(q) * (1.0f / 1024.0f) + 1e-5f);
#pragma unroll
        for (int j = 0; j < 4; ++j) { const int c = j * 256 + lane * 4; f32x4 x = (v[j] - mean) * rstd * *(const f32x4*)(lg + c) + *(const f32x4*)(lb + c);
#ifdef DBG_SANITIZE
            for (int i_ = 0; i_ < 4; ++i_) x[i_] = (x[i_] == x[i_] && fabsf(x[i_]) < 1e30f) ? x[i_] : 0.f;
#endif
            *(f32x4*)(xr + c) = x;
            if (l + 1 < DEPTH) { const float* mn = MODN + (size_t)mr * 6144; const f32x4 hh = x * (*(const f32x4*)(mn + 1024 + c) + 1.0f) + *(const f32x4*)(mn + c);
                u32x2 w; w.x = cvt_pk_bf16(hh[0], hh[1]); w.y = cvt_pk_bf16(hh[2], hh[3]); *(u32x2*)(H + (size_t)row * D + c) = w; } }
    }
}
constexpr float ATT_C2 = 0.125f * 1.4426950408889634f;
PHASE_FN void phase_prep(int wv, PRM p) {
    bf16_t* U = (bf16_t*)(p.ws + WS_U); const float* COS = (const float*)(p.ws + WS_ROPE); const float* SIN = COS + 4096 * 32; const int lane = LANE;
    for (int r = BLK * 8 + WAVE; r < NTOK; r += gridDim.x * 8) {
        const int t = r % TPB; const bool lat = t >= LCTX; const int n = t - LCTX;
        const int c0 = lane * 8, a = (c0 >> 5) & 1, jj = (c0 >> 4) & 1, pp0 = c0 & 15;
        float cs[8], sn[8];
#pragma unroll
        for (int i = 0; i < 8; ++i) { cs[i] = 1.f; sn[i] = 0.f; }
        if (lat) {
#pragma unroll
            for (int i = 0; i < 8; ++i) { cs[i] = COS[n * 32 + a * 16 + pp0 + i]; sn[i] = SIN[n * 32 + a * 16 + pp0 + i]; } }
#pragma unroll
        for (int which = 0; which < 2; ++which) {
            bf16_t* ptr = U + (size_t)r * UC + (which == 0 ? U_DF_Q : U_DF_K) + c0;
            float x[8]; unpack8(*(const u32x4*)ptr, x); float o[8];
#pragma unroll
            for (int i = 0; i < 8; ++i) { const float other = dppf<0x4E>(x[i]);
                o[i] = jj == 0 ? x[i] * cs[i] - other * sn[i] : x[i] * cs[i] + other * sn[i];
                if (which == 0) o[i] *= ATT_C2; }
            if (lat || which == 0) *(u32x4*)ptr = pack8(o);
        }
    }
}
PHASE_FN void phase_fin(int wv, PRM p, int l) {
    const bf16_t* U = (const bf16_t*)(p.ws + WS_U); bf16_t* Y = (bf16_t*)(p.ws + WS_Y); const int lane = LANE, c0 = lane * 8;
    const bf16_t* SSDY = (const bf16_t*)(p.ws + WS_SSDY); const bf16_t* RWY = (const bf16_t*)(p.ws + WS_RWY); const bf16_t* RWG = (const bf16_t*)(p.ws + WS_RWG);
    const bf16_t* GLAO = (const bf16_t*)(p.ws + WS_GLAO); const float* BD = (const float*)(p.ws + WS_RWBD);
    const float* ssd_ng = p.in[I_SSD_NG] + l * 512; const float* lnxg = p.in[I_RW_LNG] + l * 512; const float* lnxb = p.in[I_RW_LNB] + l * 512;
    const float* mu_v = p.in[I_RW_MU] + l * 1920 + 1024; const float* gla_ng = p.in[I_GLA_NG] + l * 128;
    for (int r = BLK * 8 + WAVE; r < NTOK; r += gridDim.x * 8) {
        const int t = r % TPB; const bool has_prev = (t != 0) && (t != LCTX), has_next = (t != LCTX - 1) && (t != TPB - 1);
        {
            float a[8], b[8], z[8]; unpack8(*(const u32x4*)(SSDY + (size_t)r * 512 + c0), a); unpack8(*(const u32x4*)(SSDY + ((size_t)NTOK + r) * 512 + c0), b); unpack8(*(const u32x4*)(U + (size_t)r * UC + U_SSD_Z + c0), z);
            float y[8], ss = 0.f;
#pragma unroll
            for (int i = 0; i < 8; ++i) { y[i] = (a[i] + b[i]) * siluf_(z[i]); ss += y[i] * y[i]; }
            const float rs = rsqrtf(sum32(ss) * (1.0f / 256.0f) + 1e-5f);
#pragma unroll
            for (int i = 0; i < 8; ++i) y[i] = y[i] * rs * ssd_ng[c0 + i];
            *(u32x4*)(Y + (size_t)r * 2048 + c0) = pack8(y); }
        {
            float a[8], b[8], g[8], vc[8], vp[8], vn[8]; unpack8(*(const u32x4*)(RWY + (size_t)r * 512 + c0), a); unpack8(*(const u32x4*)(RWY + ((size_t)NTOK + r) * 512 + c0), b);
            unpack8(*(const u32x4*)(RWG + (size_t)r * 512 + c0), g); unpack8(*(const u32x4*)(U + (size_t)r * UC + U_RW_V + c0), vc);
#pragma unroll
            for (int i = 0; i < 8; ++i) { vp[i] = 0.f; vn[i] = 0.f; }
            if (has_prev) unpack8(*(const u32x4*)(U + (size_t)(r - 1) * UC + U_RW_V + c0), vp);
            if (has_next) unpack8(*(const u32x4*)(U + (size_t)(r + 1) * UC + U_RW_V + c0), vn);
            const int head = lane >> 3; const float bd = BD[(size_t)r * 8 + head] + BD[((size_t)NTOK + r) * 8 + head];
            float y[8], s = 0.f;
#pragma unroll
            for (int i = 0; i < 8; ++i) { y[i] = a[i] + b[i]; s += y[i]; }
            const float mean = sum8(s) * (1.0f / 64.0f); float q = 0.f;
#pragma unroll
            for (int i = 0; i < 8; ++i) { y[i] -= mean; q += y[i] * y[i]; }
            const float rs = rsqrtf(sum8(q) * (1.0f / 64.0f) + 64e-5f);
#pragma unroll
            for (int i = 0; i < 8; ++i) { const float vm = vc[i] + mu_v[c0 + i] * (0.5f * (vp[i] + vn[i]) - vc[i]);
                y[i] = (y[i] * rs * lnxg[c0 + i] + lnxb[c0 + i] + bd * vm) * g[i]; }
            *(u32x4*)(Y + (size_t)r * 2048 + 512 + c0) = pack8(y); }
        {
            float a[8], b[8], og[8]; unpack8(*(const u32x4*)(GLAO + (size_t)r * 512 + c0), a); unpack8(*(const u32x4*)(GLAO + ((size_t)NTOK + r) * 512 + c0), b); unpack8(*(const u32x4*)(U + (size_t)r * UC + U_GLA_OG + c0), og);
            float y[8], ss = 0.f;
#pragma unroll
            for (int i = 0; i < 8; ++i) { y[i] = a[i] + b[i]; ss += y[i] * y[i]; }
            const float rs = rsqrtf(sum16(ss) * (1.0f / 128.0f) + 1e-5f);
#pragma unroll
            for (int i = 0; i < 8; ++i) y[i] = y[i] * rs * gla_ng[(c0 + i) & 127] * siluf_(og[i]);
            *(u32x4*)(Y + (size_t)r * 2048 + 1536 + c0) = pack8(y); }
    }
}
typedef short v4i16_t __attribute__((ext_vector_type(4)));
__device__ __forceinline__ s16x4 vtr(const LAS unsigned char* pp) { return __builtin_bit_cast(s16x4, __builtin_amdgcn_ds_read_tr16_b64_v4i16((LAS v4i16_t*)pp)); }
constexpr int AT_K0 = 0, AT_K1 = 9216, AT_V = 18432, AT_AL = 38912, AT_XO = 40960;
PHASE_FN void attn_unit(int wv, PRM p, LAS unsigned char* L, int qrow0, int krow0, int ntiles, int h, float lam, float outscale, const float* subg) {
    const int tid = TID, lane = tid & 63, wave = wv, m = wave >> 2, qs = wave & 3, r32 = lane & 31, hh = lane >> 5;
    const bf16_t* U = (const bf16_t*)(p.ws + WS_U); bf16_t* Y = (bf16_t*)(p.ws + WS_Y);
    const int kr = tid >> 3, kc = tid & 7;
    const bf16_t* gk = U + (size_t)(krow0 + kr) * UC + U_DF_K + h * 128 + kc * 8;
    const int vr0 = tid >> 4, vc = tid & 15;
    const bf16_t* gv = U + (size_t)(krow0 + vr0) * UC + U_DF_V + h * 128 + vc * 8;
    u32x4 rk0, rk1, rv0, rv1;
#define AT_LOAD(t) do { const size_t o_ = (size_t)(t) * 64 * UC; rk0 = *(const u32x4*)(gk + o_); rk1 = *(const u32x4*)(gk + o_ + 64); rv0 = *(const u32x4*)(gv + o_); rv1 = *(const u32x4*)(gv + o_ + (size_t)32 * UC); } while (0)
    AT_LOAD(0);
    bf16x8 qf[4];
    { const bf16_t* qp = U + (size_t)(qrow0 + qs * 32 + r32) * UC + U_DF_Q + h * 128 + m * 64 + hh * 8;
#pragma unroll
      for (int d0 = 0; d0 < 4; ++d0) qf[d0] = *(const bf16x8*)(qp + d0 * 16); }
    f32x16 o[4];
#pragma unroll
    for (int db = 0; db < 4; ++db) o[db] = (f32x16){0.f,0.f,0.f,0.f,0.f,0.f,0.f,0.f,0.f,0.f,0.f,0.f,0.f,0.f,0.f,0.f};
    float m_run = -INFINITY, l_run = 0.f;
    LAS float* AL = (LAS float*)(L + AT_AL) + wave * 32;
    const LAS unsigned char* Km = L + (m ? AT_K1 : AT_K0);
    const int i16 = lane & 15; const int vtr_off = (4 * hh + (i16 >> 2)) * 320 + (((lane >> 4) & 1) * 16 + (i16 & 3) * 4) * 2;
    for (int t = 0; t < ntiles; ++t) {
        __syncthreads();
        *(LAS u32x4*)(L + AT_K0 + (kr * 72 + kc * 8) * 2) = rk0; *(LAS u32x4*)(L + AT_K1 + (kr * 72 + kc * 8) * 2) = rk1;
        *(LAS u32x4*)(L + AT_V + vr0 * 320 + vc * 16) = rv0; *(LAS u32x4*)(L + AT_V + (vr0 + 32) * 320 + vc * 16) = rv1;
        __syncthreads();
        if (t + 1 < ntiles) AT_LOAD(t + 1);
        f32x16 p0 = (f32x16){0.f,0.f,0.f,0.f,0.f,0.f,0.f,0.f,0.f,0.f,0.f,0.f,0.f,0.f,0.f,0.f}, p1 = p0;
#pragma unroll
        for (int d0 = 0; d0 < 4; ++d0) {
            const bf16x8 k0 = *(const LAS bf16x8*)(Km + (r32 * 72 + d0 * 16 + hh * 8) * 2);
            const bf16x8 k1 = *(const LAS bf16x8*)(Km + ((r32 + 32) * 72 + d0 * 16 + hh * 8) * 2);
            p0 = __builtin_amdgcn_mfma_f32_32x32x16_bf16(k0, qf[d0], p0, 0, 0, 0);
            p1 = __builtin_amdgcn_mfma_f32_32x32x16_bf16(k1, qf[d0], p1, 0, 0, 0); }
        float mx = fmaxf(p0[0], p1[0]);
#pragma unroll
        for (int r = 1; r < 16; ++r) mx = fmaxf(mx, fmaxf(p0[r], p1[r]));
        mx = fmaxf(mx, shflx(mx, 32));
        const float m_new = fmaxf(m_run, mx); const float alpha = exp2f(m_run - m_new); m_run = m_new;
        float ps = 0.f;
#pragma unroll
        for (int r = 0; r < 16; ++r) { p0[r] = exp2f(p0[r] - m_new); p1[r] = exp2f(p1[r] - m_new); ps += p0[r] + p1[r]; }
        l_run = l_run * alpha + ps;
        if (__any(alpha != 1.0f)) {
            if (hh == 0) AL[r32] = alpha;
            asm volatile("s_waitcnt lgkmcnt(0)" ::: "memory");
#pragma unroll
            for (int g = 0; g < 4; ++g) { const f32x4 a4 = *(const LAS f32x4*)(AL + 8 * g + 4 * hh);
#pragma unroll
                for (int db = 0; db < 4; ++db) { o[db][4 * g] *= a4[0]; o[db][4 * g + 1] *= a4[1]; o[db][4 * g + 2] *= a4[2]; o[db][4 * g + 3] *= a4[3]; } }
            asm volatile("s_waitcnt lgkmcnt(0)" ::: "memory");
        }
        bf16x8 pa[4];
#pragma unroll
        for (int ks = 0; ks < 4; ++ks) { const int b0 = (ks & 1) * 8; u32x4 w;
            if (ks < 2) { w.x = cvt_pk_bf16(p0[b0], p0[b0 + 1]); w.y = cvt_pk_bf16(p0[b0 + 2], p0[b0 + 3]); w.z = cvt_pk_bf16(p0[b0 + 4], p0[b0 + 5]); w.w = cvt_pk_bf16(p0[b0 + 6], p0[b0 + 7]); }
            else { w.x = cvt_pk_bf16(p1[b0], p1[b0 + 1]); w.y = cvt_pk_bf16(p1[b0 + 2], p1[b0 + 3]); w.z = cvt_pk_bf16(p1[b0 + 4], p1[b0 + 5]); w.w = cvt_pk_bf16(p1[b0 + 6], p1[b0 + 7]); }
            pa[ks] = __builtin_bit_cast(bf16x8, w); }
#pragma unroll
        for (int db = 0; db < 4; ++db)
#pragma unroll
            for (int ks = 0; ks < 4; ++ks) { const LAS unsigned char* vb = L + AT_V + vtr_off + ks * 16 * 320 + db * 64;
                const s16x4 lo = vtr(vb), hi = vtr(vb + 8 * 320);
                const bf16x8 vf = (bf16x8){lo[0], lo[1], lo[2], lo[3], hi[0], hi[1], hi[2], hi[3]};
                o[db] = __builtin_amdgcn_mfma_f32_32x32x16_bf16(pa[ks], vf, o[db], 0, 0, 0); }
    }
#undef AT_LOAD
    const float ltot = l_run + shflx(l_run, 32);
    if (hh == 0) AL[r32] = (m ? lam : 1.0f) / ltot;
    asm volatile("s_waitcnt lgkmcnt(0)" ::: "memory");
    float sc[16];
#pragma unroll
    for (int g = 0; g < 4; ++g) { const f32x4 a4 = *(const LAS f32x4*)(AL + 8 * g + 4 * hh); sc[4 * g] = a4[0]; sc[4 * g + 1] = a4[1]; sc[4 * g + 2] = a4[2]; sc[4 * g + 3] = a4[3]; }
    LAS float* XO = (LAS float*)(L + AT_XO);
    if (m == 1) {
#pragma unroll
        for (int r = 0; r < 16; ++r) { const int q = qs * 32 + (r & 3) + 8 * (r >> 2) + 4 * hh;
#pragma unroll
            for (int db = 0; db < 4; ++db) XO[q * 128 + db * 32 + r32] = o[db][r] * sc[r]; } }
    __syncthreads();
    if (m == 0) {
#pragma unroll
        for (int r = 0; r < 16; ++r) { const int q = qs * 32 + (r & 3) + 8 * (r >> 2) + 4 * hh; float ss = 0.f;
#pragma unroll
            for (int db = 0; db < 4; ++db) { const float v = o[db][r] * sc[r] - XO[q * 128 + db * 32 + r32]; o[db][r] = v; ss += v * v; }
            const float rs = rsqrtf(sum32(ss) * (1.0f / 128.0f) + 1e-5f) * outscale;
            bf16_t* yp = Y + (size_t)(qrow0 + q) * 2048 + 1024 + h * 128 + r32;
#pragma unroll
            for (int db = 0; db < 4; ++db) yp[db * 32] = f2bf(o[db][r] * rs * subg[db * 32 + r32]); } }
}
struct ChunkPos { int rowbase, t_lo, seglen; };
__device__ __forceinline__ ChunkPos chunk_pos(int b, int d, int ci) { ChunkPos c; const bool isctx = ci < 8; const int cl = isctx ? ci : ci - 8; c.seglen = isctx ? LCTX : LAT;
    c.rowbase = b * TPB + (isctx ? 0 : LCTX); c.t_lo = d == 0 ? cl * 32 : c.seglen - 32 * (cl + 1); return c; }
constexpr int NCHUNK = TPB / 32;

PHASE_FN void rwkv_chain(int wv, PRM p, int l, LAS unsigned char* L, int d, int b, int h) {
    const int tid = TID, lane = tid & 63, wave = wv, r32 = lane & 31, hh = lane >> 5;
    LAS bf16_t* RAW = (LAS bf16_t*)(L + 0);
    LAS bf16_t* TW = (LAS bf16_t*)(L + 30464);
    LAS bf16_t* TA = (LAS bf16_t*)(L + 35072);
    LAS bf16_t* TG = (LAS bf16_t*)(L + 39680);
    LAS float* R_ = (LAS float*)(L + 49152); LAS float* KT = R_ + 2048; LAS float* V_ = KT + 2048; LAS float* W_ = V_ + 2048; LAS float* AA = W_ + 2048;
    LAS float* KK = AA + 2048; LAS float* KKA = KK + 2048; LAS float* KD = KKA + 2048; LAS float* YO = KD + 2048;
    LAS float* MU = YO + 2048;
    LAS float* CW0 = MU + 448; LAS float* CA0 = CW0 + 64; LAS float* CKK = CA0 + 64; LAS float* CKA = CKK + 64; LAS float* CRK = CKA + 64;
    const bf16_t* U = (const bf16_t*)(p.ws + WS_U);
    bf16_t* RWY = (bf16_t*)(p.ws + WS_RWY) + (size_t)d * NTOK * 512; bf16_t* RWG = (bf16_t*)(p.ws + WS_RWG); float* BD = (float*)(p.ws + WS_RWBD) + (size_t)d * NTOK * 8;
    __syncthreads();
    if (tid < 448) { const int cc = tid; int gc;
        if (cc < 192) gc = (cc >> 6) * 512 + h * 64 + (cc & 63); else if (cc < 256) gc = 1536 + d * 64 + (cc - 192); else if (cc < 320) gc = 1664 + d * 64 + (cc - 256); else gc = 1792 + (cc - 320);
        MU[cc] = p.in[I_RW_MU][l * 1920 + gc]; }
    if (tid < 64) { const int c = h * 64 + tid; CW0[tid] = p.in[I_RW_W0][(l * 2 + d) * 512 + c]; CA0[tid] = p.in[I_RW_A0][(l * 2 + d) * 512 + c];
        CKK[tid] = p.in[I_RW_KK][l * 512 + c]; CKA[tid] = p.in[I_RW_KA][l * 512 + c]; CRK[tid] = p.in[I_RW_RK][l * 512 + c]; }
    bf16x8 Bf[8];
    if (wave < 4) {
#pragma unroll
        for (int f = 0; f < 8; ++f) { float v[8];
#pragma unroll
            for (int j = 0; j < 8; ++j) { float x;
                if (wave < 2) { const int cb = f >> 2, ks = f & 3, k = ks * 16 + hh * 8 + j; const float* w = wave == 0 ? p.in[I_RW_WUP] : p.in[I_RW_AUP]; x = w[((size_t)(l * 2 + d) * 64 + k) * 512 + h * 64 + cb * 32 + r32]; }
                else { const int cb = wave - 2, k = f * 16 + hh * 8 + j; x = p.in[I_RW_GUP][((size_t)l * 128 + k) * 512 + h * 64 + cb * 32 + r32]; }
                v[j] = x; }
            Bf[f] = __builtin_bit_cast(bf16x8, pack8(v)); } }
    const int vl = lane >> 4, kq = lane & 15; float S[2][4];
#pragma unroll
    for (int i = 0; i < 2; ++i)
#pragma unroll
        for (int j = 0; j < 4; ++j) S[i][j] = 0.f;
    u32x4 rawreg[4];
#define RW_RAW_LOAD(cpx) do { _Pragma("unroll") for (int it = 0; it < 4; ++it) { const int idx = tid + it * NTHR; u32x4 v = (u32x4){0u, 0u, 0u, 0u}; \
        if (idx < 34 * 56) { const int row = idx / 56, ch = idx - row * 56; const int t = (cpx).t_lo - 1 + row; \
            int gcol; if (ch < 24) gcol = U_RW_R + (ch >> 3) * 512 + h * 64 + (ch & 7) * 8; else if (ch < 32) gcol = U_RW_WD + d * 64 + (ch - 24) * 8; else if (ch < 40) gcol = U_RW_AD + d * 64 + (ch - 32) * 8; else gcol = U_RW_GD + (ch - 40) * 8; \
            if (t >= 0 && t < (cpx).seglen) v = *(const u32x4*)(U + (size_t)((cpx).rowbase + t) * UC + gcol); } \
        rawreg[it] = v; } } while (0)
    { const ChunkPos cp0 = chunk_pos(b, d, 0); RW_RAW_LOAD(cp0); }
    for (int ci = 0; ci < NCHUNK; ++ci) {
        const ChunkPos cp = chunk_pos(b, d, ci);
        __syncthreads();
#pragma unroll
        for (int it = 0; it < 4; ++it) { const int idx = tid + it * NTHR; if (idx < 34 * 56) { const int row = idx / 56, ch = idx - row * 56; *(LAS u32x4*)(RAW + row * 448 + ch * 8) = rawreg[it]; } }
        __syncthreads();
        for (int idx = tid; idx < 32 * 56; idx += NTHR) { const int s = idx / 56, ch = idx - s * 56, cc = ch * 8;
            float c0[8], pv[8], nx[8], mx[8];
            unpack8(*(const LAS u32x4*)(RAW + (s + 1) * 448 + cc), c0); unpack8(*(const LAS u32x4*)(RAW + s * 448 + cc), pv); unpack8(*(const LAS u32x4*)(RAW + (s + 2) * 448 + cc), nx);
            const f32x4 m0 = *(const LAS f32x4*)(MU + cc), m1 = *(const LAS f32x4*)(MU + cc + 4);
#pragma unroll
            for (int j = 0; j < 8; ++j) { const float mu = j < 4 ? m0[j] : m1[j - 4]; mx[j] = c0[j] + mu * (0.5f * (pv[j] + nx[j]) - c0[j]); }
            if (ch < 24) { LAS float* dst = (ch < 8 ? R_ : (ch < 16 ? KT : V_)) + s * 64 + (cc & 63);
                *(LAS f32x4*)dst = (f32x4){mx[0], mx[1], mx[2], mx[3]}; *(LAS f32x4*)(dst + 4) = (f32x4){mx[4], mx[5], mx[6], mx[7]}; }
            else if (ch < 32) {
#pragma unroll
                for (int j = 0; j < 8; ++j) mx[j] = tanh_fast(mx[j]);
                *(LAS u32x4*)(TW + s * 72 + cc - 192) = pack8(mx); }
            else if (ch < 40) *(LAS u32x4*)(TA + s * 72 + cc - 256) = pack8(mx);
            else {
#pragma unroll
                for (int j = 0; j < 8; ++j) mx[j] = sigmoidf_(mx[j]);
                *(LAS u32x4*)(TG + s * 136 + cc - 320) = pack8(mx); } }
        __syncthreads();
        if (wave < 2) {
#pragma unroll
            for (int cb = 0; cb < 2; ++cb) { f32x16 acc = (f32x16){0.f,0.f,0.f,0.f,0.f,0.f,0.f,0.f,0.f,0.f,0.f,0.f,0.f,0.f,0.f,0.f};
#pragma unroll
                for (int ks = 0; ks < 4; ++ks) { const bf16x8 a = *(const LAS bf16x8*)((wave == 0 ? TW : TA) + r32 * 72 + ks * 16 + hh * 8); acc = __builtin_amdgcn_mfma_f32_32x32x16_bf16(a, Bf[cb * 4 + ks], acc, 0, 0, 0); }
                const int c = cb * 32 + r32;
#pragma unroll
                for (int r = 0; r < 16; ++r) { const int s = (r & 3) + 8 * (r >> 2) + 4 * hh;
                    if (wave == 0) W_[s * 64 + c] = acc[r]; else AA[s * 64 + c] = acc[r]; } } }
        else if (wave < 4 && d == 0) { const int cb = wave - 2; f32x16 acc = (f32x16){0.f,0.f,0.f,0.f,0.f,0.f,0.f,0.f,0.f,0.f,0.f,0.f,0.f,0.f,0.f,0.f};
#pragma unroll
            for (int ks = 0; ks < 8; ++ks) { const bf16x8 a = *(const LAS bf16x8*)(TG + r32 * 136 + ks * 16 + hh * 8); acc = __builtin_amdgcn_mfma_f32_32x32x16_bf16(a, Bf[ks], acc, 0, 0, 0); }
#pragma unroll
            for (int r = 0; r < 16; ++r) { const int s = (r & 3) + 8 * (r >> 2) + 4 * hh; RWG[(size_t)(cp.rowbase + cp.t_lo + s) * 512 + h * 64 + cb * 32 + r32] = f2bf(acc[r]); } }
        __syncthreads();
        { const int s = tid >> 4, c4 = (tid & 15) * 4; float kkv[4], ssq = 0.f, bdp = 0.f, av[4], kt[4];
#pragma unroll
            for (int j = 0; j < 4; ++j) { const int c = c4 + j; kt[j] = KT[s * 64 + c]; av[j] = sigmoidf_(CA0[c] + AA[s * 64 + c]); kkv[j] = kt[j] * CKK[c]; ssq += kkv[j] * kkv[j];
                const float wl = -softplus_fast(-(CW0[c] + W_[s * 64 + c])) - 0.5f; W_[s * 64 + c] = __expf(-__expf(wl)); }
            const float inv = rsqrtf(sum16(ssq) + 1e-12f);
#pragma unroll
            for (int j = 0; j < 4; ++j) { const int c = c4 + j; const float kn = kkv[j] * inv; KK[s * 64 + c] = -kn; KKA[s * 64 + c] = kn * av[j];
                const float kd = kt[j] * (1.0f + (av[j] - 1.0f) * CKA[c]); KD[s * 64 + c] = kd; bdp += R_[s * 64 + c] * kd * CRK[c]; }
            bdp = sum16(bdp); if ((tid & 15) == 0) BD[(size_t)(cp.rowbase + cp.t_lo + s) * 8 + h] = bdp; }
        __syncthreads();
        if (ci + 1 < NCHUNK) { const ChunkPos cpn = chunk_pos(b, d, ci + 1); RW_RAW_LOAD(cpn); }
        { const int sm0 = d ? 31 : 0;
          f32x4 w4 = *(const LAS f32x4*)(W_ + sm0 * 64 + 4 * kq), k4 = *(const LAS f32x4*)(KK + sm0 * 64 + 4 * kq), ka4 = *(const LAS f32x4*)(KKA + sm0 * 64 + 4 * kq),
                kd4 = *(const LAS f32x4*)(KD + sm0 * 64 + 4 * kq), r4 = *(const LAS f32x4*)(R_ + sm0 * 64 + 4 * kq);
          f32x2 v2 = *(const LAS f32x2*)(V_ + sm0 * 64 + 8 * wave + 2 * vl);
#pragma unroll 2
          for (int st = 0; st < 32; ++st) { const int sm = d ? 31 - st : st; const int sn = d ? (st < 31 ? 30 - st : 0) : (st < 31 ? st + 1 : 31);
            const f32x4 w4n = *(const LAS f32x4*)(W_ + sn * 64 + 4 * kq), k4n = *(const LAS f32x4*)(KK + sn * 64 + 4 * kq), ka4n = *(const LAS f32x4*)(KKA + sn * 64 + 4 * kq),
                        kd4n = *(const LAS f32x4*)(KD + sn * 64 + 4 * kq), r4n = *(const LAS f32x4*)(R_ + sn * 64 + 4 * kq);
            const f32x2 v2n = *(const LAS f32x2*)(V_ + sn * 64 + 8 * wave + 2 * vl);
            float y[2];
#pragma unroll
            for (int i = 0; i < 2; ++i) { float sa = (S[i][0] * k4[0] + S[i][1] * k4[1]) + (S[i][2] * k4[2] + S[i][3] * k4[3]); sa = sum16(sa);
#pragma unroll
                for (int j = 0; j < 4; ++j) S[i][j] = S[i][j] * w4[j] + sa * ka4[j] + v2[i] * kd4[j];
                y[i] = sum16((S[i][0] * r4[0] + S[i][1] * r4[1]) + (S[i][2] * r4[2] + S[i][3] * r4[3])); }
            if (kq == 0) *(LAS f32x2*)(YO + sm * 64 + 8 * wave + 2 * vl) = (f32x2){y[0], y[1]};
            w4 = w4n; k4 = k4n; ka4 = ka4n; kd4 = kd4n; r4 = r4n; v2 = v2n; } }
        __syncthreads();
        { const int s = tid >> 4, v4 = (tid & 15) * 4; const f32x4 y = *(const LAS f32x4*)(YO + s * 64 + v4); u32x2 w; w.x = cvt_pk_bf16(y[0], y[1]); w.y = cvt_pk_bf16(y[2], y[3]);
            *(u32x2*)(RWY + (size_t)(cp.rowbase + cp.t_lo + s) * 512 + h * 64 + v4) = w; }
    }
}

constexpr int SD_RAW = 0, SD_BM = 42240, SD_CM = 59648, SD_XM = 77056, SD_XST = 86272, SD_H0 = 95488, SD_CUM = 130304, SD_DTC = 130560, SD_LA = 130816, SD_CW = 131072, SD_CB = 134912;
constexpr int SD_LDB = 272, SD_LDX = 144;
struct ChunkPos64 { int rowbase, t_lo, seglen; };
__device__ __forceinline__ ChunkPos64 chunk_pos64(int b, int d, int ci) { ChunkPos64 c; const bool isctx = ci < 4; const int cl = isctx ? ci : ci - 4; c.seglen = isctx ? LCTX : LAT;
    c.rowbase = b * TPB + (isctx ? 0 : LCTX); c.t_lo = d == 0 ? cl * 64 : c.seglen - 64 * (cl + 1); return c; }
PHASE_FN void ssd_chain(int wv, PRM p, int l, LAS unsigned char* L, int d, int b, int h) {
    const int tid = TID, lane = tid & 63, wave = wv, r32 = lane & 31, hh = lane >> 5, g = h >> 2;
    LAS bf16_t* RAW = (LAS bf16_t*)(L + SD_RAW);
    LAS float* CUM = (LAS float*)(L + SD_CUM); LAS float* DTC = (LAS float*)(L + SD_DTC); LAS float* LA = (LAS float*)(L + SD_LA);
    LAS float* CWt = (LAS float*)(L + SD_CW); LAS float* CBs = (LAS float*)(L + SD_CB);
    const bf16_t* U = (const bf16_t*)(p.ws + WS_U); bf16_t* SSDY = (bf16_t*)(p.ws + WS_SSDY) + (size_t)d * NTOK * 512;
    __syncthreads();
    if (tid < 320) { const int cc = tid; const int ch = cc < 64 ? h * 64 + cc : (cc < 192 ? 512 + g * 128 + (cc - 64) : 768 + g * 128 + (cc - 192));
#pragma unroll
        for (int j = 0; j < 3; ++j) CWt[j * 320 + cc] = p.in[I_SSD_CW][((size_t)l * 3 + j) * 1024 + ch];
        CBs[cc] = p.in[I_SSD_CB][l * 1024 + ch]; }
    for (int i = tid; i < 64 * SD_LDB / 4; i += NTHR) ((LAS unsigned*)(L + SD_H0))[i] = 0u;
    const float Aneg = -__expf(p.in[I_SSD_ALOG][(l * 2 + d) * 8 + h]), dtb = p.in[I_SSD_DTB][(l * 2 + d) * 8 + h], Dh = p.in[I_SSD_D][l * 8 + h];
    f32x16 hst[2];
    hst[0] = (f32x16){0.f,0.f,0.f,0.f,0.f,0.f,0.f,0.f,0.f,0.f,0.f,0.f,0.f,0.f,0.f,0.f}; hst[1] = hst[0];
    u32x4 rawreg[6]; float dtreg = 0.f;
#define SD_LOAD(cpx) do { _Pragma("unroll") for (int it = 0; it < 6; ++it) { const int idx = tid + it * NTHR; u32x4 v = (u32x4){0u, 0u, 0u, 0u}; \
        if (idx < 66 * 40) { const int row = idx / 40, ch = idx - row * 40; const int t = (cpx).t_lo - 1 + row; \
            const int gcol = ch < 8 ? U_SSD_X + h * 64 + ch * 8 : (ch < 24 ? U_SSD_B + g * 128 + (ch - 8) * 8 : U_SSD_C + g * 128 + (ch - 24) * 8); \
            if (t >= 0 && t < (cpx).seglen) v = *(const u32x4*)(U + (size_t)((cpx).rowbase + t) * UC + gcol); } \
        rawreg[it] = v; } \
        if (tid < 64) { const int sm = d ? 63 - tid : tid; dtreg = bf2f(U[(size_t)((cpx).rowbase + (cpx).t_lo + sm) * UC + U_SSD_DT + h]); } } while (0)
    { const ChunkPos64 c0 = chunk_pos64(b, d, 0); SD_LOAD(c0); }
    const int i16 = lane & 15; const int troff = (4 * hh + (i16 >> 2)), trcol = (((lane >> 4) & 1) * 16 + (i16 & 3) * 4) * 2;
    for (int ci = 0; ci < 68; ++ci) {
        const ChunkPos64 cp = chunk_pos64(b, d, ci);
        LAS unsigned char* H0c = L + SD_H0 + (ci & 1) * 64 * SD_LDB; LAS unsigned char* H0n = L + SD_H0 + ((ci + 1) & 1) * 64 * SD_LDB;
        __syncthreads();
#pragma unroll
        for (int it = 0; it < 6; ++it) { const int idx = tid + it * NTHR; if (idx < 66 * 40) { const int row = idx / 40, ch = idx - row * 40; *(LAS u32x4*)(RAW + row * 320 + ch * 8) = rawreg[it]; } }
        if (tid < 64) { const float dtc = softplus_fast(dtreg + dtb); DTC[tid] = dtc; LA[tid] = dtc * Aneg; }
        __syncthreads();
        if (ci + 1 < 68) { const ChunkPos64 cn = chunk_pos64(b, d, ci + 1); SD_LOAD(cn); }
        for (int idx = tid; idx < 64 * 40; idx += NTHR) { const int sm = idx / 40, ch = idx - sm * 40, cc = ch * 8; const int i = d ? 63 - sm : sm;
            float a0[8], a1[8], a2[8], o[8]; unpack8(*(const LAS u32x4*)(RAW + sm * 320 + cc), a0); unpack8(*(const LAS u32x4*)(RAW + (sm + 1) * 320 + cc), a1); unpack8(*(const LAS u32x4*)(RAW + (sm + 2) * 320 + cc), a2);
#pragma unroll
            for (int q = 0; q < 8; ++q) o[q] = siluf_(CBs[cc + q] + CWt[cc + q] * a0[q] + CWt[320 + cc + q] * a1[q] + CWt[640 + cc + q] * a2[q]);
            LAS unsigned char* dst = ch < 8 ? L + SD_XM + i * SD_LDX + cc * 2 : (ch < 24 ? L + SD_BM + i * SD_LDB + (cc - 64) * 2 : L + SD_CM + i * SD_LDB + (cc - 192) * 2);
            *(LAS u32x4*)dst = pack8(o); }
        if (tid < 64) { float s = 0.f; for (int j = 0; j <= tid; ++j) s += LA[j]; CUM[tid] = s; }
        __syncthreads();
        { const int j = tid >> 3, pc = tid & 7; float x[8]; unpack8(*(const LAS u32x4*)(L + SD_XM + j * SD_LDX + pc * 16), x); const float f = __expf(CUM[63] - CUM[j]) * DTC[j];
#pragma unroll
            for (int q = 0; q < 8; ++q) *(LAS bf16_t*)(L + SD_XST + (pc * 8 + q) * SD_LDX + j * 2) = f2bf(x[q] * f); }
        __syncthreads();
        if (wave < 4) {
            const int ib = wave >> 1, pb = wave & 1;
            f32x16 accy = (f32x16){0.f,0.f,0.f,0.f,0.f,0.f,0.f,0.f,0.f,0.f,0.f,0.f,0.f,0.f,0.f,0.f};
            const float cum_i = CUM[32 * ib + r32];
            for (int jb = 0; jb <= ib; ++jb) {
                f32x16 st = (f32x16){0.f,0.f,0.f,0.f,0.f,0.f,0.f,0.f,0.f,0.f,0.f,0.f,0.f,0.f,0.f,0.f};
#pragma unroll
                for (int ks = 0; ks < 8; ++ks) { const bf16x8 a = *(const LAS bf16x8*)(L + SD_BM + (32 * jb + r32) * SD_LDB + (ks * 16 + hh * 8) * 2);
                    const bf16x8 bq = *(const LAS bf16x8*)(L + SD_CM + (32 * ib + r32) * SD_LDB + (ks * 16 + hh * 8) * 2); st = __builtin_amdgcn_mfma_f32_32x32x16_bf16(a, bq, st, 0, 0, 0); }
                float pv[16];
#pragma unroll
                for (int g4 = 0; g4 < 4; ++g4) { const f32x4 cj = *(const LAS f32x4*)(CUM + 32 * jb + 8 * g4 + 4 * hh), dj = *(const LAS f32x4*)(DTC + 32 * jb + 8 * g4 + 4 * hh);
#pragma unroll
                    for (int q = 0; q < 4; ++q) { const int jl = 8 * g4 + 4 * hh + q; const bool dead = (jb == ib) && (jl > r32); pv[4 * g4 + q] = dead ? 0.f : st[4 * g4 + q] * __expf(cum_i - cj[q]) * dj[q]; } }
#pragma unroll
                for (int ks = 0; ks < 2; ++ks) { float t8[8];
#pragma unroll
                    for (int q = 0; q < 8; ++q) t8[q] = pv[8 * ks + q];
                    const bf16x8 pa = __builtin_bit_cast(bf16x8, pack8(t8));
                    const LAS unsigned char* vb = L + SD_XM + (32 * jb + 16 * ks + troff) * SD_LDX + pb * 64 + trcol;
                    const s16x4 lo = vtr(vb), hi = vtr(vb + 8 * SD_LDX); const bf16x8 vf = (bf16x8){lo[0], lo[1], lo[2], lo[3], hi[0], hi[1], hi[2], hi[3]};
                    accy = __builtin_amdgcn_mfma_f32_32x32x16_bf16(pa, vf, accy, 0, 0, 0); }
            }
            f32x16 acc2 = (f32x16){0.f,0.f,0.f,0.f,0.f,0.f,0.f,0.f,0.f,0.f,0.f,0.f,0.f,0.f,0.f,0.f};
#pragma unroll
            for (int ks = 0; ks < 8; ++ks) { const bf16x8 a = *(const LAS bf16x8*)(L + SD_CM + (32 * ib + r32) * SD_LDB + (ks * 16 + hh * 8) * 2);
                const bf16x8 bq = *(const LAS bf16x8*)(H0c + (32 * pb + r32) * SD_LDB + (ks * 16 + hh * 8) * 2); acc2 = __builtin_amdgcn_mfma_f32_32x32x16_bf16(a, bq, acc2, 0, 0, 0); }
#pragma unroll
            for (int r = 0; r < 16; ++r) { const int il = (r & 3) + 8 * (r >> 2) + 4 * hh, i = 32 * ib + il; float y = accy[r] + __expf(CUM[i]) * acc2[r];
                if (d == 0) y += Dh * bf2f(*(const LAS bf16_t*)(L + SD_XM + i * SD_LDX + (32 * pb + r32) * 2));
                const int sm = d ? 63 - i : i; SSDY[(size_t)(cp.rowbase + cp.t_lo + sm) * 512 + h * 64 + 32 * pb + r32] = f2bf(y); }
        } else {
            const float e_last = __expf(CUM[63]);
#pragma unroll
            for (int tt = 0; tt < 2; ++tt) { const int t = 2 * (wave - 4) + tt, pb = t & 1, nb = t >> 1;
                hst[tt] = hst[tt] * e_last;
#pragma unroll
                for (int ks = 0; ks < 4; ++ks) { const bf16x8 a = *(const LAS bf16x8*)(L + SD_XST + (32 * pb + r32) * SD_LDX + (ks * 16 + hh * 8) * 2);
                    const LAS unsigned char* vb = L + SD_BM + (16 * ks + 8 * hh + (i16 >> 2)) * SD_LDB + nb * 64 + trcol;
                    const s16x4 lo = vtr(vb), hi = vtr(vb + 4 * SD_LDB); const bf16x8 vf = (bf16x8){lo[0], lo[1], lo[2], lo[3], hi[0], hi[1], hi[2], hi[3]};
                    hst[tt] = __builtin_amdgcn_mfma_f32_32x32x16_bf16(a, vf, hst[tt], 0, 0, 0); }
#pragma unroll
                for (int r = 0; r < 16; ++r) { const int pl = (r & 3) + 8 * (r >> 2) + 4 * hh; *(LAS bf16_t*)(H0n + (32 * pb + pl) * SD_LDB + (32 * nb + r32) * 2) = f2bf(hst[tt][r]); } }
        }
    }
#undef SD_LOAD
}
constexpr int GL_RAW = 0, GL_GC = 34816, GL_SEG = 51200, GL_QP = 53248, GL_KP = 62464, GL_QE = 71680, GL_K2T = 80896, GL_V = 90112, GL_S0T = 107520, GL_EL = 144384, GL_GUP = 144640, GL_GB = 148736;
PHASE_FN void gla_chain(int wv, PRM p, int l, LAS unsigned char* L, int d, int b, int h) {
    const int tid = TID, lane = tid & 63, wave = wv, r32 = lane & 31, hh = lane >> 5;
    LAS bf16_t* RAW = (LAS bf16_t*)(L + GL_RAW);
    LAS float* GC = (LAS float*)(L + GL_GC); LAS float* SEG = (LAS float*)(L + GL_SEG); LAS float* EL = (LAS float*)(L + GL_EL); LAS float* GUP = (LAS float*)(L + GL_GUP); LAS float* GB = (LAS float*)(L + GL_GB);
    const bf16_t* U = (const bf16_t*)(p.ws + WS_U); bf16_t* GLAO = (bf16_t*)(p.ws + WS_GLAO) + (size_t)d * NTOK * 512;
    __syncthreads();
    for (int i = tid; i < 1024; i += NTHR) GUP[i] = p.in[I_GLA_GUP][((size_t)(l * 2 + d) * 16 + (i >> 6)) * 256 + h * 64 + (i & 63)];
    if (tid < 64) GB[tid] = p.in[I_GLA_GB][(l * 2 + d) * 256 + h * 64 + tid];
    for (int i = tid; i < 128 * SD_LDX / 4; i += NTHR) ((LAS unsigned*)(L + GL_S0T))[i] = 0u;
    f32x16 sst[2]; sst[0] = (f32x16){0.f,0.f,0.f,0.f,0.f,0.f,0.f,0.f,0.f,0.f,0.f,0.f,0.f,0.f,0.f,0.f}; sst[1] = sst[0];
    u32x4 rawreg[5];
#define GL_LOAD(cpx) do { _Pragma("unroll") for (int it = 0; it < 5; ++it) { const int idx = tid + it * NTHR; u32x4 v = (u32x4){0u, 0u, 0u, 0u}; \
        if (idx < 64 * 34) { const int row = idx / 34, ch = idx - row * 34; \
            const int gcol = ch < 8 ? U_GLA_Q + h * 64 + ch * 8 : (ch < 16 ? U_GLA_K + h * 64 + (ch - 8) * 8 : (ch < 32 ? U_GLA_V + h * 128 + (ch - 16) * 8 : U_GLA_GD + d * 16 + (ch - 32) * 8)); \
            v = *(const u32x4*)(U + (size_t)((cpx).rowbase + (cpx).t_lo + row) * UC + gcol); } \
        rawreg[it] = v; } } while (0)
    { const ChunkPos64 c0 = chunk_pos64(b, d, 0); GL_LOAD(c0); }
    const int i16 = lane & 15, q4 = i16 >> 2; const int trcol = (((lane >> 4) & 1) * 16 + (i16 & 3) * 4) * 2;
    for (int ci = 0; ci < 68; ++ci) {
        const ChunkPos64 cp = chunk_pos64(b, d, ci);
        LAS unsigned char* S0c = L + GL_S0T + (ci & 1) * 128 * SD_LDX; LAS unsigned char* S0n = L + GL_S0T + ((ci + 1) & 1) * 128 * SD_LDX;
        __syncthreads();
#pragma unroll
        for (int it = 0; it < 5; ++it) { const int idx = tid + it * NTHR; if (idx < 64 * 34) { const int row = idx / 34, ch = idx - row * 34; *(LAS u32x4*)(RAW + row * 272 + ch * 8) = rawreg[it]; } }
        __syncthreads();
        if (ci + 1 < 68) { const ChunkPos64 cn = chunk_pos64(b, d, ci + 1); GL_LOAD(cn); }
        for (int idx = tid; idx < 64 * 64; idx += NTHR) { const int i = idx >> 6, k = idx & 63; const int sm = d ? 63 - i : i; float gt = GB[k];
#pragma unroll
            for (int r = 0; r < 16; ++r) gt += bf2f(RAW[sm * 272 + 256 + r]) * GUP[r * 64 + k];
            GC[idx] = -softplus_fast(-gt) * (1.0f / 16.0f); }
        __syncthreads();
        { const int k = tid & 63, seg = tid >> 6; float run = 0.f;
#pragma unroll
            for (int ii = 0; ii < 8; ++ii) { run += GC[(seg * 8 + ii) * 64 + k]; GC[(seg * 8 + ii) * 64 + k] = run; }
            SEG[seg * 64 + k] = run;
            __syncthreads();
            float pre = 0.f; for (int s2 = 0; s2 < seg; ++s2) pre += SEG[s2 * 64 + k];
#pragma unroll
            for (int ii = 0; ii < 8; ++ii) GC[(seg * 8 + ii) * 64 + k] += pre; }
        __syncthreads();
        { const int i = tid >> 3, kc = tid & 7; const int sm = d ? 63 - i : i; float q8[8], k8[8];
            unpack8(*(const LAS u32x4*)(RAW + sm * 272 + kc * 8), q8); unpack8(*(const LAS u32x4*)(RAW + sm * 272 + 64 + kc * 8), k8);
            float qp[8], kp[8], qe[8];
#pragma unroll
            for (int q = 0; q < 8; ++q) { const int k = kc * 8 + q; const float gci = GC[i * 64 + k], gref = GC[32 * 64 + k], gl = GC[63 * 64 + k];
                const float qs = q8[q] * 0.125f; qp[q] = qs * __expf(gci - gref); kp[q] = k8[q] * __expf(gref - gci); qe[q] = qs * __expf(gci);
                *(LAS bf16_t*)(L + GL_K2T + k * SD_LDX + i * 2) = f2bf(k8[q] * __expf(gl - gci)); }
            *(LAS u32x4*)(L + GL_QP + i * SD_LDX + kc * 16) = pack8(qp); *(LAS u32x4*)(L + GL_KP + i * SD_LDX + kc * 16) = pack8(kp); *(LAS u32x4*)(L + GL_QE + i * SD_LDX + kc * 16) = pack8(qe); }
        for (int idx = tid; idx < 64 * 16; idx += NTHR) { const int i = idx >> 4, vc = idx & 15; const int sm = d ? 63 - i : i; *(LAS u32x4*)(L + GL_V + i * SD_LDB + vc * 16) = *(const LAS u32x4*)(RAW + sm * 272 + 128 + vc * 8); }
        if (tid < 64) EL[tid] = __expf(GC[63 * 64 + tid]);
        __syncthreads();
        if (wave < 4) {
            const int ib = wave >> 1, eh = wave & 1;
            f32x16 acc[2]; acc[0] = (f32x16){0.f,0.f,0.f,0.f,0.f,0.f,0.f,0.f,0.f,0.f,0.f,0.f,0.f,0.f,0.f,0.f}; acc[1] = acc[0];
            for (int jb = 0; jb <= ib; ++jb) {
                f32x16 at = (f32x16){0.f,0.f,0.f,0.f,0.f,0.f,0.f,0.f,0.f,0.f,0.f,0.f,0.f,0.f,0.f,0.f};
#pragma unroll
                for (int ks = 0; ks < 4; ++ks) { const bf16x8 a = *(const LAS bf16x8*)(L + GL_KP + (32 * jb + r32) * SD_LDX + (ks * 16 + hh * 8) * 2);
                    const bf16x8 bq = *(const LAS bf16x8*)(L + GL_QP + (32 * ib + r32) * SD_LDX + (ks * 16 + hh * 8) * 2); at = __builtin_amdgcn_mfma_f32_32x32x16_bf16(a, bq, at, 0, 0, 0); }
#pragma unroll
                for (int ks = 0; ks < 2; ++ks) { float t8[8];
#pragma unroll
                    for (int q = 0; q < 8; ++q) { const int r = 8 * ks + q; const int jl = (r & 3) + 8 * (r >> 2) + 4 * hh; t8[q] = ((jb == ib) && (jl > r32)) ? 0.f : at[r]; }
                    const bf16x8 pa = __builtin_bit_cast(bf16x8, pack8(t8));
#pragma unroll
                    for (int ebi = 0; ebi < 2; ++ebi) { const LAS unsigned char* vb = L + GL_V + (32 * jb + 16 * ks + 4 * hh + q4) * SD_LDB + (2 * eh + ebi) * 64 + trcol;
                        const s16x4 lo = vtr(vb), hi = vtr(vb + 8 * SD_LDB); const bf16x8 vf = (bf16x8){lo[0], lo[1], lo[2], lo[3], hi[0], hi[1], hi[2], hi[3]};
                        acc[ebi] = __builtin_amdgcn_mfma_f32_32x32x16_bf16(pa, vf, acc[ebi], 0, 0, 0); } }
            }
#pragma unroll
            for (int ebi = 0; ebi < 2; ++ebi)
#pragma unroll
                for (int ks = 0; ks < 4; ++ks) { const bf16x8 a = *(const LAS bf16x8*)(L + GL_QE + (32 * ib + r32) * SD_LDX + (ks * 16 + hh * 8) * 2);
                    const bf16x8 bq = *(const LAS bf16x8*)(S0c + (32 * (2 * eh + ebi) + r32) * SD_LDX + (ks * 16 + hh * 8) * 2); acc[ebi] = __builtin_amdgcn_mfma_f32_32x32x16_bf16(a, bq, acc[ebi], 0, 0, 0); }
#pragma unroll
            for (int r = 0; r < 16; ++r) { const int i = 32 * ib + (r & 3) + 8 * (r >> 2) + 4 * hh; const int sm = d ? 63 - i : i;
                bf16_t* op = GLAO + (size_t)(cp.rowbase + cp.t_lo + sm) * 512 + h * 128 + 64 * eh + r32;
                op[0] = f2bf(acc[0][r]); op[32] = f2bf(acc[1][r]); }
        } else {
#pragma unroll
            for (int tt = 0; tt < 2; ++tt) { const int t = 2 * (wave - 4) + tt, kb = t & 1, eb = t >> 1;
#pragma unroll
                for (int g4 = 0; g4 < 4; ++g4) { const f32x4 e4 = *(const LAS f32x4*)(EL + 32 * kb + 8 * g4 + 4 * hh);
#pragma unroll
                    for (int q = 0; q < 4; ++q) sst[tt][4 * g4 + q] *= e4[q]; }
#pragma unroll
                for (int ks = 0; ks < 4; ++ks) { const bf16x8 a = *(const LAS bf16x8*)(L + GL_K2T + (32 * kb + r32) * SD_LDX + (ks * 16 + hh * 8) * 2);
                    const LAS unsigned char* vb = L + GL_V + (16 * ks + 8 * hh + q4) * SD_LDB + eb * 64 + trcol;
                    const s16x4 lo = vtr(vb), hi = vtr(vb + 4 * SD_LDB); const bf16x8 vf = (bf16x8){lo[0], lo[1], lo[2], lo[3], hi[0], hi[1], hi[2], hi[3]};
                    sst[tt] = __builtin_amdgcn_mfma_f32_32x32x16_bf16(a, vf, sst[tt], 0, 0, 0); }
#pragma unroll
                for (int g4 = 0; g4 < 4; ++g4) { u32x2 w; w.x = cvt_pk_bf16(sst[tt][4 * g4], sst[tt][4 * g4 + 1]); w.y = cvt_pk_bf16(sst[tt][4 * g4 + 2], sst[tt][4 * g4 + 3]);
                    *(LAS u32x2*)(S0n + (32 * eb + r32) * SD_LDX + (32 * kb + 8 * g4 + 4 * hh) * 2) = w; } }
        }
    }
#undef GL_LOAD
}
PHASE_FN void phase_mix(int wv, PRM p, int l, LAS unsigned char* lds, int qsel = 0, int item0 = 0, int item1 = 1 << 30) {
    LAS int* slot = (LAS int*)(lds + 32);
    unsigned* q = (unsigned*)(p.ws + WS_CTL) + CW_QUEUE + l * 64 + qsel * 16;
    const float lam_init = 0.8f - 0.6f * expf(-0.3f * (float)l);
    float s1 = 0.f, s2 = 0.f;
    for (int i = 0; i < 64; ++i) { s1 += p.in[I_DF_Q1][l * 64 + i] * p.in[I_DF_K1][l * 64 + i]; s2 += p.in[I_DF_Q2][l * 64 + i] * p.in[I_DF_K2][l * 64 + i]; }
    const float lam = expf(s1) - expf(s2) + lam_init;
    const int n_ctx_att = (l < DEPTH - 1) ? 64 : 0, nitems = 320 + 1024 + n_ctx_att;
    for (;;) {
        if (TID == 0) *slot = (int)atomicAdd(q, 1u);
        __syncthreads();
        const int item = *slot + item0;
        __syncthreads();
        if (item >= nitems || item >= item1) break;
        CParams& pp = *kparams(); LAS unsigned char* L = olds(lds) + LDS_STAGE;
        if (item < 128) { const int i = item; ssd_chain(wv, pp, l, L, i & 1, (i >> 1) & 7, i >> 4); }
        else if (item < 192) { const int i = item - 128; gla_chain(wv, pp, l, L, i & 1, (i >> 1) & 7, i >> 4); }
        else if (item < 320) { const int i = item - 192; rwkv_chain(wv, pp, l, L, i & 1, (i >> 1) & 7, i >> 4); }
        else if (item < 320 + 1024) { const int i = item - 320; const int b = i >> 7, h = (i >> 5) & 3, qb = i & 31; attn_unit(wv, pp, L, b * TPB + LCTX + qb * 128, b * TPB, TPB / 64, h, lam, 1.0f - lam_init, pp.in[I_DF_SG] + l * 128); }
        else { const int i = item - 1344; const int b = i >> 3, h = (i >> 1) & 3, qb = i & 1; attn_unit(wv, pp, L, b * TPB + qb * 128, b * TPB, LCTX / 64, h, lam, 1.0f - lam_init, pp.in[I_DF_SG] + l * 128); }
    }
}

PHASE_FN void phase_g1(int wv, PRM p, LAS unsigned char* lds) {
    const char* ws = p.ws; SchedDense S{NPANEL, UC / 256, (int)gridDim.x, BLK, ws + WS_H, ws + WS_WIN, (size_t)256 * 1024 * 2, (size_t)256 * 1024 * 2};
    EpiStoreBf16<0> E{(bf16_t*)(p.ws + WS_U), UC};
    pg8::gemm_phase(wv, lds + LDS_STAGE, pg8::Gemm{1024, 1024, 1024}, S, E); }
PHASE_FN void phase_g2(int wv, PRM p, LAS unsigned char* lds) {
    const char* ws = p.ws; SchedDense S{NPANEL, 16, (int)gridDim.x, BLK, ws + WS_H, ws + WS_WG, (size_t)256 * 1024 * 2, (size_t)256 * 1024 * 2};
    EpiStoreBf16<1> E{(bf16_t*)(p.ws + WS_GATES), 4096};
    pg8::gemm_phase(wv, lds + LDS_STAGE, pg8::Gemm{1024, 1024, 1024}, S, E); }
PHASE_FN void phase_g3(int wv, PRM p, LAS unsigned char* lds) {
    const char* ws = p.ws; SchedMerge S{(int)gridDim.x, BLK, ws + WS_Y, ws + WS_WB};
    EpiMerge E{(const bf16_t*)(ws + WS_GATES), (float*)(p.ws + WS_M), (bf16_t*)(p.ws + WS_H)};
    pg8::gemm_phase(wv, lds + LDS_STAGE, pg8::Gemm{2048, 512, 512}, S, E); }
PHASE_FN void phase_g4(int wv, PRM p, int l, LAS unsigned char* lds) {
    const char* ws = p.ws; SchedDense S{NPANEL, 4, (int)gridDim.x, BLK, ws + WS_H, ws + WS_WO, (size_t)256 * 1024 * 2, (size_t)256 * 1024 * 2};
    EpiResid E{(float*)(p.ws + WS_XC), p.out, p.in[I_CTX], p.in[I_X], l, (const float*)(ws + WS_MOD) + (size_t)l * 9 * 6144};
    pg8::gemm_phase(wv, lds + LDS_STAGE, pg8::Gemm{1024, 1024, 1024}, S, E); }
PHASE_FN void phase_g5(int wv, PRM p, int l, LAS unsigned char* lds) {
    const char* ws = p.ws; LAS int* tab = (LAS int*)(lds + LDS_TAB); moe_tables(wv, p, l, tab, tab + 320);
    SchedMoe S{(int)gridDim.x, BLK, tab, ws + WS_XB, ws + WS_GU, (size_t)256 * 1024 * 2, (size_t)1024 * 1024 * 2, (size_t)256 * 1024 * 2};
    EpiSwiGLU E{(bf16_t*)(p.ws + WS_HID)};
    pg8::gemm_phase(wv, lds + LDS_STAGE, pg8::Gemm{1024, 1024, 1024}, S, E); }
PHASE_FN void phase_g6(int wv, PRM p, int l, LAS unsigned char* lds) {
    const char* ws = p.ws; LAS int* tab = (LAS int*)(lds + LDS_TAB); moe_tables(wv, p, l, tab, tab + 320);
    SchedMoe S{(int)gridDim.x, BLK, tab, ws + WS_HID, ws + WS_DW, (size_t)256 * 512 * 2, (size_t)1024 * 512 * 2, (size_t)256 * 512 * 2};
    EpiStoreBf16<0> E{(bf16_t*)(p.ws + WS_YB), 1024};
    pg8::gemm_phase(wv, lds + LDS_STAGE, pg8::Gemm{512, 512, 512}, S, E); }

constexpr int PH_PER_LAYER = 13, N_PHASES = 1 + DEPTH * PH_PER_LAYER;
constexpr int LDS_PARAMS = 256;
#ifdef PROBE_MIX_TWICE
#define PROBE_MIX2(l) if (PH_ON) phase_mix(wv, *kparams(), l, olds(lds), 1, PROBE_I0, PROBE_I1); if (single) xcd_barrier(bar);
#else
#define PROBE_MIX2(l)
#endif
#define LAYER_BODY(l) { if (PH_ON) { phase_convert(wv, *kparams(), l, olds(lds)); if (l == 0) phase_modulate0(wv, *kparams()); } PH_NEXT; if (PH_ON) phase_g1(wv, *kparams(), olds(lds)); PH_NEXT; if (PH_ON) phase_prep(wv, *kparams()); PH_NEXT; if (PH_ON) phase_mix(wv, *kparams(), l, olds(lds)); PH_NEXT; PROBE_MIX2(l) if (PH_ON) phase_fin(wv, *kparams(), l); PH_NEXT; if (PH_ON) phase_g2(wv, *kparams(), olds(lds)); PH_NEXT; if (PH_ON) phase_g3(wv, *kparams(), olds(lds)); PH_NEXT; if (PH_ON) phase_g4(wv, *kparams(), l, olds(lds)); PH_NEXT; if (PH_ON) phase_ln1_router(wv, *kparams(), l, olds(lds)); PH_NEXT; if (PH_ON) phase_moe_assign(wv, *kparams(), l, olds(lds)); PH_NEXT; if (PH_ON) phase_g5(wv, *kparams(), l, olds(lds)); PH_NEXT; if (PH_ON) phase_g6(wv, *kparams(), l, olds(lds)); PH_NEXT; if (PH_ON) phase_ln2(wv, *kparams(), l); PH_NEXT; }
__global__ void __launch_bounds__(NTHR, 2) fwd_kernel(Params p) {
    extern __shared__ __attribute__((aligned(16))) unsigned char shm[];
    LAS unsigned char* lds = (LAS unsigned char*)shm;
    const int ph_lo = p.ph_lo, ph_hi = p.ph_hi;
    const int wv = __builtin_amdgcn_readfirstlane((int)threadIdx.x >> 6);
    const bool single = (ph_hi - ph_lo) > 1;
    if (threadIdx.x == 0) *(LAS u32x4*)lds = (u32x4){0u, 0u, 0u, 0u};
    __syncthreads();
    XcdBarrier bar; bar.bar = (unsigned*)(p.ws + WS_CTL); bar.x = 0; bar.st = (volatile LAS unsigned*)lds;
    if (single) bar = xcd_barrier_post((unsigned*)(p.ws + WS_CTL), (volatile LAS unsigned*)lds);
    int gph = 0;
#define PH_ON (gph >= ph_lo && gph < ph_hi)
#define PH_NEXT do { ++gph; if (single) xcd_barrier(bar); } while (0)
    if (PH_ON) { phase_mod(wv, *kparams(), olds(lds)); phase_rope_table(wv, *kparams()); }
    PH_NEXT;
    LAYER_BODY(0) LAYER_BODY(1) LAYER_BODY(2) LAYER_BODY(3)
}
#ifndef MK_NO_HOST
#ifndef MK_MULTI
#define MK_MULTI 1
#endif
extern "C" void kernel_launch(void* const* d_in, const int* in_sizes, int n_in, void* d_out, int out_size, void* d_ws, size_t ws_size, hipStream_t stream) {
    static int grid = 0;
    if (grid == 0) {
        if (n_in != N_IN || ws_size < WS_END) { fprintf(stderr, "kernel_launch: unexpected n_in %d or ws_size %zu (< %zu)\n", n_in, ws_size, (size_t)WS_END); grid = -1; return; }
        int dev = 0, cus = 0, per_cu = 0;
        if (hipGetDevice(&dev) != hipSuccess || hipDeviceGetAttribute(&cus, hipDeviceAttributeMultiprocessorCount, dev) != hipSuccess) { grid = -1; return; }
        if (hipFuncSetAttribute((const void*)fwd_kernel, hipFuncAttributeMaxDynamicSharedMemorySize, LDS_BYTES) != hipSuccess) { fprintf(stderr, "kernel_launch: hipFuncSetAttribute failed\n"); grid = -1; return; }
        if (hipOccupancyMaxActiveBlocksPerMultiprocessor(&per_cu, fwd_kernel, NTHR, LDS_BYTES) != hipSuccess || per_cu < 1) { fprintf(stderr, "kernel_launch: occupancy query failed (%d)\n", per_cu); grid = -1; return; }
        grid = cus;
    }
    if (grid <= 0) return;
    (void)hipMemsetAsync((char*)d_ws + WS_CTL, 0, CTL_BYTES, stream);
    Params p{};
    for (int i = 0; i < N_IN; ++i) p.in[i] = (const float*)d_in[i];
    p.out = (float*)d_out; p.ws = (char*)d_ws;
#ifdef DBG_DET
    unsigned long long* cks = (unsigned long long*)((char*)d_ws + WS_END);
    (void)hipMemsetAsync(cks, 0, 2 * DBG_SLOTS * 8, stream);
    for (int run = 0; run < 2; ++run) {
        (void)hipMemsetAsync((char*)d_ws + WS_CTL, 0, CTL_BYTES, stream);
        for (int ph = 0; ph < N_PHASES; ++ph) { p.ph_lo = ph; p.ph_hi = ph + 1; hipLaunchKernelGGL(fwd_kernel, dim3(grid), dim3(NTHR), LDS_BYTES, stream, p);
            dbg_phase_ck(stream, (char*)d_ws, (float*)d_out, ph, cks + run * DBG_SLOTS + ph); }
    }
    hipLaunchKernelGGL(dbg_final, dim3(1024), dim3(256), 0, stream, cks, DBG_SLOTS, (float*)d_out, out_size);
#elif MK_MULTI
    for (int ph = 0; ph < N_PHASES; ++ph) { p.ph_lo = ph; p.ph_hi = ph + 1; hipLaunchKernelGGL(fwd_kernel, dim3(grid), dim3(NTHR), LDS_BYTES, stream, p); }
#else
    p.ph_lo = 0; p.ph_hi = N_PHASES;
    hipLaunchKernelGGL(fwd_kernel, dim3(grid), dim3(NTHR), LDS_BYTES, stream, p);
#endif
}
#endif
```

```cpp
#define MK_MULTI 0
#include <hip/hip_runtime.h>
#include <stdint.h>
#include <stdio.h>

#define LAS __attribute__((address_space(3)))
typedef unsigned short bf16_t;
typedef short bf16x8 __attribute__((ext_vector_type(8)));
typedef short s16x4 __attribute__((ext_vector_type(4)));
typedef float f32x2 __attribute__((ext_vector_type(2)));
typedef float f32x4 __attribute__((ext_vector_type(4)));
typedef float f32x16 __attribute__((ext_vector_type(16)));
typedef unsigned u32x2 __attribute__((ext_vector_type(2)));
typedef unsigned u32x4 __attribute__((ext_vector_type(4)));

constexpr int D = 1024, NBATCH = 8, LAT = 4096, LCTX = 256, TPB = 4352, NTOK = NBATCH * TPB, DEPTH = 4;
constexpr int NPANEL = NTOK / 256;
constexpr int UC = 6656;
constexpr int U_SSD_Z = 0, U_SSD_X = 512, U_SSD_B = 1024, U_SSD_C = 1280, U_RW_R = 1536, U_RW_K = 2048, U_RW_V = 2560, U_RW_WD = 3072, U_RW_AD = 3200,
              U_RW_GD = 3328, U_SSD_DT = 3456, U_GLA_GD = 3464, U_DF_Q = 3584, U_DF_K = 4096, U_DF_V = 4608, U_GLA_Q = 5120, U_GLA_K = 5376, U_GLA_V = 5632, U_GLA_OG = 6144;
constexpr int IN_COLS = 10664, GATE_COL0 = 6568;
constexpr int NEXP = 32, MOE_FF = 512, NSLOTBLK = 304, NSLOT = NSLOTBLK * 256;
constexpr float DN_ALPHA = 1.681792830507429f;
constexpr int NTHR = 512;
constexpr int LDS_BYTES = 159744;
constexpr int LDS_STAGE = 1024;
constexpr int LDS_TAB = LDS_STAGE + 131072;

enum { I_X = 0, I_C, I_CTX, I_CCTX, I_ADAW, I_ADAB, I_WIN, I_SSD_CW, I_SSD_CB, I_SSD_ALOG, I_SSD_DTB, I_SSD_D, I_SSD_NG, I_RW_MU, I_RW_W0, I_RW_WUP, I_RW_A0, I_RW_AUP,
       I_RW_GUP, I_RW_KK, I_RW_KA, I_RW_RK, I_RW_LNG, I_RW_LNB, I_DF_Q1, I_DF_K1, I_DF_Q2, I_DF_K2, I_DF_SG, I_GLA_GUP, I_GLA_GB, I_GLA_NG, I_WBR, I_WOUT, I_LN1G, I_LN1B,
       I_MOE_WG, I_MOE_BG, I_MOE_WE, I_MOE_BE, I_MOE_GATE, I_MOE_UP, I_MOE_DOWN, I_LN2G, I_LN2B, N_IN };

constexpr size_t al256(size_t x) { return (x + 255) & ~(size_t)255; }
constexpr size_t WS_CTL = 0;
constexpr size_t CTL_BYTES = 65536;
constexpr int CW_QUEUE = 4096, CW_CNT = 8192, CW_CUR = 12288;
constexpr size_t WS_MOD = WS_CTL + CTL_BYTES;
constexpr size_t WS_ROPE = al256(WS_MOD + (size_t)DEPTH * 9 * 6144 * 4);
constexpr size_t WS_XC = al256(WS_ROPE + (size_t)2 * 4096 * 32 * 4);
constexpr size_t WS_H = al256(WS_XC + (size_t)2048 * 1024 * 4);
constexpr size_t WS_U = al256(WS_H + (size_t)NTOK * 1024 * 2);
constexpr size_t U_BYTES = (size_t)NTOK * UC * 2;
constexpr size_t WS_GATES = WS_U;
constexpr size_t WS_M = al256(WS_GATES + (size_t)NTOK * 4096 * 2);
constexpr size_t WS_XB = WS_U;
constexpr size_t WS_HID = al256(WS_XB + (size_t)NSLOT * 1024 * 2);
constexpr size_t WS_YB = al256(WS_HID + (size_t)NSLOT * 512 * 2);
static_assert(WS_M + (size_t)NTOK * 1024 * 4 <= WS_U + U_BYTES, "M overlay");
static_assert(WS_YB + (size_t)NSLOT * 1024 * 2 <= WS_U + U_BYTES, "moe overlay");
constexpr size_t WS_Y = al256(WS_U + U_BYTES);
constexpr size_t WS_SSDY = al256(WS_Y + (size_t)NTOK * 2048 * 2);
constexpr size_t WS_RWY = al256(WS_SSDY + (size_t)2 * NTOK * 512 * 2);
constexpr size_t WS_RWG = al256(WS_RWY + (size_t)2 * NTOK * 512 * 2);
constexpr size_t WS_GLAO = al256(WS_RWG + (size_t)NTOK * 512 * 2);
constexpr size_t WS_RWBD = al256(WS_GLAO + (size_t)2 * NTOK * 512 * 2);
constexpr size_t WS_WIN = al256(WS_RWBD + (size_t)2 * NTOK * 8 * 4);
constexpr size_t WS_WG = al256(WS_WIN + (size_t)UC * 1024 * 2);
constexpr size_t WS_WB = al256(WS_WG + (size_t)4096 * 1024 * 2);
constexpr size_t WS_WO = al256(WS_WB + (size_t)4 * 1024 * 512 * 2);
constexpr size_t WS_GU = al256(WS_WO + (size_t)1024 * 1024 * 2);
constexpr size_t WS_DW = al256(WS_GU + (size_t)32 * 1024 * 1024 * 2);
constexpr size_t WS_EID = al256(WS_DW + (size_t)32 * 1024 * 512 * 2);
constexpr size_t WS_WTS = al256(WS_EID + (size_t)NTOK * 2 * 4);
constexpr size_t WS_SLOT = al256(WS_WTS + (size_t)NTOK * 2 * 4);
constexpr size_t WS_END = al256(WS_SLOT + (size_t)NTOK * 2 * 4);

struct Params { const float* in[N_IN]; float* out; char* ws; int ph_lo, ph_hi; };
typedef const __attribute__((address_space(4))) Params CParams;
#define PRM CParams&
__device__ __forceinline__ LAS unsigned char* olds(LAS unsigned char* q) { asm volatile("" : "+s"(q)); return q; }
__device__ __forceinline__ CParams* kparams() { CParams* q = (CParams*)__builtin_amdgcn_kernarg_segment_ptr(); asm volatile("" : "+s"(q)); return q; }
#ifndef PHASE_FN
#define PHASE_FN __device__ __forceinline__
#endif

__device__ __forceinline__ int olane() { unsigned z = 0u; asm volatile("" : "+v"(z)); return (int)__builtin_amdgcn_mbcnt_hi(~0u, __builtin_amdgcn_mbcnt_lo(~0u, z)); }
__device__ __forceinline__ int otid(int wv) { return (wv << 6) | olane(); }
#define TID (otid(wv))
#define LANE (olane())
#define WAVE (wv)
__device__ __forceinline__ int oblk() { int b = (int)blockIdx.x; asm volatile("" : "+s"(b)); return b; }
#define BLK (oblk())
__device__ __forceinline__ float bf2f(unsigned b) { return __uint_as_float(b << 16); }
typedef __bf16 bf16x2_t __attribute__((ext_vector_type(2)));
__device__ __forceinline__ unsigned cvt_pk_bf16(float lo, float hi) { const f32x2 v = {lo, hi}; return __builtin_bit_cast(unsigned, __builtin_convertvector(v, bf16x2_t)); }
__device__ __forceinline__ bf16_t f2bf(float f) { return (bf16_t)(cvt_pk_bf16(f, 0.f) & 0xffffu); }
__device__ __forceinline__ void unpack8(const u32x4 w, float (&f)[8]) {
    f[0] = __uint_as_float(w.x << 16); f[1] = __uint_as_float(w.x & 0xffff0000u); f[2] = __uint_as_float(w.y << 16); f[3] = __uint_as_float(w.y & 0xffff0000u);
    f[4] = __uint_as_float(w.z << 16); f[5] = __uint_as_float(w.z & 0xffff0000u); f[6] = __uint_as_float(w.w << 16); f[7] = __uint_as_float(w.w & 0xffff0000u); }
__device__ __forceinline__ u32x4 pack8(const float (&f)[8]) { u32x4 w; w.x = cvt_pk_bf16(f[0], f[1]); w.y = cvt_pk_bf16(f[2], f[3]); w.z = cvt_pk_bf16(f[4], f[5]); w.w = cvt_pk_bf16(f[6], f[7]); return w; }
template <int CTRL> __device__ __forceinline__ float dppf(float v) { return __int_as_float(__builtin_amdgcn_update_dpp(0, __float_as_int(v), CTRL, 0xf, 0xf, true)); }
__device__ __forceinline__ float sum4(float v)  { v += dppf<0xB1>(v); v += dppf<0x4E>(v); return v; }
__device__ __forceinline__ float sum8(float v)  { v = sum4(v); v += dppf<0x141>(v); return v; }
__device__ __forceinline__ float sum16(float v) { v = sum8(v); v += dppf<0x140>(v); return v; }
__device__ __forceinline__ float shflx(float v, int mask) { const int ln = olane(); return __int_as_float(__builtin_amdgcn_ds_bpermute(((ln ^ mask) & 63) << 2, __float_as_int(v))); }
__device__ __forceinline__ float sum32(float v) { v = sum16(v); v += shflx(v, 16); return v; }
__device__ __forceinline__ float sum64(float v) { v = sum16(v);
    return __int_as_float(__builtin_amdgcn_readlane(__float_as_int(v), 0)) + __int_as_float(__builtin_amdgcn_readlane(__float_as_int(v), 16))
         + __int_as_float(__builtin_amdgcn_readlane(__float_as_int(v), 32)) + __int_as_float(__builtin_amdgcn_readlane(__float_as_int(v), 48)); }
__device__ __forceinline__ float sigmoidf_(float x) { return __builtin_amdgcn_rcpf(1.0f + __expf(-x)); }
__device__ __forceinline__ float siluf_(float x) { return x * __builtin_amdgcn_rcpf(1.0f + __expf(-x)); }
__device__ __forceinline__ float wave_incl_scan(float v, int lane) {
#pragma unroll
    for (int off = 1; off < 64; off <<= 1) { const float t = __int_as_float(__builtin_amdgcn_ds_bpermute(((lane - off) & 63) << 2, __float_as_int(v))); v += lane >= off ? t : 0.f; }
    return v; }
__device__ __forceinline__ float softplusf_(float x) { return x > 20.f ? x : log1pf(__expf(x)); }
__device__ __forceinline__ float softplus_fast(float x) { return fmaxf(x, 0.f) + __logf(1.0f + __expf(-fabsf(x))); }
__device__ __forceinline__ float tanh_fast(float x) { return 1.0f - 2.0f * __builtin_amdgcn_rcpf(__expf(2.0f * x) + 1.0f); }

__device__ __forceinline__ float* xs_row(PRM p, int r) { const int b = r / TPB, t = r - b * TPB;
    return t < LCTX ? (float*)(p.ws + WS_XC) + ((size_t)b * LCTX + t) * D : p.out + ((size_t)b * LAT + (t - LCTX)) * D; }
__device__ __forceinline__ const float* xin_row(PRM p, int r) { const int b = r / TPB, t = r - b * TPB;
    return t < LCTX ? p.in[I_CTX] + ((size_t)b * LCTX + t) * D : p.in[I_X] + ((size_t)b * LAT + (t - LCTX)) * D; }
__device__ __forceinline__ int mod_row(int r) { const int b = r / TPB, t = r - b * TPB; return t < LCTX ? 8 : b; }
#define XB_TMO      128
#define XB_XCNT(j)  (256  + 64 * (j))
#define XB_XSUB(j)  (1280 + 64 * (j))
#define XB_XGEN(j)  (2304 + 64 * (j))
#define XB_TOP      3328
#define XB_TOPGEN   3392
#define XCD_BAR_WORDS 3456
#define XB_SPIN_CAP (1u << 18)

__device__ __forceinline__ unsigned xb_ld(unsigned* p)              { return __hip_atomic_load(p, __ATOMIC_RELAXED, __HIP_MEMORY_SCOPE_AGENT); }
__device__ __forceinline__ unsigned xb_add(unsigned* p, unsigned v) { return __hip_atomic_fetch_add(p, v, __ATOMIC_RELAXED, __HIP_MEMORY_SCOPE_AGENT); }
__device__ __forceinline__ unsigned xb_xcc_id() { return (unsigned)__builtin_amdgcn_s_getreg((3 << 11) | 20) & 0xFu; }
#define XB_SPIN(cond, bar) do { unsigned _sp = 0; while (cond) { __builtin_amdgcn_s_sleep(1); \
    if ((++_sp & 255u) == 0u) { if (xb_ld(&(bar)[XB_TMO])) break; if (_sp > XB_SPIN_CAP) { atomicAdd(&(bar)[XB_TMO], 1u); break; } } } } while (0)

struct XcdBarrier {
    unsigned* bar; unsigned x;
    volatile LAS unsigned* st;
};

__device__ __forceinline__ XcdBarrier xcd_barrier_post(unsigned* bar, volatile LAS unsigned* st) {
    XcdBarrier b; b.bar = bar; b.x = xb_xcc_id(); b.st = st;
    if (threadIdx.x == 0) (void)xb_add(&bar[XB_XCNT(b.x)], 1u);
    return b;
}
__device__ __forceinline__ void xcd_barrier_complete(unsigned* bar, unsigned x, unsigned& nloc, unsigned& nx) {
    const unsigned G = gridDim.x * gridDim.y * gridDim.z;
    unsigned sum, cnt, mine, sp = 0u;
    for (;;) {
        sum = 0u; cnt = 0u; mine = 0u;
#pragma unroll
        for (unsigned j = 0; j < 16; ++j) { const unsigned c = xb_ld(&bar[XB_XCNT(j)]); sum += c; cnt += (c > 0u) ? 1u : 0u; mine = (j == x) ? c : mine; }
        if (sum == G) break;
        __builtin_amdgcn_s_sleep(1);
        if ((++sp & 255u) == 0u) { if (xb_ld(&bar[XB_TMO])) break; if (sp > XB_SPIN_CAP) { atomicAdd(&bar[XB_TMO], 1u); break; } }
    }
    nloc = mine > 0u ? mine : 1u; nx = cnt > 0u ? cnt : 1u;
}

__device__ __forceinline__ void xcd_barrier(const XcdBarrier& b) {
    asm volatile("s_waitcnt vmcnt(0)" ::: "memory");
    __syncthreads();
    if (threadIdx.x == 0) {
        unsigned* bar = b.bar;
        __builtin_amdgcn_s_waitcnt(0);
        unsigned nloc = b.st[0], nx = b.st[1];
        if (nloc == 0u) { xcd_barrier_complete(bar, b.x, nloc, nx); b.st[0] = nloc; b.st[1] = nx; }
        const unsigned old = xb_add(&bar[XB_XSUB(b.x)], 1u);
        const unsigned gen = old / nloc;
        if (old + 1u == (gen + 1u) * nloc) {
            __builtin_amdgcn_fence(__ATOMIC_RELEASE, "agent");
            asm volatile("s_waitcnt vmcnt(0)" ::: "memory");
            const unsigned og = xb_add(&bar[XB_TOP], 1u);
            const unsigned tg = og / nx;
            if (og + 1u == (tg + 1u) * nx) xb_add(&bar[XB_TOPGEN], 1u);
            else XB_SPIN(xb_ld(&bar[XB_TOPGEN]) == tg, bar);
            __builtin_amdgcn_fence(__ATOMIC_ACQUIRE, "agent");
            xb_add(&bar[XB_XGEN(b.x)], 1u);
            asm volatile("s_waitcnt vmcnt(0)" ::: "memory");
        } else {
            XB_SPIN(xb_ld(&bar[XB_XGEN(b.x)]) == gen, bar);
            __builtin_amdgcn_fence(__ATOMIC_ACQUIRE, "agent");
            asm volatile("s_waitcnt vmcnt(0)" ::: "memory");
        }
    }
    __syncthreads();
}

namespace pg8 {
constexpr int BM = 256, BK = 64, HALF = 128, HTB = HALF * BK * 2, STAGE_BYTES = 8 * HTB, NXCD = 8, WGM = 8;
__host__ __device__ __forceinline__ int lds_byte(int r, int c) { const int st = (r >> 4) * 2 + (c >> 5), rr = r & 15, cc = c & 31, ob = rr * 64 + cc * 2; return st * 1024 + (ob ^ (((ob >> 9) & 1) << 5)); }
__host__ __device__ __forceinline__ void stage_rc(int b, int& R, int& C) { const int st = b / 1024, sb = b % 1024, swz = sb ^ (((sb >> 9) & 1) << 5); R = (st >> 1) * 16 + swz / 64; C = (st & 1) * 32 + (swz % 64) / 2; }
__host__ __device__ __forceinline__ int perm32(int rho) { const int n = rho >> 4, i = rho & 15; return 8 * (i >> 2) + 4 * n + (i & 3); }

struct Unit { int pm, pn, x; const char* a; const char* b; };
struct Gemm { int lda, ldb, K; };

__device__ __forceinline__ bool static_tile(int L, int nM, int nN, int& pm, int& pn) {
    const int nwg = nM * nN; if (L >= nwg) return false;
    int wgid = L; { const int q = nwg / NXCD, r = nwg % NXCD, xcd = wgid % NXCD, off = wgid / NXCD; wgid = (xcd < r ? xcd * (q + 1) : r * (q + 1) + (xcd - r) * q) + off; }
    const int nig = WGM * nN, gid = wgid / nig, fm = gid * WGM, gsz = (nM - fm) < WGM ? (nM - fm) : WGM;
    pm = fm + ((wgid % nig) % gsz); pn = (wgid % nig) / gsz; return true;
}

template <class Epi, class Sched>
__device__ __forceinline__ void gemm_phase(int wv, LAS unsigned char* lds, const Gemm g, const Sched& S, const Epi& E) {
    const int tid = otid(wv), wid = wv, lane = tid & 63, wr = wid >> 2, wc = wid & 3, fr = lane & 15, fq = lane >> 4;
    const int K = g.K, nt = K / BK;
    unsigned voffA[2], voffB[2];
#pragma unroll
    for (int i = 0; i < 2; ++i) { int R, C; stage_rc(tid * 16 + i * 8192, R, C); const int Rb = (R & ~31) + perm32(R & 31);
        voffA[i] = (unsigned)(R * g.lda + C) * 2u; voffB[i] = (unsigned)(Rb * g.ldb + C) * 2u; }
    const size_t kstep = (size_t)(BK * 2);
    const size_t hstepA = (size_t)HALF * g.lda * 2, hstepB = (size_t)HALF * g.ldb * 2;
    const unsigned ldsw = (unsigned)wid * 1024u;
    const int aoff = lds_byte(wr * 64 + fr, fq * 8), boff = lds_byte(wc * 32 + fr, fq * 8);
#define PG8_SA(b, h) (((b) * 2 + (h)) * HTB)
#define PG8_SB(b, h) ((4 + (b) * 2 + (h)) * HTB)
#define PG8_STAGE(bufoff, gbase, voff) do { _Pragma("unroll") for (int _i = 0; _i < 2; ++_i) \
        __builtin_amdgcn_global_load_lds((const unsigned*)((const char*)(gbase) + (voff)[_i]), (LAS unsigned*)(lds + (bufoff) + ldsw + _i * 8192), 16, 0, 0); } while (0)
#define PG8_LDA(dst, b, h) do { _Pragma("unroll") for (int m = 0; m < 4; ++m) _Pragma("unroll") for (int k = 0; k < 2; ++k) dst[m][k] = *(const LAS bf16x8*)(lds + PG8_SA(b, h) + aoff + m * 2048 + k * 1024); } while (0)
#define PG8_LDB(dst, b, h) do { _Pragma("unroll") for (int n = 0; n < 2; ++n) _Pragma("unroll") for (int k = 0; k < 2; ++k) dst[n][k] = *(const LAS bf16x8*)(lds + PG8_SB(b, h) + boff + n * 2048 + k * 1024); } while (0)
#define PG8_MMA(ai, bj, At, Bt) do { __builtin_amdgcn_s_setprio(1); _Pragma("unroll") for (int m = 0; m < 4; ++m) _Pragma("unroll") for (int n = 0; n < 2; ++n) _Pragma("unroll") for (int k = 0; k < 2; ++k) \
        acc[ai][bj][m][n] = __builtin_amdgcn_mfma_f32_16x16x32_bf16(Bt[n][k], At[m][k], acc[ai][bj][m][n], 0, 0, 0); __builtin_amdgcn_s_setprio(0); } while (0)
#define PG8_WAIT_V(n) asm volatile("s_waitcnt vmcnt(" #n ")" ::: "memory")
#define PG8_WAIT_L(n) asm volatile("s_waitcnt lgkmcnt(" #n ")" ::: "memory")
#define PG8_BAR __builtin_amdgcn_s_barrier()
#define PG8_SCHED __builtin_amdgcn_sched_barrier(0)
    Unit cur, nxt; int ui = 0;
    if (!S.next(0, cur)) return;
    f32x4 acc[2][2][4][2];
#pragma unroll
    for (int a = 0; a < 2; ++a)
#pragma unroll
        for (int b = 0; b < 2; ++b)
#pragma unroll
            for (int m = 0; m < 4; ++m)
#pragma unroll
                for (int n = 0; n < 2; ++n) acc[a][b][m][n] = (f32x4){0.f, 0.f, 0.f, 0.f};
    bf16x8 At[4][2], B0[2][2], B1[2][2];
    const char* cA = cur.a; const char* cB = cur.b;
    PG8_STAGE(PG8_SB(0, 0), cB, voffB); PG8_STAGE(PG8_SB(0, 1), cB + hstepB, voffB); PG8_STAGE(PG8_SA(0, 0), cA, voffA); PG8_STAGE(PG8_SA(0, 1), cA + hstepA, voffA);
    if (wr == 1) PG8_BAR;
    PG8_WAIT_V(2); PG8_BAR;
    PG8_STAGE(PG8_SB(1, 0), cB + kstep, voffB); PG8_STAGE(PG8_SA(1, 0), cA + kstep, voffA); PG8_STAGE(PG8_SB(1, 1), cB + hstepB + kstep, voffB);
    PG8_WAIT_V(6); PG8_BAR;
    for (;;) {
        const bool has_next = S.next(ui + 1, nxt);
        const char* nA = has_next ? nxt.a : cA; const char* nB = has_next ? nxt.b : cB;
        for (int t = 0; t < nt; t += 2) {
            const bool last = (t == nt - 2);
            const char* a1 = cA + (size_t)(t + 1) * kstep;
            const char* a2 = last ? nA : cA + (size_t)(t + 2) * kstep; const char* b2 = last ? nB : cB + (size_t)(t + 2) * kstep;
            const char* a3 = a2 + kstep; const char* b3 = b2 + kstep;
            PG8_LDB(B0, 0, 0); PG8_LDB(B1, 0, 1); PG8_SCHED; PG8_LDA(At, 0, 0); PG8_STAGE(PG8_SA(1, 1), a1 + hstepA, voffA);
            PG8_WAIT_V(8); PG8_WAIT_L(0); PG8_BAR; PG8_MMA(0, 0, At, B0); PG8_MMA(0, 1, At, B1); PG8_BAR; PG8_SCHED;
            PG8_LDA(At, 0, 1); PG8_STAGE(PG8_SB(0, 0), b2, voffB); PG8_STAGE(PG8_SB(0, 1), b2 + hstepB, voffB); PG8_STAGE(PG8_SA(0, 0), a2, voffA);
            PG8_WAIT_V(8); PG8_WAIT_L(0); PG8_BAR; PG8_MMA(1, 0, At, B0); PG8_MMA(1, 1, At, B1); PG8_BAR; PG8_SCHED;
            PG8_LDB(B0, 1, 0); PG8_LDB(B1, 1, 1); PG8_SCHED; PG8_LDA(At, 1, 0); PG8_STAGE(PG8_SA(0, 1), a2 + hstepA, voffA);
            PG8_WAIT_V(8); PG8_WAIT_L(0); PG8_BAR; PG8_MMA(0, 0, At, B0); PG8_MMA(0, 1, At, B1); PG8_BAR; PG8_SCHED;
            PG8_LDA(At, 1, 1); PG8_STAGE(PG8_SB(1, 0), b3, voffB); PG8_STAGE(PG8_SB(1, 1), b3 + hstepB, voffB); PG8_STAGE(PG8_SA(1, 0), a3, voffA);
            PG8_WAIT_V(8); PG8_WAIT_L(0); PG8_BAR; PG8_MMA(1, 0, At, B0); PG8_MMA(1, 1, At, B1); PG8_BAR; PG8_SCHED;
        }
        if (wr == 0) PG8_BAR;
        E(acc, cur, wr, wc, fr, fq);
        if (!has_next) break;
#pragma unroll
        for (int a = 0; a < 2; ++a)
#pragma unroll
            for (int b = 0; b < 2; ++b)
#pragma unroll
                for (int m = 0; m < 4; ++m)
#pragma unroll
                    for (int n = 0; n < 2; ++n) acc[a][b][m][n] = (f32x4){0.f, 0.f, 0.f, 0.f};
        cur = nxt; cA = nA; cB = nB; ++ui;
        if (wr == 1) PG8_BAR;
    }
    PG8_WAIT_V(0);
    PG8_BAR;
#undef PG8_SA
#undef PG8_SB
#undef PG8_STAGE
#undef PG8_LDA
#undef PG8_LDB
#undef PG8_MMA
#undef PG8_WAIT_V
#undef PG8_WAIT_L
#undef PG8_BAR
#undef PG8_SCHED
}
}
using pg8::Unit;
template <int ACT  > struct EpiStoreBf16 {
    bf16_t* O; int ldc;
    __device__ __forceinline__ void operator()(const f32x4 (&acc)[2][2][4][2], const Unit& u, int wr, int wc, int fr, int fq) const {
        const int row0 = u.pm * 256 + wr * 64 + fr, col0 = u.pn * 256 + wc * 32 + 8 * fq;
#pragma unroll
        for (int ai = 0; ai < 2; ++ai)
#pragma unroll
            for (int m = 0; m < 4; ++m) { bf16_t* rowp = O + (size_t)(row0 + ai * 128 + m * 16) * ldc + col0;
#pragma unroll
                for (int bj = 0; bj < 2; ++bj) { f32x4 v0 = acc[ai][bj][m][0], v1 = acc[ai][bj][m][1];
                    if (ACT == 1) {
#pragma unroll
                        for (int j = 0; j < 4; ++j) { v0[j] = __builtin_amdgcn_rcpf(1.0f + __expf(-v0[j])); v1[j] = __builtin_amdgcn_rcpf(1.0f + __expf(-v1[j])); } }
                    u32x4 w; w.x = cvt_pk_bf16(v0[0], v0[1]); w.y = cvt_pk_bf16(v0[2], v0[3]); w.z = cvt_pk_bf16(v1[0], v1[1]); w.w = cvt_pk_bf16(v1[2], v1[3]);
                    *(u32x4*)(rowp + bj * 128) = w; } }
    }
};
struct EpiMerge {
    const bf16_t* G; float* M; bf16_t* MB;
    __device__ __forceinline__ void operator()(const f32x4 (&acc)[2][2][4][2], const Unit& u, int wr, int wc, int fr, int fq) const {
        const int br = u.x; const int row0 = u.pm * 256 + wr * 64 + fr, col0 = u.pn * 256 + wc * 32 + 8 * fq;
        const bf16_t* __restrict__ gp = G; const float* __restrict__ mrd = M; float* __restrict__ mwr = M; bf16_t* __restrict__ mb = MB;
#pragma unroll
        for (int aih = 0; aih < 4; ++aih) { const int ai = aih >> 1, mh = (aih & 1) * 2;
            u32x4 gw[2][2]; f32x4 m0[2][2], m1[2][2];
#pragma unroll
            for (int mm = 0; mm < 2; ++mm)
#pragma unroll
                for (int bj = 0; bj < 2; ++bj) { const int m = mh + mm; const size_t r = (size_t)(row0 + ai * 128 + m * 16); const int c = col0 + bj * 128;
                    gw[mm][bj] = *(const u32x4*)(gp + r * 4096 + br * 1024 + c);
                    if (br > 0) { m0[mm][bj] = *(const f32x4*)(mrd + r * 1024 + c); m1[mm][bj] = *(const f32x4*)(mrd + r * 1024 + c + 4); } }
#pragma unroll
            for (int mm = 0; mm < 2; ++mm)
#pragma unroll
                for (int bj = 0; bj < 2; ++bj) { const int m = mh + mm; const size_t r = (size_t)(row0 + ai * 128 + m * 16); const int c = col0 + bj * 128;
                    float gs[8]; unpack8(gw[mm][bj], gs);
                    f32x4 v0 = acc[ai][bj][m][0], v1 = acc[ai][bj][m][1];
#pragma unroll
                    for (int j = 0; j < 4; ++j) { v0[j] *= gs[j]; v1[j] *= gs[4 + j]; }
                    if (br > 0) { v0 += m0[mm][bj]; v1 += m1[mm][bj]; }
                    if (br < 3) { *(f32x4*)(mwr + r * 1024 + c) = v0; *(f32x4*)(mwr + r * 1024 + c + 4) = v1; }
                    else { u32x4 w; w.x = cvt_pk_bf16(v0[0], v0[1]); w.y = cvt_pk_bf16(v0[2], v0[3]); w.z = cvt_pk_bf16(v1[0], v1[1]); w.w = cvt_pk_bf16(v1[2], v1[3]);
                        *(u32x4*)(mb + r * 1024 + c) = w; } }
            asm volatile("" ::: "memory");
        }
    }
};
struct EpiResid {
    float* xc; float* out; const float* ctxin; const float* xin; int layer; const float* modl;
    __device__ __forceinline__ void operator()(const f32x4 (&acc)[2][2][4][2], const Unit& u, int wr, int wc, int fr, int fq) const {
        asm volatile("" : "+v"(fr), "+v"(fq));
        const int b = u.pm / 17, pr = u.pm - b * 17; const bool isctx = pr == 0; const int mb = isctx ? 8 : b;
        float* dst = isctx ? xc + (size_t)b * LCTX * D : out + ((size_t)b * LAT + (size_t)(pr - 1) * 256) * D;
        const float* src = layer == 0 ? (isctx ? ctxin + (size_t)b * LCTX * D : xin + ((size_t)b * LAT + (size_t)(pr - 1) * 256) * D) : dst;
        const int rr0 = wr * 64 + fr, col0 = u.pn * 256 + wc * 32 + 8 * fq;
        const float* g1 = modl + mb * 6144 + 2048 + col0;
        f32x4 gv[2][2];
#pragma unroll
        for (int bj = 0; bj < 2; ++bj) { gv[bj][0] = *(const f32x4*)(g1 + bj * 128); gv[bj][1] = *(const f32x4*)(g1 + bj * 128 + 4); }
#pragma unroll
        for (int ai = 0; ai < 2; ++ai)
#pragma unroll
            for (int m = 0; m < 4; ++m) { const size_t ro = (size_t)(rr0 + ai * 128 + m * 16) * D + col0;
#pragma unroll
                for (int bj = 0; bj < 2; ++bj) {
                    const f32x4 x0 = *(const f32x4*)(src + ro + bj * 128), x1 = *(const f32x4*)(src + ro + bj * 128 + 4);
                    *(f32x4*)(dst + ro + bj * 128) = x0 * DN_ALPHA + gv[bj][0] * acc[ai][bj][m][0];
                    *(f32x4*)(dst + ro + bj * 128 + 4) = x1 * DN_ALPHA + gv[bj][1] * acc[ai][bj][m][1]; }
                asm volatile("" ::: "memory"); }
    }
};
struct EpiSwiGLU {
    bf16_t* HID;
    __device__ __forceinline__ void operator()(const f32x4 (&acc)[2][2][4][2], const Unit& u, int wr, int wc, int fr, int fq) const {
        const int row0 = u.pm * 256 + wr * 64 + fr, col0 = u.pn * 128 + wc * 32 + 8 * fq;
#pragma unroll
        for (int ai = 0; ai < 2; ++ai)
#pragma unroll
            for (int m = 0; m < 4; ++m) { float h[8];
#pragma unroll
                for (int n = 0; n < 2; ++n)
#pragma unroll
                    for (int j = 0; j < 4; ++j) { const float g = acc[ai][0][m][n][j], up = acc[ai][1][m][n][j]; h[4 * n + j] = g * __builtin_amdgcn_rcpf(1.0f + __expf(-g)) * up; }
                *(u32x4*)(HID + (size_t)(row0 + ai * 128 + m * 16) * MOE_FF + col0) = pack8(h); }
    }
};
struct SchedDense {
    int nM, nN, G, c; const char* A; const char* B; size_t ta, tb;
    __device__ __forceinline__ bool next(int i, Unit& u) const { int pm, pn; if (!pg8::static_tile(i * G + c, nM, nN, pm, pn)) return false;
        u.pm = pm; u.pn = pn; u.x = 0; u.a = A + (size_t)pm * ta; u.b = B + (size_t)pn * tb; return true; }
};
struct SchedMerge {
    int G, c; const char* Y; const char* WB;
    __device__ __forceinline__ bool next(int i, Unit& u) const { int pm, pn; if (!pg8::static_tile((i >> 2) * G + c, NPANEL, 4, pm, pn)) return false; const int br = i & 3;
        u.pm = pm; u.pn = pn; u.x = br; u.a = Y + (size_t)pm * 256 * 2048 * 2 + (size_t)br * 512 * 2; u.b = WB + (size_t)br * 1024 * 512 * 2 + (size_t)pn * 256 * 512 * 2; return true; }
};
struct SchedMoe {
    int G, c; const LAS int* tab; const char* A; const char* B; size_t ta, be, bt;
    __device__ __forceinline__ bool next(int i, Unit& u) const { const int L = i * G + c; const int nblk = tab[0]; if (L >= nblk * 4) return false; const int blk = L >> 2, t = L & 3, e = tab[1 + blk];
        u.pm = blk; u.pn = t; u.x = e; u.a = A + (size_t)blk * ta; u.b = B + (size_t)e * be + (size_t)t * bt; return true; }
};

PHASE_FN void phase_mod(int wv, PRM p, LAS unsigned char* lds) {
    LAS float* s = (LAS float*)(lds + LDS_STAGE); LAS float* red = s + 9 * 1024;
    const int tid = TID;
    for (int i = tid; i < 9 * 1024; i += NTHR) { const int b = i >> 10, k = i & 1023; const float v = b < 8 ? p.in[I_C][b * 1024 + k] : p.in[I_CCTX][k]; s[i] = siluf_(v); }
    __syncthreads();
    float* MOD = (float*)(p.ws + WS_MOD);
    for (int task = BLK; task < DEPTH * 48; task += gridDim.x) {
        const int l = task / 48, j0 = (task % 48) * 128, cq = tid & 127, kq = tid >> 7;
        float acc[9];
#pragma unroll
        for (int b = 0; b < 9; ++b) acc[b] = 0.f;
        const float* w = p.in[I_ADAW] + ((size_t)l * 1024 + kq * 256) * 6144 + j0 + cq;
        for (int k = 0; k < 256; ++k) { const float wv = w[(size_t)k * 6144];
#pragma unroll
            for (int b = 0; b < 9; ++b) acc[b] += s[b * 1024 + kq * 256 + k] * wv; }
#pragma unroll
        for (int b = 0; b < 9; ++b) red[(kq * 9 + b) * 128 + cq] = acc[b];
        __syncthreads();
        for (int o = tid; o < 9 * 128; o += NTHR) { const int b = o >> 7, c2 = o & 127;
            const float v = red[(0 * 9 + b) * 128 + c2] + red[(1 * 9 + b) * 128 + c2] + red[(2 * 9 + b) * 128 + c2] + red[(3 * 9 + b) * 128 + c2] + p.in[I_ADAB][l * 6144 + j0 + c2];
            MOD[((size_t)l * 9 + b) * 6144 + j0 + c2] = v; }
        __syncthreads();
    }
}
PHASE_FN void phase_rope_table(int wv, PRM p) {
    float* COS = (float*)(p.ws + WS_ROPE); float* SIN = COS + 4096 * 32;
    for (int i = BLK * NTHR + TID; i < 4096 * 32; i += gridDim.x * NTHR) { const int n = i >> 5, a = (i >> 4) & 1, pp = i & 15;
        const float inv = powf(10000.0f, -(float)pp / 16.0f); const float ang = (float)(a == 0 ? (n >> 6) : (n & 63)) * inv;
        COS[i] = cosf(ang); SIN[i] = sinf(ang); }
}
PHASE_FN void phase_modulate0(int wv, PRM p) {
    const float* MOD = (const float*)(p.ws + WS_MOD); bf16_t* H = (bf16_t*)(p.ws + WS_H); const int lane = LANE;
    for (int r = BLK * 8 + WAVE; r < NTOK; r += gridDim.x * 8) {
        const float* x = xin_row(p, r); const float* md = MOD + (size_t)mod_row(r) * 6144;
#pragma unroll
        for (int j = 0; j < 4; ++j) { const int c = j * 256 + lane * 4; const f32x4 v = *(const f32x4*)(x + c), sh = *(const f32x4*)(md + c), sc = *(const f32x4*)(md + 1024 + c);
            const f32x4 h = v * (sc + 1.0f) + sh; u32x2 w; w.x = cvt_pk_bf16(h[0], h[1]); w.y = cvt_pk_bf16(h[2], h[3]); *(u32x2*)(H + (size_t)r * D + c) = w; }
    }
}
__device__ __forceinline__ int win_src_col(int j) {
    if (j < 1536) return j;
    if (j < 3456) return 1544 + (j - 1536);
    if (j < 3464) return 1536 + (j - 3456);
    if (j < 3496) return 6024 + (j - 3464);
    if (j < 3584) return -1;
    if (j < 5120) return 3464 + (j - 3584);
    if (j < 6144) return 5000 + (j - 5120);
    return 6056 + (j - 6144);
}
PHASE_FN void phase_convert(int wv, PRM p, int l, LAS unsigned char* lds) {
    LAS float* tile = (LAS float*)(lds + LDS_STAGE);
    const int tid = TID;
    constexpr int T0 = 104 * 16, T1 = T0 + 64 * 16, T2 = T1 + 4 * 16 * 8, T3 = T2 + 16 * 16, T4 = T3 + 32 * 16 * 16, T5 = T4 + 32 * 16 * 8;
    for (int task = BLK; task < T5; task += gridDim.x) {
        const float* src; int sld; bf16_t* dst; int dld; int n0, k0, kind = 0, cadd = 0;
        if (task < T0) { const int t = task; n0 = (t >> 4) * 64; k0 = (t & 15) * 64; src = p.in[I_WIN] + (size_t)l * 1024 * IN_COLS; sld = IN_COLS; dst = (bf16_t*)(p.ws + WS_WIN); dld = 1024; kind = 1; }
        else if (task < T1) { const int t = task - T0; n0 = (t >> 4) * 64; k0 = (t & 15) * 64; src = p.in[I_WIN] + (size_t)l * 1024 * IN_COLS; sld = IN_COLS; dst = (bf16_t*)(p.ws + WS_WG); dld = 1024; cadd = GATE_COL0; }
        else if (task < T2) { const int t = task - T1; const int br = t >> 7, tt = t & 127; n0 = (tt >> 3) * 64; k0 = (tt & 7) * 64; src = p.in[I_WBR] + ((size_t)l * 4 + br) * 512 * 1024; sld = 1024; dst = (bf16_t*)(p.ws + WS_WB) + (size_t)br * 1024 * 512; dld = 512; }
        else if (task < T3) { const int t = task - T2; n0 = (t >> 4) * 64; k0 = (t & 15) * 64; src = p.in[I_WOUT] + (size_t)l * 1024 * 1024; sld = 1024; dst = (bf16_t*)(p.ws + WS_WO); dld = 1024; }
        else if (task < T4) { const int t = task - T3; const int e = t >> 8, tt = t & 255; const int j0 = (tt >> 4) * 64; k0 = (tt & 15) * 64;
            const int q = j0 >> 8, rr = j0 & 255; src = (rr < 128 ? p.in[I_MOE_GATE] : p.in[I_MOE_UP]) + ((size_t)l * 32 + e) * 1024 * 512; sld = 512; cadd = 128 * q + (rr & 127) - j0; n0 = j0;
            dst = (bf16_t*)(p.ws + WS_GU) + (size_t)e * 1024 * 1024; dld = 1024; }
        else { const int t = task - T4; const int e = t >> 7, tt = t & 127; n0 = (tt >> 3) * 64; k0 = (tt & 7) * 64; src = p.in[I_MOE_DOWN] + ((size_t)l * 32 + e) * 512 * 1024; sld = 1024; dst = (bf16_t*)(p.ws + WS_DW) + (size_t)e * 1024 * 512; dld = 512; }
        { const int nx = tid & 63, ky = tid >> 6; const int j = n0 + nx; const int sc = kind == 1 ? win_src_col(j) : j + cadd;
#pragma unroll
            for (int i = 0; i < 8; ++i) { const int k = ky + 8 * i; tile[k * 65 + nx] = sc >= 0 ? src[(size_t)(k0 + k) * sld + sc] : 0.f; } }
        __syncthreads();
        { const int kx = tid & 31, ny = tid >> 5;
#pragma unroll
            for (int i = 0; i < 4; ++i) { const int j = ny + 16 * i; *(unsigned*)(dst + (size_t)(n0 + j) * dld + k0 + 2 * kx) = cvt_pk_bf16(tile[(2 * kx) * 65 + j], tile[(2 * kx + 1) * 65 + j]); } }
        __syncthreads();
    }
}
PHASE_FN void phase_ln1_router(int wv, PRM p, int l, LAS unsigned char* lds) {
    LAS float* Wl = (LAS float*)(lds + LDS_STAGE);
    LAS unsigned* hist = (LAS unsigned*)(lds + 64);
    const int tid = TID, lane = LANE;
    const float* wg = p.in[I_MOE_WG] + (size_t)l * 1024 * 4; const float* we = p.in[I_MOE_WE] + (size_t)l * 1024 * 32;
    for (int i = tid; i < 1024 * 36; i += NTHR) { const int k = i / 36, e = i - k * 36;
        const int j = k >> 8, ln = (k >> 2) & 63, q = k & 3; Wl[((j * 4 + q) * 64 + ln) * 36 + e] = e < 4 ? wg[k * 4 + e] : we[k * 32 + (e - 4)]; }
    if (tid < 32) hist[tid] = 0u;
    __syncthreads();
    const float* MOD = (const float*)(p.ws + WS_MOD) + (size_t)l * 9 * 6144; bf16_t* H = (bf16_t*)(p.ws + WS_H);
    const float* lg = p.in[I_LN1G] + l * 1024; const float* lb = p.in[I_LN1B] + l * 1024;
    const float* bg = p.in[I_MOE_BG] + l * 4; const float* be = p.in[I_MOE_BE] + l * 32;
    int* EID = (int*)(p.ws + WS_EID); float* WTS = (float*)(p.ws + WS_WTS);
    for (int g4 = BLK * 8 + WAVE; g4 < NTOK / 2; g4 += gridDim.x * 8) {
        float h[2][16];
#pragma unroll
        for (int r = 0; r < 2; ++r) { const int row = g4 * 2 + r; float* xr = xs_row(p, row); const float* md = MOD + (size_t)mod_row(row) * 6144;
            f32x4 v[4]; float s = 0.f;
#pragma unroll
            for (int j = 0; j < 4; ++j) { v[j] = *(const f32x4*)(xr + j * 256 + lane * 4); s += (v[j][0] + v[j][1]) + (v[j][2] + v[j][3]); }
            const float mean = sum64(s) * (1.0f / 1024.0f); float q = 0.f;
#pragma unroll
            for (int j = 0; j < 4; ++j) { const f32x4 d = v[j] - mean; q += (d[0] * d[0] + d[1] * d[1]) + (d[2] * d[2] + d[3] * d[3]); }
            const float rstd = rsqrtf(sum64(q) * (1.0f / 1024.0f) + 1e-5f);
#pragma unroll
            for (int j = 0; j < 4; ++j) { const int c = j * 256 + lane * 4; const f32x4 x = (v[j] - mean) * rstd * *(const f32x4*)(lg + c) + *(const f32x4*)(lb + c);
                *(f32x4*)(xr + c) = x; const f32x4 hh = x * (*(const f32x4*)(md + 4 * 1024 + c) + 1.0f) + *(const f32x4*)(md + 3 * 1024 + c);
                u32x2 w; w.x = cvt_pk_bf16(hh[0], hh[1]); w.y = cvt_pk_bf16(hh[2], hh[3]); *(u32x2*)(H + (size_t)row * D + c) = w;
                h[r][j * 4 + 0] = hh[0]; h[r][j * 4 + 1] = hh[1]; h[r][j * 4 + 2] = hh[2]; h[r][j * 4 + 3] = hh[3]; } }
        LAS float* LG = (LAS float*)(lds + LDS_STAGE + 147456) + WAVE * 144;
#pragma unroll 1
        for (int pass = 0; pass < 3; ++pass) {
            float acc[2][12];
#pragma unroll
            for (int r = 0; r < 2; ++r)
#pragma unroll
                for (int e = 0; e < 12; ++e) acc[r][e] = 0.f;
#pragma unroll
            for (int idx = 0; idx < 16; ++idx) { const LAS float* wr = Wl + (idx * 64 + lane) * 36 + pass * 12; float w[12];
#pragma unroll
                for (int e4 = 0; e4 < 3; ++e4) { const f32x4 t = *(const LAS f32x4*)(wr + 4 * e4); w[4 * e4] = t[0]; w[4 * e4 + 1] = t[1]; w[4 * e4 + 2] = t[2]; w[4 * e4 + 3] = t[3]; }
#pragma unroll
                for (int r = 0; r < 2; ++r)
#pragma unroll
                    for (int e = 0; e < 12; ++e) acc[r][e] += h[r][idx] * w[e]; }
#pragma unroll
            for (int r = 0; r < 2; ++r)
#pragma unroll
                for (int e = 0; e < 12; ++e) LG[r * 36 + pass * 12 + e] = sum64(acc[r][e]);
        }
        asm volatile("s_waitcnt lgkmcnt(0)" ::: "memory");
        if (lane < 2) { const int r = lane, row = g4 * 2 + r; const LAS float* lr = LG + r * 36;
            float gl[4];
#pragma unroll
            for (int g = 0; g < 4; ++g) gl[g] = lr[g] + bg[g];
            int gi = 0; float gm = gl[0];
#pragma unroll
            for (int g = 1; g < 4; ++g) if (gl[g] > gm) { gm = gl[g]; gi = g; }
            float gs = 0.f;
#pragma unroll
            for (int g = 0; g < 4; ++g) gs += __expf(gl[g] - gm);
            const float gp = 1.0f / gs;
            float el[8];
#pragma unroll
            for (int j = 0; j < 8; ++j) el[j] = lr[4 + gi * 8 + j] + be[gi * 8 + j];
            int i1 = 0; float m1 = el[0];
#pragma unroll
            for (int j = 1; j < 8; ++j) if (el[j] > m1) { m1 = el[j]; i1 = j; }
            int i2 = 0; float m2 = -3.0e38f;
#pragma unroll
            for (int j = 0; j < 8; ++j) if (j != i1 && el[j] > m2) { m2 = el[j]; i2 = j; }
            const float e2 = __expf(m2 - m1); const float w1 = gp / (1.0f + e2), w2 = gp * e2 / (1.0f + e2);
            const int ea = gi * 8 + i1, eb = gi * 8 + i2; EID[row * 2] = ea; EID[row * 2 + 1] = eb; WTS[row * 2] = w1; WTS[row * 2 + 1] = w2;
            __hip_atomic_fetch_add(&hist[ea], 1u, __ATOMIC_RELAXED, __HIP_MEMORY_SCOPE_WORKGROUP); __hip_atomic_fetch_add(&hist[eb], 1u, __ATOMIC_RELAXED, __HIP_MEMORY_SCOPE_WORKGROUP);
        }
        asm volatile("s_waitcnt lgkmcnt(0)" ::: "memory");
    }
    __syncthreads();
    if (tid < 32) { const unsigned c = hist[tid]; if (c) atomicAdd((unsigned*)(p.ws + WS_CTL) + CW_CNT + l * 64 + tid, c); }
    __syncthreads();
}
__device__ __forceinline__ void moe_tables(int wv, PRM p, int l, LAS int* tab, LAS int* beg) {
    if (TID == 0) { const unsigned* cnt = (const unsigned*)(p.ws + WS_CTL) + CW_CNT + l * 64; int nb = 0;
        for (int e = 0; e < NEXP; ++e) { const int c = (int)__hip_atomic_load(cnt + e, __ATOMIC_RELAXED, __HIP_MEMORY_SCOPE_AGENT); const int k = (c + 255) >> 8; beg[e] = nb; for (int j = 0; j < k; ++j) tab[1 + nb + j] = e; nb += k; }
        tab[0] = nb; }
    __syncthreads();
}
PHASE_FN void phase_moe_assign(int wv, PRM p, int l, LAS unsigned char* lds) {
    LAS int* tab = (LAS int*)(lds + LDS_TAB); LAS int* beg = tab + 320;
    moe_tables(wv, p, l, tab, beg);
    const int* EID = (const int*)(p.ws + WS_EID); int* SLOT = (int*)(p.ws + WS_SLOT); unsigned* cur = (unsigned*)(p.ws + WS_CTL) + CW_CUR + l * 64;
    const bf16_t* H = (const bf16_t*)(p.ws + WS_H); bf16_t* XB = (bf16_t*)(p.ws + WS_XB); const int lane = LANE;
    for (int a = BLK * 8 + WAVE; a < NTOK * 2; a += gridDim.x * 8) {
        const int e = EID[a]; int slot = 0;
        if (lane == 0) { const unsigned rank = atomicAdd(cur + e, 1u); slot = beg[e] * 256 + (int)rank; SLOT[a] = slot; }
        slot = __builtin_amdgcn_readfirstlane(slot);
        const u32x4* src = (const u32x4*)(H + (size_t)(a >> 1) * D); u32x4* dst = (u32x4*)(XB + (size_t)slot * D);
        dst[lane] = src[lane]; dst[lane + 64] = src[lane + 64];
    }
}
PHASE_FN void phase_ln2(int wv, PRM p, int l) {
    const float* MOD = (const float*)(p.ws + WS_MOD) + (size_t)l * 9 * 6144; const float* MODN = MOD + 9 * 6144; bf16_t* H = (bf16_t*)(p.ws + WS_H);
    const float* lg = p.in[I_LN2G] + l * 1024; const float* lb = p.in[I_LN2B] + l * 1024;
    const int* SLOT = (const int*)(p.ws + WS_SLOT); const float* WTS = (const float*)(p.ws + WS_WTS); const bf16_t* YB = (const bf16_t*)(p.ws + WS_YB); const int lane = LANE;
    for (int row = BLK * 8 + WAVE; row < NTOK; row += gridDim.x * 8) {
        float* xr = xs_row(p, row); const int mr = mod_row(row); const float* md = MOD + (size_t)mr * 6144;
        const int s0 = SLOT[row * 2], s1 = SLOT[row * 2 + 1]; const float w0 = WTS[row * 2], w1 = WTS[row * 2 + 1];
        f32x4 v[4]; float s = 0.f;
#pragma unroll
        for (int j = 0; j < 4; ++j) { const int c = j * 256 + lane * 4; const u32x2 a = *(const u32x2*)(YB + (size_t)s0 * D + c), b = *(const u32x2*)(YB + (size_t)s1 * D + c);
            f32x4 m; m[0] = w0 * bf2f(a.x & 0xffffu) + w1 * bf2f(b.x & 0xffffu); m[1] = w0 * bf2f(a.x >> 16) + w1 * bf2f(b.x >> 16);
            m[2] = w0 * bf2f(a.y & 0xffffu) + w1 * bf2f(b.y & 0xffffu); m[3] = w0 * bf2f(a.y >> 16) + w1 * bf2f(b.y >> 16);
            v[j] = *(const f32x4*)(xr + c) * DN_ALPHA + *(const f32x4*)(md + 5 * 1024 + c) * m; s += (v[j][0] + v[j][1]) + (v[j][2] + v[j][3]); }
        const float mean = sum64(s) * (1.0f / 1024.0f); float q = 0.f;
#pragma unroll
        for (int j = 0; j < 4; ++j) { const f32x4 d = v[j] - mean; q += (d[0] * d[0] + d[1] * d[1]) + (d[2] * d[2] + d[3] * d[3]); }
        const float rstd = rsqrtf(sum64(q) * (1.0f / 1024.0f) + 1e-5f);
#pragma unroll
        for (int j = 0; j < 4; ++j) { const int c = j * 256 + lane * 4; f32x4 x = (v[j] - mean) * rstd * *(const f32x4*)(lg + c) + *(const f32x4*)(lb + c);
#ifdef DBG_SANITIZE
            for (int i_ = 0; i_ < 4; ++i_) x[i_] = (x[i_] == x[i_] && fabsf(x[i_]) < 1e30f) ? x[i_] : 0.f;
#endif
            *(f32x4*)(xr + c) = x;
            if (l + 1 < DEPTH) { const float* mn = MODN + (size_t)mr * 6144; const f32x4 hh = x * (*(const f32x4*)(mn + 1024 + c) + 1.0f) + *(const f32x4*)(mn + c);
                u32x2 w; w.x = cvt_pk_bf16(hh[0], hh[1]); w.y = cvt_pk_bf16(hh[2], hh[3]); *(u32x2*)(H + (size_t)row * D + c) = w; } }
    }
}
constexpr float ATT_C2 = 0.125f * 1.4426950408889634f;
PHASE_FN void phase_prep(int wv, PRM p) {
    bf16_t* U = (bf16_t*)(p.ws + WS_U); const float* COS = (const float*)(p.ws + WS_ROPE); const float* SIN = COS + 4096 * 32; const int lane = LANE;
    for (int r = BLK * 8 + WAVE; r < NTOK; r += gridDim.x * 8) {
        const int t = r % TPB; const bool lat = t >= LCTX; const int n = t - LCTX;
        const int c0 = lane * 8, a = (c0 >> 5) & 1, jj = (c0 >> 4) & 1, pp0 = c0 & 15;
        float cs[8], sn[8];
#pragma unroll
        for (int i = 0; i < 8; ++i) { cs[i] = 1.f; sn[i] = 0.f; }
        if (lat) {
#pragma unroll
            for (int i = 0; i < 8; ++i) { cs[i] = COS[n * 32 + a * 16 + pp0 + i]; sn[i] = SIN[n * 32 + a * 16 + pp0 + i]; } }
#pragma unroll
        for (int which = 0; which < 2; ++which) {
            bf16_t* ptr = U + (size_t)r * UC + (which == 0 ? U_DF_Q : U_DF_K) + c0;
            float x[8]; unpack8(*(const u32x4*)ptr, x); float o[8];
#pragma unroll
            for (int i = 0; i < 8; ++i) { const float other = dppf<0x4E>(x[i]);
                o[i] = jj == 0 ? x[i] * cs[i] - other * sn[i] : x[i] * cs[i] + other * sn[i];
                if (which == 0) o[i] *= ATT_C2; }
            if (lat || which == 0) *(u32x4*)ptr = pack8(o);
        }
    }
}
PHASE_FN void phase_fin(int wv, PRM p, int l) {
    const bf16_t* U = (const bf16_t*)(p.ws + WS_U); bf16_t* Y = (bf16_t*)(p.ws + WS_Y); const int lane = LANE, c0 = lane * 8;
    const bf16_t* SSDY = (const bf16_t*)(p.ws + WS_SSDY); const bf16_t* RWY = (const bf16_t*)(p.ws + WS_RWY); const bf16_t* RWG = (const bf16_t*)(p.ws + WS_RWG);
    const bf16_t* GLAO = (const bf16_t*)(p.ws + WS_GLAO); const float* BD = (const float*)(p.ws + WS_RWBD);
    const float* ssd_ng = p.in[I_SSD_NG] + l * 512; const float* lnxg = p.in[I_RW_LNG] + l * 512; const float* lnxb = p.in[I_RW_LNB] + l * 512;
    const float* mu_v = p.in[I_RW_MU] + l * 1920 + 1024; const float* gla_ng = p.in[I_GLA_NG] + l * 128;
    for (int r = BLK * 8 + WAVE; r < NTOK; r += gridDim.x * 8) {
        const int t = r % TPB; const bool has_prev = (t != 0) && (t != LCTX), has_next = (t != LCTX - 1) && (t != TPB - 1);
        {
            float a[8], b[8], z[8]; unpack8(*(const u32x4*)(SSDY + (size_t)r * 512 + c0), a); unpack8(*(const u32x4*)(SSDY + ((size_t)NTOK + r) * 512 + c0), b); unpack8(*(const u32x4*)(U + (size_t)r * UC + U_SSD_Z + c0), z);
            float y[8], ss = 0.f;
#pragma unroll
            for (int i = 0; i < 8; ++i) { y[i] = (a[i] + b[i]) * siluf_(z[i]); ss += y[i] * y[i]; }
            const float rs = rsqrtf(sum32(ss) * (1.0f / 256.0f) + 1e-5f);
#pragma unroll
            for (int i = 0; i < 8; ++i) y[i] = y[i] * rs * ssd_ng[c0 + i];
            *(u32x4*)(Y + (size_t)r * 2048 + c0) = pack8(y); }
        {
            float a[8], b[8], g[8], vc[8], vp[8], vn[8]; unpack8(*(const u32x4*)(RWY + (size_t)r * 512 + c0), a); unpack8(*(const u32x4*)(RWY + ((size_t)NTOK + r) * 512 + c0), b);
            unpack8(*(const u32x4*)(RWG + (size_t)r * 512 + c0), g); unpack8(*(const u32x4*)(U + (size_t)r * UC + U_RW_V + c0), vc);
#pragma unroll
            for (int i = 0; i < 8; ++i) { vp[i] = 0.f; vn[i] = 0.f; }
            if (has_prev) unpack8(*(const u32x4*)(U + (size_t)(r - 1) * UC + U_RW_V + c0), vp);
            if (has_next) unpack8(*(const u32x4*)(U + (size_t)(r + 1) * UC + U_RW_V + c0), vn);
            const int head = lane >> 3; const float bd = BD[(size_t)r * 8 + head] + BD[((size_t)NTOK + r) * 8 + head];
            float y[8], s = 0.f;
#pragma unroll
            for (int i = 0; i < 8; ++i) { y[i] = a[i] + b[i]; s += y[i]; }
            const float mean = sum8(s) * (1.0f / 64.0f); float q = 0.f;
#pragma unroll
            for (int i = 0; i < 8; ++i) { y[i] -= mean; q += y[i] * y[i]; }
            const float rs = rsqrtf(sum8(q) * (1.0f / 64.0f) + 64e-5f);
#pragma unroll
            for (int i = 0; i < 8; ++i) { const float vm = vc[i] + mu_v[c0 + i] * (0.5f * (vp[i] + vn[i]) - vc[i]);
                y[i] = (y[i] * rs * lnxg[c0 + i] + lnxb[c0 + i] + bd * vm) * g[i]; }
            *(u32x4*)(Y + (size_t)r * 2048 + 512 + c0) = pack8(y); }
        {
            float a[8], b[8], og[8]; unpack8(*(const u32x4*)(GLAO + (size_t)r * 512 + c0), a); unpack8(*(const u32x4*)(GLAO + ((size_t)NTOK + r) * 512 + c0), b); unpack8(*(const u32x4*)(U + (size_t)r * UC + U_GLA_OG + c0), og);
            float y[8], ss = 0.f;
#pragma unroll
            for (int i = 0; i < 8; ++i) { y[i] = a[i] + b[i]; ss += y[i] * y[i]; }
            const float rs = rsqrtf(sum16(ss) * (1.0f / 128.0f) + 1e-5f);
#pragma unroll
            for (int i = 0; i < 8; ++i) y[i] = y[i] * rs * gla_ng[(c0 + i) & 127] * siluf_(og[i]);
            *(u32x4*)(Y + (size_t)r * 2048 + 1536 + c0) = pack8(y); }
    }
}
typedef short v4i16_t __attribute__((ext_vector_type(4)));
__device__ __forceinline__ s16x4 vtr(const LAS unsigned char* pp) { return __builtin_bit_cast(s16x4, __builtin_amdgcn_ds_read_tr16_b64_v4i16((LAS v4i16_t*)pp)); }
constexpr int AT_BUF = 38912;
constexpr int AT_K0 = 0, AT_K1 = 9216, AT_V = 18432, AT_AL = 2 * AT_BUF, AT_XO = 2 * AT_BUF + 1024;
constexpr float AT_THR = 8.0f;
PHASE_FN void attn_unit(int wv, PRM p, LAS unsigned char* L, int qrow0, int krow0, int ntiles, int h, const LAS float* lamp, const float* subg) {
    const int tid = TID, lane = tid & 63, wave = wv, m = wave >> 2, qs = wave & 3, r32 = lane & 31, hh = lane >> 5;
    const bf16_t* U = (const bf16_t*)(p.ws + WS_U); bf16_t* Y = (bf16_t*)(p.ws + WS_Y);
    const int kr = tid >> 3, kc = tid & 7;
    const bf16_t* gk = U + (size_t)(krow0 + kr) * UC + U_DF_K + h * 128 + kc * 8;
    const int vr0 = tid >> 4, vc = tid & 15;
    const bf16_t* gv = U + (size_t)(krow0 + vr0) * UC + U_DF_V + h * 128 + vc * 8;
    u32x4 rk0, rk1, rv0, rv1;
#define AT_LOAD(t) do { const size_t o_ = (size_t)(t) * 64 * UC; rk0 = *(const u32x4*)(gk + o_); rk1 = *(const u32x4*)(gk + o_ + 64); rv0 = *(const u32x4*)(gv + o_); rv1 = *(const u32x4*)(gv + o_ + (size_t)32 * UC); } while (0)
#define AT_STORE(B) do { LAS unsigned char* b_ = L + (B) * AT_BUF; *(LAS u32x4*)(b_ + AT_K0 + (kr * 72 + kc * 8) * 2) = rk0; *(LAS u32x4*)(b_ + AT_K1 + (kr * 72 + kc * 8) * 2) = rk1; \
        *(LAS u32x4*)(b_ + AT_V + vr0 * 320 + vc * 16) = rv0; *(LAS u32x4*)(b_ + AT_V + (vr0 + 32) * 320 + vc * 16) = rv1; } while (0)
    AT_LOAD(0);
    bf16x8 qf[4];
    { const bf16_t* qp = U + (size_t)(qrow0 + qs * 32 + r32) * UC + U_DF_Q + h * 128 + m * 64 + hh * 8;
#pragma unroll
      for (int d0 = 0; d0 < 4; ++d0) qf[d0] = *(const bf16x8*)(qp + d0 * 16); }
    f32x16 o[4];
#pragma unroll
    for (int db = 0; db < 4; ++db) o[db] = (f32x16){0.f,0.f,0.f,0.f,0.f,0.f,0.f,0.f,0.f,0.f,0.f,0.f,0.f,0.f,0.f,0.f};
    float m_run = -INFINITY, l_run = 0.f;
    LAS float* AL = (LAS float*)(L + AT_AL) + wave * 32;
    const int i16 = lane & 15; const int vtr_off = (4 * hh + (i16 >> 2)) * 320 + (((lane >> 4) & 1) * 16 + (i16 & 3) * 4) * 2;
    __syncthreads();
    AT_STORE(0);
    if (ntiles > 1) AT_LOAD(1);
    for (int t = 0; t < ntiles; ++t) {
        __syncthreads();
        if (t + 1 < ntiles) { AT_STORE((t + 1) & 1); if (t + 2 < ntiles) AT_LOAD(t + 2); }
        const LAS unsigned char* Lb = L + (t & 1) * AT_BUF; const LAS unsigned char* Km = Lb + (m ? AT_K1 : AT_K0);
        f32x16 p0 = (f32x16){0.f,0.f,0.f,0.f,0.f,0.f,0.f,0.f,0.f,0.f,0.f,0.f,0.f,0.f,0.f,0.f}, p1 = p0;
#pragma unroll
        for (int d0 = 0; d0 < 4; ++d0) {
            const bf16x8 k0 = *(const LAS bf16x8*)(Km + (r32 * 72 + d0 * 16 + hh * 8) * 2);
            const bf16x8 k1 = *(const LAS bf16x8*)(Km + ((r32 + 32) * 72 + d0 * 16 + hh * 8) * 2);
            p0 = __builtin_amdgcn_mfma_f32_32x32x16_bf16(k0, qf[d0], p0, 0, 0, 0);
            p1 = __builtin_amdgcn_mfma_f32_32x32x16_bf16(k1, qf[d0], p1, 0, 0, 0); }
        float mx = fmaxf(p0[0], p1[0]);
#pragma unroll
        for (int r = 1; r < 16; ++r) mx = fmaxf(mx, fmaxf(p0[r], p1[r]));
        mx = fmaxf(mx, shflx(mx, 32));
        if (__any(mx > m_run + AT_THR)) {
            const float m_new = fmaxf(m_run, mx); const float alpha = __builtin_amdgcn_exp2f(m_run - m_new); m_run = m_new; l_run *= alpha;
            if (hh == 0) AL[r32] = alpha;
            asm volatile("s_waitcnt lgkmcnt(0)" ::: "memory");
#pragma unroll
            for (int g = 0; g < 4; ++g) { const f32x4 a4 = *(const LAS f32x4*)(AL + 8 * g + 4 * hh);
#pragma unroll
                for (int db = 0; db < 4; ++db) { o[db][4 * g] *= a4[0]; o[db][4 * g + 1] *= a4[1]; o[db][4 * g + 2] *= a4[2]; o[db][4 * g + 3] *= a4[3]; } }
            asm volatile("s_waitcnt lgkmcnt(0)" ::: "memory");
        }
        float ps = 0.f;
#pragma unroll
        for (int r = 0; r < 16; ++r) { p0[r] = __builtin_amdgcn_exp2f(p0[r] - m_run); p1[r] = __builtin_amdgcn_exp2f(p1[r] - m_run); ps += p0[r] + p1[r]; }
        l_run += ps;
        bf16x8 pa[4];
#pragma unroll
        for (int ks = 0; ks < 4; ++ks) { const int b0 = (ks & 1) * 8; u32x4 w;
            if (ks < 2) { w.x = cvt_pk_bf16(p0[b0], p0[b0 + 1]); w.y = cvt_pk_bf16(p0[b0 + 2], p0[b0 + 3]); w.z = cvt_pk_bf16(p0[b0 + 4], p0[b0 + 5]); w.w = cvt_pk_bf16(p0[b0 + 6], p0[b0 + 7]); }
            else { w.x = cvt_pk_bf16(p1[b0], p1[b0 + 1]); w.y = cvt_pk_bf16(p1[b0 + 2], p1[b0 + 3]); w.z = cvt_pk_bf16(p1[b0 + 4], p1[b0 + 5]); w.w = cvt_pk_bf16(p1[b0 + 6], p1[b0 + 7]); }
            pa[ks] = __builtin_bit_cast(bf16x8, w); }
#pragma unroll
        for (int db = 0; db < 4; ++db)
#pragma unroll
            for (int ks = 0; ks < 4; ++ks) { const LAS unsigned char* vb = Lb + AT_V + vtr_off + ks * 16 * 320 + db * 64;
                const s16x4 lo = vtr(vb), hi = vtr(vb + 8 * 320);
                const bf16x8 vf = (bf16x8){lo[0], lo[1], lo[2], lo[3], hi[0], hi[1], hi[2], hi[3]};
                o[db] = __builtin_amdgcn_mfma_f32_32x32x16_bf16(pa[ks], vf, o[db], 0, 0, 0); }
    }
#undef AT_LOAD
#undef AT_STORE
    const float ltot = l_run + shflx(l_run, 32);
    { const float lam2 = lamp[0];
      if (hh == 0) AL[r32] = (m ? lam2 : 1.0f) * __builtin_amdgcn_rcpf(ltot); }
    asm volatile("s_waitcnt lgkmcnt(0)" ::: "memory");
    float sc[16];
#pragma unroll
    for (int g = 0; g < 4; ++g) { const f32x4 a4 = *(const LAS f32x4*)(AL + 8 * g + 4 * hh); sc[4 * g] = a4[0]; sc[4 * g + 1] = a4[1]; sc[4 * g + 2] = a4[2]; sc[4 * g + 3] = a4[3]; }
    LAS float* XO = (LAS float*)(L + AT_XO);
    if (m == 1) {
#pragma unroll
        for (int r = 0; r < 16; ++r) { const int q = qs * 32 + (r & 3) + 8 * (r >> 2) + 4 * hh;
#pragma unroll
            for (int db = 0; db < 4; ++db) XO[q * 128 + db * 32 + r32] = o[db][r] * sc[r]; } }
    __syncthreads();
    if (m == 0) {
#pragma unroll
        for (int r = 0; r < 16; ++r) { const int q = qs * 32 + (r & 3) + 8 * (r >> 2) + 4 * hh; float ss = 0.f;
#pragma unroll
            for (int db = 0; db < 4; ++db) { const float v = o[db][r] * sc[r] - XO[q * 128 + db * 32 + r32]; o[db][r] = v; ss += v * v; }
            const float rs = rsqrtf(sum32(ss) * (1.0f / 128.0f) + 1e-5f) * lamp[1];
            bf16_t* yp = Y + (size_t)(qrow0 + q) * 2048 + 1024 + h * 128 + r32;
#pragma unroll
            for (int db = 0; db < 4; ++db) yp[db * 32] = f2bf(o[db][r] * rs * subg[db * 32 + r32]); } }
}
struct ChunkPos { int rowbase, t_lo, seglen; };
__device__ __forceinline__ ChunkPos chunk_pos(int b, int d, int ci) { ChunkPos c; const bool isctx = ci < 8; const int cl = isctx ? ci : ci - 8; c.seglen = isctx ? LCTX : LAT;
    c.rowbase = b * TPB + (isctx ? 0 : LCTX); c.t_lo = d == 0 ? cl * 32 : c.seglen - 32 * (cl + 1); return c; }
constexpr int NCHUNK = TPB / 32;

constexpr int RW_OP = 0, RW_OPB = 49152, RW_RAW = 98304, RW_TW = 128768, RW_TA = 133376, RW_TG = 137984, RW_MU = 146688, RW_CST = 148480;
#define RW_BAR() do { asm volatile("s_waitcnt vmcnt(0) lgkmcnt(0)" ::: "memory"); __builtin_amdgcn_s_barrier(); asm volatile("" ::: "memory"); } while (0)
#define RW_BAR_NV() do { asm volatile("s_waitcnt lgkmcnt(0)" ::: "memory"); __builtin_amdgcn_s_barrier(); asm volatile("" ::: "memory"); } while (0)
PHASE_FN void rwkv_chain(int wv, PRM p, int l, LAS unsigned char* L, int d, int b, int h) {
    const int tid = TID, lane = tid & 63, wave = wv, r32 = lane & 31, hh = lane >> 5;
    LAS bf16_t* RAW = (LAS bf16_t*)(L + RW_RAW);
    LAS bf16_t* TW = (LAS bf16_t*)(L + RW_TW); LAS bf16_t* TA = (LAS bf16_t*)(L + RW_TA); LAS bf16_t* TG = (LAS bf16_t*)(L + RW_TG);
    LAS float* MU = (LAS float*)(L + RW_MU);
    LAS float* CW0 = (LAS float*)(L + RW_CST); LAS float* CA0 = CW0 + 64; LAS float* CKK = CA0 + 64; LAS float* CKA = CKK + 64; LAS float* CRK = CKA + 64;
    const bf16_t* U = (const bf16_t*)(p.ws + WS_U);
    bf16_t* RWY = (bf16_t*)(p.ws + WS_RWY) + (size_t)d * NTOK * 512; bf16_t* RWG = (bf16_t*)(p.ws + WS_RWG); float* BD = (float*)(p.ws + WS_RWBD) + (size_t)d * NTOK * 8;
    __syncthreads();
    if (tid < 448) { const int cc = tid; int gc;
        if (cc < 192) gc = (cc >> 6) * 512 + h * 64 + (cc & 63); else if (cc < 256) gc = 1536 + d * 64 + (cc - 192); else if (cc < 320) gc = 1664 + d * 64 + (cc - 256); else gc = 1792 + (cc - 320);
        MU[cc] = p.in[I_RW_MU][l * 1920 + gc]; }
    if (tid < 64) { const int c = h * 64 + tid; CW0[tid] = p.in[I_RW_W0][(l * 2 + d) * 512 + c]; CA0[tid] = p.in[I_RW_A0][(l * 2 + d) * 512 + c];
        CKK[tid] = p.in[I_RW_KK][l * 512 + c]; CKA[tid] = p.in[I_RW_KA][l * 512 + c]; CRK[tid] = p.in[I_RW_RK][l * 512 + c]; }
    __syncthreads();
    if (wave >= 4) {
        const int t2 = tid - 256, sw = wave - 4;
        bf16x8 Bf[8];
#pragma unroll
        for (int f = 0; f < 8; ++f) { float v[8];
#pragma unroll
            for (int j = 0; j < 8; ++j) { float x;
                if (sw < 2) { const int cb = f >> 2, ks = f & 3, k = ks * 16 + hh * 8 + j; const float* w = sw == 0 ? p.in[I_RW_WUP] : p.in[I_RW_AUP]; x = w[((size_t)(l * 2 + d) * 64 + k) * 512 + h * 64 + cb * 32 + r32]; }
                else { const int cb = sw - 2, k = f * 16 + hh * 8 + j; x = p.in[I_RW_GUP][((size_t)l * 128 + k) * 512 + h * 64 + cb * 32 + r32]; }
                v[j] = x; }
            Bf[f] = __builtin_bit_cast(bf16x8, pack8(v)); }
        u32x4 rawreg[8];
#define RW_RAW_LOAD(cix) do { const ChunkPos cq = chunk_pos(b, d, (cix)); _Pragma("unroll") for (int it = 0; it < 8; ++it) { const int idx = t2 + it * 256; u32x4 v = (u32x4){0u, 0u, 0u, 0u}; \
            if (idx < 34 * 56) { const int row = idx / 56, ch = idx - row * 56; const int t = cq.t_lo - 1 + row; \
                int gcol; if (ch < 24) gcol = U_RW_R + (ch >> 3) * 512 + h * 64 + (ch & 7) * 8; else if (ch < 32) gcol = U_RW_WD + d * 64 + (ch - 24) * 8; else if (ch < 40) gcol = U_RW_AD + d * 64 + (ch - 32) * 8; else gcol = U_RW_GD + (ch - 40) * 8; \
                if (t >= 0 && t < cq.seglen) v = *(const u32x4*)(U + (size_t)(cq.rowbase + t) * UC + gcol); } \
            rawreg[it] = v; } } while (0)
        RW_RAW_LOAD(0);
        for (int cs = 0; cs < NCHUNK; ++cs) {
            const ChunkPos cp = chunk_pos(b, d, cs);
            LAS float* OP = (LAS float*)(L + ((cs & 1) ? RW_OPB : RW_OP)); LAS float* W_ = OP; LAS float* KK = OP + 2048; LAS float* KKA = OP + 4096; LAS float* KD = OP + 6144; LAS float* R_ = OP + 8192; LAS float* V_ = OP + 10240;
            asm volatile("s_waitcnt vmcnt(0)" ::: "memory");
#pragma unroll
            for (int it = 0; it < 8; ++it) { const int idx = t2 + it * 256; if (idx < 34 * 56) { const int row = idx / 56, ch = idx - row * 56; *(LAS u32x4*)(RAW + row * 448 + ch * 8) = rawreg[it]; } }
            RW_BAR_NV();
            if (cs + 1 < NCHUNK) RW_RAW_LOAD(cs + 1);
            for (int idx = t2; idx < 32 * 56; idx += 256) { const int s = idx / 56, ch = idx - s * 56, cc = ch * 8;
                float c0[8], pv[8], nx[8], mx[8];
                unpack8(*(const LAS u32x4*)(RAW + (s + 1) * 448 + cc), c0); unpack8(*(const LAS u32x4*)(RAW + s * 448 + cc), pv); unpack8(*(const LAS u32x4*)(RAW + (s + 2) * 448 + cc), nx);
                const f32x4 m0 = *(const LAS f32x4*)(MU + cc), m1 = *(const LAS f32x4*)(MU + cc + 4);
#pragma unroll
                for (int j = 0; j < 8; ++j) { const float mu = j < 4 ? m0[j] : m1[j - 4]; mx[j] = c0[j] + mu * (0.5f * (pv[j] + nx[j]) - c0[j]); }
                if (ch < 24) { LAS float* dst = (ch < 8 ? R_ : (ch < 16 ? KD : V_)) + s * 64 + (cc & 63);
                    *(LAS f32x4*)dst = (f32x4){mx[0], mx[1], mx[2], mx[3]}; *(LAS f32x4*)(dst + 4) = (f32x4){mx[4], mx[5], mx[6], mx[7]}; }
                else if (ch < 32) {
#pragma unroll
                    for (int j = 0; j < 8; ++j) mx[j] = tanh_fast(mx[j]);
                    *(LAS u32x4*)(TW + s * 72 + cc - 192) = pack8(mx); }
                else if (ch < 40) *(LAS u32x4*)(TA + s * 72 + cc - 256) = pack8(mx);
                else {
#pragma unroll
                    for (int j = 0; j < 8; ++j) mx[j] = sigmoidf_(mx[j]);
                    *(LAS u32x4*)(TG + s * 136 + cc - 320) = pack8(mx); } }
            RW_BAR_NV();
            if (sw < 2) {
#pragma unroll
                for (int cb = 0; cb < 2; ++cb) { f32x16 acc = (f32x16){0.f,0.f,0.f,0.f,0.f,0.f,0.f,0.f,0.f,0.f,0.f,0.f,0.f,0.f,0.f,0.f};
#pragma unroll
                    for (int ks = 0; ks < 4; ++ks) { const bf16x8 a = *(const LAS bf16x8*)((sw == 0 ? TW : TA) + r32 * 72 + ks * 16 + hh * 8); acc = __builtin_amdgcn_mfma_f32_32x32x16_bf16(a, Bf[cb * 4 + ks], acc, 0, 0, 0); }
                    const int c = cb * 32 + r32;
#pragma unroll
                    for (int r = 0; r < 16; ++r) { const int s = (r & 3) + 8 * (r >> 2) + 4 * hh; if (sw == 0) W_[s * 64 + c] = acc[r]; else KKA[s * 64 + c] = acc[r]; } } }
            else if (d == 0) { const int cb = sw - 2; f32x16 acc = (f32x16){0.f,0.f,0.f,0.f,0.f,0.f,0.f,0.f,0.f,0.f,0.f,0.f,0.f,0.f,0.f,0.f};
#pragma unroll
                for (int ks = 0; ks < 8; ++ks) { const bf16x8 a = *(const LAS bf16x8*)(TG + r32 * 136 + ks * 16 + hh * 8); acc = __builtin_amdgcn_mfma_f32_32x32x16_bf16(a, Bf[ks], acc, 0, 0, 0); }
#pragma unroll
                for (int r = 0; r < 16; ++r) { const int s = (r & 3) + 8 * (r >> 2) + 4 * hh; RWG[(size_t)(cp.rowbase + cp.t_lo + s) * 512 + h * 64 + cb * 32 + r32] = f2bf(acc[r]); } }
            RW_BAR_NV();
            { const int s = t2 >> 3, c8 = (t2 & 7) * 8; float kkv[8], av[8], kt[8], wr[8], rr[8], cw0[8], ca0[8], ckk[8], cka[8], crk[8], ssq = 0.f, bdp = 0.f;
#define RW_LD8(dst, ptr) do { const f32x4 t0_ = *(const LAS f32x4*)(ptr), t1_ = *(const LAS f32x4*)((ptr) + 4); _Pragma("unroll") for (int q_ = 0; q_ < 4; ++q_) { dst[q_] = t0_[q_]; dst[4 + q_] = t1_[q_]; } } while (0)
#define RW_ST8(ptr, src) do { *(LAS f32x4*)(ptr) = (f32x4){src[0], src[1], src[2], src[3]}; *(LAS f32x4*)((ptr) + 4) = (f32x4){src[4], src[5], src[6], src[7]}; } while (0)
                RW_LD8(kt, KD + s * 64 + c8); RW_LD8(av, KKA + s * 64 + c8); RW_LD8(wr, W_ + s * 64 + c8); RW_LD8(rr, R_ + s * 64 + c8);
                RW_LD8(cw0, CW0 + c8); RW_LD8(ca0, CA0 + c8); RW_LD8(ckk, CKK + c8); RW_LD8(cka, CKA + c8); RW_LD8(crk, CRK + c8);
#pragma unroll
                for (int j = 0; j < 8; ++j) { av[j] = sigmoidf_(ca0[j] + av[j]); kkv[j] = kt[j] * ckk[j]; ssq += kkv[j] * kkv[j];
                    const float wl = -softplus_fast(-(cw0[j] + wr[j])) - 0.5f; wr[j] = __expf(-__expf(wl)); }
                const float inv = rsqrtf(sum8(ssq) + 1e-12f); float kk8[8], kka8[8], kd8[8];
#pragma unroll
                for (int j = 0; j < 8; ++j) { const float kn = kkv[j] * inv; kk8[j] = -kn; kka8[j] = kn * av[j]; kd8[j] = kt[j] * (1.0f + (av[j] - 1.0f) * cka[j]); bdp += rr[j] * kd8[j] * crk[j]; }
                RW_ST8(W_ + s * 64 + c8, wr); RW_ST8(KK + s * 64 + c8, kk8); RW_ST8(KKA + s * 64 + c8, kka8); RW_ST8(KD + s * 64 + c8, kd8);
                bdp = sum8(bdp); if ((t2 & 7) == 0) BD[(size_t)(cp.rowbase + cp.t_lo + s) * 8 + h] = bdp; }
            RW_BAR();
        }
        RW_BAR_NV(); RW_BAR_NV(); RW_BAR_NV(); RW_BAR_NV();
#undef RW_RAW_LOAD
    } else {
        const int vl = lane >> 3, kq = lane & 7; float S[2][8];
#pragma unroll
        for (int i = 0; i < 2; ++i)
#pragma unroll
            for (int j = 0; j < 8; ++j) S[i][j] = 0.f;
        RW_BAR_NV(); RW_BAR_NV(); RW_BAR_NV(); RW_BAR_NV();
        for (int ci = 0; ci < NCHUNK; ++ci) {
            const ChunkPos cp = chunk_pos(b, d, ci);
            const LAS float* OP = (const LAS float*)(L + ((ci & 1) ? RW_OPB : RW_OP)); const LAS float* W_ = OP; const LAS float* KK = OP + 2048; const LAS float* KKA = OP + 4096; const LAS float* KD = OP + 6144; const LAS float* R_ = OP + 8192; const LAS float* V_ = OP + 10240;
            bf16_t* yrow = RWY + (size_t)(cp.rowbase + cp.t_lo) * 512 + h * 64 + 16 * wave + 2 * vl;
#pragma unroll 1
            for (int seg = 0; seg < 4; ++seg) {
#pragma unroll 2
                for (int s8 = 0; s8 < 8; ++s8) { const int st = seg * 8 + s8, sm = d ? 31 - st : st; const int o = sm * 64 + 8 * kq;
                    const f32x4 w0 = *(const LAS f32x4*)(W_ + o), w1 = *(const LAS f32x4*)(W_ + o + 4), k0 = *(const LAS f32x4*)(KK + o), k1 = *(const LAS f32x4*)(KK + o + 4),
                                a0 = *(const LAS f32x4*)(KKA + o), a1 = *(const LAS f32x4*)(KKA + o + 4), d0 = *(const LAS f32x4*)(KD + o), d1 = *(const LAS f32x4*)(KD + o + 4),
                                r0 = *(const LAS f32x4*)(R_ + o), r1 = *(const LAS f32x4*)(R_ + o + 4);
                    const f32x2 v2 = *(const LAS f32x2*)(V_ + sm * 64 + 16 * wave + 2 * vl);
                    float y[2];
#pragma unroll
                    for (int i = 0; i < 2; ++i) {
                        float sa = ((S[i][0] * k0[0] + S[i][1] * k0[1]) + (S[i][2] * k0[2] + S[i][3] * k0[3])) + ((S[i][4] * k1[0] + S[i][5] * k1[1]) + (S[i][6] * k1[2] + S[i][7] * k1[3]));
                        sa = sum8(sa);
#pragma unroll
                        for (int j = 0; j < 4; ++j) { S[i][j] = S[i][j] * w0[j] + sa * a0[j] + v2[i] * d0[j]; S[i][4 + j] = S[i][4 + j] * w1[j] + sa * a1[j] + v2[i] * d1[j]; }
                        y[i] = sum8(((S[i][0] * r0[0] + S[i][1] * r0[1]) + (S[i][2] * r0[2] + S[i][3] * r0[3])) + ((S[i][4] * r1[0] + S[i][5] * r1[1]) + (S[i][6] * r1[2] + S[i][7] * r1[3]))); }
                    if (kq == 0) *(unsigned*)(yrow + (size_t)sm * 512) = cvt_pk_bf16(y[0], y[1]); }
                if (seg < 3) RW_BAR_NV(); else RW_BAR();
            }
        }
    }
}
constexpr int SD_RAW = 0, SD_BM = 42240, SD_CM = 59648, SD_XM = 77056, SD_XST = 86272, SD_H0 = 95488, SD_CUM = 130304, SD_DTC = 130560, SD_LA = 130816, SD_CW = 131072, SD_CB = 134912;
constexpr int SD_LDB = 272, SD_LDX = 144;
struct ChunkPos64 { int rowbase, t_lo, seglen; };
__device__ __forceinline__ ChunkPos64 chunk_pos64(int b, int d, int ci) { ChunkPos64 c; const bool isctx = ci < 4; const int cl = isctx ? ci : ci - 4; c.seglen = isctx ? LCTX : LAT;
    c.rowbase = b * TPB + (isctx ? 0 : LCTX); c.t_lo = d == 0 ? cl * 64 : c.seglen - 64 * (cl + 1); return c; }
PHASE_FN void ssd_chain(int wv, PRM p, int l, LAS unsigned char* L, int d, int b, int h) {
    const int tid = TID, lane = tid & 63, wave = wv, r32 = lane & 31, hh = lane >> 5, g = h >> 2;
    LAS bf16_t* RAW = (LAS bf16_t*)(L + SD_RAW);
    LAS float* CUM = (LAS float*)(L + SD_CUM); LAS float* DTC = (LAS float*)(L + SD_DTC); LAS float* LA = (LAS float*)(L + SD_LA);
    LAS float* CWt = (LAS float*)(L + SD_CW); LAS float* CBs = (LAS float*)(L + SD_CB);
    const bf16_t* U = (const bf16_t*)(p.ws + WS_U); bf16_t* SSDY = (bf16_t*)(p.ws + WS_SSDY) + (size_t)d * NTOK * 512;
    __syncthreads();
    if (tid < 320) { const int cc = tid; const int ch = cc < 64 ? h * 64 + cc : (cc < 192 ? 512 + g * 128 + (cc - 64) : 768 + g * 128 + (cc - 192));
#pragma unroll
        for (int j = 0; j < 3; ++j) CWt[j * 320 + cc] = p.in[I_SSD_CW][((size_t)l * 3 + j) * 1024 + ch];
        CBs[cc] = p.in[I_SSD_CB][l * 1024 + ch]; }
    for (int i = tid; i < 64 * SD_LDB / 4; i += NTHR) ((LAS unsigned*)(L + SD_H0))[i] = 0u;
    const float Aneg = -__expf(p.in[I_SSD_ALOG][(l * 2 + d) * 8 + h]), dtb = p.in[I_SSD_DTB][(l * 2 + d) * 8 + h], Dh = p.in[I_SSD_D][l * 8 + h];
    f32x16 hst[2];
    hst[0] = (f32x16){0.f,0.f,0.f,0.f,0.f,0.f,0.f,0.f,0.f,0.f,0.f,0.f,0.f,0.f,0.f,0.f}; hst[1] = hst[0];
    u32x4 rawreg[6]; float dtreg = 0.f;
#define SD_LOAD(cpx) do { _Pragma("unroll") for (int it = 0; it < 6; ++it) { const int idx = tid + it * NTHR; u32x4 v = (u32x4){0u, 0u, 0u, 0u}; \
        if (idx < 66 * 40) { const int row = idx / 40, ch = idx - row * 40; const int t = (cpx).t_lo - 1 + row; \
            const int gcol = ch < 8 ? U_SSD_X + h * 64 + ch * 8 : (ch < 24 ? U_SSD_B + g * 128 + (ch - 8) * 8 : U_SSD_C + g * 128 + (ch - 24) * 8); \
            if (t >= 0 && t < (cpx).seglen) v = *(const u32x4*)(U + (size_t)((cpx).rowbase + t) * UC + gcol); } \
        rawreg[it] = v; } \
        if (tid < 64) { const int sm = d ? 63 - tid : tid; dtreg = bf2f(U[(size_t)((cpx).rowbase + (cpx).t_lo + sm) * UC + U_SSD_DT + h]); } } while (0)
    { const ChunkPos64 c0 = chunk_pos64(b, d, 0); SD_LOAD(c0); }
    const int i16 = lane & 15; const int troff = (4 * hh + (i16 >> 2)), trcol = (((lane >> 4) & 1) * 16 + (i16 & 3) * 4) * 2;
    for (int ci = 0; ci < 68; ++ci) {
        const ChunkPos64 cp = chunk_pos64(b, d, ci);
        LAS unsigned char* H0c = L + SD_H0 + (ci & 1) * 64 * SD_LDB; LAS unsigned char* H0n = L + SD_H0 + ((ci + 1) & 1) * 64 * SD_LDB;
        __syncthreads();
#pragma unroll
        for (int it = 0; it < 6; ++it) { const int idx = tid + it * NTHR; if (idx < 66 * 40) { const int row = idx / 40, ch = idx - row * 40; *(LAS u32x4*)(RAW + row * 320 + ch * 8) = rawreg[it]; } }
        if (tid < 64) { const float dtc = softplus_fast(dtreg + dtb); DTC[tid] = dtc; LA[tid] = dtc * Aneg; }
        __syncthreads();
        if (ci + 1 < 68) { const ChunkPos64 cn = chunk_pos64(b, d, ci + 1); SD_LOAD(cn); }
        for (int idx = tid; idx < 64 * 40; idx += NTHR) { const int sm = idx / 40, ch = idx - sm * 40, cc = ch * 8; const int i = d ? 63 - sm : sm;
            float a0[8], a1[8], a2[8], o[8]; unpack8(*(const LAS u32x4*)(RAW + sm * 320 + cc), a0); unpack8(*(const LAS u32x4*)(RAW + (sm + 1) * 320 + cc), a1); unpack8(*(const LAS u32x4*)(RAW + (sm + 2) * 320 + cc), a2);
            float cb8[8], w0[8], w1[8], w2[8];
            { const f32x4 t0 = *(const LAS f32x4*)(CBs + cc), t1 = *(const LAS f32x4*)(CBs + cc + 4), u0 = *(const LAS f32x4*)(CWt + cc), u1 = *(const LAS f32x4*)(CWt + cc + 4),
                          x0 = *(const LAS f32x4*)(CWt + 320 + cc), x1 = *(const LAS f32x4*)(CWt + 320 + cc + 4), y0 = *(const LAS f32x4*)(CWt + 640 + cc), y1 = *(const LAS f32x4*)(CWt + 640 + cc + 4);
#pragma unroll
              for (int q = 0; q < 4; ++q) { cb8[q] = t0[q]; cb8[4 + q] = t1[q]; w0[q] = u0[q]; w0[4 + q] = u1[q]; w1[q] = x0[q]; w1[4 + q] = x1[q]; w2[q] = y0[q]; w2[4 + q] = y1[q]; } }
#pragma unroll
            for (int q = 0; q < 8; ++q) o[q] = siluf_(cb8[q] + w0[q] * a0[q] + w1[q] * a1[q] + w2[q] * a2[q]);
            LAS unsigned char* dst = ch < 8 ? L + SD_XM + i * SD_LDX + cc * 2 : (ch < 24 ? L + SD_BM + i * SD_LDB + (cc - 64) * 2 : L + SD_CM + i * SD_LDB + (cc - 192) * 2);
            *(LAS u32x4*)dst = pack8(o); }
        if (wave == 7) CUM[lane] = wave_incl_scan(LA[lane], lane);
        __syncthreads();
        { const int pp = tid & 63, jc = tid >> 6; const float cl = CUM[63]; float x[8];
#pragma unroll
            for (int q = 0; q < 8; ++q) { const int j = 8 * jc + q; x[q] = bf2f(*(const LAS bf16_t*)(L + SD_XM + j * SD_LDX + pp * 2)) * (__expf(cl - CUM[j]) * DTC[j]); }
            *(LAS u32x4*)(L + SD_XST + pp * SD_LDX + jc * 16) = pack8(x); }
        __syncthreads();
        if (wave < 4) {
            const int ib = wave >> 1, pb = wave & 1;
            f32x16 accy = (f32x16){0.f,0.f,0.f,0.f,0.f,0.f,0.f,0.f,0.f,0.f,0.f,0.f,0.f,0.f,0.f,0.f};
            const float cum_i = CUM[32 * ib + r32];
            for (int jb = 0; jb <= ib; ++jb) {
                f32x16 st = (f32x16){0.f,0.f,0.f,0.f,0.f,0.f,0.f,0.f,0.f,0.f,0.f,0.f,0.f,0.f,0.f,0.f};
#pragma unroll
                for (int ks = 0; ks < 8; ++ks) { const bf16x8 a = *(const LAS bf16x8*)(L + SD_BM + (32 * jb + r32) * SD_LDB + (ks * 16 + hh * 8) * 2);
                    const bf16x8 bq = *(const LAS bf16x8*)(L + SD_CM + (32 * ib + r32) * SD_LDB + (ks * 16 + hh * 8) * 2); st = __builtin_amdgcn_mfma_f32_32x32x16_bf16(a, bq, st, 0, 0, 0); }
                float pv[16];
#pragma unroll
                for (int g4 = 0; g4 < 4; ++g4) { const f32x4 cj = *(const LAS f32x4*)(CUM + 32 * jb + 8 * g4 + 4 * hh), dj = *(const LAS f32x4*)(DTC + 32 * jb + 8 * g4 + 4 * hh);
#pragma unroll
                    for (int q = 0; q < 4; ++q) { const int jl = 8 * g4 + 4 * hh + q; const bool dead = (jb == ib) && (jl > r32); pv[4 * g4 + q] = dead ? 0.f : st[4 * g4 + q] * __expf(cum_i - cj[q]) * dj[q]; } }
#pragma unroll
                for (int ks = 0; ks < 2; ++ks) { float t8[8];
#pragma unroll
                    for (int q = 0; q < 8; ++q) t8[q] = pv[8 * ks + q];
                    const bf16x8 pa = __builtin_bit_cast(bf16x8, pack8(t8));
                    const LAS unsigned char* vb = L + SD_XM + (32 * jb + 16 * ks + troff) * SD_LDX + pb * 64 + trcol;
                    const s16x4 lo = vtr(vb), hi = vtr(vb + 8 * SD_LDX); const bf16x8 vf = (bf16x8){lo[0], lo[1], lo[2], lo[3], hi[0], hi[1], hi[2], hi[3]};
                    accy = __builtin_amdgcn_mfma_f32_32x32x16_bf16(pa, vf, accy, 0, 0, 0); }
            }
            f32x16 acc2 = (f32x16){0.f,0.f,0.f,0.f,0.f,0.f,0.f,0.f,0.f,0.f,0.f,0.f,0.f,0.f,0.f,0.f};
#pragma unroll
            for (int ks = 0; ks < 8; ++ks) { const bf16x8 a = *(const LAS bf16x8*)(L + SD_CM + (32 * ib + r32) * SD_LDB + (ks * 16 + hh * 8) * 2);
                const bf16x8 bq = *(const LAS bf16x8*)(H0c + (32 * pb + r32) * SD_LDB + (ks * 16 + hh * 8) * 2); acc2 = __builtin_amdgcn_mfma_f32_32x32x16_bf16(a, bq, acc2, 0, 0, 0); }
#pragma unroll
            for (int r = 0; r < 16; ++r) { const int il = (r & 3) + 8 * (r >> 2) + 4 * hh, i = 32 * ib + il; float y = accy[r] + __expf(CUM[i]) * acc2[r];
                if (d == 0) y += Dh * bf2f(*(const LAS bf16_t*)(L + SD_XM + i * SD_LDX + (32 * pb + r32) * 2));
                const int sm = d ? 63 - i : i; SSDY[(size_t)(cp.rowbase + cp.t_lo + sm) * 512 + h * 64 + 32 * pb + r32] = f2bf(y); }
        } else {
            const float e_last = __expf(CUM[63]);
#pragma unroll
            for (int tt = 0; tt < 2; ++tt) { const int t = 2 * (wave - 4) + tt, pb = t & 1, nb = t >> 1;
                hst[tt] = hst[tt] * e_last;
#pragma unroll
                for (int ks = 0; ks < 4; ++ks) { const bf16x8 a = *(const LAS bf16x8*)(L + SD_XST + (32 * pb + r32) * SD_LDX + (ks * 16 + hh * 8) * 2);
                    const LAS unsigned char* vb = L + SD_BM + (16 * ks + 8 * hh + (i16 >> 2)) * SD_LDB + nb * 64 + trcol;
                    const s16x4 lo = vtr(vb), hi = vtr(vb + 4 * SD_LDB); const bf16x8 vf = (bf16x8){lo[0], lo[1], lo[2], lo[3], hi[0], hi[1], hi[2], hi[3]};
                    hst[tt] = __builtin_amdgcn_mfma_f32_32x32x16_bf16(a, vf, hst[tt], 0, 0, 0); }
#pragma unroll
                for (int r = 0; r < 16; ++r) { const int pl = (r & 3) + 8 * (r >> 2) + 4 * hh; *(LAS bf16_t*)(H0n + (32 * pb + pl) * SD_LDB + (32 * nb + r32) * 2) = f2bf(hst[tt][r]); } }
        }
    }
#undef SD_LOAD
}
constexpr int GL_RAW = 0, GL_GC = 34816, GL_SEG = 51200, GL_QP = 53248, GL_KP = 62464, GL_QE = 71680, GL_K2T = 80896, GL_V = 90112, GL_S0T = 107520, GL_EL = 144384, GL_GUP = 144640, GL_GB = 148736;
PHASE_FN void gla_chain(int wv, PRM p, int l, LAS unsigned char* L, int d, int b, int h) {
    const int tid = TID, lane = tid & 63, wave = wv, r32 = lane & 31, hh = lane >> 5;
    LAS bf16_t* RAW = (LAS bf16_t*)(L + GL_RAW);
    LAS float* GC = (LAS float*)(L + GL_GC); LAS float* SEG = (LAS float*)(L + GL_SEG); LAS float* EL = (LAS float*)(L + GL_EL); LAS float* GUP = (LAS float*)(L + GL_GUP); LAS float* GB = (LAS float*)(L + GL_GB);
    const bf16_t* U = (const bf16_t*)(p.ws + WS_U); bf16_t* GLAO = (bf16_t*)(p.ws + WS_GLAO) + (size_t)d * NTOK * 512;
    __syncthreads();
    for (int i = tid; i < 1024; i += NTHR) GUP[i] = p.in[I_GLA_GUP][((size_t)(l * 2 + d) * 16 + (i >> 6)) * 256 + h * 64 + (i & 63)];
    if (tid < 64) GB[tid] = p.in[I_GLA_GB][(l * 2 + d) * 256 + h * 64 + tid];
    for (int i = tid; i < 128 * SD_LDX / 4; i += NTHR) ((LAS unsigned*)(L + GL_S0T))[i] = 0u;
    f32x16 sst[2]; sst[0] = (f32x16){0.f,0.f,0.f,0.f,0.f,0.f,0.f,0.f,0.f,0.f,0.f,0.f,0.f,0.f,0.f,0.f}; sst[1] = sst[0];
    u32x4 rawreg[5];
#define GL_LOAD(cpx) do { _Pragma("unroll") for (int it = 0; it < 5; ++it) { const int idx = tid + it * NTHR; u32x4 v = (u32x4){0u, 0u, 0u, 0u}; \
        if (idx < 64 * 34) { const int row = idx / 34, ch = idx - row * 34; \
            const int gcol = ch < 8 ? U_GLA_Q + h * 64 + ch * 8 : (ch < 16 ? U_GLA_K + h * 64 + (ch - 8) * 8 : (ch < 32 ? U_GLA_V + h * 128 + (ch - 16) * 8 : U_GLA_GD + d * 16 + (ch - 32) * 8)); \
            v = *(const u32x4*)(U + (size_t)((cpx).rowbase + (cpx).t_lo + row) * UC + gcol); } \
        rawreg[it] = v; } } while (0)
    { const ChunkPos64 c0 = chunk_pos64(b, d, 0); GL_LOAD(c0); }
    const int i16 = lane & 15, q4 = i16 >> 2; const int trcol = (((lane >> 4) & 1) * 16 + (i16 & 3) * 4) * 2;
    for (int ci = 0; ci < 68; ++ci) {
        const ChunkPos64 cp = chunk_pos64(b, d, ci);
        LAS unsigned char* S0c = L + GL_S0T + (ci & 1) * 128 * SD_LDX; LAS unsigned char* S0n = L + GL_S0T + ((ci + 1) & 1) * 128 * SD_LDX;
        __syncthreads();
#pragma unroll
        for (int it = 0; it < 5; ++it) { const int idx = tid + it * NTHR; if (idx < 64 * 34) { const int row = idx / 34, ch = idx - row * 34; *(LAS u32x4*)(RAW + row * 272 + ch * 8) = rawreg[it]; } }
        __syncthreads();
        if (ci + 1 < 68) { const ChunkPos64 cn = chunk_pos64(b, d, ci + 1); GL_LOAD(cn); }
        { const int i = tid >> 3, kc = tid & 7; const int sm = d ? 63 - i : i; float gdA[8], gdB[8], gt[8];
            unpack8(*(const LAS u32x4*)(RAW + sm * 272 + 256), gdA); unpack8(*(const LAS u32x4*)(RAW + sm * 272 + 264), gdB);
            { const f32x4 b0 = *(const LAS f32x4*)(GB + kc * 8), b1 = *(const LAS f32x4*)(GB + kc * 8 + 4);
#pragma unroll
              for (int q = 0; q < 4; ++q) { gt[q] = b0[q]; gt[4 + q] = b1[q]; } }
#pragma unroll
            for (int r = 0; r < 16; ++r) { const f32x4 u0 = *(const LAS f32x4*)(GUP + r * 64 + kc * 8), u1 = *(const LAS f32x4*)(GUP + r * 64 + kc * 8 + 4);
#pragma unroll
                for (int q = 0; q < 4; ++q) { const float gv = r < 8 ? gdA[r & 7] : gdB[r & 7]; gt[q] += gv * u0[q]; gt[4 + q] += gv * u1[q]; } }
            f32x4 o0, o1;
#pragma unroll
            for (int q = 0; q < 4; ++q) { o0[q] = -softplus_fast(-gt[q]) * (1.0f / 16.0f); o1[q] = -softplus_fast(-gt[4 + q]) * (1.0f / 16.0f); }
            *(LAS f32x4*)(GC + i * 64 + kc * 8) = o0; *(LAS f32x4*)(GC + i * 64 + kc * 8 + 4) = o1; }
        __syncthreads();
        { const int k = tid & 63, seg = tid >> 6; float run = 0.f;
#pragma unroll
            for (int ii = 0; ii < 8; ++ii) { run += GC[(seg * 8 + ii) * 64 + k]; GC[(seg * 8 + ii) * 64 + k] = run; }
            SEG[seg * 64 + k] = run;
            __syncthreads();
            float pre = 0.f; for (int s2 = 0; s2 < seg; ++s2) pre += SEG[s2 * 64 + k];
#pragma unroll
            for (int ii = 0; ii < 8; ++ii) GC[(seg * 8 + ii) * 64 + k] += pre; }
        __syncthreads();
        { const int i = tid >> 3, kc = tid & 7; const int sm = d ? 63 - i : i; float q8[8], k8[8], gci[8], gref[8];
            unpack8(*(const LAS u32x4*)(RAW + sm * 272 + kc * 8), q8); unpack8(*(const LAS u32x4*)(RAW + sm * 272 + 64 + kc * 8), k8);
            { const f32x4 a0 = *(const LAS f32x4*)(GC + i * 64 + kc * 8), a1 = *(const LAS f32x4*)(GC + i * 64 + kc * 8 + 4), r0 = *(const LAS f32x4*)(GC + 32 * 64 + kc * 8), r1 = *(const LAS f32x4*)(GC + 32 * 64 + kc * 8 + 4);
#pragma unroll
              for (int q = 0; q < 4; ++q) { gci[q] = a0[q]; gci[4 + q] = a1[q]; gref[q] = r0[q]; gref[4 + q] = r1[q]; } }
            float qp[8], kp[8], qe[8];
#pragma unroll
            for (int q = 0; q < 8; ++q) { const float qs = q8[q] * 0.125f; qp[q] = qs * __expf(gci[q] - gref[q]); kp[q] = k8[q] * __expf(gref[q] - gci[q]); qe[q] = qs * __expf(gci[q]); }
            *(LAS u32x4*)(L + GL_QP + i * SD_LDX + kc * 16) = pack8(qp); *(LAS u32x4*)(L + GL_KP + i * SD_LDX + kc * 16) = pack8(kp); *(LAS u32x4*)(L + GL_QE + i * SD_LDX + kc * 16) = pack8(qe); }
        { const int k = tid & 63, jc = tid >> 6; const float gl = GC[63 * 64 + k]; float x[8];
#pragma unroll
            for (int q = 0; q < 8; ++q) { const int j = 8 * jc + q; const int sm = d ? 63 - j : j; x[q] = bf2f(RAW[sm * 272 + 64 + k]) * __expf(gl - GC[j * 64 + k]); }
            *(LAS u32x4*)(L + GL_K2T + k * SD_LDX + jc * 16) = pack8(x); }
        for (int idx = tid; idx < 64 * 16; idx += NTHR) { const int i = idx >> 4, vc = idx & 15; const int sm = d ? 63 - i : i; *(LAS u32x4*)(L + GL_V + i * SD_LDB + vc * 16) = *(const LAS u32x4*)(RAW + sm * 272 + 128 + vc * 8); }
        if (tid < 64) EL[tid] = __expf(GC[63 * 64 + tid]);
        __syncthreads();
        if (wave < 4) {
            const int ib = wave >> 1, eh = wave & 1;
            f32x16 acc[2]; acc[0] = (f32x16){0.f,0.f,0.f,0.f,0.f,0.f,0.f,0.f,0.f,0.f,0.f,0.f,0.f,0.f,0.f,0.f}; acc[1] = acc[0];
            for (int jb = 0; jb <= ib; ++jb) {
                f32x16 at = (f32x16){0.f,0.f,0.f,0.f,0.f,0.f,0.f,0.f,0.f,0.f,0.f,0.f,0.f,0.f,0.f,0.f};
#pragma unroll
                for (int ks = 0; ks < 4; ++ks) { const bf16x8 a = *(const LAS bf16x8*)(L + GL_KP + (32 * jb + r32) * SD_LDX + (ks * 16 + hh * 8) * 2);
                    const bf16x8 bq = *(const LAS bf16x8*)(L + GL_QP + (32 * ib + r32) * SD_LDX + (ks * 16 + hh * 8) * 2); at = __builtin_amdgcn_mfma_f32_32x32x16_bf16(a, bq, at, 0, 0, 0); }
#pragma unroll
                for (int ks = 0; ks < 2; ++ks) { float t8[8];
#pragma unroll
                    for (int q = 0; q < 8; ++q) { const int r = 8 * ks + q; const int jl = (r & 3) + 8 * (r >> 2) + 4 * hh; t8[q] = ((jb == ib) && (jl > r32)) ? 0.f : at[r]; }
                    const bf16x8 pa = __builtin_bit_cast(bf16x8, pack8(t8));
#pragma unroll
                    for (int ebi = 0; ebi < 2; ++ebi) { const LAS unsigned char* vb = L + GL_V + (32 * jb + 16 * ks + 4 * hh + q4) * SD_LDB + (2 * eh + ebi) * 64 + trcol;
                        const s16x4 lo = vtr(vb), hi = vtr(vb + 8 * SD_LDB); const bf16x8 vf = (bf16x8){lo[0], lo[1], lo[2], lo[3], hi[0], hi[1], hi[2], hi[3]};
                        acc[ebi] = __builtin_amdgcn_mfma_f32_32x32x16_bf16(pa, vf, acc[ebi], 0, 0, 0); } }
            }
#pragma unroll
            for (int ebi = 0; ebi < 2; ++ebi)
#pragma unroll
                for (int ks = 0; ks < 4; ++ks) { const bf16x8 a = *(const LAS bf16x8*)(L + GL_QE + (32 * ib + r32) * SD_LDX + (ks * 16 + hh * 8) * 2);
                    const bf16x8 bq = *(const LAS bf16x8*)(S0c + (32 * (2 * eh + ebi) + r32) * SD_LDX + (ks * 16 + hh * 8) * 2); acc[ebi] = __builtin_amdgcn_mfma_f32_32x32x16_bf16(a, bq, acc[ebi], 0, 0, 0); }
#pragma unroll
            for (int r = 0; r < 16; ++r) { const int i = 32 * ib + (r & 3) + 8 * (r >> 2) + 4 * hh; const int sm = d ? 63 - i : i;
                bf16_t* op = GLAO + (size_t)(cp.rowbase + cp.t_lo + sm) * 512 + h * 128 + 64 * eh + r32;
                op[0] = f2bf(acc[0][r]); op[32] = f2bf(acc[1][r]); }
        } else {
#pragma unroll
            for (int tt = 0; tt < 2; ++tt) { const int t = 2 * (wave - 4) + tt, kb = t & 1, eb = t >> 1;
#pragma unroll
                for (int g4 = 0; g4 < 4; ++g4) { const f32x4 e4 = *(const LAS f32x4*)(EL + 32 * kb + 8 * g4 + 4 * hh);
#pragma unroll
                    for (int q = 0; q < 4; ++q) sst[tt][4 * g4 + q] *= e4[q]; }
#pragma unroll
                for (int ks = 0; ks < 4; ++ks) { const bf16x8 a = *(const LAS bf16x8*)(L + GL_K2T + (32 * kb + r32) * SD_LDX + (ks * 16 + hh * 8) * 2);
                    const LAS unsigned char* vb = L + GL_V + (16 * ks + 8 * hh + q4) * SD_LDB + eb * 64 + trcol;
                    const s16x4 lo = vtr(vb), hi = vtr(vb + 4 * SD_LDB); const bf16x8 vf = (bf16x8){lo[0], lo[1], lo[2], lo[3], hi[0], hi[1], hi[2], hi[3]};
                    sst[tt] = __builtin_amdgcn_mfma_f32_32x32x16_bf16(a, vf, sst[tt], 0, 0, 0); }
#pragma unroll
                for (int g4 = 0; g4 < 4; ++g4) { u32x2 w; w.x = cvt_pk_bf16(sst[tt][4 * g4], sst[tt][4 * g4 + 1]); w.y = cvt_pk_bf16(sst[tt][4 * g4 + 2], sst[tt][4 * g4 + 3]);
                    *(LAS u32x2*)(S0n + (32 * eb + r32) * SD_LDX + (32 * kb + 8 * g4 + 4 * hh) * 2) = w; } }
        }
    }
#undef GL_LOAD
}
PHASE_FN void phase_mix(int wv, PRM p, int l, LAS unsigned char* lds, int qsel = 0, int item0 = 0, int item1 = 1 << 30) {
    LAS int* slot = (LAS int*)(lds + 32);
    unsigned* q = (unsigned*)(p.ws + WS_CTL) + CW_QUEUE + l * 64 + qsel * 16;
    const float lam_init = 0.8f - 0.6f * expf(-0.3f * (float)l);
    float s1 = 0.f, s2 = 0.f;
    for (int i = 0; i < 64; ++i) { s1 += p.in[I_DF_Q1][l * 64 + i] * p.in[I_DF_K1][l * 64 + i]; s2 += p.in[I_DF_Q2][l * 64 + i] * p.in[I_DF_K2][l * 64 + i]; }
    if (TID == 0) { LAS float* lp = (LAS float*)(lds + 40); lp[0] = expf(s1) - expf(s2) + lam_init; lp[1] = 1.0f - lam_init; }
    const LAS float* lamp = (const LAS float*)(lds + 40);
    const int n_ctx_att = (l < DEPTH - 1) ? 64 : 0, nitems = 320 + 1024 + n_ctx_att;
    for (;;) {
        if (TID == 0) *slot = (int)atomicAdd(q, 1u);
        __syncthreads();
        const int item = *slot + item0;
        __syncthreads();
        if (item >= nitems || item >= item1) break;
        CParams& pp = *kparams(); LAS unsigned char* L = olds(lds) + LDS_STAGE;
        if (item < 128) { const int i = item; rwkv_chain(wv, pp, l, L, i & 1, (i >> 1) & 7, i >> 4); }
        else if (item < 256) { const int i = item - 128; ssd_chain(wv, pp, l, L, i & 1, (i >> 1) & 7, i >> 4); }
        else if (item < 320) { const int i = item - 256; gla_chain(wv, pp, l, L, i & 1, (i >> 1) & 7, i >> 4); }
        else if (item < 320 + 1024) { const int i = item - 320; const int b = i >> 7, h = (i >> 5) & 3, qb = i & 31; attn_unit(wv, pp, L, b * TPB + LCTX + qb * 128, b * TPB, TPB / 64, h, lamp, pp.in[I_DF_SG] + l * 128); }
        else { const int i = item - 1344; const int b = i >> 3, h = (i >> 1) & 3, qb = i & 1; attn_unit(wv, pp, L, b * TPB + qb * 128, b * TPB, LCTX / 64, h, lamp, pp.in[I_DF_SG] + l * 128); }
    }
}

PHASE_FN void phase_g1(int wv, PRM p, LAS unsigned char* lds) {
    const char* ws = p.ws; SchedDense S{NPANEL, UC / 256, (int)gridDim.x, BLK, ws + WS_H, ws + WS_WIN, (size_t)256 * 1024 * 2, (size_t)256 * 1024 * 2};
    EpiStoreBf16<0> E{(bf16_t*)(p.ws + WS_U), UC};
    pg8::gemm_phase(wv, lds + LDS_STAGE, pg8::Gemm{1024, 1024, 1024}, S, E); }
PHASE_FN void phase_g2(int wv, PRM p, LAS unsigned char* lds) {
    const char* ws = p.ws; SchedDense S{NPANEL, 16, (int)gridDim.x, BLK, ws + WS_H, ws + WS_WG, (size_t)256 * 1024 * 2, (size_t)256 * 1024 * 2};
    EpiStoreBf16<1> E{(bf16_t*)(p.ws + WS_GATES), 4096};
    pg8::gemm_phase(wv, lds + LDS_STAGE, pg8::Gemm{1024, 1024, 1024}, S, E); }
PHASE_FN void phase_g3(int wv, PRM p, LAS unsigned char* lds) {
    const char* ws = p.ws; SchedMerge S{(int)gridDim.x, BLK, ws + WS_Y, ws + WS_WB};
    EpiMerge E{(const bf16_t*)(ws + WS_GATES), (float*)(p.ws + WS_M), (bf16_t*)(p.ws + WS_H)};
    pg8::gemm_phase(wv, lds + LDS_STAGE, pg8::Gemm{2048, 512, 512}, S, E); }
PHASE_FN void phase_g4(int wv, PRM p, int l, LAS unsigned char* lds) {
    const char* ws = p.ws; SchedDense S{NPANEL, 4, (int)gridDim.x, BLK, ws + WS_H, ws + WS_WO, (size_t)256 * 1024 * 2, (size_t)256 * 1024 * 2};
    EpiResid E{(float*)(p.ws + WS_XC), p.out, p.in[I_CTX], p.in[I_X], l, (const float*)(ws + WS_MOD) + (size_t)l * 9 * 6144};
    pg8::gemm_phase(wv, lds + LDS_STAGE, pg8::Gemm{1024, 1024, 1024}, S, E); }
PHASE_FN void phase_g5(int wv, PRM p, int l, LAS unsigned char* lds) {
    const char* ws = p.ws; LAS int* tab = (LAS int*)(lds + LDS_TAB); moe_tables(wv, p, l, tab, tab + 320);
    SchedMoe S{(int)gridDim.x, BLK, tab, ws + WS_XB, ws + WS_GU, (size_t)256 * 1024 * 2, (size_t)1024 * 1024 * 2, (size_t)256 * 1024 * 2};
    EpiSwiGLU E{(bf16_t*)(p.ws + WS_HID)};
    pg8::gemm_phase(wv, lds + LDS_STAGE, pg8::Gemm{1024, 1024, 1024}, S, E); }
PHASE_FN void phase_g6(int wv, PRM p, int l, LAS unsigned char* lds) {
    const char* ws = p.ws; LAS int* tab = (LAS int*)(lds + LDS_TAB); moe_tables(wv, p, l, tab, tab + 320);
    SchedMoe S{(int)gridDim.x, BLK, tab, ws + WS_HID, ws + WS_DW, (size_t)256 * 512 * 2, (size_t)1024 * 512 * 2, (size_t)256 * 512 * 2};
    EpiStoreBf16<0> E{(bf16_t*)(p.ws + WS_YB), 1024};
    pg8::gemm_phase(wv, lds + LDS_STAGE, pg8::Gemm{512, 512, 512}, S, E); }

constexpr int PH_PER_LAYER = 13, N_PHASES = 1 + DEPTH * PH_PER_LAYER;
constexpr int LDS_PARAMS = 256;
#ifndef PROBE_G1
#define PROBE_G1 1
#endif
#ifndef PROBE_G2
#define PROBE_G2 1
#endif
#ifndef PROBE_G3
#define PROBE_G3 1
#endif
#ifndef PROBE_FIN
#define PROBE_FIN 1
#endif
#ifndef PROBE_G5
#define PROBE_G5 1
#endif
#ifndef PROBE_CONV
#define PROBE_CONV 1
#endif
#ifdef PROBE_MIX_TWICE
#define PROBE_NREP 2
#else
#define PROBE_NREP 1
#define PROBE_I0 0
#define PROBE_I1 0
#endif
#define LAYER_BODY(l) { if (PH_ON) { for (int rep = 0; rep < PROBE_CONV; ++rep) { phase_convert(wv, *kparams(), l, olds(lds)); } if (l == 0) phase_modulate0(wv, *kparams()); } PH_NEXT; if (PH_ON) { for (int rep = 0; rep < PROBE_G1; ++rep) { phase_g1(wv, *kparams(), olds(lds)); } } PH_NEXT; if (PH_ON) phase_prep(wv, *kparams()); PH_NEXT; if (PH_ON) { for (int rep = 0; rep < PROBE_NREP; ++rep) { phase_mix(wv, *kparams(), l, olds(lds), rep, rep ? PROBE_I0 : 0, rep ? PROBE_I1 : (1 << 30)); if (single && rep + 1 < PROBE_NREP) xcd_barrier(bar); } } PH_NEXT; if (PH_ON) { for (int rep = 0; rep < PROBE_FIN; ++rep) { phase_fin(wv, *kparams(), l); } } PH_NEXT; if (PH_ON) { for (int rep = 0; rep < PROBE_G2; ++rep) { phase_g2(wv, *kparams(), olds(lds)); } } PH_NEXT; if (PH_ON) { for (int rep = 0; rep < PROBE_G3; ++rep) { phase_g3(wv, *kparams(), olds(lds)); } } PH_NEXT; if (PH_ON) phase_g4(wv, *kparams(), l, olds(lds)); PH_NEXT; if (PH_ON) phase_ln1_router(wv, *kparams(), l, olds(lds)); PH_NEXT; if (PH_ON) phase_moe_assign(wv, *kparams(), l, olds(lds)); PH_NEXT; if (PH_ON) { for (int rep = 0; rep < PROBE_G5; ++rep) { phase_g5(wv, *kparams(), l, olds(lds)); } } PH_NEXT; if (PH_ON) phase_g6(wv, *kparams(), l, olds(lds)); PH_NEXT; if (PH_ON) phase_ln2(wv, *kparams(), l); PH_NEXT; }
__global__ void __launch_bounds__(NTHR, 2) fwd_kernel(Params p) {
    extern __shared__ __attribute__((aligned(16))) unsigned char shm[];
    LAS unsigned char* lds = (LAS unsigned char*)shm;
    const int ph_lo = p.ph_lo, ph_hi = p.ph_hi;
    const int wv = __builtin_amdgcn_readfirstlane((int)threadIdx.x >> 6);
    const bool single = (ph_hi - ph_lo) > 1;
    if (threadIdx.x == 0) *(LAS u32x4*)lds = (u32x4){0u, 0u, 0u, 0u};
    __syncthreads();
    XcdBarrier bar; bar.bar = (unsigned*)(p.ws + WS_CTL); bar.x = 0; bar.st = (volatile LAS unsigned*)lds;
    if (single) bar = xcd_barrier_post((unsigned*)(p.ws + WS_CTL), (volatile LAS unsigned*)lds);
    int gph = 0;
#define PH_ON (gph >= ph_lo && gph < ph_hi)
#define PH_NEXT do { ++gph; if (single) xcd_barrier(bar); } while (0)
    if (PH_ON) { phase_mod(wv, *kparams(), olds(lds)); phase_rope_table(wv, *kparams()); }
    PH_NEXT;
    LAYER_BODY(0) LAYER_BODY(1) LAYER_BODY(2) LAYER_BODY(3)
}
#ifndef MK_NO_HOST
#ifndef MK_MULTI
#define MK_MULTI 1
#endif
extern "C" void kernel_launch(void* const* d_in, const int* in_sizes, int n_in, void* d_out, int out_size, void* d_ws, size_t ws_size, hipStream_t stream) {
    static int grid = 0;
    if (grid == 0) {
        if (n_in != N_IN || ws_size < WS_END) { fprintf(stderr, "kernel_launch: unexpected n_in %d or ws_size %zu (< %zu)\n", n_in, ws_size, (size_t)WS_END); grid = -1; return; }
        int dev = 0, cus = 0, per_cu = 0;
        if (hipGetDevice(&dev) != hipSuccess || hipDeviceGetAttribute(&cus, hipDeviceAttributeMultiprocessorCount, dev) != hipSuccess) { grid = -1; return; }
        if (hipFuncSetAttribute((const void*)fwd_kernel, hipFuncAttributeMaxDynamicSharedMemorySize, LDS_BYTES) != hipSuccess) { fprintf(stderr, "kernel_launch: hipFuncSetAttribute failed\n"); grid = -1; return; }
        if (hipOccupancyMaxActiveBlocksPerMultiprocessor(&per_cu, fwd_kernel, NTHR, LDS_BYTES) != hipSuccess || per_cu < 1) { fprintf(stderr, "kernel_launch: occupancy query failed (%d)\n", per_cu); grid = -1; return; }
        grid = cus;
    }
    if (grid <= 0) return;
    (void)hipMemsetAsync((char*)d_ws + WS_CTL, 0, CTL_BYTES, stream);
    Params p{};
    for (int i = 0; i < N_IN; ++i) p.in[i] = (const float*)d_in[i];
    p.out = (float*)d_out; p.ws = (char*)d_ws;
#ifdef DBG_DET
    unsigned long long* cks = (unsigned long long*)((char*)d_ws + WS_END);
    (void)hipMemsetAsync(cks, 0, 2 * DBG_SLOTS * 8, stream);
    for (int run = 0; run < 2; ++run) {
        (void)hipMemsetAsync((char*)d_ws + WS_CTL, 0, CTL_BYTES, stream);
        for (int ph = 0; ph < N_PHASES; ++ph) { p.ph_lo = ph; p.ph_hi = ph + 1; hipLaunchKernelGGL(fwd_kernel, dim3(grid), dim3(NTHR), LDS_BYTES, stream, p);
            dbg_phase_ck(stream, (char*)d_ws, (float*)d_out, ph, cks + run * DBG_SLOTS + ph); }
    }
    hipLaunchKernelGGL(dbg_final, dim3(1024), dim3(256), 0, stream, cks, DBG_SLOTS, (float*)d_out, out_size);
#elif MK_MULTI
    for (int ph = 0; ph < N_PHASES; ++ph) { p.ph_lo = ph; p.ph_hi = ph + 1; hipLaunchKernelGGL(fwd_kernel, dim3(grid), dim3(NTHR), LDS_BYTES, stream, p); }
#else
    p.ph_lo = 0; p.ph_hi = N_PHASES;
    hipLaunchKernelGGL(fwd_kernel, dim3(grid), dim3(NTHR), LDS_BYTES, stream, p);
#endif
}
#endif
```

```cpp
#include <hip/hip_runtime.h>
#include <stdint.h>
#include <stdio.h>

#define LAS __attribute__((address_space(3)))
typedef unsigned short bf16_t;
typedef short bf16x8 __attribute__((ext_vector_type(8)));
typedef short s16x4 __attribute__((ext_vector_type(4)));
typedef float f32x2 __attribute__((ext_vector_type(2)));
typedef float f32x4 __attribute__((ext_vector_type(4)));
typedef float f32x16 __attribute__((ext_vector_type(16)));
typedef unsigned u32x2 __attribute__((ext_vector_type(2)));
typedef unsigned u32x4 __attribute__((ext_vector_type(4)));

constexpr int D = 1024, NBATCH = 8, LAT = 4096, LCTX = 256, TPB = 4352, NTOK = NBATCH * TPB, DEPTH = 4;
constexpr int NPANEL = NTOK / 256;
constexpr int UC = 6656;
constexpr int U_SSD_Z = 0, U_SSD_X = 512, U_SSD_B = 1024, U_SSD_C = 1280, U_RW_R = 1536, U_RW_K = 2048, U_RW_V = 2560, U_RW_WD = 3072, U_RW_AD = 3200,
              U_RW_GD = 3328, U_SSD_DT = 3456, U_GLA_GD = 3464, U_DF_Q = 3584, U_DF_K = 4096, U_DF_V = 4608, U_GLA_Q = 5120, U_GLA_K = 5376, U_GLA_V = 5632, U_GLA_OG = 6144;
constexpr int IN_COLS = 10664, GATE_COL0 = 6568;
constexpr int NEXP = 32, MOE_FF = 512, NSLOTBLK = 304, NSLOT = NSLOTBLK * 256;
constexpr float DN_ALPHA = 1.681792830507429f;
constexpr int NTHR = 512;
constexpr int LDS_BYTES = 159744;
constexpr int LDS_STAGE = 1024;
constexpr int LDS_TAB = LDS_STAGE + 131072;

enum { I_X = 0, I_C, I_CTX, I_CCTX, I_ADAW, I_ADAB, I_WIN, I_SSD_CW, I_SSD_CB, I_SSD_ALOG, I_SSD_DTB, I_SSD_D, I_SSD_NG, I_RW_MU, I_RW_W0, I_RW_WUP, I_RW_A0, I_RW_AUP,
       I_RW_GUP, I_RW_KK, I_RW_KA, I_RW_RK, I_RW_LNG, I_RW_LNB, I_DF_Q1, I_DF_K1, I_DF_Q2, I_DF_K2, I_DF_SG, I_GLA_GUP, I_GLA_GB, I_GLA_NG, I_WBR, I_WOUT, I_LN1G, I_LN1B,
       I_MOE_WG, I_MOE_BG, I_MOE_WE, I_MOE_BE, I_MOE_GATE, I_MOE_UP, I_MOE_DOWN, I_LN2G, I_LN2B, N_IN };

constexpr size_t al256(size_t x) { return (x + 255) & ~(size_t)255; }
constexpr size_t WS_CTL = 0;
constexpr size_t WS_TOK = 65536;
constexpr size_t CTL_BYTES = 65536 + (size_t)304 * 256 * 4;
constexpr int CW_QUEUE = 4096, CW_CNT = 8192, CW_CUR = 12288;
constexpr size_t WS_MOD = WS_CTL + CTL_BYTES;
constexpr size_t WS_ROPE = al256(WS_MOD + (size_t)DEPTH * 9 * 6144 * 4);
constexpr size_t WS_XC = al256(WS_ROPE + (size_t)2 * 4096 * 32 * 4);
constexpr size_t WS_H = al256(WS_XC + (size_t)2048 * 1024 * 4);
constexpr size_t WS_U = al256(WS_H + (size_t)NTOK * 1024 * 2);
constexpr size_t U_BYTES = (size_t)NTOK * UC * 2;
constexpr size_t WS_GATES = WS_U;
constexpr size_t WS_M = al256(WS_GATES + (size_t)NTOK * 4096 * 2);
constexpr size_t WS_XB = WS_U;
constexpr size_t WS_HID = al256(WS_XB + (size_t)NSLOT * 1024 * 2);
constexpr size_t WS_YB = al256(WS_HID + (size_t)NSLOT * 512 * 2);
static_assert(WS_M + (size_t)NTOK * 1024 * 4 <= WS_U + U_BYTES, "M overlay");
static_assert(WS_YB + (size_t)NSLOT * 1024 * 2 <= WS_U + U_BYTES, "moe overlay");
constexpr size_t WS_Y = al256(WS_U + U_BYTES);
constexpr size_t WS_SSDY = al256(WS_Y + (size_t)NTOK * 2048 * 2);
constexpr size_t WS_RWY = al256(WS_SSDY + (size_t)2 * NTOK * 512 * 2);
constexpr size_t WS_RWG = al256(WS_RWY + (size_t)2 * NTOK * 512 * 2);
constexpr size_t WS_GLAO = al256(WS_RWG + (size_t)NTOK * 512 * 2);
constexpr size_t WS_RWBD = al256(WS_GLAO + (size_t)2 * NTOK * 512 * 2);
constexpr size_t WS_WIN = al256(WS_RWBD + (size_t)2 * NTOK * 8 * 4);
constexpr size_t WS_WG = al256(WS_WIN + (size_t)UC * 1024 * 2);
constexpr size_t WS_WB = al256(WS_WG + (size_t)4096 * 1024 * 2);
constexpr size_t WS_WO = al256(WS_WB + (size_t)4 * 1024 * 512 * 2);
constexpr size_t WS_GU = al256(WS_WO + (size_t)1024 * 1024 * 2);
constexpr size_t WS_DW = al256(WS_GU + (size_t)32 * 1024 * 1024 * 2);
constexpr size_t WS_EID = al256(WS_DW + (size_t)32 * 1024 * 512 * 2);
constexpr size_t WS_WTS = al256(WS_EID + (size_t)NTOK * 2 * 4);
constexpr size_t WS_SLOT = al256(WS_WTS + (size_t)NTOK * 2 * 4);
constexpr size_t WS_XBC = al256(WS_SLOT + (size_t)NTOK * 2 * 4);
constexpr size_t WS_XSB = al256(WS_XBC + (size_t)NTOK * 1024 * 2);
constexpr size_t WS_END = al256(WS_XSB + (size_t)NTOK * 1024 * 2);

struct Params { const float* in[N_IN]; float* out; char* ws; int ph_lo, ph_hi; };
typedef const __attribute__((address_space(4))) Params CParams;
#define PRM CParams&
__device__ __forceinline__ LAS unsigned char* olds(LAS unsigned char* q) { asm volatile("" : "+s"(q)); return q; }
__device__ __forceinline__ CParams* kparams() { CParams* q = (CParams*)__builtin_amdgcn_kernarg_segment_ptr(); asm volatile("" : "+s"(q)); return q; }
#ifndef PHASE_FN
#define PHASE_FN __device__ __forceinline__
#endif

__device__ __forceinline__ int olane() { unsigned z = 0u; asm volatile("" : "+v"(z)); return (int)__builtin_amdgcn_mbcnt_hi(~0u, __builtin_amdgcn_mbcnt_lo(~0u, z)); }
__device__ __forceinline__ int otid(int wv) { return (wv << 6) | olane(); }
#define TID (otid(wv))
#define LANE (olane())
#define WAVE (wv)
__device__ __forceinline__ int oblk() { int b = (int)blockIdx.x; asm volatile("" : "+s"(b)); return b; }
#define BLK (oblk())
__device__ __forceinline__ float bf2f(unsigned b) { return __uint_as_float(b << 16); }
typedef __bf16 bf16x2_t __attribute__((ext_vector_type(2)));
__device__ __forceinline__ unsigned cvt_pk_bf16(float lo, float hi) { const f32x2 v = {lo, hi}; return __builtin_bit_cast(unsigned, __builtin_convertvector(v, bf16x2_t)); }
__device__ __forceinline__ bf16_t f2bf(float f) { return (bf16_t)(cvt_pk_bf16(f, 0.f) & 0xffffu); }
__device__ __forceinline__ void unpack8(const u32x4 w, float (&f)[8]) {
    f[0] = __uint_as_float(w.x << 16); f[1] = __uint_as_float(w.x & 0xffff0000u); f[2] = __uint_as_float(w.y << 16); f[3] = __uint_as_float(w.y & 0xffff0000u);
    f[4] = __uint_as_float(w.z << 16); f[5] = __uint_as_float(w.z & 0xffff0000u); f[6] = __uint_as_float(w.w << 16); f[7] = __uint_as_float(w.w & 0xffff0000u); }
__device__ __forceinline__ u32x4 pack8(const float (&f)[8]) { u32x4 w; w.x = cvt_pk_bf16(f[0], f[1]); w.y = cvt_pk_bf16(f[2], f[3]); w.z = cvt_pk_bf16(f[4], f[5]); w.w = cvt_pk_bf16(f[6], f[7]); return w; }
template <int CTRL> __device__ __forceinline__ float dppf(float v) { return __int_as_float(__builtin_amdgcn_update_dpp(0, __float_as_int(v), CTRL, 0xf, 0xf, true)); }
__device__ __forceinline__ float sum4(float v)  { v += dppf<0xB1>(v); v += dppf<0x4E>(v); return v; }
__device__ __forceinline__ float sum8(float v)  { v = sum4(v); v += dppf<0x141>(v); return v; }
__device__ __forceinline__ float sum16(float v) { v = sum8(v); v += dppf<0x140>(v); return v; }
__device__ __forceinline__ float shflx(float v, int mask) { const int ln = olane(); return __int_as_float(__builtin_amdgcn_ds_bpermute(((ln ^ mask) & 63) << 2, __float_as_int(v))); }
__device__ __forceinline__ float sum32(float v) { v = sum16(v); v += shflx(v, 16); return v; }
__device__ __forceinline__ float sum64(float v) { v = sum16(v);
    return __int_as_float(__builtin_amdgcn_readlane(__float_as_int(v), 0)) + __int_as_float(__builtin_amdgcn_readlane(__float_as_int(v), 16))
         + __int_as_float(__builtin_amdgcn_readlane(__float_as_int(v), 32)) + __int_as_float(__builtin_amdgcn_readlane(__float_as_int(v), 48)); }
__device__ __forceinline__ float sigmoidf_(float x) { return __builtin_amdgcn_rcpf(1.0f + __expf(-x)); }
__device__ __forceinline__ float siluf_(float x) { return x * __builtin_amdgcn_rcpf(1.0f + __expf(-x)); }
__device__ __forceinline__ float wave_incl_scan(float v, int lane) {
#pragma unroll
    for (int off = 1; off < 64; off <<= 1) { const float t = __int_as_float(__builtin_amdgcn_ds_bpermute(((lane - off) & 63) << 2, __float_as_int(v))); v += lane >= off ? t : 0.f; }
    return v; }
__device__ __forceinline__ float softplusf_(float x) { return x > 20.f ? x : log1pf(__expf(x)); }
__device__ __forceinline__ float softplus_fast(float x) { return fmaxf(x, 0.f) + __logf(1.0f + __expf(-fabsf(x))); }
__device__ __forceinline__ float tanh_fast(float x) { return 1.0f - 2.0f * __builtin_amdgcn_rcpf(__expf(2.0f * x) + 1.0f); }

#define BAR_LDS() do { asm volatile("s_waitcnt lgkmcnt(0)" ::: "memory"); __builtin_amdgcn_s_barrier(); asm volatile("" ::: "memory"); } while (0)
__device__ __forceinline__ float* xs_row(PRM p, int r) { const int b = r / TPB, t = r - b * TPB;
    return t < LCTX ? (float*)(p.ws + WS_XC) + ((size_t)b * LCTX + t) * D : p.out + ((size_t)b * LAT + (t - LCTX)) * D; }
__device__ __forceinline__ const float* xin_row(PRM p, int r) { const int b = r / TPB, t = r - b * TPB;
    return t < LCTX ? p.in[I_CTX] + ((size_t)b * LCTX + t) * D : p.in[I_X] + ((size_t)b * LAT + (t - LCTX)) * D; }
__device__ __forceinline__ int mod_row(int r) { const int b = r / TPB, t = r - b * TPB; return t < LCTX ? 8 : b; }
#define XB_TMO      128
#define XB_XCNT(j)  (256  + 64 * (j))
#define XB_XSUB(j)  (1280 + 64 * (j))
#define XB_XGEN(j)  (2304 + 64 * (j))
#define XB_TOP      3328
#define XB_TOPGEN   3392
#define XCD_BAR_WORDS 3456
#define XB_SPIN_CAP (1u << 18)

__device__ __forceinline__ unsigned xb_ld(unsigned* p)              { return __hip_atomic_load(p, __ATOMIC_RELAXED, __HIP_MEMORY_SCOPE_AGENT); }
__device__ __forceinline__ unsigned xb_add(unsigned* p, unsigned v) { return __hip_atomic_fetch_add(p, v, __ATOMIC_RELAXED, __HIP_MEMORY_SCOPE_AGENT); }
__device__ __forceinline__ unsigned xb_xcc_id() { return (unsigned)__builtin_amdgcn_s_getreg((3 << 11) | 20) & 0xFu; }
#define XB_SPIN(cond, bar) do { unsigned _sp = 0; while (cond) { __builtin_amdgcn_s_sleep(1); \
    if ((++_sp & 255u) == 0u) { if (xb_ld(&(bar)[XB_TMO])) break; if (_sp > XB_SPIN_CAP) { atomicAdd(&(bar)[XB_TMO], 1u); break; } } } } while (0)

struct XcdBarrier {
    unsigned* bar; unsigned x;
    volatile LAS unsigned* st;
};

__device__ __forceinline__ XcdBarrier xcd_barrier_post(unsigned* bar, volatile LAS unsigned* st) {
    XcdBarrier b; b.bar = bar; b.x = xb_xcc_id(); b.st = st;
    if (threadIdx.x == 0) (void)xb_add(&bar[XB_XCNT(b.x)], 1u);
    return b;
}
__device__ __forceinline__ void xcd_barrier_complete(unsigned* bar, unsigned x, unsigned& nloc, unsigned& nx) {
    const unsigned G = gridDim.x * gridDim.y * gridDim.z;
    unsigned sum, cnt, mine, sp = 0u;
    for (;;) {
        sum = 0u; cnt = 0u; mine = 0u;
#pragma unroll
        for (unsigned j = 0; j < 16; ++j) { const unsigned c = xb_ld(&bar[XB_XCNT(j)]); sum += c; cnt += (c > 0u) ? 1u : 0u; mine = (j == x) ? c : mine; }
        if (sum == G) break;
        __builtin_amdgcn_s_sleep(1);
        if ((++sp & 255u) == 0u) { if (xb_ld(&bar[XB_TMO])) break; if (sp > XB_SPIN_CAP) { atomicAdd(&bar[XB_TMO], 1u); break; } }
    }
    nloc = mine > 0u ? mine : 1u; nx = cnt > 0u ? cnt : 1u;
}

__device__ __forceinline__ void xcd_barrier(const XcdBarrier& b) {
    asm volatile("s_waitcnt vmcnt(0)" ::: "memory");
    __syncthreads();
    if (threadIdx.x == 0) {
        unsigned* bar = b.bar;
        __builtin_amdgcn_s_waitcnt(0);
        unsigned nloc = b.st[0], nx = b.st[1];
        if (nloc == 0u) { xcd_barrier_complete(bar, b.x, nloc, nx); b.st[0] = nloc; b.st[1] = nx; }
        const unsigned old = xb_add(&bar[XB_XSUB(b.x)], 1u);
        const unsigned gen = old / nloc;
        if (old + 1u == (gen + 1u) * nloc) {
            __builtin_amdgcn_fence(__ATOMIC_RELEASE, "agent");
            asm volatile("s_waitcnt vmcnt(0)" ::: "memory");
            const unsigned og = xb_add(&bar[XB_TOP], 1u);
            const unsigned tg = og / nx;
            if (og + 1u == (tg + 1u) * nx) xb_add(&bar[XB_TOPGEN], 1u);
            else XB_SPIN(xb_ld(&bar[XB_TOPGEN]) == tg, bar);
            __builtin_amdgcn_fence(__ATOMIC_ACQUIRE, "agent");
            xb_add(&bar[XB_XGEN(b.x)], 1u);
            asm volatile("s_waitcnt vmcnt(0)" ::: "memory");
        } else {
            XB_SPIN(xb_ld(&bar[XB_XGEN(b.x)]) == gen, bar);
            __builtin_amdgcn_fence(__ATOMIC_ACQUIRE, "agent");
            asm volatile("s_waitcnt vmcnt(0)" ::: "memory");
        }
    }
    __syncthreads();
}

namespace pg8 {
constexpr int BM = 256, BK = 64, HALF = 128, HTB = HALF * BK * 2, STAGE_BYTES = 8 * HTB, NXCD = 8, WGM = 8, GIDX_OFF = STAGE_BYTES + 2048;
__host__ __device__ __forceinline__ int lds_byte(int r, int c) { const int st = (r >> 4) * 2 + (c >> 5), rr = r & 15, cc = c & 31, ob = rr * 64 + cc * 2; return st * 1024 + (ob ^ (((ob >> 9) & 1) << 5)); }
__host__ __device__ __forceinline__ void stage_rc(int b, int& R, int& C) { const int st = b / 1024, sb = b % 1024, swz = sb ^ (((sb >> 9) & 1) << 5); R = (st >> 1) * 16 + swz / 64; C = (st & 1) * 32 + (swz % 64) / 2; }
__host__ __device__ __forceinline__ int perm32(int rho) { const int n = rho >> 4, i = rho & 15; return 8 * (i >> 2) + 4 * n + (i & 3); }

struct Unit { int pm, pn, x; const char* a; const char* b; const int* rows; };
struct Gemm { int lda, ldb, K; };

__device__ __forceinline__ bool static_tile(int L, int nM, int nN, int& pm, int& pn) {
    const int nwg = nM * nN; if (L >= nwg) return false;
    int wgid = L; { const int q = nwg / NXCD, r = nwg % NXCD, xcd = wgid % NXCD, off = wgid / NXCD; wgid = (xcd < r ? xcd * (q + 1) : r * (q + 1) + (xcd - r) * q) + off; }
    const int nig = WGM * nN, gid = wgid / nig, fm = gid * WGM, gsz = (nM - fm) < WGM ? (nM - fm) : WGM;
    pm = fm + ((wgid % nig) % gsz); pn = (wgid % nig) / gsz; return true;
}

template <class Epi, class Sched, bool GATHER = false>
__device__ __forceinline__ void gemm_phase(int wv, LAS unsigned char* lds, const Gemm g, const Sched& S, const Epi& E) {
    const int tid = otid(wv), wid = wv, lane = tid & 63, wr = wid >> 2, wc = wid & 3, fr = lane & 15, fq = lane >> 4;
    const int K = g.K, nt = K / BK;
    unsigned voffA[2], voffB[2];
#pragma unroll
    for (int i = 0; i < 2; ++i) { int R, C; stage_rc(tid * 16 + i * 8192, R, C); const int Rb = (R & ~31) + perm32(R & 31);
        voffA[i] = (unsigned)(R * g.lda + C) * 2u; voffB[i] = (unsigned)(Rb * g.ldb + C) * 2u; }
    const size_t kstep = (size_t)(BK * 2);
    const size_t hstepA = (size_t)HALF * g.lda * 2, hstepB = (size_t)HALF * g.ldb * 2;
    const unsigned ldsw = (unsigned)wid * 1024u;
    const int aoff = lds_byte(wr * 64 + fr, fq * 8), boff = lds_byte(wc * 32 + fr, fq * 8);
#define PG8_SA(b, h) (((b) * 2 + (h)) * HTB)
#define PG8_SB(b, h) ((4 + (b) * 2 + (h)) * HTB)
#define PG8_STAGE(bufoff, gbase, voff) do { _Pragma("unroll") for (int _i = 0; _i < 2; ++_i) \
        __builtin_amdgcn_global_load_lds((const unsigned*)((const char*)(gbase) + (voff)[_i]), (LAS unsigned*)(lds + (bufoff) + ldsw + _i * 8192), 16, 0, 0); } while (0)
    int rsrc_[2][2]; unsigned gA[2][2], gN[2][2];
#pragma unroll
    for (int h_ = 0; h_ < 2; ++h_)
#pragma unroll
        for (int i_ = 0; i_ < 2; ++i_) { int R, C; stage_rc(tid * 16 + i_ * 8192, R, C); rsrc_[h_][i_] = h_ * HALF + R; gA[h_][i_] = 0u; gN[h_][i_] = (unsigned)C * 2u; }
#define PG8_GLOAD(dst, up) do { _Pragma("unroll") for (int h_ = 0; h_ < 2; ++h_) _Pragma("unroll") for (int i_ = 0; i_ < 2; ++i_) { int R_, C_; stage_rc(tid * 16 + i_ * 8192, R_, C_); \
        dst[h_][i_] = (unsigned)(up).rows[rsrc_[h_][i_]] * (unsigned)(g.lda * 2) + (unsigned)C_ * 2u; } } while (0)
#define PG8_STAGE_A(bufoff, usenext, kbyte, half) do { if constexpr (GATHER) { unsigned vo_[2]; vo_[0] = (usenext) ? gN[half][0] : gA[half][0]; vo_[1] = (usenext) ? gN[half][1] : gA[half][1]; \
            PG8_STAGE(bufoff, cA + (kbyte), vo_); } \
        else { PG8_STAGE(bufoff, ((usenext) ? nA : cA) + (kbyte) + (half) * hstepA, voffA); } } while (0)
#define PG8_LDA(dst, b, h) do { _Pragma("unroll") for (int m = 0; m < 4; ++m) _Pragma("unroll") for (int k = 0; k < 2; ++k) dst[m][k] = *(const LAS bf16x8*)(lds + PG8_SA(b, h) + aoff + m * 2048 + k * 1024); } while (0)
#define PG8_LDB(dst, b, h) do { _Pragma("unroll") for (int n = 0; n < 2; ++n) _Pragma("unroll") for (int k = 0; k < 2; ++k) dst[n][k] = *(const LAS bf16x8*)(lds + PG8_SB(b, h) + boff + n * 2048 + k * 1024); } while (0)
#define PG8_MMA(ai, bj, At, Bt) do { __builtin_amdgcn_s_setprio(1); _Pragma("unroll") for (int m = 0; m < 4; ++m) _Pragma("unroll") for (int n = 0; n < 2; ++n) _Pragma("unroll") for (int k = 0; k < 2; ++k) \
        acc[ai][bj][m][n] = __builtin_amdgcn_mfma_f32_16x16x32_bf16(Bt[n][k], At[m][k], acc[ai][bj][m][n], 0, 0, 0); __builtin_amdgcn_s_setprio(0); } while (0)
#define PG8_WAIT_V(n) asm volatile("s_waitcnt vmcnt(" #n ")" ::: "memory")
#define PG8_WAIT_L(n) asm volatile("s_waitcnt lgkmcnt(" #n ")" ::: "memory")
#define PG8_BAR __builtin_amdgcn_s_barrier()
#define PG8_SCHED __builtin_amdgcn_sched_barrier(0)
    Unit cur, nxt; int ui = 0;
    if (!S.next(0, cur)) return;
    f32x4 acc[2][2][4][2];
#pragma unroll
    for (int a = 0; a < 2; ++a)
#pragma unroll
        for (int b = 0; b < 2; ++b)
#pragma unroll
            for (int m = 0; m < 4; ++m)
#pragma unroll
                for (int n = 0; n < 2; ++n) acc[a][b][m][n] = (f32x4){0.f, 0.f, 0.f, 0.f};
    bf16x8 At[4][2], B0[2][2], B1[2][2];
    const char* cA = cur.a; const char* cB = cur.b; const char* nA = cA;
    if constexpr (GATHER) { PG8_GLOAD(gA, cur); _Pragma("unroll") for (int h_ = 0; h_ < 2; ++h_) _Pragma("unroll") for (int i_ = 0; i_ < 2; ++i_) gN[h_][i_] = gA[h_][i_]; }
    PG8_STAGE(PG8_SB(0, 0), cB, voffB); PG8_STAGE(PG8_SB(0, 1), cB + hstepB, voffB); PG8_STAGE_A(PG8_SA(0, 0), false, 0, 0); PG8_STAGE_A(PG8_SA(0, 1), false, 0, 1);
    if (wr == 1) PG8_BAR;
    PG8_WAIT_V(2); PG8_BAR;
    PG8_STAGE(PG8_SB(1, 0), cB + kstep, voffB); PG8_STAGE_A(PG8_SA(1, 0), false, kstep, 0); PG8_STAGE(PG8_SB(1, 1), cB + hstepB + kstep, voffB);
    PG8_WAIT_V(6); PG8_BAR;
    for (;;) {
        const bool has_next = S.next(ui + 1, nxt);
        nA = has_next ? nxt.a : cA; const char* nB = has_next ? nxt.b : cB;
        if constexpr (GATHER) { if (has_next && wid < 4)
                __builtin_amdgcn_global_load_lds((const unsigned*)(nxt.rows + wid * 64 + lane), (LAS unsigned*)(lds + GIDX_OFF + wid * 256), 4, 0, 0); }
        for (int t = 0; t < nt; t += 2) {
            const bool last = (t == nt - 2);
            if constexpr (GATHER) { if (last && has_next) { _Pragma("unroll") for (int h_ = 0; h_ < 2; ++h_) _Pragma("unroll") for (int i_ = 0; i_ < 2; ++i_) { int R_, C_; stage_rc(tid * 16 + i_ * 8192, R_, C_);
                gN[h_][i_] = (unsigned)*(const LAS int*)(lds + GIDX_OFF + (h_ * HALF + R_) * 4) * (unsigned)(g.lda * 2) + (unsigned)C_ * 2u; } } }
            const size_t k1 = (size_t)(t + 1) * kstep, k2 = last ? (size_t)0 : (size_t)(t + 2) * kstep, k3 = k2 + kstep;
            const char* b2 = last ? nB : cB + (size_t)(t + 2) * kstep; const char* b3 = b2 + kstep;
            PG8_LDB(B0, 0, 0); PG8_LDB(B1, 0, 1); PG8_SCHED; PG8_LDA(At, 0, 0); PG8_STAGE_A(PG8_SA(1, 1), false, k1, 1);
            PG8_WAIT_V(8); PG8_WAIT_L(0); PG8_BAR; PG8_MMA(0, 0, At, B0); PG8_MMA(0, 1, At, B1); PG8_BAR; PG8_SCHED;
            PG8_LDA(At, 0, 1); PG8_STAGE(PG8_SB(0, 0), b2, voffB); PG8_STAGE(PG8_SB(0, 1), b2 + hstepB, voffB); PG8_STAGE_A(PG8_SA(0, 0), last, k2, 0);
            PG8_WAIT_V(8); PG8_WAIT_L(0); PG8_BAR; PG8_MMA(1, 0, At, B0); PG8_MMA(1, 1, At, B1); PG8_BAR; PG8_SCHED;
            PG8_LDB(B0, 1, 0); PG8_LDB(B1, 1, 1); PG8_SCHED; PG8_LDA(At, 1, 0); PG8_STAGE_A(PG8_SA(0, 1), last, k2, 1);
            PG8_WAIT_V(8); PG8_WAIT_L(0); PG8_BAR; PG8_MMA(0, 0, At, B0); PG8_MMA(0, 1, At, B1); PG8_BAR; PG8_SCHED;
            PG8_LDA(At, 1, 1); PG8_STAGE(PG8_SB(1, 0), b3, voffB); PG8_STAGE(PG8_SB(1, 1), b3 + hstepB, voffB); PG8_STAGE_A(PG8_SA(1, 0), last, k3, 0);
            PG8_WAIT_V(8); PG8_WAIT_L(0); PG8_BAR; PG8_MMA(1, 0, At, B0); PG8_MMA(1, 1, At, B1); PG8_BAR; PG8_SCHED;
        }
        if (wr == 0) PG8_BAR;
        E(acc, cur, wr, wc, fr, fq);
        if (!has_next) break;
#pragma unroll
        for (int a = 0; a < 2; ++a)
#pragma unroll
            for (int b = 0; b < 2; ++b)
#pragma unroll
                for (int m = 0; m < 4; ++m)
#pragma unroll
                    for (int n = 0; n < 2; ++n) acc[a][b][m][n] = (f32x4){0.f, 0.f, 0.f, 0.f};
        cur = nxt; cA = nA; cB = nB; ++ui;
        if constexpr (GATHER) { _Pragma("unroll") for (int h_ = 0; h_ < 2; ++h_) _Pragma("unroll") for (int i_ = 0; i_ < 2; ++i_) gA[h_][i_] = gN[h_][i_]; }
        if (wr == 1) PG8_BAR;
    }
    PG8_WAIT_V(0);
    PG8_BAR;
#undef PG8_SA
#undef PG8_SB
#undef PG8_STAGE
#undef PG8_STAGE_A
#undef PG8_GLOAD
#undef PG8_LDA
#undef PG8_LDB
#undef PG8_MMA
#undef PG8_WAIT_V
#undef PG8_WAIT_L
#undef PG8_BAR
#undef PG8_SCHED
}
}
using pg8::Unit;
template <int ACT  > struct EpiStoreBf16 {
    bf16_t* O; int ldc;
    __device__ __forceinline__ void operator()(const f32x4 (&acc)[2][2][4][2], const Unit& u, int wr, int wc, int fr, int fq) const {
        const int row0 = u.pm * 256 + wr * 64 + fr, col0 = u.pn * 256 + wc * 32 + 8 * fq;
#pragma unroll
        for (int ai = 0; ai < 2; ++ai)
#pragma unroll
            for (int m = 0; m < 4; ++m) { bf16_t* rowp = O + (size_t)(row0 + ai * 128 + m * 16) * ldc + col0;
#pragma unroll
                for (int bj = 0; bj < 2; ++bj) { f32x4 v0 = acc[ai][bj][m][0], v1 = acc[ai][bj][m][1];
                    if (ACT == 1) {
#pragma unroll
                        for (int j = 0; j < 4; ++j) { v0[j] = __builtin_amdgcn_rcpf(1.0f + __expf(-v0[j])); v1[j] = __builtin_amdgcn_rcpf(1.0f + __expf(-v1[j])); } }
                    u32x4 w; w.x = cvt_pk_bf16(v0[0], v0[1]); w.y = cvt_pk_bf16(v0[2], v0[3]); w.z = cvt_pk_bf16(v1[0], v1[1]); w.w = cvt_pk_bf16(v1[2], v1[3]);
                    *(u32x4*)(rowp + bj * 128) = w; } }
    }
};
struct EpiMerge {
    const bf16_t* G; float* M; bf16_t* MB;
    __device__ __forceinline__ void operator()(const f32x4 (&acc)[2][2][4][2], const Unit& u, int wr, int wc, int fr, int fq) const {
        const int br = u.x; const int row0 = u.pm * 256 + wr * 64 + fr, col0 = u.pn * 256 + wc * 32 + 8 * fq;
        const bf16_t* __restrict__ gp = G; bf16_t* mb = MB;
#pragma unroll
        for (int ai = 0; ai < 2; ++ai) {
            u32x4 gw[4][2], mw[4][2];
#pragma unroll
            for (int m = 0; m < 4; ++m)
#pragma unroll
                for (int bj = 0; bj < 2; ++bj) { const size_t r = (size_t)(row0 + ai * 128 + m * 16); const int c = col0 + bj * 128;
                    gw[m][bj] = *(const u32x4*)(gp + r * 4096 + br * 1024 + c);
                    if (br > 0) mw[m][bj] = *(const u32x4*)(mb + r * 1024 + c); }
#pragma unroll
            for (int m = 0; m < 4; ++m)
#pragma unroll
                for (int bj = 0; bj < 2; ++bj) { const size_t r = (size_t)(row0 + ai * 128 + m * 16); const int c = col0 + bj * 128;
                    float gs[8], v[8]; unpack8(gw[m][bj], gs);
#pragma unroll
                    for (int j = 0; j < 8; ++j) gs[j] = __builtin_amdgcn_rcpf(1.0f + __expf(-gs[j]));
#pragma unroll
                    for (int j = 0; j < 4; ++j) { v[j] = acc[ai][bj][m][0][j] * gs[j]; v[4 + j] = acc[ai][bj][m][1][j] * gs[4 + j]; }
                    if (br > 0) { float pm[8]; unpack8(mw[m][bj], pm);
#pragma unroll
                        for (int j = 0; j < 8; ++j) v[j] += pm[j]; }
                    *(u32x4*)(mb + r * 1024 + c) = pack8(v); }
            asm volatile("" ::: "memory");
        }
    }
};
struct EpiResid {
    bf16_t* xsb; const float* ctxin; const float* xin; int layer; const float* modl;
    __device__ __forceinline__ void operator()(const f32x4 (&acc)[2][2][4][2], const Unit& u, int wr, int wc, int fr, int fq) const {
        asm volatile("" : "+v"(fr), "+v"(fq));
        const int b = u.pm / 17, pr = u.pm - b * 17; const bool isctx = pr == 0; const int mb = isctx ? 8 : b;
        bf16_t* dst = xsb + (size_t)u.pm * 256 * D;
        const float* src0 = isctx ? ctxin + (size_t)b * LCTX * D : xin + ((size_t)b * LAT + (size_t)(pr - 1) * 256) * D;
        const int rr0 = wr * 64 + fr, col0 = u.pn * 256 + wc * 32 + 8 * fq;
        const float* g1 = modl + mb * 6144 + 2048 + col0;
        f32x4 gv[2][2];
#pragma unroll
        for (int bj = 0; bj < 2; ++bj) { gv[bj][0] = *(const f32x4*)(g1 + bj * 128); gv[bj][1] = *(const f32x4*)(g1 + bj * 128 + 4); }
#pragma unroll
        for (int ai = 0; ai < 2; ++ai) {
            f32x4 x0[4][2], x1[4][2];
#pragma unroll
            for (int m = 0; m < 4; ++m)
#pragma unroll
                for (int bj = 0; bj < 2; ++bj) { const size_t ro = (size_t)(rr0 + ai * 128 + m * 16) * D + col0 + bj * 128;
                    if (layer == 0) { x0[m][bj] = *(const f32x4*)(src0 + ro); x1[m][bj] = *(const f32x4*)(src0 + ro + 4); }
                    else { float t8[8]; unpack8(*(const u32x4*)(dst + ro), t8); x0[m][bj] = (f32x4){t8[0], t8[1], t8[2], t8[3]}; x1[m][bj] = (f32x4){t8[4], t8[5], t8[6], t8[7]}; } }
#pragma unroll
            for (int m = 0; m < 4; ++m)
#pragma unroll
                for (int bj = 0; bj < 2; ++bj) { const size_t ro = (size_t)(rr0 + ai * 128 + m * 16) * D + col0 + bj * 128;
                    const f32x4 t0 = x0[m][bj] * DN_ALPHA + gv[bj][0] * acc[ai][bj][m][0], t1 = x1[m][bj] * DN_ALPHA + gv[bj][1] * acc[ai][bj][m][1];
                    u32x4 w; w.x = cvt_pk_bf16(t0[0], t0[1]); w.y = cvt_pk_bf16(t0[2], t0[3]); w.z = cvt_pk_bf16(t1[0], t1[1]); w.w = cvt_pk_bf16(t1[2], t1[3]);
                    *(u32x4*)(dst + ro) = w; }
            asm volatile("" ::: "memory"); }
    }
};
struct EpiSwiGLU {
    bf16_t* HID;
    __device__ __forceinline__ void operator()(const f32x4 (&acc)[2][2][4][2], const Unit& u, int wr, int wc, int fr, int fq) const {
        const int row0 = u.pm * 256 + wr * 64 + fr, col0 = u.pn * 128 + wc * 32 + 8 * fq;
#pragma unroll
        for (int ai = 0; ai < 2; ++ai)
#pragma unroll
            for (int m = 0; m < 4; ++m) { float h[8];
#pragma unroll
                for (int n = 0; n < 2; ++n)
#pragma unroll
                    for (int j = 0; j < 4; ++j) { const float g = acc[ai][0][m][n][j], up = acc[ai][1][m][n][j]; h[4 * n + j] = g * __builtin_amdgcn_rcpf(1.0f + __expf(-g)) * up; }
                *(u32x4*)(HID + (size_t)(row0 + ai * 128 + m * 16) * MOE_FF + col0) = pack8(h); }
    }
};
__device__ __forceinline__ int lat_panel(int q) { return (q >> 4) * 17 + 1 + (q & 15); }
struct SchedDense {
    int nM, nN, G, c; const char* A; const char* B; size_t ta, tb; int lat;
    __device__ __forceinline__ bool next(int i, Unit& u) const { int pm, pn; if (!pg8::static_tile(i * G + c, nM, nN, pm, pn)) return false;
        if (lat) pm = lat_panel(pm);
        u.pm = pm; u.pn = pn; u.x = 0; u.a = A + (size_t)pm * ta; u.b = B + (size_t)pn * tb; return true; }
};
struct SchedMerge {
    int G, c; const char* Y; const char* WB; int lat;
    __device__ __forceinline__ bool next(int i, Unit& u) const { int pm, pn; if (!pg8::static_tile((i >> 2) * G + c, lat ? 128 : NPANEL, 4, pm, pn)) return false; const int br = i & 3;
        if (lat) pm = lat_panel(pm);
        u.pm = pm; u.pn = pn; u.x = br; u.a = Y + (size_t)pm * 256 * 2048 * 2 + (size_t)br * 512 * 2; u.b = WB + (size_t)br * 1024 * 512 * 2 + (size_t)pn * 256 * 512 * 2; return true; }
};
struct SchedMoe {
    int G, c; const LAS int* tab; const char* A; const char* B; size_t ta, be, bt; const int* rows;
    __device__ __forceinline__ bool next(int i, Unit& u) const { const int nblk = tab[0]; int blk, t;
        if ((G & 31) == 0) { const int x = c & 7, y = c >> 3, per = G >> 5; if ((y >> 2) >= per) return false; blk = i * (G >> 2) + x * per + (y >> 2); t = y & 3; } else { const int L = i * G + c; blk = L >> 2; t = L & 3; }
        if (blk >= nblk) return false; const int e = tab[1 + blk];
        u.pm = blk; u.pn = t; u.x = e; u.a = A + (size_t)blk * ta; u.b = B + (size_t)e * be + (size_t)t * bt; u.rows = rows + blk * 256; return true; }
};

PHASE_FN void phase_mod(int wv, PRM p, LAS unsigned char* lds) {
    LAS float* s = (LAS float*)(lds + LDS_STAGE); LAS float* red = s + 9 * 1024;
    const int tid = TID;
    for (int i = tid; i < 9 * 1024; i += NTHR) { const int b = i >> 10, k = i & 1023; const float v = b < 8 ? p.in[I_C][b * 1024 + k] : p.in[I_CCTX][k]; s[i] = siluf_(v); }
    __syncthreads();
    float* MOD = (float*)(p.ws + WS_MOD);
    for (int task = BLK; task < DEPTH * 48; task += gridDim.x) {
        const int l = task / 48, j0 = (task % 48) * 128, cq = tid & 127, kq = tid >> 7;
        float acc[9];
#pragma unroll
        for (int b = 0; b < 9; ++b) acc[b] = 0.f;
        const float* w = p.in[I_ADAW] + ((size_t)l * 1024 + kq * 256) * 6144 + j0 + cq;
        for (int k0 = 0; k0 < 256; k0 += 8) { float wv8[8];
#pragma unroll
            for (int kk = 0; kk < 8; ++kk) wv8[kk] = w[(size_t)(k0 + kk) * 6144];
#pragma unroll
            for (int kk = 0; kk < 8; ++kk)
#pragma unroll
                for (int b = 0; b < 9; ++b) acc[b] += s[b * 1024 + kq * 256 + k0 + kk] * wv8[kk]; }
#pragma unroll
        for (int b = 0; b < 9; ++b) red[(kq * 9 + b) * 128 + cq] = acc[b];
        __syncthreads();
        for (int o = tid; o < 9 * 128; o += NTHR) { const int b = o >> 7, c2 = o & 127;
            const float v = red[(0 * 9 + b) * 128 + c2] + red[(1 * 9 + b) * 128 + c2] + red[(2 * 9 + b) * 128 + c2] + red[(3 * 9 + b) * 128 + c2] + p.in[I_ADAB][l * 6144 + j0 + c2];
            MOD[((size_t)l * 9 + b) * 6144 + j0 + c2] = v; }
        __syncthreads();
    }
}
PHASE_FN void phase_rope_table(int wv, PRM p) {
    float* COS = (float*)(p.ws + WS_ROPE); float* SIN = COS + 4096 * 32;
    for (int i = BLK * NTHR + TID; i < 4096 * 32; i += gridDim.x * NTHR) { const int n = i >> 5, a = (i >> 4) & 1, pp = i & 15;
        const float inv = powf(10000.0f, -(float)pp / 16.0f); const float ang = (float)(a == 0 ? (n >> 6) : (n & 63)) * inv;
        COS[i] = cosf(ang); SIN[i] = sinf(ang); }
}
PHASE_FN void phase_modulate0(int wv, PRM p) {
    const float* MOD = (const float*)(p.ws + WS_MOD); bf16_t* H = (bf16_t*)(p.ws + WS_H); const int lane = LANE;
    for (int r = BLK * 8 + WAVE; r < NTOK; r += gridDim.x * 8) {
        const float* x = xin_row(p, r); const float* md = MOD + (size_t)mod_row(r) * 6144;
#pragma unroll
        for (int j = 0; j < 4; ++j) { const int c = j * 256 + lane * 4; const f32x4 v = *(const f32x4*)(x + c), sh = *(const f32x4*)(md + c), sc = *(const f32x4*)(md + 1024 + c);
            const f32x4 h = v * (sc + 1.0f) + sh; u32x2 w; w.x = cvt_pk_bf16(h[0], h[1]); w.y = cvt_pk_bf16(h[2], h[3]); *(u32x2*)(H + (size_t)r * D + c) = w; }
    }
}
__device__ __forceinline__ int win_src_col(int j) {
    if (j < 1536) return j;
    if (j < 3456) return 1544 + (j - 1536);
    if (j < 3464) return 1536 + (j - 3456);
    if (j < 3496) return 6024 + (j - 3464);
    if (j < 3584) return -1;
    if (j < 5120) return 3464 + (j - 3584);
    if (j < 6144) return 5000 + (j - 5120);
    return 6056 + (j - 6144);
}
struct ConvDesc { const float* src; bf16_t* dst; int sld, dld, n0, k0, kind, cadd; };
__device__ __forceinline__ ConvDesc conv_desc(PRM p, int l, int task) {
    constexpr int T0 = 104 * 16, T1 = T0 + 64 * 16, T2 = T1 + 4 * 16 * 8, T3 = T2 + 16 * 16, T4 = T3 + 32 * 16 * 16;
    ConvDesc c; c.kind = 0; c.cadd = 0;
    if (task < T0) { const int t = task; c.n0 = (t >> 4) * 64; c.k0 = (t & 15) * 64; c.src = p.in[I_WIN] + (size_t)l * 1024 * IN_COLS; c.sld = IN_COLS; c.dst = (bf16_t*)(p.ws + WS_WIN); c.dld = 1024; c.kind = 1; }
    else if (task < T1) { const int t = task - T0; c.n0 = (t >> 4) * 64; c.k0 = (t & 15) * 64; c.src = p.in[I_WIN] + (size_t)l * 1024 * IN_COLS; c.sld = IN_COLS; c.dst = (bf16_t*)(p.ws + WS_WG); c.dld = 1024; c.cadd = GATE_COL0; }
    else if (task < T2) { const int t = task - T1; const int br = t >> 7, tt = t & 127; c.n0 = (tt >> 3) * 64; c.k0 = (tt & 7) * 64; c.src = p.in[I_WBR] + ((size_t)l * 4 + br) * 512 * 1024; c.sld = 1024; c.dst = (bf16_t*)(p.ws + WS_WB) + (size_t)br * 1024 * 512; c.dld = 512; }
    else if (task < T3) { const int t = task - T2; c.n0 = (t >> 4) * 64; c.k0 = (t & 15) * 64; c.src = p.in[I_WOUT] + (size_t)l * 1024 * 1024; c.sld = 1024; c.dst = (bf16_t*)(p.ws + WS_WO); c.dld = 1024; }
    else if (task < T4) { const int t = task - T3; const int e = t >> 8, tt = t & 255; const int j0 = (tt >> 4) * 64; c.k0 = (tt & 15) * 64;
        const int q = j0 >> 8, rr = j0 & 255; c.src = (rr < 128 ? p.in[I_MOE_GATE] : p.in[I_MOE_UP]) + ((size_t)l * 32 + e) * 1024 * 512; c.sld = 512; c.cadd = 128 * q + (rr & 127) - j0; c.n0 = j0;
        c.dst = (bf16_t*)(p.ws + WS_GU) + (size_t)e * 1024 * 1024; c.dld = 1024; }
    else { const int t = task - T4; const int e = t >> 7, tt = t & 127; c.n0 = (tt >> 3) * 64; c.k0 = (tt & 7) * 64; c.src = p.in[I_MOE_DOWN] + ((size_t)l * 32 + e) * 512 * 1024; c.sld = 1024; c.dst = (bf16_t*)(p.ws + WS_DW) + (size_t)e * 1024 * 512; c.dld = 512; }
    return c;
}
constexpr int CV_T0 = 104 * 16, CV_T1 = CV_T0 + 64 * 16, CV_T2 = CV_T1 + 4 * 16 * 8, CV_T3 = CV_T2 + 16 * 16, CV_T4 = CV_T3 + 32 * 16 * 16, CV_T5 = CV_T4 + 32 * 16 * 8;
PHASE_FN void phase_convert(int wv, PRM p, int l, LAS unsigned char* lds, int t0, int T5, int worker, int nworkers) {
    LAS float* tile = (LAS float*)(lds + LDS_STAGE);
    const int tid = TID;
    const int nx = tid & 63, ky = tid >> 6, kx = tid & 31, ny = tid >> 5;
    float r[8], rn[8];
#define CV_LOAD(dst_, task_) do { const ConvDesc c_ = conv_desc(p, l, (task_)); const int j_ = c_.n0 + nx; const int sc_ = c_.kind == 1 ? win_src_col(j_) : j_ + c_.cadd; \
        _Pragma("unroll") for (int i = 0; i < 8; ++i) dst_[i] = sc_ >= 0 ? c_.src[(size_t)(c_.k0 + ky + 8 * i) * c_.sld + sc_] : 0.f; } while (0)
    int task = t0 + worker;
    if (task < T5) CV_LOAD(r, task);
    for (; task < T5; task += nworkers) {
        const int nxt = task + nworkers;
        if (nxt < T5) CV_LOAD(rn, nxt);
#pragma unroll
        for (int i = 0; i < 8; ++i) tile[(ky + 8 * i) * 65 + nx] = r[i];
        BAR_LDS();
        { const ConvDesc c = conv_desc(p, l, task);
#pragma unroll
            for (int i = 0; i < 4; ++i) { const int j = ny + 16 * i; *(unsigned*)(c.dst + (size_t)(c.n0 + j) * c.dld + c.k0 + 2 * kx) = cvt_pk_bf16(tile[(2 * kx) * 65 + j], tile[(2 * kx + 1) * 65 + j]); } }
        BAR_LDS();
#pragma unroll
        for (int i = 0; i < 8; ++i) r[i] = rn[i];
    }
#undef CV_LOAD
}
PHASE_FN void phase_ln1_router(int wv, PRM p, int l, LAS unsigned char* lds, int dry = 0) {
    LAS float* Wl = (LAS float*)(lds + LDS_STAGE);
    LAS unsigned* hist = (LAS unsigned*)(lds + 64);
    constexpr int HBS = 2064;
    LAS unsigned char* HBH = lds + LDS_STAGE; LAS unsigned char* HBL = HBH + 16 * HBS;
    LAS f32x4* PART = (LAS f32x4*)(HBL + 16 * HBS);
    LAS float* LGA = (LAS float*)(PART + 8 * 3 * 64);
    const int tid = TID, lane = LANE;
    const float* wg = p.in[I_MOE_WG] + (size_t)l * 1024 * 4; const float* we = p.in[I_MOE_WE] + (size_t)l * 1024 * 32;
#pragma unroll
    for (int it = 0; it < 16; ++it) { const int i = tid + it * NTHR; const int k = i >> 3, e4 = (i & 7) * 4; *(LAS f32x4*)(Wl + k * 36 + 4 + e4) = *(const f32x4*)(we + (size_t)k * 32 + e4); }
#pragma unroll
    for (int it = 0; it < 2; ++it) { const int k = tid + it * NTHR; *(LAS f32x4*)(Wl + k * 36) = *(const f32x4*)(wg + (size_t)k * 4); }
    if (tid < 32) hist[tid] = 0u;
    __syncthreads();
    u32x4 Whi[3][4], Wlo[3][4];
#pragma unroll
    for (int nb = 0; nb < 3; ++nb)
#pragma unroll
        for (int ks = 0; ks < 4; ++ks) { const int c = nb * 16 + (lane & 15), k0 = wv * 128 + ks * 32 + (lane >> 4) * 8; const bool ok = c < 36;
#pragma unroll
            for (int j2 = 0; j2 < 4; ++j2) { const float v0 = ok ? Wl[(k0 + 2 * j2) * 36 + c] : 0.f, v1 = ok ? Wl[(k0 + 2 * j2 + 1) * 36 + c] : 0.f;
                const unsigned ph = cvt_pk_bf16(v0, v1); Whi[nb][ks][j2] = ph; Wlo[nb][ks][j2] = cvt_pk_bf16(v0 - bf2f(ph & 0xffffu), v1 - bf2f(ph >> 16)); } }
    __syncthreads();
    const float* MOD = (const float*)(p.ws + WS_MOD) + (size_t)l * 9 * 6144; bf16_t* H = (bf16_t*)(p.ws + WS_H);
    const float* lg = p.in[I_LN1G] + l * 1024; const float* lb = p.in[I_LN1B] + l * 1024;
    const float* bg = p.in[I_MOE_BG] + l * 4; const float* be = p.in[I_MOE_BE] + l * 32;
    int* EID = (int*)(p.ws + WS_EID); float* WTS = (float*)(p.ws + WS_WTS);
    bf16_t* XSB = (bf16_t*)(p.ws + WS_XSB);
    u32x2 vn[2][4];
#define LN1_LOAD(g_) do { _Pragma("unroll") for (int r_ = 0; r_ < 2; ++r_) { const bf16_t* xr_ = XSB + (size_t)((g_) * 2 + r_) * D; _Pragma("unroll") for (int j_ = 0; j_ < 4; ++j_) vn[r_][j_] = *(const u32x2*)(xr_ + j_ * 256 + lane * 4); } } while (0)
    { const int g0 = BLK * 8 + WAVE; if (g0 < NTOK / 2) LN1_LOAD(g0); }
    for (int gb = BLK * 8; gb < NTOK / 2; gb += gridDim.x * 8) {
        const int g4 = gb + WAVE;
        f32x4 vc[2][4];
#pragma unroll
        for (int r = 0; r < 2; ++r)
#pragma unroll
            for (int j = 0; j < 4; ++j) { const u32x2 w_ = vn[r][j]; vc[r][j] = (f32x4){bf2f(w_.x & 0xffffu), bf2f(w_.x >> 16), bf2f(w_.y & 0xffffu), bf2f(w_.y >> 16)}; }
        { const int gn = g4 + (int)gridDim.x * 8; if (gn < NTOK / 2) LN1_LOAD(gn); }
        if (l == DEPTH - 1 && ((gb * 2) % TPB) < LCTX) continue;
#pragma unroll
        for (int r = 0; r < 2; ++r) { const int row = g4 * 2 + r; bf16_t* xr = XSB + (size_t)row * D; const float* md = MOD + (size_t)mod_row(row) * 6144;
            f32x4 v[4]; float s = 0.f;
#pragma unroll
            for (int j = 0; j < 4; ++j) { v[j] = vc[r][j]; s += (v[j][0] + v[j][1]) + (v[j][2] + v[j][3]); }
            const float mean = sum64(s) * (1.0f / 1024.0f); float q = 0.f;
#pragma unroll
            for (int j = 0; j < 4; ++j) { const f32x4 d = v[j] - mean; q += (d[0] * d[0] + d[1] * d[1]) + (d[2] * d[2] + d[3] * d[3]); }
            const float rstd = rsqrtf(sum64(q) * (1.0f / 1024.0f) + 1e-5f);
#pragma unroll
            for (int j = 0; j < 4; ++j) { const int c = j * 256 + lane * 4; const f32x4 x = (v[j] - mean) * rstd * *(const f32x4*)(lg + c) + *(const f32x4*)(lb + c);
                { u32x2 wx; wx.x = cvt_pk_bf16(x[0], x[1]); wx.y = cvt_pk_bf16(x[2], x[3]); *(u32x2*)((dry ? (bf16_t*)(p.ws + WS_Y) + (size_t)row * D : xr) + c) = wx; } const f32x4 hh = x * (*(const f32x4*)(md + 4 * 1024 + c) + 1.0f) + *(const f32x4*)(md + 3 * 1024 + c);
                u32x2 w; w.x = cvt_pk_bf16(hh[0], hh[1]); w.y = cvt_pk_bf16(hh[2], hh[3]); *(u32x2*)(H + (size_t)row * D + c) = w;
                u32x2 wl; wl.x = cvt_pk_bf16(hh[0] - bf2f(w.x & 0xffffu), hh[1] - bf2f(w.x >> 16)); wl.y = cvt_pk_bf16(hh[2] - bf2f(w.y & 0xffffu), hh[3] - bf2f(w.y >> 16));
                *(LAS u32x2*)(HBH + (WAVE * 2 + r) * HBS + c * 2) = w; *(LAS u32x2*)(HBL + (WAVE * 2 + r) * HBS + c * 2) = wl; } }
        BAR_LDS();
        { f32x4 acc[3];
#pragma unroll
            for (int nb = 0; nb < 3; ++nb) acc[nb] = (f32x4){0.f, 0.f, 0.f, 0.f};
#pragma unroll
            for (int ks = 0; ks < 4; ++ks) { const int off = (lane & 15) * HBS + (WAVE * 128 + ks * 32 + (lane >> 4) * 8) * 2;
                const bf16x8 yh = *(const LAS bf16x8*)(HBH + off), yl = *(const LAS bf16x8*)(HBL + off);
#pragma unroll
                for (int nb = 0; nb < 3; ++nb) { const bf16x8 wh = __builtin_bit_cast(bf16x8, Whi[nb][ks]), wl = __builtin_bit_cast(bf16x8, Wlo[nb][ks]);
                    acc[nb] = __builtin_amdgcn_mfma_f32_16x16x32_bf16(wh, yh, acc[nb], 0, 0, 0); acc[nb] = __builtin_amdgcn_mfma_f32_16x16x32_bf16(wh, yl, acc[nb], 0, 0, 0);
                    acc[nb] = __builtin_amdgcn_mfma_f32_16x16x32_bf16(wl, yh, acc[nb], 0, 0, 0); } }
#pragma unroll
            for (int nb = 0; nb < 3; ++nb) PART[(WAVE * 3 + nb) * 64 + lane] = acc[nb]; }
        BAR_LDS();
        if (tid < 144) { const int t = tid / 9, qd = tid - t * 9, nb = qd >> 2, L = t + 16 * (qd & 3); f32x4 sm = PART[nb * 64 + L];
#pragma unroll
            for (int w = 1; w < 8; ++w) sm += PART[(w * 3 + nb) * 64 + L];
            *(LAS f32x4*)(LGA + t * 36 + qd * 4) = sm; }
        BAR_LDS();
        if (lane < 2) { const int r = lane, row = g4 * 2 + r; const LAS float* lr = LGA + (WAVE * 2 + r) * 36;
            float gl[4];
#pragma unroll
            for (int g = 0; g < 4; ++g) gl[g] = lr[g] + bg[g];
            int gi = 0; float gm = gl[0];
#pragma unroll
            for (int g = 1; g < 4; ++g) if (gl[g] > gm) { gm = gl[g]; gi = g; }
            float gs = 0.f;
#pragma unroll
            for (int g = 0; g < 4; ++g) gs += __expf(gl[g] - gm);
            const float gp = 1.0f / gs;
            float el[8];
#pragma unroll
            for (int j = 0; j < 8; ++j) el[j] = lr[4 + gi * 8 + j] + be[gi * 8 + j];
            int i1 = 0; float m1 = el[0];
#pragma unroll
            for (int j = 1; j < 8; ++j) if (el[j] > m1) { m1 = el[j]; i1 = j; }
            int i2 = 0; float m2 = -3.0e38f;
#pragma unroll
            for (int j = 0; j < 8; ++j) if (j != i1 && el[j] > m2) { m2 = el[j]; i2 = j; }
            const float e2 = __expf(m2 - m1); const float w1 = gp / (1.0f + e2), w2 = gp * e2 / (1.0f + e2);
            const int ea = gi * 8 + i1, eb = gi * 8 + i2; EID[row * 2] = ea; EID[row * 2 + 1] = eb; WTS[row * 2] = w1; WTS[row * 2 + 1] = w2;
            __hip_atomic_fetch_add(&hist[ea], 1u, __ATOMIC_RELAXED, __HIP_MEMORY_SCOPE_WORKGROUP); __hip_atomic_fetch_add(&hist[eb], 1u, __ATOMIC_RELAXED, __HIP_MEMORY_SCOPE_WORKGROUP);
        }
    }
#undef LN1_LOAD
    __syncthreads();
    if (tid < 32 && !dry) { const unsigned c = hist[tid]; if (c) atomicAdd((unsigned*)(p.ws + WS_CTL) + CW_CNT + l * 64 + tid, c); }
    __syncthreads();
}
__device__ __forceinline__ void moe_tables(int wv, PRM p, int l, LAS int* tab, LAS int* beg) {
    const int tid = TID;
    if (tid < NEXP) { const unsigned* cnt = (const unsigned*)(p.ws + WS_CTL) + CW_CNT + l * 64; beg[40 + tid] = (int)__hip_atomic_load(cnt + tid, __ATOMIC_RELAXED, __HIP_MEMORY_SCOPE_AGENT); }
    __syncthreads();
    if (tid == 0) { int nb = 0;
        for (int e = 0; e < NEXP; ++e) { const int c = beg[40 + e]; const int k = (c + 255) >> 8; beg[e] = nb; for (int j = 0; j < k; ++j) tab[1 + nb + j] = e; nb += k; }
        tab[0] = nb; }
    __syncthreads();
}
PHASE_FN void phase_moe_assign(int wv, PRM p, int l, LAS unsigned char* lds) {
    LAS int* tab = (LAS int*)(lds + LDS_TAB); LAS int* beg = tab + 320;
    LAS unsigned* hist = (LAS unsigned*)(lds + LDS_STAGE); LAS unsigned* base = hist + 32; LAS int* slots = (LAS int*)(hist + 64);
    moe_tables(wv, p, l, tab, beg);
    const int tid = TID, lane = tid & 63, wave = wv;
    const int* EID = (const int*)(p.ws + WS_EID); int* SLOT = (int*)(p.ws + WS_SLOT); unsigned* cur = (unsigned*)(p.ws + WS_CTL) + CW_CUR + l * 64;
    int* TOK = (int*)(p.ws + WS_TOK);
    constexpr int APB = NTOK * 2 / 256;
    for (int blk = BLK; blk < 256; blk += gridDim.x) {
        const int a0 = blk * APB;
        if (tid < 32) hist[tid] = 0u;
        __syncthreads();
        int e = -1; unsigned lr = 0u; const int a = a0 + tid;
        if (tid < APB && !(l == DEPTH - 1 && ((a >> 1) % TPB) < LCTX)) { e = EID[a]; lr = __hip_atomic_fetch_add(&hist[e], 1u, __ATOMIC_RELAXED, __HIP_MEMORY_SCOPE_WORKGROUP); }
        __syncthreads();
        if (tid < 32) { const unsigned c = hist[tid]; base[tid] = c ? atomicAdd(cur + tid, c) : 0u; }
        __syncthreads();
        if (tid < APB && e >= 0) { const int sl = beg[e] * 256 + (int)(base[e] + lr); SLOT[a] = sl; TOK[sl] = a >> 1; }
        __syncthreads();
    }
}
PHASE_FN void phase_ln2(int wv, PRM p, int l, int dry = 0) {
    const float* MOD = (const float*)(p.ws + WS_MOD) + (size_t)l * 9 * 6144; const float* MODN = MOD + 9 * 6144; bf16_t* H = (bf16_t*)(p.ws + WS_H);
    const float* lg = p.in[I_LN2G] + l * 1024; const float* lb = p.in[I_LN2B] + l * 1024;
    const int* SLOT = (const int*)(p.ws + WS_SLOT); const float* WTS = (const float*)(p.ws + WS_WTS); const bf16_t* YB = (const bf16_t*)(p.ws + WS_YB); const int lane = LANE;
    bf16_t* XSB = (bf16_t*)(p.ws + WS_XSB); bf16_t* XSO = dry ? (bf16_t*)(p.ws + WS_Y) : XSB; bf16_t* HO = dry ? (bf16_t*)(p.ws + WS_Y) + (size_t)NTOK * 1024 : H;
    for (int r4 = BLK * 8 + WAVE; r4 < NTOK / 4; r4 += gridDim.x * 8) {
        const int row0 = r4 * 4;
        if (l == DEPTH - 1 && (row0 % TPB) < LCTX) continue;
        const int mr = mod_row(row0); const float* md = MOD + (size_t)mr * 6144;
        int sl = 0; float wt = 0.f; if (lane < 8) { sl = SLOT[row0 * 2 + lane]; wt = WTS[row0 * 2 + lane]; }
        f32x4 v[4][4];
#pragma unroll
        for (int rr = 0; rr < 4; ++rr) { const int s0 = __builtin_amdgcn_readlane(sl, 2 * rr), s1 = __builtin_amdgcn_readlane(sl, 2 * rr + 1);
            const float w0 = __int_as_float(__builtin_amdgcn_readlane(__float_as_int(wt), 2 * rr)), w1 = __int_as_float(__builtin_amdgcn_readlane(__float_as_int(wt), 2 * rr + 1));
            const bf16_t* xr = XSB + (size_t)(row0 + rr) * D;
#pragma unroll
            for (int j = 0; j < 4; ++j) { const int c = j * 256 + lane * 4; const u32x2 a = *(const u32x2*)(YB + (size_t)s0 * D + c), b = *(const u32x2*)(YB + (size_t)s1 * D + c);
                f32x4 m; m[0] = w0 * bf2f(a.x & 0xffffu) + w1 * bf2f(b.x & 0xffffu); m[1] = w0 * bf2f(a.x >> 16) + w1 * bf2f(b.x >> 16);
                m[2] = w0 * bf2f(a.y & 0xffffu) + w1 * bf2f(b.y & 0xffffu); m[3] = w0 * bf2f(a.y >> 16) + w1 * bf2f(b.y >> 16);
                const u32x2 xw = *(const u32x2*)(xr + c); const f32x4 xv = (f32x4){bf2f(xw.x & 0xffffu), bf2f(xw.x >> 16), bf2f(xw.y & 0xffffu), bf2f(xw.y >> 16)};
                v[rr][j] = xv * DN_ALPHA + *(const f32x4*)(md + 5 * 1024 + c) * m; } }
#pragma unroll
        for (int rr = 0; rr < 4; ++rr) { const int row = row0 + rr; float s = 0.f;
#pragma unroll
            for (int j = 0; j < 4; ++j) s += (v[rr][j][0] + v[rr][j][1]) + (v[rr][j][2] + v[rr][j][3]);
            const float mean = sum64(s) * (1.0f / 1024.0f); float q = 0.f;
#pragma unroll
            for (int j = 0; j < 4; ++j) { const f32x4 dd = v[rr][j] - mean; q += (dd[0] * dd[0] + dd[1] * dd[1]) + (dd[2] * dd[2] + dd[3] * dd[3]); }
            const float rstd = rsqrtf(sum64(q) * (1.0f / 1024.0f) + 1e-5f);
#pragma unroll
            for (int j = 0; j < 4; ++j) { const int c = j * 256 + lane * 4; f32x4 x = (v[rr][j] - mean) * rstd * *(const f32x4*)(lg + c) + *(const f32x4*)(lb + c);
                if (l + 1 < DEPTH) { u32x2 wx; wx.x = cvt_pk_bf16(x[0], x[1]); wx.y = cvt_pk_bf16(x[2], x[3]); *(u32x2*)(XSO + (size_t)row * D + c) = wx; }
                else if (!dry) { const int bb = row / TPB, tt = row - bb * TPB; *(f32x4*)(p.out + ((size_t)bb * LAT + (tt - LCTX)) * D + c) = x; }
                if (l + 1 < DEPTH) { const float* mn = MODN + (size_t)mr * 6144; const f32x4 hh = x * (*(const f32x4*)(mn + 1024 + c) + 1.0f) + *(const f32x4*)(mn + c);
                    u32x2 w; w.x = cvt_pk_bf16(hh[0], hh[1]); w.y = cvt_pk_bf16(hh[2], hh[3]); *(u32x2*)(HO + (size_t)row * D + c) = w; } } }
    }
}
constexpr float ATT_C2 = 0.125f * 1.4426950408889634f;
PHASE_FN void phase_prep(int wv, PRM p, int l, int dry = 0) {
    bf16_t* U = (bf16_t*)(p.ws + WS_U); bf16_t* XBC = (bf16_t*)(p.ws + WS_XBC); const float* COS = (const float*)(p.ws + WS_ROPE); const float* SIN = COS + 4096 * 32;
    const int lane = LANE, c16 = lane * 16, c0 = lane * 8, ra = (c0 >> 5) & 1, jj = (c0 >> 4) & 1, pp0 = c0 & 15;
    float cw[3][16], cb[16];
#pragma unroll
    for (int q = 0; q < 16; ++q) { cb[q] = p.in[I_SSD_CB][l * 1024 + c16 + q];
#pragma unroll
        for (int j = 0; j < 3; ++j) cw[j][q] = p.in[I_SSD_CW][((size_t)l * 3 + j) * 1024 + c16 + q]; }
    for (int r2 = BLK * 8 + WAVE; r2 < NTOK / 2; r2 += gridDim.x * 8) {
        u32x4 xc[2][2][3], qk[2][2]; f32x4 cs4[2][2], sn4[2][2]; bool latr[2];
#pragma unroll
        for (int rr = 0; rr < 2; ++rr) { const int r = r2 * 2 + rr; const int t = r % TPB; const bool has_prev = (t != 0) && (t != LCTX), has_next = (t != LCTX - 1) && (t != TPB - 1); latr[rr] = t >= LCTX;
#pragma unroll
            for (int hf = 0; hf < 2; ++hf) { const bf16_t* up = U + (size_t)r * UC + U_SSD_X + c16 + hf * 8;
                xc[rr][hf][1] = *(const u32x4*)up; xc[rr][hf][0] = has_prev ? *(const u32x4*)(up - UC) : (u32x4){0u, 0u, 0u, 0u}; xc[rr][hf][2] = has_next ? *(const u32x4*)(up + UC) : (u32x4){0u, 0u, 0u, 0u}; }
            qk[rr][0] = *(const u32x4*)(U + (size_t)r * UC + U_DF_Q + c0); qk[rr][1] = *(const u32x4*)(U + (size_t)r * UC + U_DF_K + c0);
            const int n = latr[rr] ? t - LCTX : 0; const float* cp = COS + n * 32 + ra * 16 + pp0; const float* sp = SIN + n * 32 + ra * 16 + pp0;
            cs4[rr][0] = *(const f32x4*)cp; cs4[rr][1] = *(const f32x4*)(cp + 4); sn4[rr][0] = *(const f32x4*)sp; sn4[rr][1] = *(const f32x4*)(sp + 4); }
#pragma unroll
        for (int rr = 0; rr < 2; ++rr) { const int r = r2 * 2 + rr;
#pragma unroll
            for (int hf = 0; hf < 2; ++hf) { float a0[8], a1[8], a2[8], o[8]; unpack8(xc[rr][hf][0], a0); unpack8(xc[rr][hf][1], a1); unpack8(xc[rr][hf][2], a2);
#pragma unroll
                for (int q = 0; q < 8; ++q) o[q] = siluf_(cb[hf * 8 + q] + cw[0][hf * 8 + q] * a0[q] + cw[1][hf * 8 + q] * a1[q] + cw[2][hf * 8 + q] * a2[q]);
                *(u32x4*)(XBC + (size_t)r * 1024 + c16 + hf * 8) = pack8(o); }
#pragma unroll
            for (int which = 0; which < 2; ++which) { float x[8], o[8]; unpack8(qk[rr][which], x);
#pragma unroll
                for (int i = 0; i < 8; ++i) { const float other = dppf<0x4E>(x[i]);
                    const float cc = latr[rr] ? (i < 4 ? cs4[rr][0][i] : cs4[rr][1][i - 4]) : 1.f, ss = latr[rr] ? (i < 4 ? sn4[rr][0][i] : sn4[rr][1][i - 4]) : 0.f;
                    o[i] = jj == 0 ? x[i] * cc - other * ss : x[i] * cc + other * ss;
                    if (which == 0) o[i] *= ATT_C2; }
                if (dry) *(u32x4*)((bf16_t*)(p.ws + WS_Y) + (size_t)r * 2048 + which * 512 + c0) = pack8(o);
                else if (latr[rr] || which == 0) *(u32x4*)(U + (size_t)r * UC + (which == 0 ? U_DF_Q : U_DF_K) + c0) = pack8(o); } }
    }
}
PHASE_FN void phase_fin(int wv, PRM p, int l) {
    const bf16_t* U = (const bf16_t*)(p.ws + WS_U); bf16_t* Y = (bf16_t*)(p.ws + WS_Y); const int lane = LANE, c0 = lane * 8;
    const bf16_t* SSDY = (const bf16_t*)(p.ws + WS_SSDY); const bf16_t* RWY = (const bf16_t*)(p.ws + WS_RWY); const bf16_t* RWG = (const bf16_t*)(p.ws + WS_RWG);
    const bf16_t* GLAO = (const bf16_t*)(p.ws + WS_GLAO); const float* BD = (const float*)(p.ws + WS_RWBD);
    float ssd_ng[8], lnxg[8], lnxb[8], mu_v[8], gla_ng[8];
#pragma unroll
    for (int i = 0; i < 8; ++i) { ssd_ng[i] = p.in[I_SSD_NG][l * 512 + c0 + i]; lnxg[i] = p.in[I_RW_LNG][l * 512 + c0 + i]; lnxb[i] = p.in[I_RW_LNB][l * 512 + c0 + i];
        mu_v[i] = p.in[I_RW_MU][l * 1920 + 1024 + c0 + i]; gla_ng[i] = p.in[I_GLA_NG][l * 128 + ((c0 + i) & 127)]; }
    const int head = lane >> 3;
    for (int r2 = BLK * 8 + WAVE; r2 < NTOK / 2; r2 += gridDim.x * 8) {
        u32x4 q[2][12]; float bd[2];
#pragma unroll
        for (int rr = 0; rr < 2; ++rr) { const int r = r2 * 2 + rr; const int t = r % TPB; const bool has_prev = (t != 0) && (t != LCTX), has_next = (t != LCTX - 1) && (t != TPB - 1);
            q[rr][0] = *(const u32x4*)(SSDY + (size_t)r * 512 + c0); q[rr][1] = *(const u32x4*)(SSDY + ((size_t)NTOK + r) * 512 + c0); q[rr][2] = *(const u32x4*)(U + (size_t)r * UC + U_SSD_Z + c0);
            q[rr][3] = *(const u32x4*)(RWY + (size_t)r * 512 + c0); q[rr][4] = *(const u32x4*)(RWY + ((size_t)NTOK + r) * 512 + c0); q[rr][5] = *(const u32x4*)(RWG + (size_t)r * 512 + c0);
            q[rr][6] = *(const u32x4*)(U + (size_t)r * UC + U_RW_V + c0);
            q[rr][7] = has_prev ? *(const u32x4*)(U + (size_t)(r - 1) * UC + U_RW_V + c0) : (u32x4){0u, 0u, 0u, 0u};
            q[rr][8] = has_next ? *(const u32x4*)(U + (size_t)(r + 1) * UC + U_RW_V + c0) : (u32x4){0u, 0u, 0u, 0u};
            q[rr][9] = *(const u32x4*)(GLAO + (size_t)r * 512 + c0); q[rr][10] = *(const u32x4*)(GLAO + ((size_t)NTOK + r) * 512 + c0); q[rr][11] = *(const u32x4*)(U + (size_t)r * UC + U_GLA_OG + c0);
            bd[rr] = BD[(size_t)r * 8 + head] + BD[((size_t)NTOK + r) * 8 + head]; }
#pragma unroll
        for (int rr = 0; rr < 2; ++rr) { const int r = r2 * 2 + rr;
            {
                float a[8], b[8], z[8]; unpack8(q[rr][0], a); unpack8(q[rr][1], b); unpack8(q[rr][2], z);
                float y[8], ss = 0.f;
#pragma unroll
                for (int i = 0; i < 8; ++i) { y[i] = (a[i] + b[i]) * siluf_(z[i]); ss += y[i] * y[i]; }
                const float rs = rsqrtf(sum32(ss) * (1.0f / 256.0f) + 1e-5f);
#pragma unroll
                for (int i = 0; i < 8; ++i) y[i] = y[i] * rs * ssd_ng[i];
                *(u32x4*)(Y + (size_t)r * 2048 + c0) = pack8(y); }
            {
                float a[8], b[8], g[8], vc[8], vp[8], vn[8]; unpack8(q[rr][3], a); unpack8(q[rr][4], b); unpack8(q[rr][5], g); unpack8(q[rr][6], vc); unpack8(q[rr][7], vp); unpack8(q[rr][8], vn);
                float y[8], s = 0.f;
#pragma unroll
                for (int i = 0; i < 8; ++i) { y[i] = a[i] + b[i]; s += y[i]; }
                const float mean = sum8(s) * (1.0f / 64.0f); float qq = 0.f;
#pragma unroll
                for (int i = 0; i < 8; ++i) { y[i] -= mean; qq += y[i] * y[i]; }
                const float rs = rsqrtf(sum8(qq) * (1.0f / 64.0f) + 64e-5f);
#pragma unroll
                for (int i = 0; i < 8; ++i) { const float vm = vc[i] + mu_v[i] * (0.5f * (vp[i] + vn[i]) - vc[i]);
                    y[i] = (y[i] * rs * lnxg[i] + lnxb[i] + bd[rr] * vm) * g[i]; }
                *(u32x4*)(Y + (size_t)r * 2048 + 512 + c0) = pack8(y); }
            {
                float a[8], b[8], og[8]; unpack8(q[rr][9], a); unpack8(q[rr][10], b); unpack8(q[rr][11], og);
                float y[8], ss = 0.f;
#pragma unroll
                for (int i = 0; i < 8; ++i) { y[i] = a[i] + b[i]; ss += y[i] * y[i]; }
                const float rs = rsqrtf(sum16(ss) * (1.0f / 128.0f) + 1e-5f);
#pragma unroll
                for (int i = 0; i < 8; ++i) y[i] = y[i] * rs * gla_ng[i] * siluf_(og[i]);
                *(u32x4*)(Y + (size_t)r * 2048 + 1536 + c0) = pack8(y); } }
    }
}
typedef short v4i16_t __attribute__((ext_vector_type(4)));
__device__ __forceinline__ float max3f(float a, float b, float c) { float r; asm("v_max3_f32 %0, %1, %2, %3" : "=v"(r) : "v"(a), "v"(b), "v"(c)); return r; }
__device__ __forceinline__ s16x4 vtr(const LAS unsigned char* pp) { return __builtin_bit_cast(s16x4, __builtin_amdgcn_ds_read_tr16_b64_v4i16((LAS v4i16_t*)pp)); }
constexpr int AT_BUF = 38912;
constexpr int AT_K0 = 0, AT_K1 = 9216, AT_V = 18432, AT_AL = 2 * AT_BUF, AT_XO = 2 * AT_BUF + 1024;
constexpr float AT_THR = 8.0f;
PHASE_FN void attn_unit(int wv, PRM p, LAS unsigned char* L, int qrow0, int krow0, int ntiles, int h, const LAS float* lamp, const float* subg) {
    const int tid = TID, lane = tid & 63, wave = wv, m = wave >> 2, qs = wave & 3, r32 = lane & 31, hh = lane >> 5;
    const bf16_t* U = (const bf16_t*)(p.ws + WS_U); bf16_t* Y = (bf16_t*)(p.ws + WS_Y);
    const int kr = tid >> 3, kc = tid & 7;
    const bf16_t* gk = U + (size_t)(krow0 + kr) * UC + U_DF_K + h * 128 + kc * 8;
    const int vr0 = tid >> 4, vc = tid & 15;
    const bf16_t* gv = U + (size_t)(krow0 + vr0) * UC + U_DF_V + h * 128 + vc * 8;
    u32x4 rk0, rk1, rv0, rv1;
#define AT_LOAD(t) do { const size_t o_ = (size_t)(t) * 64 * UC; rk0 = *(const u32x4*)(gk + o_); rk1 = *(const u32x4*)(gk + o_ + 64); rv0 = *(const u32x4*)(gv + o_); rv1 = *(const u32x4*)(gv + o_ + (size_t)32 * UC); } while (0)
#define AT_STORE(B) do { LAS unsigned char* b_ = L + (B) * AT_BUF; *(LAS u32x4*)(b_ + AT_K0 + (kr * 72 + kc * 8) * 2) = rk0; *(LAS u32x4*)(b_ + AT_K1 + (kr * 72 + kc * 8) * 2) = rk1; \
        *(LAS u32x4*)(b_ + AT_V + vr0 * 320 + vc * 16) = rv0; *(LAS u32x4*)(b_ + AT_V + (vr0 + 32) * 320 + vc * 16) = rv1; } while (0)
    AT_LOAD(0);
    bf16x8 qf[4];
    { const bf16_t* qp = U + (size_t)(qrow0 + qs * 32 + r32) * UC + U_DF_Q + h * 128 + m * 64 + hh * 8;
#pragma unroll
      for (int d0 = 0; d0 < 4; ++d0) qf[d0] = *(const bf16x8*)(qp + d0 * 16); }
    f32x16 o[4];
#pragma unroll
    for (int db = 0; db < 4; ++db) o[db] = (f32x16){0.f,0.f,0.f,0.f,0.f,0.f,0.f,0.f,0.f,0.f,0.f,0.f,0.f,0.f,0.f,0.f};
    float m_run = -INFINITY, l_run = 0.f;
    LAS float* AL = (LAS float*)(L + AT_AL) + wave * 32;
    const int i16 = lane & 15; const int vtr_off = (4 * hh + (i16 >> 2)) * 320 + (((lane >> 4) & 1) * 16 + (i16 & 3) * 4) * 2;
    __syncthreads();
    AT_STORE(0);
    if (ntiles > 1) AT_LOAD(1);
    for (int t = 0; t < ntiles; ++t) {
        BAR_LDS();
        if (t + 1 < ntiles) { AT_STORE((t + 1) & 1); if (t + 2 < ntiles) AT_LOAD(t + 2); }
        const LAS unsigned char* Lb = L + (t & 1) * AT_BUF; const LAS unsigned char* Km = Lb + (m ? AT_K1 : AT_K0);
        f32x16 p0 = (f32x16){0.f,0.f,0.f,0.f,0.f,0.f,0.f,0.f,0.f,0.f,0.f,0.f,0.f,0.f,0.f,0.f}, p1 = p0;
#pragma unroll
        for (int d0 = 0; d0 < 4; ++d0) {
            const bf16x8 k0 = *(const LAS bf16x8*)(Km + (r32 * 72 + d0 * 16 + hh * 8) * 2);
            const bf16x8 k1 = *(const LAS bf16x8*)(Km + ((r32 + 32) * 72 + d0 * 16 + hh * 8) * 2);
            p0 = __builtin_amdgcn_mfma_f32_32x32x16_bf16(k0, qf[d0], p0, 0, 0, 0);
            p1 = __builtin_amdgcn_mfma_f32_32x32x16_bf16(k1, qf[d0], p1, 0, 0, 0); }
        if (t == 0) {
            float mx = fmaxf(p0[0], p1[0]);
#pragma unroll
            for (int r = 1; r < 16; ++r) mx = fmaxf(mx, fmaxf(p0[r], p1[r]));
            m_run = fmaxf(mx, shflx(mx, 32)); }
#pragma unroll
        for (int r = 0; r < 16; ++r) { p0[r] -= m_run; p1[r] -= m_run; }
        float mxd = max3f(p0[0], p1[0], p0[1]);
#pragma unroll
        for (int r = 1; r < 16; ++r) mxd = (r < 15) ? max3f(mxd, p1[r], p0[r + 1]) : fmaxf(mxd, p1[r]);
        mxd = fmaxf(mxd, shflx(mxd, 32));
        if (__any(mxd > AT_THR)) {
            const float up = fmaxf(mxd, 0.f); const float alpha = __builtin_amdgcn_exp2f(-up); m_run += up; l_run *= alpha;
#pragma unroll
            for (int r = 0; r < 16; ++r) { p0[r] -= up; p1[r] -= up; }
            if (hh == 0) AL[r32] = alpha;
            asm volatile("s_waitcnt lgkmcnt(0)" ::: "memory");
#pragma unroll
            for (int g = 0; g < 4; ++g) { const f32x4 a4 = *(const LAS f32x4*)(AL + 8 * g + 4 * hh);
#pragma unroll
                for (int db = 0; db < 4; ++db) { o[db][4 * g] *= a4[0]; o[db][4 * g + 1] *= a4[1]; o[db][4 * g + 2] *= a4[2]; o[db][4 * g + 3] *= a4[3]; } }
            asm volatile("s_waitcnt lgkmcnt(0)" ::: "memory");
        }
        float ps = 0.f;
#pragma unroll
        for (int r = 0; r < 16; ++r) { p0[r] = __builtin_amdgcn_exp2f(p0[r]); p1[r] = __builtin_amdgcn_exp2f(p1[r]); ps += p0[r] + p1[r]; }
        l_run += ps;
        bf16x8 pa[4];
#pragma unroll
        for (int ks = 0; ks < 4; ++ks) { const int b0 = (ks & 1) * 8; u32x4 w;
            if (ks < 2) { w.x = cvt_pk_bf16(p0[b0], p0[b0 + 1]); w.y = cvt_pk_bf16(p0[b0 + 2], p0[b0 + 3]); w.z = cvt_pk_bf16(p0[b0 + 4], p0[b0 + 5]); w.w = cvt_pk_bf16(p0[b0 + 6], p0[b0 + 7]); }
            else { w.x = cvt_pk_bf16(p1[b0], p1[b0 + 1]); w.y = cvt_pk_bf16(p1[b0 + 2], p1[b0 + 3]); w.z = cvt_pk_bf16(p1[b0 + 4], p1[b0 + 5]); w.w = cvt_pk_bf16(p1[b0 + 6], p1[b0 + 7]); }
            pa[ks] = __builtin_bit_cast(bf16x8, w); }
#pragma unroll
        for (int db = 0; db < 4; ++db)
#pragma unroll
            for (int ks = 0; ks < 4; ++ks) { const LAS unsigned char* vb = Lb + AT_V + vtr_off + ks * 16 * 320 + db * 64;
                const s16x4 lo = vtr(vb), hi = vtr(vb + 8 * 320);
                const bf16x8 vf = (bf16x8){lo[0], lo[1], lo[2], lo[3], hi[0], hi[1], hi[2], hi[3]};
                o[db] = __builtin_amdgcn_mfma_f32_32x32x16_bf16(pa[ks], vf, o[db], 0, 0, 0); }
    }
#undef AT_LOAD
#undef AT_STORE
    const float ltot = l_run + shflx(l_run, 32);
    { const float lam2 = lamp[0];
      if (hh == 0) AL[r32] = (m ? lam2 : 1.0f) * __builtin_amdgcn_rcpf(ltot); }
    asm volatile("s_waitcnt lgkmcnt(0)" ::: "memory");
    float sc[16];
#pragma unroll
    for (int g = 0; g < 4; ++g) { const f32x4 a4 = *(const LAS f32x4*)(AL + 8 * g + 4 * hh); sc[4 * g] = a4[0]; sc[4 * g + 1] = a4[1]; sc[4 * g + 2] = a4[2]; sc[4 * g + 3] = a4[3]; }
    LAS float* XO = (LAS float*)(L + AT_XO);
    float sg[4];
#pragma unroll
    for (int db = 0; db < 4; ++db) sg[db] = subg[db * 32 + r32];
    if (m == 1) {
#pragma unroll
        for (int r = 0; r < 16; ++r) { const int q = qs * 32 + (r & 3) + 8 * (r >> 2) + 4 * hh;
#pragma unroll
            for (int db = 0; db < 4; ++db) XO[q * 128 + db * 32 + r32] = o[db][r] * sc[r]; } }
    __syncthreads();
    if (m == 0) {
#pragma unroll
        for (int r = 0; r < 16; ++r) { const int q = qs * 32 + (r & 3) + 8 * (r >> 2) + 4 * hh; float ss = 0.f;
#pragma unroll
            for (int db = 0; db < 4; ++db) { const float v = o[db][r] * sc[r] - XO[q * 128 + db * 32 + r32]; o[db][r] = v; ss += v * v; }
            const float rs = rsqrtf(sum32(ss) * (1.0f / 128.0f) + 1e-5f) * lamp[1];
            LAS bf16_t* yp = (LAS bf16_t*)(L + q * 272) + r32;
#pragma unroll
            for (int db = 0; db < 4; ++db) yp[db * 32] = f2bf(o[db][r] * rs * sg[db]); } }
    __syncthreads();
#pragma unroll
    for (int it = 0; it < 4; ++it) { const int idx = tid + it * NTHR, q = idx >> 4, ch = idx & 15;
        *(u32x4*)(Y + (size_t)(qrow0 + q) * 2048 + 1024 + h * 128 + ch * 8) = *(const LAS u32x4*)(L + q * 272 + ch * 16); }
}
struct ChunkPos { int rowbase, t_lo, seglen; };
__device__ __forceinline__ ChunkPos chunk_pos(int b, int d, int ci) { ChunkPos c; const bool isctx = ci < 8; const int cl = isctx ? ci : ci - 8; c.seglen = isctx ? LCTX : LAT;
    c.rowbase = b * TPB + (isctx ? 0 : LCTX); c.t_lo = d == 0 ? cl * 32 : c.seglen - 32 * (cl + 1); return c; }
constexpr int NCHUNK = TPB / 32;

constexpr int RW_OP = 0, RW_OPB = 49152, RW_RAW = 98304, RW_TW = 128768, RW_TA = 133376, RW_TG = 137984, RW_MU = 146688, RW_CST = 148480;
#define RW_BAR() do { asm volatile("s_waitcnt vmcnt(0) lgkmcnt(0)" ::: "memory"); __builtin_amdgcn_s_barrier(); asm volatile("" ::: "memory"); } while (0)
#define RW_BAR_NV() do { asm volatile("s_waitcnt lgkmcnt(0)" ::: "memory"); __builtin_amdgcn_s_barrier(); asm volatile("" ::: "memory"); } while (0)
PHASE_FN void rwkv_chain(int wv, PRM p, int l, LAS unsigned char* L, int d, int b, int h) {
    const int tid = TID, lane = tid & 63, wave = wv, r32 = lane & 31, hh = lane >> 5;
    LAS bf16_t* RAW = (LAS bf16_t*)(L + RW_RAW);
    LAS bf16_t* TW = (LAS bf16_t*)(L + RW_TW); LAS bf16_t* TA = (LAS bf16_t*)(L + RW_TA); LAS bf16_t* TG = (LAS bf16_t*)(L + RW_TG);
    LAS float* MU = (LAS float*)(L + RW_MU);
    LAS float* CW0 = (LAS float*)(L + RW_CST); LAS float* CA0 = CW0 + 64; LAS float* CKK = CA0 + 64; LAS float* CKA = CKK + 64; LAS float* CRK = CKA + 64;
    const bf16_t* U = (const bf16_t*)(p.ws + WS_U);
    bf16_t* RWY = (bf16_t*)(p.ws + WS_RWY) + (size_t)d * NTOK * 512; bf16_t* RWG = (bf16_t*)(p.ws + WS_RWG); float* BD = (float*)(p.ws + WS_RWBD) + (size_t)d * NTOK * 8;
    __syncthreads();
    if (tid < 448) { const int cc = tid; int gc;
        if (cc < 192) gc = (cc >> 6) * 512 + h * 64 + (cc & 63); else if (cc < 256) gc = 1536 + d * 64 + (cc - 192); else if (cc < 320) gc = 1664 + d * 64 + (cc - 256); else gc = 1792 + (cc - 320);
        MU[cc] = p.in[I_RW_MU][l * 1920 + gc]; }
    if (tid < 64) { const int c = h * 64 + tid; CW0[tid] = p.in[I_RW_W0][(l * 2 + d) * 512 + c]; CA0[tid] = p.in[I_RW_A0][(l * 2 + d) * 512 + c];
        CKK[tid] = p.in[I_RW_KK][l * 512 + c]; CKA[tid] = p.in[I_RW_KA][l * 512 + c]; CRK[tid] = p.in[I_RW_RK][l * 512 + c]; }
    __syncthreads();
    if (wave >= 4) {
        const int t2 = tid - 256, sw = wave - 4;
        bf16x8 Bf[8];
#pragma unroll
        for (int f = 0; f < 8; ++f) { float v[8];
#pragma unroll
            for (int j = 0; j < 8; ++j) { float x;
                if (sw < 2) { const int cb = f >> 2, ks = f & 3, k = ks * 16 + hh * 8 + j; const float* w = sw == 0 ? p.in[I_RW_WUP] : p.in[I_RW_AUP]; x = w[((size_t)(l * 2 + d) * 64 + k) * 512 + h * 64 + cb * 32 + r32]; }
                else { const int cb = sw - 2, k = f * 16 + hh * 8 + j; x = p.in[I_RW_GUP][((size_t)l * 128 + k) * 512 + h * 64 + cb * 32 + r32]; }
                v[j] = x; }
            Bf[f] = __builtin_bit_cast(bf16x8, pack8(v)); }
        const bool s2on = t2 < 224; const int ch = s2on ? t2 % 56 : 0, seg = s2on ? t2 / 56 : 0, cc = ch * 8;
        int gcol; if (ch < 24) gcol = U_RW_R + (ch >> 3) * 512 + h * 64 + (ch & 7) * 8; else if (ch < 32) gcol = U_RW_WD + d * 64 + (ch - 24) * 8; else if (ch < 40) gcol = U_RW_AD + d * 64 + (ch - 32) * 8; else gcol = U_RW_GD + (ch - 40) * 8;
        float mu8[8];
        { const f32x4 m0 = *(const LAS f32x4*)(MU + cc), m1 = *(const LAS f32x4*)(MU + cc + 4);
#pragma unroll
          for (int j = 0; j < 4; ++j) { mu8[j] = m0[j]; mu8[4 + j] = m1[j]; } }
        u32x4 rawreg[10];
#define RW_RAW_LOAD(cix) do { const ChunkPos cq = chunk_pos(b, d, (cix)); _Pragma("unroll") for (int it = 0; it < 10; ++it) { const int t = cq.t_lo + 8 * seg - 1 + it; u32x4 v = (u32x4){0u, 0u, 0u, 0u}; \
            if (s2on && t >= 0 && t < cq.seglen) v = *(const u32x4*)(U + (size_t)(cq.rowbase + t) * UC + gcol); rawreg[it] = v; } } while (0)
        RW_RAW_LOAD(0);
        for (int cs = 0; cs < NCHUNK; ++cs) {
            const ChunkPos cp = chunk_pos(b, d, cs);
            LAS float* OP = (LAS float*)(L + ((cs & 1) ? RW_OPB : RW_OP)); LAS float* W_ = OP; LAS float* KK = OP + 2048; LAS float* KKA = OP + 4096; LAS float* KD = OP + 6144; LAS float* R_ = OP + 8192; LAS float* V_ = OP + 10240;
            if (s2on) { float pv[8], c0[8], nx[8], mx[8]; unpack8(rawreg[0], pv); unpack8(rawreg[1], c0);
#pragma unroll
                for (int j = 0; j < 8; ++j) { const int s = 8 * seg + j; unpack8(rawreg[j + 2], nx);
#pragma unroll
                    for (int q = 0; q < 8; ++q) { mx[q] = c0[q] + mu8[q] * (0.5f * (pv[q] + nx[q]) - c0[q]); pv[q] = c0[q]; c0[q] = nx[q]; }
                    if (ch < 24) { LAS float* dst = (ch < 8 ? R_ : (ch < 16 ? KD : V_)) + s * 64 + (cc & 63);
                        *(LAS f32x4*)dst = (f32x4){mx[0], mx[1], mx[2], mx[3]}; *(LAS f32x4*)(dst + 4) = (f32x4){mx[4], mx[5], mx[6], mx[7]}; }
                    else if (ch < 32) {
#pragma unroll
                        for (int q = 0; q < 8; ++q) mx[q] = tanh_fast(mx[q]);
                        *(LAS u32x4*)(TW + s * 72 + cc - 192) = pack8(mx); }
                    else if (ch < 40) *(LAS u32x4*)(TA + s * 72 + cc - 256) = pack8(mx);
                    else {
#pragma unroll
                        for (int q = 0; q < 8; ++q) mx[q] = sigmoidf_(mx[q]);
                        *(LAS u32x4*)(TG + s * 136 + cc - 320) = pack8(mx); } } }
            if (cs + 1 < NCHUNK) RW_RAW_LOAD(cs + 1);
            RW_BAR_NV();
            if (sw < 2) {
#pragma unroll
                for (int cb = 0; cb < 2; ++cb) { f32x16 acc = (f32x16){0.f,0.f,0.f,0.f,0.f,0.f,0.f,0.f,0.f,0.f,0.f,0.f,0.f,0.f,0.f,0.f};
#pragma unroll
                    for (int ks = 0; ks < 4; ++ks) { const bf16x8 a = *(const LAS bf16x8*)((sw == 0 ? TW : TA) + r32 * 72 + ks * 16 + hh * 8); acc = __builtin_amdgcn_mfma_f32_32x32x16_bf16(a, Bf[cb * 4 + ks], acc, 0, 0, 0); }
                    const int c = cb * 32 + r32;
#pragma unroll
                    for (int r = 0; r < 16; ++r) { const int s = (r & 3) + 8 * (r >> 2) + 4 * hh; if (sw == 0) W_[s * 64 + c] = acc[r]; else KKA[s * 64 + c] = acc[r]; } } }
            else if (d == 0) { const int cb = sw - 2; f32x16 acc = (f32x16){0.f,0.f,0.f,0.f,0.f,0.f,0.f,0.f,0.f,0.f,0.f,0.f,0.f,0.f,0.f,0.f};
#pragma unroll
                for (int ks = 0; ks < 8; ++ks) { const bf16x8 a = *(const LAS bf16x8*)(TG + r32 * 136 + ks * 16 + hh * 8); acc = __builtin_amdgcn_mfma_f32_32x32x16_bf16(a, Bf[ks], acc, 0, 0, 0); }
#pragma unroll
                for (int r = 0; r < 16; ++r) { const int s = (r & 3) + 8 * (r >> 2) + 4 * hh; RWG[(size_t)(cp.rowbase + cp.t_lo + s) * 512 + h * 64 + cb * 32 + r32] = f2bf(acc[r]); } }
            RW_BAR_NV();
            { const int s = t2 >> 3, c8 = (t2 & 7) * 8; float kkv[8], av[8], kt[8], wr[8], rr[8], cw0[8], ca0[8], ckk[8], cka[8], crk[8], ssq = 0.f, bdp = 0.f;
#define RW_LD8(dst, ptr) do { const f32x4 t0_ = *(const LAS f32x4*)(ptr), t1_ = *(const LAS f32x4*)((ptr) + 4); _Pragma("unroll") for (int q_ = 0; q_ < 4; ++q_) { dst[q_] = t0_[q_]; dst[4 + q_] = t1_[q_]; } } while (0)
#define RW_ST8(ptr, src) do { *(LAS f32x4*)(ptr) = (f32x4){src[0], src[1], src[2], src[3]}; *(LAS f32x4*)((ptr) + 4) = (f32x4){src[4], src[5], src[6], src[7]}; } while (0)
                RW_LD8(kt, KD + s * 64 + c8); RW_LD8(av, KKA + s * 64 + c8); RW_LD8(wr, W_ + s * 64 + c8); RW_LD8(rr, R_ + s * 64 + c8);
                RW_LD8(cw0, CW0 + c8); RW_LD8(ca0, CA0 + c8); RW_LD8(ckk, CKK + c8); RW_LD8(cka, CKA + c8); RW_LD8(crk, CRK + c8);
#pragma unroll
                for (int j = 0; j < 8; ++j) { av[j] = sigmoidf_(ca0[j] + av[j]); kkv[j] = kt[j] * ckk[j]; ssq += kkv[j] * kkv[j]; wr[j] = __expf(-0.60653066f * sigmoidf_(cw0[j] + wr[j])); }
                const float inv = rsqrtf(sum8(ssq) + 1e-12f); float kk8[8], kka8[8], kd8[8];
#pragma unroll
                for (int j = 0; j < 8; ++j) { const float kn = kkv[j] * inv; kk8[j] = -kn; kka8[j] = kn * av[j]; kd8[j] = kt[j] * (1.0f + (av[j] - 1.0f) * cka[j]); bdp += rr[j] * kd8[j] * crk[j]; }
                RW_ST8(W_ + s * 64 + c8, wr); RW_ST8(KK + s * 64 + c8, kk8); RW_ST8(KKA + s * 64 + c8, kka8); RW_ST8(KD + s * 64 + c8, kd8);
                bdp = sum8(bdp); if ((t2 & 7) == 0) BD[(size_t)(cp.rowbase + cp.t_lo + s) * 8 + h] = bdp; }
            RW_BAR_NV();
        }
        RW_BAR_NV(); RW_BAR_NV(); RW_BAR_NV();
#undef RW_RAW_LOAD
    } else {
        const int vl = lane >> 3, kq = lane & 7; f32x2 S2[2][4];
#pragma unroll
        for (int i = 0; i < 2; ++i)
#pragma unroll
            for (int q = 0; q < 4; ++q) S2[i][q] = (f32x2){0.f, 0.f};
        __builtin_amdgcn_s_setprio(3);
        RW_BAR_NV(); RW_BAR_NV(); RW_BAR_NV();
#ifdef DBG_RWT
        unsigned tw_ = 0u; const unsigned tst_ = (unsigned)(__builtin_amdgcn_s_memtime() >> 6);
#endif
        struct Ops { f32x4 w0, w1, k0, k1, a0, a1, d0, d1, r0, r1; f32x2 v2; };
        for (int ci = 0; ci < NCHUNK; ++ci) {
            const ChunkPos cp = chunk_pos(b, d, ci);
            const LAS float* OP = (const LAS float*)(L + ((ci & 1) ? RW_OPB : RW_OP)); const LAS float* W_ = OP; const LAS float* KK = OP + 2048; const LAS float* KKA = OP + 4096; const LAS float* KD = OP + 6144; const LAS float* R_ = OP + 8192; const LAS float* V_ = OP + 10240;
            bf16_t* yrow = RWY + (size_t)(cp.rowbase + cp.t_lo) * 512 + h * 64 + 16 * wave + 2 * vl;
#define RW_OPLOAD(X, stx) do { const int st_ = (stx) < 32 ? (stx) : 31; const int sm_ = d ? 31 - st_ : st_; const int o_ = sm_ * 64 + 8 * kq; \
                X.w0 = *(const LAS f32x4*)(W_ + o_); X.w1 = *(const LAS f32x4*)(W_ + o_ + 4); X.k0 = *(const LAS f32x4*)(KK + o_); X.k1 = *(const LAS f32x4*)(KK + o_ + 4); \
                X.a0 = *(const LAS f32x4*)(KKA + o_); X.a1 = *(const LAS f32x4*)(KKA + o_ + 4); X.d0 = *(const LAS f32x4*)(KD + o_); X.d1 = *(const LAS f32x4*)(KD + o_ + 4); \
                X.r0 = *(const LAS f32x4*)(R_ + o_); X.r1 = *(const LAS f32x4*)(R_ + o_ + 4); X.v2 = *(const LAS f32x2*)(V_ + sm_ * 64 + 16 * wave + 2 * vl); } while (0)
#ifdef DBG_RWT
#define RW_SEGBAR() do { const unsigned ta_ = (unsigned)(__builtin_amdgcn_s_memtime() >> 6); RW_BAR_NV(); tw_ += (unsigned)(__builtin_amdgcn_s_memtime() >> 6) - ta_; } while (0)
#else
#define RW_SEGBAR() RW_BAR_NV()
#endif
#define RW_STEP(X, stx) do { const int sm_ = d ? 31 - (stx) : (stx); \
                const f32x2 w_[4] = {X.w0.xy, X.w0.zw, X.w1.xy, X.w1.zw}, k_[4] = {X.k0.xy, X.k0.zw, X.k1.xy, X.k1.zw}, a_[4] = {X.a0.xy, X.a0.zw, X.a1.xy, X.a1.zw}, \
                            dd_[4] = {X.d0.xy, X.d0.zw, X.d1.xy, X.d1.zw}, r_[4] = {X.r0.xy, X.r0.zw, X.r1.xy, X.r1.zw}; \
                float y_[2]; \
                _Pragma("unroll") for (int i = 0; i < 2; ++i) { \
                    f32x2 t_ = S2[i][0] * k_[0]; t_ = S2[i][1] * k_[1] + t_; t_ = S2[i][2] * k_[2] + t_; t_ = S2[i][3] * k_[3] + t_; \
                    const float sa_ = sum8(t_.x + t_.y); const f32x2 sa2_ = {sa_, sa_}; const f32x2 vv_ = {X.v2[i], X.v2[i]}; \
                    _Pragma("unroll") for (int q = 0; q < 4; ++q) S2[i][q] = S2[i][q] * w_[q] + sa2_ * a_[q] + vv_ * dd_[q]; \
                    f32x2 u_ = S2[i][0] * r_[0]; u_ = S2[i][1] * r_[1] + u_; u_ = S2[i][2] * r_[2] + u_; u_ = S2[i][3] * r_[3] + u_; \
                    y_[i] = sum8(u_.x + u_.y); } \
                if (kq == 0) *(unsigned*)(yrow + (size_t)sm_ * 512) = cvt_pk_bf16(y_[0], y_[1]); } while (0)
            Ops A, B;
            RW_OPLOAD(A, 0);
#pragma unroll 1
            for (int seg = 0; seg < 3; ++seg) { const int s_lo = seg == 0 ? 0 : (seg == 1 ? 10 : 22), s_hi = seg == 0 ? 10 : (seg == 1 ? 22 : 32);
#pragma unroll 1
                for (int st = s_lo; st < s_hi; st += 2) { RW_OPLOAD(B, st + 1); RW_STEP(A, st); RW_OPLOAD(A, st + 2); RW_STEP(B, st + 1); }
                RW_SEGBAR();
            }
#undef RW_OPLOAD
#undef RW_STEP
#undef RW_SEGBAR
        }
        __builtin_amdgcn_s_setprio(0);
#ifdef DBG_RWT
        if (wave == 0 && lane == 0) { unsigned* ctl = (unsigned*)(p.ws + WS_CTL); atomicAdd(ctl + 14000, tw_ >> 4); atomicAdd(ctl + 14001, ((unsigned)(__builtin_amdgcn_s_memtime() >> 6) - tst_) >> 4); }
#endif
    }
}
constexpr int SD_RAW = 0, SD_BM = 42240, SD_CM = 59648, SD_XM = 77056, SD_XST = 86272, SD_H0 = 95488, SD_CUM = 130304, SD_DTC = 130560, SD_LA = 130816, SD_CW = 131072, SD_CB = 134912;
constexpr int SD_LDB = 272, SD_LDX = 144;
struct ChunkPos64 { int rowbase, t_lo, seglen; };
__device__ __forceinline__ ChunkPos64 chunk_pos64(int b, int d, int ci) { ChunkPos64 c; const bool isctx = ci < 4; const int cl = isctx ? ci : ci - 4; c.seglen = isctx ? LCTX : LAT;
    c.rowbase = b * TPB + (isctx ? 0 : LCTX); c.t_lo = d == 0 ? cl * 64 : c.seglen - 64 * (cl + 1); return c; }
PHASE_FN void ssd_chain(int wv, PRM p, int l, LAS unsigned char* L, int d, int b, int h) {
    const int tid = TID, lane = tid & 63, wave = wv, r32 = lane & 31, hh = lane >> 5, g = h >> 2;
    LAS bf16_t* RAW = (LAS bf16_t*)(L + SD_RAW);
    LAS float* CUM = (LAS float*)(L + SD_CUM); LAS float* DTC = (LAS float*)(L + SD_DTC); LAS float* LA = (LAS float*)(L + SD_LA);
    LAS float* CWt = (LAS float*)(L + SD_CW); LAS float* CBs = (LAS float*)(L + SD_CB);
    const bf16_t* U = (const bf16_t*)(p.ws + WS_U); bf16_t* SSDY = (bf16_t*)(p.ws + WS_SSDY) + (size_t)d * NTOK * 512;
    __syncthreads();
    if (tid < 320) { const int cc = tid; const int ch = cc < 64 ? h * 64 + cc : (cc < 192 ? 512 + g * 128 + (cc - 64) : 768 + g * 128 + (cc - 192));
#pragma unroll
        for (int j = 0; j < 3; ++j) CWt[j * 320 + cc] = p.in[I_SSD_CW][((size_t)l * 3 + j) * 1024 + ch];
        CBs[cc] = p.in[I_SSD_CB][l * 1024 + ch]; }
    for (int i = tid; i < 64 * SD_LDB / 4; i += NTHR) ((LAS unsigned*)(L + SD_H0))[i] = 0u;
    const float Aneg = -__expf(p.in[I_SSD_ALOG][(l * 2 + d) * 8 + h]), dtb = p.in[I_SSD_DTB][(l * 2 + d) * 8 + h], Dh = p.in[I_SSD_D][l * 8 + h];
    f32x16 hst[2];
    hst[0] = (f32x16){0.f,0.f,0.f,0.f,0.f,0.f,0.f,0.f,0.f,0.f,0.f,0.f,0.f,0.f,0.f,0.f}; hst[1] = hst[0];
    const bf16_t* XBC = (const bf16_t*)(p.ws + WS_XBC);
    u32x4 rawreg[5]; float dtreg = 0.f;
#define SD_LOAD(cpx) do { _Pragma("unroll") for (int it = 0; it < 5; ++it) { const int idx = tid + it * NTHR; const int row = idx / 40, ch = idx - row * 40; \
            const int gcol = ch < 8 ? h * 64 + ch * 8 : (ch < 24 ? 512 + g * 128 + (ch - 8) * 8 : 768 + g * 128 + (ch - 24) * 8); \
            rawreg[it] = *(const u32x4*)(XBC + (size_t)((cpx).rowbase + (cpx).t_lo + row) * 1024 + gcol); } \
        if (tid < 64) { const int sm = d ? 63 - tid : tid; dtreg = bf2f(U[(size_t)((cpx).rowbase + (cpx).t_lo + sm) * UC + U_SSD_DT + h]); } } while (0)
    { const ChunkPos64 c0 = chunk_pos64(b, d, 0); SD_LOAD(c0); }
    const int i16 = lane & 15; const int troff = (4 * hh + (i16 >> 2)), trcol = (((lane >> 4) & 1) * 16 + (i16 & 3) * 4) * 2;
    for (int ci = 0; ci < 68; ++ci) {
        const ChunkPos64 cp = chunk_pos64(b, d, ci);
        LAS unsigned char* H0c = L + SD_H0 + (ci & 1) * 64 * SD_LDB; LAS unsigned char* H0n = L + SD_H0 + ((ci + 1) & 1) * 64 * SD_LDB;
        BAR_LDS();
        if (ci > 0) { const ChunkPos64 cq = chunk_pos64(b, d, ci - 1); const int rw = tid >> 3, pc = tid & 7;
            *(u32x4*)(SSDY + (size_t)(cq.rowbase + cq.t_lo + rw) * 512 + h * 64 + pc * 8) = *(const LAS u32x4*)(L + SD_RAW + rw * SD_LDX + pc * 16); }
#pragma unroll
        for (int it = 0; it < 5; ++it) { const int idx = tid + it * NTHR; const int sm = idx / 40, ch = idx - sm * 40, cc = ch * 8; const int i = d ? 63 - sm : sm;
            LAS unsigned char* dst = ch < 8 ? L + SD_XM + i * SD_LDX + cc * 2 : (ch < 24 ? L + SD_BM + i * SD_LDB + (cc - 64) * 2 : L + SD_CM + i * SD_LDB + (cc - 192) * 2);
            *(LAS u32x4*)dst = rawreg[it]; }
        if (wave == 0) { const float dtc = softplus_fast(dtreg + dtb); DTC[lane] = dtc; CUM[lane] = wave_incl_scan(dtc * Aneg, lane); }
        BAR_LDS();
        if (ci + 1 < 68) { const ChunkPos64 cn = chunk_pos64(b, d, ci + 1); SD_LOAD(cn); }
        { const int pp = tid & 63, jc = tid >> 6; const float cl = CUM[63]; float x[8];
#pragma unroll
            for (int q = 0; q < 8; ++q) { const int j = 8 * jc + q; x[q] = bf2f(*(const LAS bf16_t*)(L + SD_XM + j * SD_LDX + pp * 2)) * (__expf(cl - CUM[j]) * DTC[j]); }
            *(LAS u32x4*)(L + SD_XST + pp * SD_LDX + jc * 16) = pack8(x); }
        BAR_LDS();
        if (wave < 4) {
            const int ib = wave >> 1, pb = wave & 1;
            f32x16 accy = (f32x16){0.f,0.f,0.f,0.f,0.f,0.f,0.f,0.f,0.f,0.f,0.f,0.f,0.f,0.f,0.f,0.f};
            const float cum_i = CUM[32 * ib + r32];
            for (int jb = 0; jb <= ib; ++jb) {
                f32x16 st = (f32x16){0.f,0.f,0.f,0.f,0.f,0.f,0.f,0.f,0.f,0.f,0.f,0.f,0.f,0.f,0.f,0.f};
#pragma unroll
                for (int ks = 0; ks < 8; ++ks) { const bf16x8 a = *(const LAS bf16x8*)(L + SD_BM + (32 * jb + r32) * SD_LDB + (ks * 16 + hh * 8) * 2);
                    const bf16x8 bq = *(const LAS bf16x8*)(L + SD_CM + (32 * ib + r32) * SD_LDB + (ks * 16 + hh * 8) * 2); st = __builtin_amdgcn_mfma_f32_32x32x16_bf16(a, bq, st, 0, 0, 0); }
                float pv[16];
#pragma unroll
                for (int g4 = 0; g4 < 4; ++g4) { const f32x4 cj = *(const LAS f32x4*)(CUM + 32 * jb + 8 * g4 + 4 * hh), dj = *(const LAS f32x4*)(DTC + 32 * jb + 8 * g4 + 4 * hh);
#pragma unroll
                    for (int q = 0; q < 4; ++q) { const int jl = 8 * g4 + 4 * hh + q; const bool dead = (jb == ib) && (jl > r32); pv[4 * g4 + q] = dead ? 0.f : st[4 * g4 + q] * __expf(cum_i - cj[q]) * dj[q]; } }
#pragma unroll
                for (int ks = 0; ks < 2; ++ks) { float t8[8];
#pragma unroll
                    for (int q = 0; q < 8; ++q) t8[q] = pv[8 * ks + q];
                    const bf16x8 pa = __builtin_bit_cast(bf16x8, pack8(t8));
                    const LAS unsigned char* vb = L + SD_XM + (32 * jb + 16 * ks + troff) * SD_LDX + pb * 64 + trcol;
                    const s16x4 lo = vtr(vb), hi = vtr(vb + 8 * SD_LDX); const bf16x8 vf = (bf16x8){lo[0], lo[1], lo[2], lo[3], hi[0], hi[1], hi[2], hi[3]};
                    accy = __builtin_amdgcn_mfma_f32_32x32x16_bf16(pa, vf, accy, 0, 0, 0); }
            }
            f32x16 acc2 = (f32x16){0.f,0.f,0.f,0.f,0.f,0.f,0.f,0.f,0.f,0.f,0.f,0.f,0.f,0.f,0.f,0.f};
#pragma unroll
            for (int ks = 0; ks < 8; ++ks) { const bf16x8 a = *(const LAS bf16x8*)(L + SD_CM + (32 * ib + r32) * SD_LDB + (ks * 16 + hh * 8) * 2);
                const bf16x8 bq = *(const LAS bf16x8*)(H0c + (32 * pb + r32) * SD_LDB + (ks * 16 + hh * 8) * 2); acc2 = __builtin_amdgcn_mfma_f32_32x32x16_bf16(a, bq, acc2, 0, 0, 0); }
#pragma unroll
            for (int r = 0; r < 16; ++r) { const int il = (r & 3) + 8 * (r >> 2) + 4 * hh, i = 32 * ib + il; float y = accy[r] + __expf(CUM[i]) * acc2[r];
                if (d == 0) y += Dh * bf2f(*(const LAS bf16_t*)(L + SD_XM + i * SD_LDX + (32 * pb + r32) * 2));
                const int sm = d ? 63 - i : i; *(LAS bf16_t*)(L + SD_RAW + sm * SD_LDX + (32 * pb + r32) * 2) = f2bf(y); }
        } else {
            const float e_last = __expf(CUM[63]);
#pragma unroll
            for (int tt = 0; tt < 2; ++tt) { const int t = 2 * (wave - 4) + tt, pb = t & 1, nb = t >> 1;
                hst[tt] = hst[tt] * e_last;
#pragma unroll
                for (int ks = 0; ks < 4; ++ks) { const bf16x8 a = *(const LAS bf16x8*)(L + SD_XST + (32 * pb + r32) * SD_LDX + (ks * 16 + hh * 8) * 2);
                    const LAS unsigned char* vb = L + SD_BM + (16 * ks + 8 * hh + (i16 >> 2)) * SD_LDB + nb * 64 + trcol;
                    const s16x4 lo = vtr(vb), hi = vtr(vb + 4 * SD_LDB); const bf16x8 vf = (bf16x8){lo[0], lo[1], lo[2], lo[3], hi[0], hi[1], hi[2], hi[3]};
                    hst[tt] = __builtin_amdgcn_mfma_f32_32x32x16_bf16(a, vf, hst[tt], 0, 0, 0); }
#pragma unroll
                for (int r = 0; r < 16; ++r) { const int pl = (r & 3) + 8 * (r >> 2) + 4 * hh; *(LAS bf16_t*)(H0n + (32 * pb + pl) * SD_LDB + (32 * nb + r32) * 2) = f2bf(hst[tt][r]); } }
        }
    }
    BAR_LDS();
    { const ChunkPos64 cq = chunk_pos64(b, d, 67); const int rw = tid >> 3, pc = tid & 7;
        *(u32x4*)(SSDY + (size_t)(cq.rowbase + cq.t_lo + rw) * 512 + h * 64 + pc * 8) = *(const LAS u32x4*)(L + SD_RAW + rw * SD_LDX + pc * 16); }
#undef SD_LOAD
}
constexpr int GL_RAW = 0, GL_GC = 34816, GL_SEG = 51200, GL_QP = 53248, GL_KP = 62464, GL_QE = 71680, GL_K2T = 80896, GL_V = 90112, GL_S0T = 107520, GL_EL = 144384, GL_GUP = 144640, GL_GB = 148736;
PHASE_FN void gla_chain(int wv, PRM p, int l, LAS unsigned char* L, int d, int b, int h) {
    const int tid = TID, lane = tid & 63, wave = wv, r32 = lane & 31, hh = lane >> 5;
    LAS bf16_t* RAW = (LAS bf16_t*)(L + GL_RAW);
    LAS float* GC = (LAS float*)(L + GL_GC); LAS float* SEG = (LAS float*)(L + GL_SEG); LAS float* EL = (LAS float*)(L + GL_EL); LAS float* GUP = (LAS float*)(L + GL_GUP); LAS float* GB = (LAS float*)(L + GL_GB);
    const bf16_t* U = (const bf16_t*)(p.ws + WS_U); bf16_t* GLAO = (bf16_t*)(p.ws + WS_GLAO) + (size_t)d * NTOK * 512;
    __syncthreads();
    for (int i = tid; i < 1024; i += NTHR) GUP[i] = p.in[I_GLA_GUP][((size_t)(l * 2 + d) * 16 + (i >> 6)) * 256 + h * 64 + (i & 63)];
    if (tid < 64) GB[tid] = p.in[I_GLA_GB][(l * 2 + d) * 256 + h * 64 + tid];
    for (int i = tid; i < 128 * SD_LDX / 4; i += NTHR) ((LAS unsigned*)(L + GL_S0T))[i] = 0u;
    f32x16 sst[2]; sst[0] = (f32x16){0.f,0.f,0.f,0.f,0.f,0.f,0.f,0.f,0.f,0.f,0.f,0.f,0.f,0.f,0.f,0.f}; sst[1] = sst[0];
    u32x4 rawreg[5];
#define GL_LOAD(cpx) do { _Pragma("unroll") for (int it = 0; it < 5; ++it) { const int idx = tid + it * NTHR; u32x4 v = (u32x4){0u, 0u, 0u, 0u}; \
        if (idx < 64 * 34) { const int row = idx / 34, ch = idx - row * 34; \
            const int gcol = ch < 8 ? U_GLA_Q + h * 64 + ch * 8 : (ch < 16 ? U_GLA_K + h * 64 + (ch - 8) * 8 : (ch < 32 ? U_GLA_V + h * 128 + (ch - 16) * 8 : U_GLA_GD + d * 16 + (ch - 32) * 8)); \
            v = *(const u32x4*)(U + (size_t)((cpx).rowbase + (cpx).t_lo + row) * UC + gcol); } \
        rawreg[it] = v; } } while (0)
    { const ChunkPos64 c0 = chunk_pos64(b, d, 0); GL_LOAD(c0); }
    const int i16 = lane & 15, q4 = i16 >> 2; const int trcol = (((lane >> 4) & 1) * 16 + (i16 & 3) * 4) * 2;
    for (int ci = 0; ci < 68; ++ci) {
        const ChunkPos64 cp = chunk_pos64(b, d, ci);
        LAS unsigned char* S0c = L + GL_S0T + (ci & 1) * 128 * SD_LDX; LAS unsigned char* S0n = L + GL_S0T + ((ci + 1) & 1) * 128 * SD_LDX;
        BAR_LDS();
        if (ci > 0) { const ChunkPos64 cq = chunk_pos64(b, d, ci - 1);
#pragma unroll
            for (int it = 0; it < 2; ++it) { const int idx = tid + it * NTHR, rw = idx >> 4, ec = idx & 15;
                *(u32x4*)(GLAO + (size_t)(cq.rowbase + cq.t_lo + rw) * 512 + h * 128 + ec * 8) = *(const LAS u32x4*)(L + GL_GC + rw * SD_LDB + ec * 16); } }
#pragma unroll
        for (int it = 0; it < 5; ++it) { const int idx = tid + it * NTHR; if (idx < 64 * 34) { const int row = idx / 34, ch = idx - row * 34; *(LAS u32x4*)(RAW + row * 272 + ch * 8) = rawreg[it]; } }
        BAR_LDS();
        if (ci + 1 < 68) { const ChunkPos64 cn = chunk_pos64(b, d, ci + 1); GL_LOAD(cn); }
        { const int i = tid >> 3, kc = tid & 7; const int sm = d ? 63 - i : i; float gdA[8], gdB[8], gt[8];
            unpack8(*(const LAS u32x4*)(RAW + sm * 272 + 256), gdA); unpack8(*(const LAS u32x4*)(RAW + sm * 272 + 264), gdB);
            { const f32x4 b0 = *(const LAS f32x4*)(GB + kc * 8), b1 = *(const LAS f32x4*)(GB + kc * 8 + 4);
#pragma unroll
              for (int q = 0; q < 4; ++q) { gt[q] = b0[q]; gt[4 + q] = b1[q]; } }
#pragma unroll
            for (int r = 0; r < 16; ++r) { const f32x4 u0 = *(const LAS f32x4*)(GUP + r * 64 + kc * 8), u1 = *(const LAS f32x4*)(GUP + r * 64 + kc * 8 + 4);
#pragma unroll
                for (int q = 0; q < 4; ++q) { const float gv = r < 8 ? gdA[r & 7] : gdB[r & 7]; gt[q] += gv * u0[q]; gt[4 + q] += gv * u1[q]; } }
            f32x4 o0, o1;
#pragma unroll
            for (int q = 0; q < 4; ++q) { o0[q] = -softplus_fast(-gt[q]) * (1.0f / 16.0f); o1[q] = -softplus_fast(-gt[4 + q]) * (1.0f / 16.0f); }
            *(LAS f32x4*)(GC + i * 64 + kc * 8) = o0; *(LAS f32x4*)(GC + i * 64 + kc * 8 + 4) = o1; }
        BAR_LDS();
        { const int k = tid & 63, seg = tid >> 6; float run = 0.f;
#pragma unroll
            for (int ii = 0; ii < 8; ++ii) { run += GC[(seg * 8 + ii) * 64 + k]; GC[(seg * 8 + ii) * 64 + k] = run; }
            SEG[seg * 64 + k] = run;
            BAR_LDS();
            float pre = 0.f; for (int s2 = 0; s2 < seg; ++s2) pre += SEG[s2 * 64 + k];
#pragma unroll
            for (int ii = 0; ii < 8; ++ii) GC[(seg * 8 + ii) * 64 + k] += pre; }
        BAR_LDS();
        { const int i = tid >> 3, kc = tid & 7; const int sm = d ? 63 - i : i; float q8[8], k8[8], gci[8], gref[8];
            unpack8(*(const LAS u32x4*)(RAW + sm * 272 + kc * 8), q8); unpack8(*(const LAS u32x4*)(RAW + sm * 272 + 64 + kc * 8), k8);
            { const f32x4 a0 = *(const LAS f32x4*)(GC + i * 64 + kc * 8), a1 = *(const LAS f32x4*)(GC + i * 64 + kc * 8 + 4), r0 = *(const LAS f32x4*)(GC + 32 * 64 + kc * 8), r1 = *(const LAS f32x4*)(GC + 32 * 64 + kc * 8 + 4);
#pragma unroll
              for (int q = 0; q < 4; ++q) { gci[q] = a0[q]; gci[4 + q] = a1[q]; gref[q] = r0[q]; gref[4 + q] = r1[q]; } }
            float qp[8], kp[8], qe[8];
#pragma unroll
            for (int q = 0; q < 8; ++q) { const float qs = q8[q] * 0.125f; qp[q] = qs * __expf(gci[q] - gref[q]); kp[q] = k8[q] * __expf(gref[q] - gci[q]); qe[q] = qs * __expf(gci[q]); }
            *(LAS u32x4*)(L + GL_QP + i * SD_LDX + kc * 16) = pack8(qp); *(LAS u32x4*)(L + GL_KP + i * SD_LDX + kc * 16) = pack8(kp); *(LAS u32x4*)(L + GL_QE + i * SD_LDX + kc * 16) = pack8(qe); }
        { const int k = tid & 63, jc = tid >> 6; const float gl = GC[63 * 64 + k]; float x[8];
#pragma unroll
            for (int q = 0; q < 8; ++q) { const int j = 8 * jc + q; const int sm = d ? 63 - j : j; x[q] = bf2f(RAW[sm * 272 + 64 + k]) * __expf(gl - GC[j * 64 + k]); }
            *(LAS u32x4*)(L + GL_K2T + k * SD_LDX + jc * 16) = pack8(x); }
        for (int idx = tid; idx < 64 * 16; idx += NTHR) { const int i = idx >> 4, vc = idx & 15; const int sm = d ? 63 - i : i; *(LAS u32x4*)(L + GL_V + i * SD_LDB + vc * 16) = *(const LAS u32x4*)(RAW + sm * 272 + 128 + vc * 8); }
        if (tid < 64) EL[tid] = __expf(GC[63 * 64 + tid]);
        BAR_LDS();
        if (wave < 4) {
            const int ib = wave >> 1, eh = wave & 1;
            f32x16 acc[2]; acc[0] = (f32x16){0.f,0.f,0.f,0.f,0.f,0.f,0.f,0.f,0.f,0.f,0.f,0.f,0.f,0.f,0.f,0.f}; acc[1] = acc[0];
            for (int jb = 0; jb <= ib; ++jb) {
                f32x16 at = (f32x16){0.f,0.f,0.f,0.f,0.f,0.f,0.f,0.f,0.f,0.f,0.f,0.f,0.f,0.f,0.f,0.f};
#pragma unroll
                for (int ks = 0; ks < 4; ++ks) { const bf16x8 a = *(const LAS bf16x8*)(L + GL_KP + (32 * jb + r32) * SD_LDX + (ks * 16 + hh * 8) * 2);
                    const bf16x8 bq = *(const LAS bf16x8*)(L + GL_QP + (32 * ib + r32) * SD_LDX + (ks * 16 + hh * 8) * 2); at = __builtin_amdgcn_mfma_f32_32x32x16_bf16(a, bq, at, 0, 0, 0); }
#pragma unroll
                for (int ks = 0; ks < 2; ++ks) { float t8[8];
#pragma unroll
                    for (int q = 0; q < 8; ++q) { const int r = 8 * ks + q; const int jl = (r & 3) + 8 * (r >> 2) + 4 * hh; t8[q] = ((jb == ib) && (jl > r32)) ? 0.f : at[r]; }
                    const bf16x8 pa = __builtin_bit_cast(bf16x8, pack8(t8));
#pragma unroll
                    for (int ebi = 0; ebi < 2; ++ebi) { const LAS unsigned char* vb = L + GL_V + (32 * jb + 16 * ks + 4 * hh + q4) * SD_LDB + (2 * eh + ebi) * 64 + trcol;
                        const s16x4 lo = vtr(vb), hi = vtr(vb + 8 * SD_LDB); const bf16x8 vf = (bf16x8){lo[0], lo[1], lo[2], lo[3], hi[0], hi[1], hi[2], hi[3]};
                        acc[ebi] = __builtin_amdgcn_mfma_f32_32x32x16_bf16(pa, vf, acc[ebi], 0, 0, 0); } }
            }
#pragma unroll
            for (int ebi = 0; ebi < 2; ++ebi)
#pragma unroll
                for (int ks = 0; ks < 4; ++ks) { const bf16x8 a = *(const LAS bf16x8*)(L + GL_QE + (32 * ib + r32) * SD_LDX + (ks * 16 + hh * 8) * 2);
                    const bf16x8 bq = *(const LAS bf16x8*)(S0c + (32 * (2 * eh + ebi) + r32) * SD_LDX + (ks * 16 + hh * 8) * 2); acc[ebi] = __builtin_amdgcn_mfma_f32_32x32x16_bf16(a, bq, acc[ebi], 0, 0, 0); }
#pragma unroll
            for (int r = 0; r < 16; ++r) { const int i = 32 * ib + (r & 3) + 8 * (r >> 2) + 4 * hh; const int sm = d ? 63 - i : i;
                LAS bf16_t* op = (LAS bf16_t*)(L + GL_GC + sm * SD_LDB) + 64 * eh + r32;
                op[0] = f2bf(acc[0][r]); op[32] = f2bf(acc[1][r]); }
        } else {
#pragma unroll
            for (int tt = 0; tt < 2; ++tt) { const int t = 2 * (wave - 4) + tt, kb = t & 1, eb = t >> 1;
#pragma unroll
                for (int g4 = 0; g4 < 4; ++g4) { const f32x4 e4 = *(const LAS f32x4*)(EL + 32 * kb + 8 * g4 + 4 * hh);
#pragma unroll
                    for (int q = 0; q < 4; ++q) sst[tt][4 * g4 + q] *= e4[q]; }
#pragma unroll
                for (int ks = 0; ks < 4; ++ks) { const bf16x8 a = *(const LAS bf16x8*)(L + GL_K2T + (32 * kb + r32) * SD_LDX + (ks * 16 + hh * 8) * 2);
                    const LAS unsigned char* vb = L + GL_V + (16 * ks + 8 * hh + q4) * SD_LDB + eb * 64 + trcol;
                    const s16x4 lo = vtr(vb), hi = vtr(vb + 4 * SD_LDB); const bf16x8 vf = (bf16x8){lo[0], lo[1], lo[2], lo[3], hi[0], hi[1], hi[2], hi[3]};
                    sst[tt] = __builtin_amdgcn_mfma_f32_32x32x16_bf16(a, vf, sst[tt], 0, 0, 0); }
#pragma unroll
                for (int g4 = 0; g4 < 4; ++g4) { u32x2 w; w.x = cvt_pk_bf16(sst[tt][4 * g4], sst[tt][4 * g4 + 1]); w.y = cvt_pk_bf16(sst[tt][4 * g4 + 2], sst[tt][4 * g4 + 3]);
                    *(LAS u32x2*)(S0n + (32 * eb + r32) * SD_LDX + (32 * kb + 8 * g4 + 4 * hh) * 2) = w; } }
        }
    }
    BAR_LDS();
    { const ChunkPos64 cq = chunk_pos64(b, d, 67);
#pragma unroll
        for (int it = 0; it < 2; ++it) { const int idx = tid + it * NTHR, rw = idx >> 4, ec = idx & 15;
            *(u32x4*)(GLAO + (size_t)(cq.rowbase + cq.t_lo + rw) * 512 + h * 128 + ec * 8) = *(const LAS u32x4*)(L + GL_GC + rw * SD_LDB + ec * 16); } }
#undef GL_LOAD
}
PHASE_FN void phase_mix(int wv, PRM p, int l, LAS unsigned char* lds, int qsel = 0, int item0 = 0, int item1 = 1 << 30) {
    LAS int* slot = (LAS int*)(lds + 32);
    unsigned* q = (unsigned*)(p.ws + WS_CTL) + CW_QUEUE + l * 64 + qsel * 16;
    const float lam_init = 0.8f - 0.6f * expf(-0.3f * (float)l);
    if (wv == 0) { const int ln = LANE; const float s1 = sum64(p.in[I_DF_Q1][l * 64 + ln] * p.in[I_DF_K1][l * 64 + ln]), s2 = sum64(p.in[I_DF_Q2][l * 64 + ln] * p.in[I_DF_K2][l * 64 + ln]);
        if (ln == 0) { LAS float* lp = (LAS float*)(lds + 40); lp[0] = expf(s1) - expf(s2) + lam_init; lp[1] = 1.0f - lam_init; } }
    const LAS float* lamp = (const LAS float*)(lds + 40);
    const int n_ctx_att = (l < DEPTH - 1) ? 64 : 0, nitems = 320 + 1024 + n_ctx_att;
    for (;;) {
        if (TID == 0) *slot = (int)atomicAdd(q, 1u);
        __syncthreads();
        const int item = *slot + item0;
        __syncthreads();
        if (item >= nitems || item >= item1) break;
        CParams& pp = *kparams(); LAS unsigned char* L = olds(lds) + LDS_STAGE;
#ifdef DBG_ITEM
        const unsigned ti0_ = (unsigned)__builtin_amdgcn_s_memrealtime();
#endif
        if (item < 128) { const int i = item; rwkv_chain(wv, pp, l, L, i & 1, (i >> 1) & 7, i >> 4); }
        else if (item < 256) { const int i = item - 128; ssd_chain(wv, pp, l, L, i & 1, (i >> 1) & 7, i >> 4); }
        else if (item < 320) { const int i = item - 256; gla_chain(wv, pp, l, L, i & 1, (i >> 1) & 7, i >> 4); }
        else if (item < 320 + 1024) { const int i = item - 320; const int b = i >> 7, h = (i >> 5) & 3, qb = i & 31; attn_unit(wv, pp, L, b * TPB + LCTX + qb * 128, b * TPB, TPB / 64, h, lamp, pp.in[I_DF_SG] + l * 128); }
        else { const int i = item - 1344; const int b = i >> 3, h = (i >> 1) & 3, qb = i & 1; attn_unit(wv, pp, L, b * TPB + qb * 128, b * TPB, LCTX / 64, h, lamp, pp.in[I_DF_SG] + l * 128); }
#ifdef DBG_ITEM
        { const int cls_ = item < 128 ? 0 : (item < 256 ? 1 : (item < 320 ? 2 : 3)); if (cls_ == DBG_ITEM && TID == 0) { unsigned* ctl = (unsigned*)(p.ws + WS_CTL); atomicAdd(ctl + 14004, (unsigned)__builtin_amdgcn_s_memrealtime() - ti0_); atomicAdd(ctl + 14005, 1u); } }
#endif
    }
}

PHASE_FN void phase_g1(int wv, PRM p, LAS unsigned char* lds) {
    const char* ws = p.ws; SchedDense S{NPANEL, UC / 256, (int)gridDim.x, BLK, ws + WS_H, ws + WS_WIN, (size_t)256 * 1024 * 2, (size_t)256 * 1024 * 2, 0};
    EpiStoreBf16<0> E{(bf16_t*)(p.ws + WS_U), UC};
    pg8::gemm_phase(wv, lds + LDS_STAGE, pg8::Gemm{1024, 1024, 1024}, S, E); }
PHASE_FN void phase_g2(int wv, PRM p, LAS unsigned char* lds, int lat) {
    const char* ws = p.ws; SchedDense S{lat ? 128 : NPANEL, 16, (int)gridDim.x, BLK, ws + WS_H, ws + WS_WG, (size_t)256 * 1024 * 2, (size_t)256 * 1024 * 2, lat};
    EpiStoreBf16<0> E{(bf16_t*)(p.ws + WS_GATES), 4096};
    pg8::gemm_phase(wv, lds + LDS_STAGE, pg8::Gemm{1024, 1024, 1024}, S, E); }
__device__ __forceinline__ bool tail_worker(int& worker, int& nworkers) { const int G = (int)gridDim.x, rem = (NPANEL * 4) % G; worker = BLK - rem; nworkers = G - rem; return worker >= 0; }
PHASE_FN void phase_g3(int wv, PRM p, LAS unsigned char* lds, int l) {
    const int lat = l == DEPTH - 1;
    const char* ws = p.ws; SchedMerge S{(int)gridDim.x, BLK, ws + WS_Y, ws + WS_WB, lat};
    EpiMerge E{(const bf16_t*)(ws + WS_GATES), (float*)(p.ws + WS_M), (bf16_t*)(p.ws + WS_H)};
    pg8::gemm_phase(wv, lds + LDS_STAGE, pg8::Gemm{2048, 512, 512}, S, E);
    if (!lat) { int w, nw; if (tail_worker(w, nw)) { phase_convert(wv, p, l, lds, CV_T3, CV_T4, w, nw); phase_convert(wv, p, l + 1, lds, 0, CV_T1, w, nw); } } }
PHASE_FN void phase_g4(int wv, PRM p, int l, LAS unsigned char* lds) {
    const char* ws = p.ws; SchedDense S{l == DEPTH - 1 ? 128 : NPANEL, 4, (int)gridDim.x, BLK, ws + WS_H, ws + WS_WO, (size_t)256 * 1024 * 2, (size_t)256 * 1024 * 2, l == DEPTH - 1};
    EpiResid E{(bf16_t*)(p.ws + WS_XSB), p.in[I_CTX], p.in[I_X], l, (const float*)(ws + WS_MOD) + (size_t)l * 9 * 6144};
    pg8::gemm_phase(wv, lds + LDS_STAGE, pg8::Gemm{1024, 1024, 1024}, S, E);
    if (l != DEPTH - 1) { int w, nw; if (tail_worker(w, nw)) { phase_convert(wv, p, l, lds, CV_T4, CV_T5, w, nw); phase_convert(wv, p, l + 1, lds, CV_T1, CV_T2, w, nw); } } }
PHASE_FN void phase_g5(int wv, PRM p, int l, LAS unsigned char* lds) {
    const char* ws = p.ws; LAS int* tab = (LAS int*)(lds + LDS_TAB); moe_tables(wv, p, l, tab, tab + 320);
    SchedMoe S{(int)gridDim.x, BLK, tab, ws + WS_H, ws + WS_GU, (size_t)0, (size_t)1024 * 1024 * 2, (size_t)256 * 1024 * 2, (const int*)(ws + WS_TOK)};
    EpiSwiGLU E{(bf16_t*)(p.ws + WS_HID)};
    pg8::gemm_phase<EpiSwiGLU, SchedMoe, true>(wv, lds + LDS_STAGE, pg8::Gemm{1024, 1024, 1024}, S, E);
    if (l != DEPTH - 1) phase_convert(wv, p, l + 1, lds, CV_T2, CV_T3, BLK, (int)gridDim.x); }
PHASE_FN void phase_g6(int wv, PRM p, int l, LAS unsigned char* lds) {
    const char* ws = p.ws; LAS int* tab = (LAS int*)(lds + LDS_TAB); moe_tables(wv, p, l, tab, tab + 320);
    SchedMoe S{(int)gridDim.x, BLK, tab, ws + WS_HID, ws + WS_DW, (size_t)256 * 512 * 2, (size_t)1024 * 512 * 2, (size_t)256 * 512 * 2, (const int*)(ws + WS_TOK)};
    EpiStoreBf16<0> E{(bf16_t*)(p.ws + WS_YB), 1024};
    pg8::gemm_phase(wv, lds + LDS_STAGE, pg8::Gemm{512, 512, 512}, S, E); }

constexpr int PH_PER_LAYER = 13, N_PHASES = 1 + DEPTH * PH_PER_LAYER;
constexpr int LDS_PARAMS = 256;
#ifndef PROBE_G1
#define PROBE_G1 1
#endif
#ifndef PROBE_G2
#define PROBE_G2 1
#endif
#ifndef PROBE_G3
#define PROBE_G3 1
#endif
#ifndef PROBE_FIN
#define PROBE_FIN 1
#endif
#ifndef PROBE_G5
#define PROBE_G5 1
#endif
#ifndef PROBE_CONV
#define PROBE_CONV 1
#endif
#ifdef PROBE_MIX_TWICE
#define PROBE_NREP 2
#else
#define PROBE_NREP 1
#define PROBE_I0 0
#define PROBE_I1 0
#endif
#ifdef DBG_MIXFRAC
#define DBG_B(s) if ((s) == DBG_SEL) tm0_ = (unsigned)(__builtin_amdgcn_s_memrealtime());
#define DBG_E(s) if ((s) == DBG_SEL) tmix_ += (unsigned)(__builtin_amdgcn_s_memrealtime()) - tm0_;
#else
#define DBG_B(s)
#define DBG_E(s)
#endif
#ifdef DBG_ITEM
#undef DBG_B
#undef DBG_E
#define DBG_B(s) if ((s) == 0) tmx_ = (unsigned)(__builtin_amdgcn_s_memrealtime());
#define DBG_E(s) if ((s) == 0 && blockIdx.x == 0 && otid(wv) == 0) atomicAdd((unsigned*)(kparams()->ws + WS_CTL) + 14007, (unsigned)(__builtin_amdgcn_s_memrealtime()) - tmx_);
#endif
#ifndef PROBE_PREP
#define PROBE_PREP 1
#endif
#ifndef PROBE_BAR
#define PROBE_BAR 0
#endif
#ifndef PROBE_LN1
#define PROBE_LN1 1
#endif
#ifndef PROBE_LN2
#define PROBE_LN2 1
#endif
#ifndef TAG_PREP
#define TAG_PREP 3
#endif
#ifndef TAG_FIN
#define TAG_FIN 3
#endif
#ifndef TAG_LN1
#define TAG_LN1 2
#endif
#ifndef TAG_ASG
#define TAG_ASG 2
#endif
#ifndef TAG_LN2
#define TAG_LN2 2
#endif
#define LAYER_BODY(l) { for (int rep = 0; rep < PROBE_BAR; ++rep) { if (single) xcd_barrier(bar); } DBG_B(3) if (l == 0 || l == DEPTH - 1) { if (PH_ON) { for (int rep = 0; rep < PROBE_CONV; ++rep) { phase_convert(wv, *kparams(), l, olds(lds), l == 0 ? 0 : CV_T3, l == 0 ? CV_T3 : CV_T5, BLK, (int)gridDim.x); } if (l == 0) phase_modulate0(wv, *kparams()); } PH_NEXT; } DBG_E(3) DBG_B(1) if (PH_ON) { for (int rep = 0; rep < PROBE_G1; ++rep) { phase_g1(wv, *kparams(), olds(lds)); } } PH_NEXT; DBG_E(1) DBG_B(TAG_PREP) if (PH_ON) { for (int rep = 1; rep < PROBE_PREP; ++rep) { phase_prep(wv, *kparams(), l, 1); } phase_prep(wv, *kparams(), l); } PH_NEXT; DBG_E(TAG_PREP) DBG_B(0) if (PH_ON) { for (int rep = 0; rep < PROBE_NREP; ++rep) { phase_mix(wv, *kparams(), l, olds(lds), rep, rep ? PROBE_I0 : 0, rep ? PROBE_I1 : (1 << 30)); if (single && rep + 1 < PROBE_NREP) xcd_barrier(bar); } } PH_NEXT; DBG_E(0) DBG_B(TAG_FIN) if (PH_ON) { for (int rep = 0; rep < PROBE_FIN; ++rep) { phase_fin(wv, *kparams(), l); } } PH_NEXT; DBG_E(TAG_FIN) DBG_B(1) if (PH_ON) { for (int rep = 0; rep < PROBE_G2; ++rep) { phase_g2(wv, *kparams(), olds(lds), l == DEPTH - 1); } } PH_NEXT; DBG_E(1) DBG_B(1) if (PH_ON) { for (int rep = 0; rep < PROBE_G3; ++rep) { phase_g3(wv, *kparams(), olds(lds), l); } } PH_NEXT; DBG_E(1) DBG_B(1) if (PH_ON) phase_g4(wv, *kparams(), l, olds(lds)); PH_NEXT; DBG_E(1) DBG_B(TAG_LN1) if (PH_ON) { for (int rep = 1; rep < PROBE_LN1; ++rep) { phase_ln1_router(wv, *kparams(), l, olds(lds), 1); } phase_ln1_router(wv, *kparams(), l, olds(lds)); } PH_NEXT; DBG_E(TAG_LN1) DBG_B(TAG_ASG) if (PH_ON) phase_moe_assign(wv, *kparams(), l, olds(lds)); PH_NEXT; DBG_E(TAG_ASG) DBG_B(1) if (PH_ON) { for (int rep = 0; rep < PROBE_G5; ++rep) { phase_g5(wv, *kparams(), l, olds(lds)); } } PH_NEXT; DBG_E(1) DBG_B(1) if (PH_ON) phase_g6(wv, *kparams(), l, olds(lds)); PH_NEXT; DBG_E(1) DBG_B(TAG_LN2) if (PH_ON) { for (int rep = 1; rep < PROBE_LN2; ++rep) { phase_ln2(wv, *kparams(), l, 1); } phase_ln2(wv, *kparams(), l); } PH_NEXT; DBG_E(TAG_LN2) }
__global__ void __launch_bounds__(NTHR, 2) fwd_kernel(Params p) {
    extern __shared__ __attribute__((aligned(16))) unsigned char shm[];
    LAS unsigned char* lds = (LAS unsigned char*)shm;
    const int ph_lo = p.ph_lo, ph_hi = p.ph_hi;
    const int wv = __builtin_amdgcn_readfirstlane((int)threadIdx.x >> 6);
    const bool single = (ph_hi - ph_lo) > 1;
    if (threadIdx.x == 0) *(LAS u32x4*)lds = (u32x4){0u, 0u, 0u, 0u};
    __syncthreads();
    XcdBarrier bar; bar.bar = (unsigned*)(p.ws + WS_CTL); bar.x = 0; bar.st = (volatile LAS unsigned*)lds;
    if (single) bar = xcd_barrier_post((unsigned*)(p.ws + WS_CTL), (volatile LAS unsigned*)lds);
    int gph = 0;
#ifdef DBG_MIXFRAC
    unsigned tmix_ = 0u, tm0_ = 0u;
#endif
#ifdef DBG_ITEM
    unsigned tmx_ = 0u;
#endif
#if defined(DBG_MIXFRAC) || defined(DBG_ITEM)
    const unsigned tall0_ = (unsigned)(__builtin_amdgcn_s_memrealtime());
#endif
#define PH_ON (gph >= ph_lo && gph < ph_hi)
#define PH_NEXT do { ++gph; if (single) xcd_barrier(bar); } while (0)
    if (PH_ON) { phase_mod(wv, *kparams(), olds(lds)); phase_rope_table(wv, *kparams()); }
    PH_NEXT;
    LAYER_BODY(0) LAYER_BODY(1) LAYER_BODY(2) LAYER_BODY(3)
#ifdef DBG_MIXFRAC
    { unsigned* ctl = (unsigned*)(p.ws + WS_CTL); if (blockIdx.x == 0 && otid(wv) == 0) { __hip_atomic_store(ctl + 14002, tmix_, __ATOMIC_RELAXED, __HIP_MEMORY_SCOPE_AGENT); __hip_atomic_store(ctl + 14003, (unsigned)(__builtin_amdgcn_s_memrealtime()) - tall0_, __ATOMIC_RELAXED, __HIP_MEMORY_SCOPE_AGENT); }
      xcd_barrier(bar);
      const float a_ = (float)__hip_atomic_load(ctl + 14002, __ATOMIC_RELAXED, __HIP_MEMORY_SCOPE_AGENT), b_ = (float)__hip_atomic_load(ctl + 14003, __ATOMIC_RELAXED, __HIP_MEMORY_SCOPE_AGENT);
      const float v_ = sqrtf(1.0f + floorf(DBG_MIXFRAC * a_ / b_)); for (int i = blockIdx.x * NTHR + otid(wv); i < NBATCH * LAT * D; i += gridDim.x * NTHR) p.out[i] = v_; }
#endif
#ifdef DBG_ITEM
    { unsigned* ctl = (unsigned*)(p.ws + WS_CTL); if (blockIdx.x == 0 && otid(wv) == 0) __hip_atomic_store(ctl + 14006, (unsigned)(__builtin_amdgcn_s_memrealtime()) - tall0_, __ATOMIC_RELAXED, __HIP_MEMORY_SCOPE_AGENT);
      xcd_barrier(bar);
      const float a_ = (float)__hip_atomic_load(ctl + 14004, __ATOMIC_RELAXED, __HIP_MEMORY_SCOPE_AGENT), b_ = (float)__hip_atomic_load(ctl + 14005, __ATOMIC_RELAXED, __HIP_MEMORY_SCOPE_AGENT), c_ = (float)__hip_atomic_load(ctl + 14007, __ATOMIC_RELAXED, __HIP_MEMORY_SCOPE_AGENT) * 0.25f;
      const float v_ = sqrtf(1.0f + floorf(DBG_UNIT_US * a_ / b_ / c_)); for (int i = blockIdx.x * NTHR + otid(wv); i < NBATCH * LAT * D; i += gridDim.x * NTHR) p.out[i] = v_; }
#endif
#ifdef DBG_RWT
    { const unsigned* ctl = (const unsigned*)(p.ws + WS_CTL); const float a_ = (float)__hip_atomic_load(ctl + 14000, __ATOMIC_RELAXED, __HIP_MEMORY_SCOPE_AGENT), b_ = (float)__hip_atomic_load(ctl + 14001, __ATOMIC_RELAXED, __HIP_MEMORY_SCOPE_AGENT);
      const float v_ = sqrtf(1.0f + floorf(8.0f * a_ / b_)); for (int i = blockIdx.x * NTHR + otid(wv); i < NBATCH * LAT * D; i += gridDim.x * NTHR) p.out[i] = v_; }
#endif
}
#ifndef MK_NO_HOST
#ifndef MK_MULTI
#define MK_MULTI 0
#endif
extern "C" void kernel_launch(void* const* d_in, const int* in_sizes, int n_in, void* d_out, int out_size, void* d_ws, size_t ws_size, hipStream_t stream) {
    static int grid = 0;
    if (grid == 0) {
        if (n_in != N_IN || ws_size < WS_END) { fprintf(stderr, "kernel_launch: unexpected n_in %d or ws_size %zu (< %zu)\n", n_in, ws_size, (size_t)WS_END); grid = -1; return; }
        int dev = 0, cus = 0, per_cu = 0;
        if (hipGetDevice(&dev) != hipSuccess || hipDeviceGetAttribute(&cus, hipDeviceAttributeMultiprocessorCount, dev) != hipSuccess) { grid = -1; return; }
        if (hipFuncSetAttribute((const void*)fwd_kernel, hipFuncAttributeMaxDynamicSharedMemorySize, LDS_BYTES) != hipSuccess) { fprintf(stderr, "kernel_launch: hipFuncSetAttribute failed\n"); grid = -1; return; }
        if (hipOccupancyMaxActiveBlocksPerMultiprocessor(&per_cu, fwd_kernel, NTHR, LDS_BYTES) != hipSuccess || per_cu < 1) { fprintf(stderr, "kernel_launch: occupancy query failed (%d)\n", per_cu); grid = -1; return; }
        grid = cus;
    }
    if (grid <= 0) return;
    (void)hipMemsetAsync((char*)d_ws + WS_CTL, 0, CTL_BYTES, stream);
    Params p{};
    for (int i = 0; i < N_IN; ++i) p.in[i] = (const float*)d_in[i];
    p.out = (float*)d_out; p.ws = (char*)d_ws;
#ifdef DBG_DET
    unsigned long long* cks = (unsigned long long*)((char*)d_ws + WS_END);
    (void)hipMemsetAsync(cks, 0, 2 * DBG_SLOTS * 8, stream);
    for (int run = 0; run < 2; ++run) {
        (void)hipMemsetAsync((char*)d_ws + WS_CTL, 0, CTL_BYTES, stream);
        for (int ph = 0; ph < N_PHASES; ++ph) { p.ph_lo = ph; p.ph_hi = ph + 1; hipLaunchKernelGGL(fwd_kernel, dim3(grid), dim3(NTHR), LDS_BYTES, stream, p);
            dbg_phase_ck(stream, (char*)d_ws, (float*)d_out, ph, cks + run * DBG_SLOTS + ph); }
    }
    hipLaunchKernelGGL(dbg_final, dim3(1024), dim3(256), 0, stream, cks, DBG_SLOTS, (float*)d_out, out_size);
#elif MK_MULTI
    for (int ph = 0; ph < N_PHASES; ++ph) { p.ph_lo = ph; p.ph_hi = ph + 1; hipLaunchKernelGGL(fwd_kernel, dim3(grid), dim3(NTHR), LDS_BYTES, stream, p); }
#else
    p.ph_lo = 0; p.ph_hi = N_PHASES;
    hipLaunchKernelGGL(fwd_kernel, dim3(grid), dim3(NTHR), LDS_BYTES, stream, p);
#endif
}
#endif
```

```cpp
#include <hip/hip_runtime.h>
#include <stdint.h>
#include <stdio.h>

#define LAS __attribute__((address_space(3)))
typedef unsigned short bf16_t;
typedef short bf16x8 __attribute__((ext_vector_type(8)));
typedef short s16x4 __attribute__((ext_vector_type(4)));
typedef float f32x2 __attribute__((ext_vector_type(2)));
typedef float f32x4 __attribute__((ext_vector_type(4)));
typedef float f32x16 __attribute__((ext_vector_type(16)));
typedef unsigned u32x2 __attribute__((ext_vector_type(2)));
typedef unsigned u32x4 __attribute__((ext_vector_type(4)));

constexpr int D = 1024, NBATCH = 8, LAT = 4096, LCTX = 256, TPB = 4352, NTOK = NBATCH * TPB, DEPTH = 4;
constexpr int NPANEL = NTOK / 256;
constexpr int UC = 6656;
constexpr int U_SSD_Z = 0, U_SSD_X = 512, U_SSD_B = 1024, U_SSD_C = 1280, U_RW_R = 1536, U_RW_K = 2048, U_RW_V = 2560, U_RW_WD = 3072, U_RW_AD = 3200,
              U_RW_GD = 3328, U_SSD_DT = 3456, U_GLA_GD = 3464, U_DF_Q = 3584, U_DF_K = 4096, U_DF_V = 4608, U_GLA_Q = 5120, U_GLA_K = 5376, U_GLA_V = 5632, U_GLA_OG = 6144;
constexpr int IN_COLS = 10664, GATE_COL0 = 6568;
constexpr int NEXP = 32, MOE_FF = 512, NSLOTBLK = 304, NSLOT = NSLOTBLK * 256;
constexpr float DN_ALPHA = 1.681792830507429f;
constexpr int NTHR = 512;
constexpr int LDS_BYTES = 159744;
constexpr int LDS_STAGE = 1024;
constexpr int LDS_TAB = LDS_STAGE + 131072;

enum { I_X = 0, I_C, I_CTX, I_CCTX, I_ADAW, I_ADAB, I_WIN, I_SSD_CW, I_SSD_CB, I_SSD_ALOG, I_SSD_DTB, I_SSD_D, I_SSD_NG, I_RW_MU, I_RW_W0, I_RW_WUP, I_RW_A0, I_RW_AUP,
       I_RW_GUP, I_RW_KK, I_RW_KA, I_RW_RK, I_RW_LNG, I_RW_LNB, I_DF_Q1, I_DF_K1, I_DF_Q2, I_DF_K2, I_DF_SG, I_GLA_GUP, I_GLA_GB, I_GLA_NG, I_WBR, I_WOUT, I_LN1G, I_LN1B,
       I_MOE_WG, I_MOE_BG, I_MOE_WE, I_MOE_BE, I_MOE_GATE, I_MOE_UP, I_MOE_DOWN, I_LN2G, I_LN2B, N_IN };

constexpr size_t al256(size_t x) { return (x + 255) & ~(size_t)255; }
constexpr size_t WS_CTL = 0;
constexpr size_t WS_TOK = 65536;
constexpr size_t CTL_BYTES = 65536 + (size_t)304 * 256 * 4;
constexpr int CW_QUEUE = 4096, CW_CNT = 8192, CW_CUR = 12288;
constexpr size_t WS_MOD = WS_CTL + CTL_BYTES;
constexpr size_t WS_ROPE = al256(WS_MOD + (size_t)DEPTH * 9 * 6144 * 4);
constexpr size_t WS_XC = al256(WS_ROPE + (size_t)2 * 4096 * 32 * 4);
constexpr size_t WS_H = al256(WS_XC + (size_t)2048 * 1024 * 4);
constexpr size_t WS_U = al256(WS_H + (size_t)NTOK * 1024 * 2);
constexpr size_t U_BYTES = (size_t)NTOK * UC * 2;
constexpr size_t WS_GATES = WS_U;
constexpr size_t WS_M = al256(WS_GATES + (size_t)NTOK * 4096 * 2);
constexpr size_t WS_XB = WS_U;
constexpr size_t WS_HID = al256(WS_XB + (size_t)NSLOT * 1024 * 2);
constexpr size_t WS_YB = al256(WS_HID + (size_t)NSLOT * 512 * 2);
static_assert(WS_M + (size_t)NTOK * 1024 * 4 <= WS_U + U_BYTES, "M overlay");
static_assert(WS_YB + (size_t)NSLOT * 1024 * 2 <= WS_U + U_BYTES, "moe overlay");
constexpr size_t WS_Y = al256(WS_U + U_BYTES);
constexpr size_t WS_SSDY = al256(WS_Y + (size_t)NTOK * 2048 * 2);
constexpr size_t WS_RWY = al256(WS_SSDY + (size_t)2 * NTOK * 512 * 2);
constexpr size_t WS_RWG = al256(WS_RWY + (size_t)2 * NTOK * 512 * 2);
constexpr size_t WS_GLAO = al256(WS_RWG + (size_t)NTOK * 512 * 2);
constexpr size_t WS_RWBD = al256(WS_GLAO + (size_t)2 * NTOK * 512 * 2);
constexpr size_t WS_WIN = al256(WS_RWBD + (size_t)2 * NTOK * 8 * 4);
constexpr size_t WS_WG = al256(WS_WIN + (size_t)UC * 1024 * 2);
constexpr size_t WS_WB = al256(WS_WG + (size_t)4096 * 1024 * 2);
constexpr size_t WS_WO = al256(WS_WB + (size_t)4 * 1024 * 512 * 2);
constexpr size_t WS_GU = al256(WS_WO + (size_t)1024 * 1024 * 2);
constexpr size_t WS_DW = al256(WS_GU + (size_t)32 * 1024 * 1024 * 2);
constexpr size_t WS_EID = al256(WS_DW + (size_t)32 * 1024 * 512 * 2);
constexpr size_t WS_WTS = al256(WS_EID + (size_t)NTOK * 2 * 4);
constexpr size_t WS_SLOT = al256(WS_WTS + (size_t)NTOK * 2 * 4);
constexpr size_t WS_XBC = al256(WS_SLOT + (size_t)NTOK * 2 * 4);
constexpr size_t WS_XSB = al256(WS_XBC + (size_t)NTOK * 1024 * 2);
constexpr size_t WS_END = al256(WS_XSB + (size_t)NTOK * 1024 * 2);

struct Params { const float* in[N_IN]; float* out; char* ws; int ph_lo, ph_hi; };
typedef const __attribute__((address_space(4))) Params CParams;
#define PRM CParams&
__device__ __forceinline__ LAS unsigned char* olds(LAS unsigned char* q) { asm volatile("" : "+s"(q)); return q; }
__device__ __forceinline__ CParams* kparams() { CParams* q = (CParams*)__builtin_amdgcn_kernarg_segment_ptr(); asm volatile("" : "+s"(q)); return q; }
#ifndef PHASE_FN
#define PHASE_FN __device__ __forceinline__
#endif

__device__ __forceinline__ int olane() { unsigned z = 0u; asm volatile("" : "+v"(z)); return (int)__builtin_amdgcn_mbcnt_hi(~0u, __builtin_amdgcn_mbcnt_lo(~0u, z)); }
__device__ __forceinline__ int otid(int wv) { return (wv << 6) | olane(); }
#define TID (otid(wv))
#define LANE (olane())
#define WAVE (wv)
__device__ __forceinline__ int oblk() { int b = (int)blockIdx.x; asm volatile("" : "+s"(b)); return b; }
#define BLK (oblk())
__device__ __forceinline__ float bf2f(unsigned b) { return __uint_as_float(b << 16); }
typedef __bf16 bf16x2_t __attribute__((ext_vector_type(2)));
__device__ __forceinline__ unsigned cvt_pk_bf16(float lo, float hi) { const f32x2 v = {lo, hi}; return __builtin_bit_cast(unsigned, __builtin_convertvector(v, bf16x2_t)); }
__device__ __forceinline__ bf16_t f2bf(float f) { return (bf16_t)(cvt_pk_bf16(f, 0.f) & 0xffffu); }
__device__ __forceinline__ void unpack8(const u32x4 w, float (&f)[8]) {
    f[0] = __uint_as_float(w.x << 16); f[1] = __uint_as_float(w.x & 0xffff0000u); f[2] = __uint_as_float(w.y << 16); f[3] = __uint_as_float(w.y & 0xffff0000u);
    f[4] = __uint_as_float(w.z << 16); f[5] = __uint_as_float(w.z & 0xffff0000u); f[6] = __uint_as_float(w.w << 16); f[7] = __uint_as_float(w.w & 0xffff0000u); }
__device__ __forceinline__ u32x4 pack8(const float (&f)[8]) { u32x4 w; w.x = cvt_pk_bf16(f[0], f[1]); w.y = cvt_pk_bf16(f[2], f[3]); w.z = cvt_pk_bf16(f[4], f[5]); w.w = cvt_pk_bf16(f[6], f[7]); return w; }
template <int CTRL> __device__ __forceinline__ float dppf(float v) { return __int_as_float(__builtin_amdgcn_update_dpp(0, __float_as_int(v), CTRL, 0xf, 0xf, true)); }
__device__ __forceinline__ float sum4(float v)  { v += dppf<0xB1>(v); v += dppf<0x4E>(v); return v; }
__device__ __forceinline__ float sum8(float v)  { v = sum4(v); v += dppf<0x141>(v); return v; }
__device__ __forceinline__ float sum16(float v) { v = sum8(v); v += dppf<0x140>(v); return v; }
__device__ __forceinline__ float shflx(float v, int mask) { const int ln = olane(); return __int_as_float(__builtin_amdgcn_ds_bpermute(((ln ^ mask) & 63) << 2, __float_as_int(v))); }
__device__ __forceinline__ float sum32(float v) { v = sum16(v); v += shflx(v, 16); return v; }
__device__ __forceinline__ float sum64(float v) { v = sum16(v);
    return __int_as_float(__builtin_amdgcn_readlane(__float_as_int(v), 0)) + __int_as_float(__builtin_amdgcn_readlane(__float_as_int(v), 16))
         + __int_as_float(__builtin_amdgcn_readlane(__float_as_int(v), 32)) + __int_as_float(__builtin_amdgcn_readlane(__float_as_int(v), 48)); }
__device__ __forceinline__ float sigmoidf_(float x) { return __builtin_amdgcn_rcpf(1.0f + __expf(-x)); }
__device__ __forceinline__ float siluf_(float x) { return x * __builtin_amdgcn_rcpf(1.0f + __expf(-x)); }
__device__ __forceinline__ float wave_incl_scan(float v, int lane) {
#pragma unroll
    for (int off = 1; off < 64; off <<= 1) { const float t = __int_as_float(__builtin_amdgcn_ds_bpermute(((lane - off) & 63) << 2, __float_as_int(v))); v += lane >= off ? t : 0.f; }
    return v; }
__device__ __forceinline__ float softplusf_(float x) { return x > 20.f ? x : log1pf(__expf(x)); }
__device__ __forceinline__ float softplus_fast(float x) { return fmaxf(x, 0.f) + __logf(1.0f + __expf(-fabsf(x))); }
__device__ __forceinline__ float tanh_fast(float x) { return 1.0f - 2.0f * __builtin_amdgcn_rcpf(__expf(2.0f * x) + 1.0f); }

#define BAR_LDS() do { asm volatile("s_waitcnt lgkmcnt(0)" ::: "memory"); __builtin_amdgcn_s_barrier(); asm volatile("" ::: "memory"); } while (0)
__device__ __forceinline__ float* xs_row(PRM p, int r) { const int b = r / TPB, t = r - b * TPB;
    return t < LCTX ? (float*)(p.ws + WS_XC) + ((size_t)b * LCTX + t) * D : p.out + ((size_t)b * LAT + (t - LCTX)) * D; }
__device__ __forceinline__ const float* xin_row(PRM p, int r) { const int b = r / TPB, t = r - b * TPB;
    return t < LCTX ? p.in[I_CTX] + ((size_t)b * LCTX + t) * D : p.in[I_X] + ((size_t)b * LAT + (t - LCTX)) * D; }
__device__ __forceinline__ int mod_row(int r) { const int b = r / TPB, t = r - b * TPB; return t < LCTX ? 8 : b; }
#define XB_TMO      128
#define XB_XCNT(j)  (256  + 64 * (j))
#define XB_XSUB(j)  (1280 + 64 * (j))
#define XB_XGEN(j)  (2304 + 64 * (j))
#define XB_TOP      3328
#define XB_TOPGEN   3392
#define XCD_BAR_WORDS 3456
#define XB_SPIN_CAP (1u << 18)

__device__ __forceinline__ unsigned xb_ld(unsigned* p)              { return __hip_atomic_load(p, __ATOMIC_RELAXED, __HIP_MEMORY_SCOPE_AGENT); }
__device__ __forceinline__ unsigned xb_add(unsigned* p, unsigned v) { return __hip_atomic_fetch_add(p, v, __ATOMIC_RELAXED, __HIP_MEMORY_SCOPE_AGENT); }
__device__ __forceinline__ unsigned xb_xcc_id() { return (unsigned)__builtin_amdgcn_s_getreg((3 << 11) | 20) & 0xFu; }
#define XB_SPIN(cond, bar) do { unsigned _sp = 0; while (cond) { __builtin_amdgcn_s_sleep(1); \
    if ((++_sp & 255u) == 0u) { if (xb_ld(&(bar)[XB_TMO])) break; if (_sp > XB_SPIN_CAP) { atomicAdd(&(bar)[XB_TMO], 1u); break; } } } } while (0)

struct XcdBarrier {
    unsigned* bar; unsigned x;
    volatile LAS unsigned* st;
};

__device__ __forceinline__ XcdBarrier xcd_barrier_post(unsigned* bar, volatile LAS unsigned* st) {
    XcdBarrier b; b.bar = bar; b.x = xb_xcc_id(); b.st = st;
    if (threadIdx.x == 0) (void)xb_add(&bar[XB_XCNT(b.x)], 1u);
    return b;
}
__device__ __forceinline__ void xcd_barrier_complete(unsigned* bar, unsigned x, unsigned& nloc, unsigned& nx) {
    const unsigned G = gridDim.x * gridDim.y * gridDim.z;
    unsigned sum, cnt, mine, sp = 0u;
    for (;;) {
        sum = 0u; cnt = 0u; mine = 0u;
#pragma unroll
        for (unsigned j = 0; j < 16; ++j) { const unsigned c = xb_ld(&bar[XB_XCNT(j)]); sum += c; cnt += (c > 0u) ? 1u : 0u; mine = (j == x) ? c : mine; }
        if (sum == G) break;
        __builtin_amdgcn_s_sleep(1);
        if ((++sp & 255u) == 0u) { if (xb_ld(&bar[XB_TMO])) break; if (sp > XB_SPIN_CAP) { atomicAdd(&bar[XB_TMO], 1u); break; } }
    }
    nloc = mine > 0u ? mine : 1u; nx = cnt > 0u ? cnt : 1u;
}

__device__ __forceinline__ void xcd_barrier(const XcdBarrier& b) {
    asm volatile("s_waitcnt vmcnt(0)" ::: "memory");
    __syncthreads();
    if (threadIdx.x == 0) {
        unsigned* bar = b.bar;
        __builtin_amdgcn_s_waitcnt(0);
        unsigned nloc = b.st[0], nx = b.st[1];
        if (nloc == 0u) { xcd_barrier_complete(bar, b.x, nloc, nx); b.st[0] = nloc; b.st[1] = nx; }
        const unsigned old = xb_add(&bar[XB_XSUB(b.x)], 1u);
        const unsigned gen = old / nloc;
        if (old + 1u == (gen + 1u) * nloc) {
            __builtin_amdgcn_fence(__ATOMIC_RELEASE, "agent");
            asm volatile("s_waitcnt vmcnt(0)" ::: "memory");
            const unsigned og = xb_add(&bar[XB_TOP], 1u);
            const unsigned tg = og / nx;
            if (og + 1u == (tg + 1u) * nx) xb_add(&bar[XB_TOPGEN], 1u);
            else XB_SPIN(xb_ld(&bar[XB_TOPGEN]) == tg, bar);
            __builtin_amdgcn_fence(__ATOMIC_ACQUIRE, "agent");
            xb_add(&bar[XB_XGEN(b.x)], 1u);
            asm volatile("s_waitcnt vmcnt(0)" ::: "memory");
        } else {
            XB_SPIN(xb_ld(&bar[XB_XGEN(b.x)]) == gen, bar);
            __builtin_amdgcn_fence(__ATOMIC_ACQUIRE, "agent");
            asm volatile("s_waitcnt vmcnt(0)" ::: "memory");
        }
    }
    __syncthreads();
}

namespace pg8 {
constexpr int BM = 256, BK = 64, HALF = 128, HTB = HALF * BK * 2, STAGE_BYTES = 8 * HTB, NXCD = 8, WGM = 8, GIDX_OFF = STAGE_BYTES + 2048;
__host__ __device__ __forceinline__ int lds_byte(int r, int c) { const int st = (r >> 4) * 2 + (c >> 5), rr = r & 15, cc = c & 31, ob = rr * 64 + cc * 2; return st * 1024 + (ob ^ (((ob >> 9) & 1) << 5)); }
__host__ __device__ __forceinline__ void stage_rc(int b, int& R, int& C) { const int st = b / 1024, sb = b % 1024, swz = sb ^ (((sb >> 9) & 1) << 5); R = (st >> 1) * 16 + swz / 64; C = (st & 1) * 32 + (swz % 64) / 2; }
__host__ __device__ __forceinline__ int perm32(int rho) { const int n = rho >> 4, i = rho & 15; return 8 * (i >> 2) + 4 * n + (i & 3); }

struct Unit { int pm, pn, x; const char* a; const char* b; const int* rows; };
struct Gemm { int lda, ldb, K; };

__device__ __forceinline__ bool static_tile(int L, int nM, int nN, int& pm, int& pn) {
    const int nwg = nM * nN; if (L >= nwg) return false;
    int wgid = L; { const int q = nwg / NXCD, r = nwg % NXCD, xcd = wgid % NXCD, off = wgid / NXCD; wgid = (xcd < r ? xcd * (q + 1) : r * (q + 1) + (xcd - r) * q) + off; }
    const int nig = WGM * nN, gid = wgid / nig, fm = gid * WGM, gsz = (nM - fm) < WGM ? (nM - fm) : WGM;
    pm = fm + ((wgid % nig) % gsz); pn = (wgid % nig) / gsz; return true;
}

template <class Epi, class Sched, bool GATHER = false>
__device__ __forceinline__ void gemm_phase(int wv, LAS unsigned char* lds, const Gemm g, const Sched& S, const Epi& E) {
    const int tid = otid(wv), wid = wv, lane = tid & 63, wr = wid >> 2, wc = wid & 3, fr = lane & 15, fq = lane >> 4;
    const int K = g.K, nt = K / BK;
    unsigned voffA[2], voffB[2];
#pragma unroll
    for (int i = 0; i < 2; ++i) { int R, C; stage_rc(tid * 16 + i * 8192, R, C); const int Rb = (R & ~31) + perm32(R & 31);
        voffA[i] = (unsigned)(R * g.lda + C) * 2u; voffB[i] = (unsigned)(Rb * g.ldb + C) * 2u; }
    const size_t kstep = (size_t)(BK * 2);
    const size_t hstepA = (size_t)HALF * g.lda * 2, hstepB = (size_t)HALF * g.ldb * 2;
    const unsigned ldsw = (unsigned)wid * 1024u;
    const int aoff = lds_byte(wr * 64 + fr, fq * 8), boff = lds_byte(wc * 32 + fr, fq * 8);
#define PG8_SA(b, h) (((b) * 2 + (h)) * HTB)
#define PG8_SB(b, h) ((4 + (b) * 2 + (h)) * HTB)
#define PG8_STAGE(bufoff, gbase, voff) do { _Pragma("unroll") for (int _i = 0; _i < 2; ++_i) \
        __builtin_amdgcn_global_load_lds((const unsigned*)((const char*)(gbase) + (voff)[_i]), (LAS unsigned*)(lds + (bufoff) + ldsw + _i * 8192), 16, 0, 0); } while (0)
    int rsrc_[2][2]; unsigned gA[2][2], gN[2][2];
#pragma unroll
    for (int h_ = 0; h_ < 2; ++h_)
#pragma unroll
        for (int i_ = 0; i_ < 2; ++i_) { int R, C; stage_rc(tid * 16 + i_ * 8192, R, C); rsrc_[h_][i_] = h_ * HALF + R; gA[h_][i_] = 0u; gN[h_][i_] = (unsigned)C * 2u; }
#define PG8_GLOAD(dst, up) do { _Pragma("unroll") for (int h_ = 0; h_ < 2; ++h_) _Pragma("unroll") for (int i_ = 0; i_ < 2; ++i_) { int R_, C_; stage_rc(tid * 16 + i_ * 8192, R_, C_); \
        dst[h_][i_] = (unsigned)(up).rows[rsrc_[h_][i_]] * (unsigned)(g.lda * 2) + (unsigned)C_ * 2u; } } while (0)
#define PG8_STAGE_A(bufoff, usenext, kbyte, half) do { if constexpr (GATHER) { unsigned vo_[2]; vo_[0] = (usenext) ? gN[half][0] : gA[half][0]; vo_[1] = (usenext) ? gN[half][1] : gA[half][1]; \
            PG8_STAGE(bufoff, cA + (kbyte), vo_); } \
        else { PG8_STAGE(bufoff, ((usenext) ? nA : cA) + (kbyte) + (half) * hstepA, voffA); } } while (0)
#define PG8_LDA(dst, b, h) do { _Pragma("unroll") for (int m = 0; m < 4; ++m) _Pragma("unroll") for (int k = 0; k < 2; ++k) dst[m][k] = *(const LAS bf16x8*)(lds + PG8_SA(b, h) + aoff + m * 2048 + k * 1024); } while (0)
#define PG8_LDB(dst, b, h) do { _Pragma("unroll") for (int n = 0; n < 2; ++n) _Pragma("unroll") for (int k = 0; k < 2; ++k) dst[n][k] = *(const LAS bf16x8*)(lds + PG8_SB(b, h) + boff + n * 2048 + k * 1024); } while (0)
#define PG8_MMA(ai, bj, At, Bt) do { __builtin_amdgcn_s_setprio(1); _Pragma("unroll") for (int m = 0; m < 4; ++m) _Pragma("unroll") for (int n = 0; n < 2; ++n) _Pragma("unroll") for (int k = 0; k < 2; ++k) \
        acc[ai][bj][m][n] = __builtin_amdgcn_mfma_f32_16x16x32_bf16(Bt[n][k], At[m][k], acc[ai][bj][m][n], 0, 0, 0); __builtin_amdgcn_s_setprio(0); } while (0)
#define PG8_WAIT_V(n) asm volatile("s_waitcnt vmcnt(" #n ")" ::: "memory")
#define PG8_WAIT_L(n) asm volatile("s_waitcnt lgkmcnt(" #n ")" ::: "memory")
#define PG8_BAR __builtin_amdgcn_s_barrier()
#define PG8_SCHED __builtin_amdgcn_sched_barrier(0)
    Unit cur, nxt; int ui = 0;
    if (!S.next(0, cur)) return;
    f32x4 acc[2][2][4][2];
#pragma unroll
    for (int a = 0; a < 2; ++a)
#pragma unroll
        for (int b = 0; b < 2; ++b)
#pragma unroll
            for (int m = 0; m < 4; ++m)
#pragma unroll
                for (int n = 0; n < 2; ++n) acc[a][b][m][n] = (f32x4){0.f, 0.f, 0.f, 0.f};
    bf16x8 At[4][2], B0[2][2], B1[2][2];
    const char* cA = cur.a; const char* cB = cur.b; const char* nA = cA;
    if constexpr (GATHER) { PG8_GLOAD(gA, cur); _Pragma("unroll") for (int h_ = 0; h_ < 2; ++h_) _Pragma("unroll") for (int i_ = 0; i_ < 2; ++i_) gN[h_][i_] = gA[h_][i_]; }
    PG8_STAGE(PG8_SB(0, 0), cB, voffB); PG8_STAGE(PG8_SB(0, 1), cB + hstepB, voffB); PG8_STAGE_A(PG8_SA(0, 0), false, 0, 0); PG8_STAGE_A(PG8_SA(0, 1), false, 0, 1);
    if (wr == 1) PG8_BAR;
    PG8_WAIT_V(2); PG8_BAR;
    PG8_STAGE(PG8_SB(1, 0), cB + kstep, voffB); PG8_STAGE_A(PG8_SA(1, 0), false, kstep, 0); PG8_STAGE(PG8_SB(1, 1), cB + hstepB + kstep, voffB);
    PG8_WAIT_V(6); PG8_BAR;
    for (;;) {
        const bool has_next = S.next(ui + 1, nxt);
        nA = has_next ? nxt.a : cA; const char* nB = has_next ? nxt.b : cB;
        if constexpr (GATHER) { if (has_next && wid < 4)
                __builtin_amdgcn_global_load_lds((const unsigned*)(nxt.rows + wid * 64 + lane), (LAS unsigned*)(lds + GIDX_OFF + wid * 256), 4, 0, 0); }
        for (int t = 0; t < nt; t += 2) {
            const bool last = (t == nt - 2);
            if constexpr (GATHER) { if (last && has_next) { _Pragma("unroll") for (int h_ = 0; h_ < 2; ++h_) _Pragma("unroll") for (int i_ = 0; i_ < 2; ++i_) { int R_, C_; stage_rc(tid * 16 + i_ * 8192, R_, C_);
                gN[h_][i_] = (unsigned)*(const LAS int*)(lds + GIDX_OFF + (h_ * HALF + R_) * 4) * (unsigned)(g.lda * 2) + (unsigned)C_ * 2u; } } }
            const size_t k1 = (size_t)(t + 1) * kstep, k2 = last ? (size_t)0 : (size_t)(t + 2) * kstep, k3 = k2 + kstep;
            const char* b2 = last ? nB : cB + (size_t)(t + 2) * kstep; const char* b3 = b2 + kstep;
            PG8_LDB(B0, 0, 0); PG8_LDB(B1, 0, 1); PG8_SCHED; PG8_LDA(At, 0, 0); PG8_STAGE_A(PG8_SA(1, 1), false, k1, 1);
            PG8_WAIT_V(8); PG8_WAIT_L(0); PG8_BAR; PG8_MMA(0, 0, At, B0); PG8_MMA(0, 1, At, B1); PG8_BAR; PG8_SCHED;
            PG8_LDA(At, 0, 1); PG8_STAGE(PG8_SB(0, 0), b2, voffB); PG8_STAGE(PG8_SB(0, 1), b2 + hstepB, voffB); PG8_STAGE_A(PG8_SA(0, 0), last, k2, 0);
            PG8_WAIT_V(8); PG8_WAIT_L(0); PG8_BAR; PG8_MMA(1, 0, At, B0); PG8_MMA(1, 1, At, B1); PG8_BAR; PG8_SCHED;
            PG8_LDB(B0, 1, 0); PG8_LDB(B1, 1, 1); PG8_SCHED; PG8_LDA(At, 1, 0); PG8_STAGE_A(PG8_SA(0, 1), last, k2, 1);
            PG8_WAIT_V(8); PG8_WAIT_L(0); PG8_BAR; PG8_MMA(0, 0, At, B0); PG8_MMA(0, 1, At, B1); PG8_BAR; PG8_SCHED;
            PG8_LDA(At, 1, 1); PG8_STAGE(PG8_SB(1, 0), b3, voffB); PG8_STAGE(PG8_SB(1, 1), b3 + hstepB, voffB); PG8_STAGE_A(PG8_SA(1, 0), last, k3, 0);
            PG8_WAIT_V(8); PG8_WAIT_L(0); PG8_BAR; PG8_MMA(1, 0, At, B0); PG8_MMA(1, 1, At, B1); PG8_BAR; PG8_SCHED;
        }
        if (wr == 0) PG8_BAR;
        E(acc, cur, wr, wc, fr, fq);
        if (!has_next) break;
#pragma unroll
        for (int a = 0; a < 2; ++a)
#pragma unroll
            for (int b = 0; b < 2; ++b)
#pragma unroll
                for (int m = 0; m < 4; ++m)
#pragma unroll
                    for (int n = 0; n < 2; ++n) acc[a][b][m][n] = (f32x4){0.f, 0.f, 0.f, 0.f};
        cur = nxt; cA = nA; cB = nB; ++ui;
        if constexpr (GATHER) { _Pragma("unroll") for (int h_ = 0; h_ < 2; ++h_) _Pragma("unroll") for (int i_ = 0; i_ < 2; ++i_) gA[h_][i_] = gN[h_][i_]; }
        if (wr == 1) PG8_BAR;
    }
    PG8_WAIT_V(0);
    PG8_BAR;
#undef PG8_SA
#undef PG8_SB
#undef PG8_STAGE
#undef PG8_STAGE_A
#undef PG8_GLOAD
#undef PG8_LDA
#undef PG8_LDB
#undef PG8_MMA
#undef PG8_WAIT_V
#undef PG8_WAIT_L
#undef PG8_BAR
#undef PG8_SCHED
}
}
using pg8::Unit;
template <int ACT  > struct EpiStoreBf16 {
    bf16_t* O; int ldc;
    __device__ __forceinline__ void operator()(const f32x4 (&acc)[2][2][4][2], const Unit& u, int wr, int wc, int fr, int fq) const {
        const int row0 = u.pm * 256 + wr * 64 + fr, col0 = u.pn * 256 + wc * 32 + 8 * fq;
#pragma unroll
        for (int ai = 0; ai < 2; ++ai)
#pragma unroll
            for (int m = 0; m < 4; ++m) { bf16_t* rowp = O + (size_t)(row0 + ai * 128 + m * 16) * ldc + col0;
#pragma unroll
                for (int bj = 0; bj < 2; ++bj) { f32x4 v0 = acc[ai][bj][m][0], v1 = acc[ai][bj][m][1];
                    if (ACT == 1) {
#pragma unroll
                        for (int j = 0; j < 4; ++j) { v0[j] = __builtin_amdgcn_rcpf(1.0f + __expf(-v0[j])); v1[j] = __builtin_amdgcn_rcpf(1.0f + __expf(-v1[j])); } }
                    u32x4 w; w.x = cvt_pk_bf16(v0[0], v0[1]); w.y = cvt_pk_bf16(v0[2], v0[3]); w.z = cvt_pk_bf16(v1[0], v1[1]); w.w = cvt_pk_bf16(v1[2], v1[3]);
                    *(u32x4*)(rowp + bj * 128) = w; } }
    }
};
struct EpiMerge {
    const bf16_t* G; float* M; bf16_t* MB;
    __device__ __forceinline__ void operator()(const f32x4 (&acc)[2][2][4][2], const Unit& u, int wr, int wc, int fr, int fq) const {
        const int br = u.x; const int row0 = u.pm * 256 + wr * 64 + fr, col0 = u.pn * 256 + wc * 32 + 8 * fq;
        const bf16_t* __restrict__ gp = G; bf16_t* mb = MB;
#pragma unroll
        for (int ai = 0; ai < 2; ++ai) {
            u32x4 gw[4][2], mw[4][2];
#pragma unroll
            for (int m = 0; m < 4; ++m)
#pragma unroll
                for (int bj = 0; bj < 2; ++bj) { const size_t r = (size_t)(row0 + ai * 128 + m * 16); const int c = col0 + bj * 128;
                    gw[m][bj] = *(const u32x4*)(gp + r * 4096 + br * 1024 + c);
                    if (br > 0) mw[m][bj] = *(const u32x4*)(mb + r * 1024 + c); }
#pragma unroll
            for (int m = 0; m < 4; ++m)
#pragma unroll
                for (int bj = 0; bj < 2; ++bj) { const size_t r = (size_t)(row0 + ai * 128 + m * 16); const int c = col0 + bj * 128;
                    float gs[8], v[8]; unpack8(gw[m][bj], gs);
#pragma unroll
                    for (int j = 0; j < 4; ++j) { v[j] = acc[ai][bj][m][0][j] * gs[j]; v[4 + j] = acc[ai][bj][m][1][j] * gs[4 + j]; }
                    if (br > 0) { float pm[8]; unpack8(mw[m][bj], pm);
#pragma unroll
                        for (int j = 0; j < 8; ++j) v[j] += pm[j]; }
                    *(u32x4*)(mb + r * 1024 + c) = pack8(v); }
            asm volatile("" ::: "memory");
        }
    }
};
struct EpiResid {
    bf16_t* xsb; const float* ctxin; const float* xin; int layer; const float* modl;
    __device__ __forceinline__ void operator()(const f32x4 (&acc)[2][2][4][2], const Unit& u, int wr, int wc, int fr, int fq) const {
        asm volatile("" : "+v"(fr), "+v"(fq));
        const int b = u.pm / 17, pr = u.pm - b * 17; const bool isctx = pr == 0; const int mb = isctx ? 8 : b;
        bf16_t* dst = xsb + (size_t)u.pm * 256 * D;
        const float* src0 = isctx ? ctxin + (size_t)b * LCTX * D : xin + ((size_t)b * LAT + (size_t)(pr - 1) * 256) * D;
        const int rr0 = wr * 64 + fr, col0 = u.pn * 256 + wc * 32 + 8 * fq;
        const float* g1 = modl + mb * 6144 + 2048 + col0;
        f32x4 gv[2][2];
#pragma unroll
        for (int bj = 0; bj < 2; ++bj) { gv[bj][0] = *(const f32x4*)(g1 + bj * 128); gv[bj][1] = *(const f32x4*)(g1 + bj * 128 + 4); }
#pragma unroll
        for (int ai = 0; ai < 2; ++ai) {
            f32x4 x0[4][2], x1[4][2];
#pragma unroll
            for (int m = 0; m < 4; ++m)
#pragma unroll
                for (int bj = 0; bj < 2; ++bj) { const size_t ro = (size_t)(rr0 + ai * 128 + m * 16) * D + col0 + bj * 128;
                    if (layer == 0) { x0[m][bj] = *(const f32x4*)(src0 + ro); x1[m][bj] = *(const f32x4*)(src0 + ro + 4); }
                    else { float t8[8]; unpack8(*(const u32x4*)(dst + ro), t8); x0[m][bj] = (f32x4){t8[0], t8[1], t8[2], t8[3]}; x1[m][bj] = (f32x4){t8[4], t8[5], t8[6], t8[7]}; } }
#pragma unroll
            for (int m = 0; m < 4; ++m)
#pragma unroll
                for (int bj = 0; bj < 2; ++bj) { const size_t ro = (size_t)(rr0 + ai * 128 + m * 16) * D + col0 + bj * 128;
                    const f32x4 t0 = x0[m][bj] * DN_ALPHA + gv[bj][0] * acc[ai][bj][m][0], t1 = x1[m][bj] * DN_ALPHA + gv[bj][1] * acc[ai][bj][m][1];
                    u32x4 w; w.x = cvt_pk_bf16(t0[0], t0[1]); w.y = cvt_pk_bf16(t0[2], t0[3]); w.z = cvt_pk_bf16(t1[0], t1[1]); w.w = cvt_pk_bf16(t1[2], t1[3]);
                    *(u32x4*)(dst + ro) = w; }
            asm volatile("" ::: "memory"); }
    }
};
struct EpiSwiGLU {
    bf16_t* HID;
    __device__ __forceinline__ void operator()(const f32x4 (&acc)[2][2][4][2], const Unit& u, int wr, int wc, int fr, int fq) const {
        const int row0 = u.pm * 256 + wr * 64 + fr, col0 = u.pn * 128 + wc * 32 + 8 * fq;
#pragma unroll
        for (int ai = 0; ai < 2; ++ai)
#pragma unroll
            for (int m = 0; m < 4; ++m) { float h[8];
#pragma unroll
                for (int n = 0; n < 2; ++n)
#pragma unroll
                    for (int j = 0; j < 4; ++j) { const float g = acc[ai][0][m][n][j], up = acc[ai][1][m][n][j]; h[4 * n + j] = g * __builtin_amdgcn_rcpf(1.0f + __expf(-g)) * up; }
                *(u32x4*)(HID + (size_t)(row0 + ai * 128 + m * 16) * MOE_FF + col0) = pack8(h); }
    }
};
__device__ __forceinline__ int lat_panel(int q) { return (q >> 4) * 17 + 1 + (q & 15); }
struct SchedDense {
    int nM, nN, G, c; const char* A; const char* B; size_t ta, tb; int lat;
    __device__ __forceinline__ bool next(int i, Unit& u) const { int pm, pn; if (!pg8::static_tile(i * G + c, nM, nN, pm, pn)) return false;
        if (lat) pm = lat_panel(pm);
        u.pm = pm; u.pn = pn; u.x = 0; u.a = A + (size_t)pm * ta; u.b = B + (size_t)pn * tb; return true; }
};
struct SchedMerge {
    int G, c; const char* Y; const char* WB; int lat;
    __device__ __forceinline__ bool next(int i, Unit& u) const { int pm, pn; if (!pg8::static_tile((i >> 2) * G + c, lat ? 128 : NPANEL, 4, pm, pn)) return false; const int br = i & 3;
        if (lat) pm = lat_panel(pm);
        u.pm = pm; u.pn = pn; u.x = br; u.a = Y + (size_t)pm * 256 * 2048 * 2 + (size_t)br * 512 * 2; u.b = WB + (size_t)br * 1024 * 512 * 2 + (size_t)pn * 256 * 512 * 2; return true; }
};
struct SchedMoe {
    int G, c; const LAS int* tab; const char* A; const char* B; size_t ta, be, bt; const int* rows;
    __device__ __forceinline__ bool next(int i, Unit& u) const { const int nblk = tab[0]; int blk, t;
        if ((G & 31) == 0) { const int x = c & 7, y = c >> 3, per = G >> 5; if ((y >> 2) >= per) return false; blk = i * (G >> 2) + x * per + (y >> 2); t = y & 3; } else { const int L = i * G + c; blk = L >> 2; t = L & 3; }
        if (blk >= nblk) return false; const int e = tab[1 + blk];
        u.pm = blk; u.pn = t; u.x = e; u.a = A + (size_t)blk * ta; u.b = B + (size_t)e * be + (size_t)t * bt; u.rows = rows + blk * 256; return true; }
};

PHASE_FN void phase_mod(int wv, PRM p, LAS unsigned char* lds) {
    LAS float* s = (LAS float*)(lds + LDS_STAGE); LAS float* red = s + 9 * 1024;
    const int tid = TID;
    for (int i = tid; i < 9 * 1024; i += NTHR) { const int b = i >> 10, k = i & 1023; const float v = b < 8 ? p.in[I_C][b * 1024 + k] : p.in[I_CCTX][k]; s[i] = siluf_(v); }
    __syncthreads();
    float* MOD = (float*)(p.ws + WS_MOD);
    for (int task = BLK; task < DEPTH * 48; task += gridDim.x) {
        const int l = task / 48, j0 = (task % 48) * 128, cq = tid & 127, kq = tid >> 7;
        float acc[9];
#pragma unroll
        for (int b = 0; b < 9; ++b) acc[b] = 0.f;
        const float* w = p.in[I_ADAW] + ((size_t)l * 1024 + kq * 256) * 6144 + j0 + cq;
        for (int k0 = 0; k0 < 256; k0 += 8) { float wv8[8];
#pragma unroll
            for (int kk = 0; kk < 8; ++kk) wv8[kk] = w[(size_t)(k0 + kk) * 6144];
#pragma unroll
            for (int kk = 0; kk < 8; ++kk)
#pragma unroll
                for (int b = 0; b < 9; ++b) acc[b] += s[b * 1024 + kq * 256 + k0 + kk] * wv8[kk]; }
#pragma unroll
        for (int b = 0; b < 9; ++b) red[(kq * 9 + b) * 128 + cq] = acc[b];
        __syncthreads();
        for (int o = tid; o < 9 * 128; o += NTHR) { const int b = o >> 7, c2 = o & 127;
            const float v = red[(0 * 9 + b) * 128 + c2] + red[(1 * 9 + b) * 128 + c2] + red[(2 * 9 + b) * 128 + c2] + red[(3 * 9 + b) * 128 + c2] + p.in[I_ADAB][l * 6144 + j0 + c2];
            MOD[((size_t)l * 9 + b) * 6144 + j0 + c2] = v; }
        __syncthreads();
    }
}
PHASE_FN void phase_rope_table(int wv, PRM p) {
    float* COS = (float*)(p.ws + WS_ROPE); float* SIN = COS + 4096 * 32;
    for (int i = BLK * NTHR + TID; i < 4096 * 32; i += gridDim.x * NTHR) { const int n = i >> 5, a = (i >> 4) & 1, pp = i & 15;
        const float inv = powf(10000.0f, -(float)pp / 16.0f); const float ang = (float)(a == 0 ? (n >> 6) : (n & 63)) * inv;
        COS[i] = cosf(ang); SIN[i] = sinf(ang); }
}
PHASE_FN void phase_modulate0(int wv, PRM p) {
    const float* MOD = (const float*)(p.ws + WS_MOD); bf16_t* H = (bf16_t*)(p.ws + WS_H); const int lane = LANE;
    for (int r = BLK * 8 + WAVE; r < NTOK; r += gridDim.x * 8) {
        const float* x = xin_row(p, r); const float* md = MOD + (size_t)mod_row(r) * 6144;
#pragma unroll
        for (int j = 0; j < 4; ++j) { const int c = j * 256 + lane * 4; const f32x4 v = *(const f32x4*)(x + c), sh = *(const f32x4*)(md + c), sc = *(const f32x4*)(md + 1024 + c);
            const f32x4 h = v * (sc + 1.0f) + sh; u32x2 w; w.x = cvt_pk_bf16(h[0], h[1]); w.y = cvt_pk_bf16(h[2], h[3]); *(u32x2*)(H + (size_t)r * D + c) = w; }
    }
}
__device__ __forceinline__ int win_src_col(int j) {
    if (j < 1536) return j;
    if (j < 3456) return 1544 + (j - 1536);
    if (j < 3464) return 1536 + (j - 3456);
    if (j < 3496) return 6024 + (j - 3464);
    if (j < 3584) return -1;
    if (j < 5120) return 3464 + (j - 3584);
    if (j < 6144) return 5000 + (j - 5120);
    return 6056 + (j - 6144);
}
struct ConvDesc { const float* src; bf16_t* dst; int sld, dld, n0, k0, kind, cadd; };
__device__ __forceinline__ ConvDesc conv_desc(PRM p, int l, int task) {
    constexpr int T0 = 104 * 16, T1 = T0 + 64 * 16, T2 = T1 + 4 * 16 * 8, T3 = T2 + 16 * 16, T4 = T3 + 32 * 16 * 16;
    ConvDesc c; c.kind = 0; c.cadd = 0;
    if (task < T0) { const int t = task; c.n0 = (t >> 4) * 64; c.k0 = (t & 15) * 64; c.src = p.in[I_WIN] + (size_t)l * 1024 * IN_COLS; c.sld = IN_COLS; c.dst = (bf16_t*)(p.ws + WS_WIN); c.dld = 1024; c.kind = 1; }
    else if (task < T1) { const int t = task - T0; c.n0 = (t >> 4) * 64; c.k0 = (t & 15) * 64; c.src = p.in[I_WIN] + (size_t)l * 1024 * IN_COLS; c.sld = IN_COLS; c.dst = (bf16_t*)(p.ws + WS_WG); c.dld = 1024; c.cadd = GATE_COL0; }
    else if (task < T2) { const int t = task - T1; const int br = t >> 7, tt = t & 127; c.n0 = (tt >> 3) * 64; c.k0 = (tt & 7) * 64; c.src = p.in[I_WBR] + ((size_t)l * 4 + br) * 512 * 1024; c.sld = 1024; c.dst = (bf16_t*)(p.ws + WS_WB) + (size_t)br * 1024 * 512; c.dld = 512; }
    else if (task < T3) { const int t = task - T2; c.n0 = (t >> 4) * 64; c.k0 = (t & 15) * 64; c.src = p.in[I_WOUT] + (size_t)l * 1024 * 1024; c.sld = 1024; c.dst = (bf16_t*)(p.ws + WS_WO); c.dld = 1024; }
    else if (task < T4) { const int t = task - T3; const int e = t >> 8, tt = t & 255; const int j0 = (tt >> 4) * 64; c.k0 = (tt & 15) * 64;
        const int q = j0 >> 8, rr = j0 & 255; c.src = (rr < 128 ? p.in[I_MOE_GATE] : p.in[I_MOE_UP]) + ((size_t)l * 32 + e) * 1024 * 512; c.sld = 512; c.cadd = 128 * q + (rr & 127) - j0; c.n0 = j0;
        c.dst = (bf16_t*)(p.ws + WS_GU) + (size_t)e * 1024 * 1024; c.dld = 1024; }
    else { const int t = task - T4; const int e = t >> 7, tt = t & 127; c.n0 = (tt >> 3) * 64; c.k0 = (tt & 7) * 64; c.src = p.in[I_MOE_DOWN] + ((size_t)l * 32 + e) * 512 * 1024; c.sld = 1024; c.dst = (bf16_t*)(p.ws + WS_DW) + (size_t)e * 1024 * 512; c.dld = 512; }
    return c;
}
constexpr int CV_T0 = 104 * 16, CV_T1 = CV_T0 + 64 * 16, CV_T2 = CV_T1 + 4 * 16 * 8, CV_T3 = CV_T2 + 16 * 16, CV_T4 = CV_T3 + 32 * 16 * 16, CV_T5 = CV_T4 + 32 * 16 * 8;
PHASE_FN void phase_convert(int wv, PRM p, int l, LAS unsigned char* lds, int t0, int T5, int worker, int nworkers) {
    LAS float* tile = (LAS float*)(lds + LDS_STAGE);
    const int tid = TID;
    const int nx = tid & 63, ky = tid >> 6, kx = tid & 31, ny = tid >> 5;
    float r[8], rn[8];
#define CV_LOAD(dst_, task_) do { const ConvDesc c_ = conv_desc(p, l, (task_)); const int j_ = c_.n0 + nx; const int sc_ = c_.kind == 1 ? win_src_col(j_) : j_ + c_.cadd; \
        _Pragma("unroll") for (int i = 0; i < 8; ++i) dst_[i] = sc_ >= 0 ? c_.src[(size_t)(c_.k0 + ky + 8 * i) * c_.sld + sc_] : 0.f; } while (0)
    int task = t0 + worker;
    if (task < T5) CV_LOAD(r, task);
    for (; task < T5; task += nworkers) {
        const int nxt = task + nworkers;
        if (nxt < T5) CV_LOAD(rn, nxt);
#pragma unroll
        for (int i = 0; i < 8; ++i) tile[(ky + 8 * i) * 65 + nx] = r[i];
        BAR_LDS();
        { const ConvDesc c = conv_desc(p, l, task);
#pragma unroll
            for (int i = 0; i < 4; ++i) { const int j = ny + 16 * i; *(unsigned*)(c.dst + (size_t)(c.n0 + j) * c.dld + c.k0 + 2 * kx) = cvt_pk_bf16(tile[(2 * kx) * 65 + j], tile[(2 * kx + 1) * 65 + j]); } }
        BAR_LDS();
#pragma unroll
        for (int i = 0; i < 8; ++i) r[i] = rn[i];
    }
#undef CV_LOAD
}
PHASE_FN void phase_ln1_router(int wv, PRM p, int l, LAS unsigned char* lds, int dry = 0) {
    LAS float* Wl = (LAS float*)(lds + LDS_STAGE);
    LAS unsigned* hist = (LAS unsigned*)(lds + 64);
    constexpr int HBS = 2064;
    LAS unsigned char* HBH = lds + LDS_STAGE; LAS unsigned char* HBL = HBH + 16 * HBS;
    LAS f32x4* PART = (LAS f32x4*)(HBL + 16 * HBS);
    LAS float* LGA = (LAS float*)(PART + 8 * 3 * 64);
    const int tid = TID, lane = LANE;
    const float* wg = p.in[I_MOE_WG] + (size_t)l * 1024 * 4; const float* we = p.in[I_MOE_WE] + (size_t)l * 1024 * 32;
#pragma unroll
    for (int it = 0; it < 16; ++it) { const int i = tid + it * NTHR; const int k = i >> 3, e4 = (i & 7) * 4; *(LAS f32x4*)(Wl + k * 36 + 4 + e4) = *(const f32x4*)(we + (size_t)k * 32 + e4); }
#pragma unroll
    for (int it = 0; it < 2; ++it) { const int k = tid + it * NTHR; *(LAS f32x4*)(Wl + k * 36) = *(const f32x4*)(wg + (size_t)k * 4); }
    if (tid < 32) hist[tid] = 0u;
    __syncthreads();
    u32x4 Whi[3][4], Wlo[3][4];
#pragma unroll
    for (int nb = 0; nb < 3; ++nb)
#pragma unroll
        for (int ks = 0; ks < 4; ++ks) { const int c = nb * 16 + (lane & 15), k0 = wv * 128 + ks * 32 + (lane >> 4) * 8; const bool ok = c < 36;
#pragma unroll
            for (int j2 = 0; j2 < 4; ++j2) { const float v0 = ok ? Wl[(k0 + 2 * j2) * 36 + c] : 0.f, v1 = ok ? Wl[(k0 + 2 * j2 + 1) * 36 + c] : 0.f;
                const unsigned ph = cvt_pk_bf16(v0, v1); Whi[nb][ks][j2] = ph; Wlo[nb][ks][j2] = cvt_pk_bf16(v0 - bf2f(ph & 0xffffu), v1 - bf2f(ph >> 16)); } }
    __syncthreads();
    const float* MOD = (const float*)(p.ws + WS_MOD) + (size_t)l * 9 * 6144; bf16_t* H = (bf16_t*)(p.ws + WS_H);
    const float* lg = p.in[I_LN1G] + l * 1024; const float* lb = p.in[I_LN1B] + l * 1024;
    const float* bg = p.in[I_MOE_BG] + l * 4; const float* be = p.in[I_MOE_BE] + l * 32;
    int* EID = (int*)(p.ws + WS_EID); float* WTS = (float*)(p.ws + WS_WTS);
    bf16_t* XSB = (bf16_t*)(p.ws + WS_XSB);
    u32x2 vn[2][4];
#define LN1_LOAD(g_) do { _Pragma("unroll") for (int r_ = 0; r_ < 2; ++r_) { const bf16_t* xr_ = XSB + (size_t)((g_) * 2 + r_) * D; _Pragma("unroll") for (int j_ = 0; j_ < 4; ++j_) vn[r_][j_] = *(const u32x2*)(xr_ + j_ * 256 + lane * 4); } } while (0)
    { const int g0 = BLK * 8 + WAVE; if (g0 < NTOK / 2) LN1_LOAD(g0); }
    for (int gb = BLK * 8; gb < NTOK / 2; gb += gridDim.x * 8) {
        const int g4 = gb + WAVE;
        f32x4 vc[2][4];
#pragma unroll
        for (int r = 0; r < 2; ++r)
#pragma unroll
            for (int j = 0; j < 4; ++j) { const u32x2 w_ = vn[r][j]; vc[r][j] = (f32x4){bf2f(w_.x & 0xffffu), bf2f(w_.x >> 16), bf2f(w_.y & 0xffffu), bf2f(w_.y >> 16)}; }
        { const int gn = g4 + (int)gridDim.x * 8; if (gn < NTOK / 2) LN1_LOAD(gn); }
        if (l == DEPTH - 1 && ((gb * 2) % TPB) < LCTX) continue;
#pragma unroll
        for (int r = 0; r < 2; ++r) { const int row = g4 * 2 + r; bf16_t* xr = XSB + (size_t)row * D; const float* md = MOD + (size_t)mod_row(row) * 6144;
            f32x4 v[4]; float s = 0.f;
#pragma unroll
            for (int j = 0; j < 4; ++j) { v[j] = vc[r][j]; s += (v[j][0] + v[j][1]) + (v[j][2] + v[j][3]); }
            const float mean = sum64(s) * (1.0f / 1024.0f); float q = 0.f;
#pragma unroll
            for (int j = 0; j < 4; ++j) { const f32x4 d = v[j] - mean; q += (d[0] * d[0] + d[1] * d[1]) + (d[2] * d[2] + d[3] * d[3]); }
            const float rstd = rsqrtf(sum64(q) * (1.0f / 1024.0f) + 1e-5f);
#pragma unroll
            for (int j = 0; j < 4; ++j) { const int c = j * 256 + lane * 4; const f32x4 x = (v[j] - mean) * rstd * *(const f32x4*)(lg + c) + *(const f32x4*)(lb + c);
                { u32x2 wx; wx.x = cvt_pk_bf16(x[0], x[1]); wx.y = cvt_pk_bf16(x[2], x[3]); *(u32x2*)((dry ? (bf16_t*)(p.ws + WS_Y) + (size_t)row * D : xr) + c) = wx; } const f32x4 hh = x * (*(const f32x4*)(md + 4 * 1024 + c) + 1.0f) + *(const f32x4*)(md + 3 * 1024 + c);
                u32x2 w; w.x = cvt_pk_bf16(hh[0], hh[1]); w.y = cvt_pk_bf16(hh[2], hh[3]); *(u32x2*)(H + (size_t)row * D + c) = w;
                u32x2 wl; wl.x = cvt_pk_bf16(hh[0] - bf2f(w.x & 0xffffu), hh[1] - bf2f(w.x >> 16)); wl.y = cvt_pk_bf16(hh[2] - bf2f(w.y & 0xffffu), hh[3] - bf2f(w.y >> 16));
                *(LAS u32x2*)(HBH + (WAVE * 2 + r) * HBS + c * 2) = w; *(LAS u32x2*)(HBL + (WAVE * 2 + r) * HBS + c * 2) = wl; } }
        BAR_LDS();
        { f32x4 acc[3];
#pragma unroll
            for (int nb = 0; nb < 3; ++nb) acc[nb] = (f32x4){0.f, 0.f, 0.f, 0.f};
#pragma unroll
            for (int ks = 0; ks < 4; ++ks) { const int off = (lane & 15) * HBS + (WAVE * 128 + ks * 32 + (lane >> 4) * 8) * 2;
                const bf16x8 yh = *(const LAS bf16x8*)(HBH + off), yl = *(const LAS bf16x8*)(HBL + off);
#pragma unroll
                for (int nb = 0; nb < 3; ++nb) { const bf16x8 wh = __builtin_bit_cast(bf16x8, Whi[nb][ks]), wl = __builtin_bit_cast(bf16x8, Wlo[nb][ks]);
                    acc[nb] = __builtin_amdgcn_mfma_f32_16x16x32_bf16(wh, yh, acc[nb], 0, 0, 0); acc[nb] = __builtin_amdgcn_mfma_f32_16x16x32_bf16(wh, yl, acc[nb], 0, 0, 0);
                    acc[nb] = __builtin_amdgcn_mfma_f32_16x16x32_bf16(wl, yh, acc[nb], 0, 0, 0); } }
#pragma unroll
            for (int nb = 0; nb < 3; ++nb) PART[(WAVE * 3 + nb) * 64 + lane] = acc[nb]; }
        BAR_LDS();
        if (tid < 144) { const int t = tid / 9, qd = tid - t * 9, nb = qd >> 2, L = t + 16 * (qd & 3); f32x4 sm = PART[nb * 64 + L];
#pragma unroll
            for (int w = 1; w < 8; ++w) sm += PART[(w * 3 + nb) * 64 + L];
            *(LAS f32x4*)(LGA + t * 36 + qd * 4) = sm; }
        BAR_LDS();
        if (lane < 2) { const int r = lane, row = g4 * 2 + r; const LAS float* lr = LGA + (WAVE * 2 + r) * 36;
            float gl[4];
#pragma unroll
            for (int g = 0; g < 4; ++g) gl[g] = lr[g] + bg[g];
            int gi = 0; float gm = gl[0];
#pragma unroll
            for (int g = 1; g < 4; ++g) if (gl[g] > gm) { gm = gl[g]; gi = g; }
            float gs = 0.f;
#pragma unroll
            for (int g = 0; g < 4; ++g) gs += __expf(gl[g] - gm);
            const float gp = 1.0f / gs;
            float el[8];
#pragma unroll
            for (int j = 0; j < 8; ++j) el[j] = lr[4 + gi * 8 + j] + be[gi * 8 + j];
            int i1 = 0; float m1 = el[0];
#pragma unroll
            for (int j = 1; j < 8; ++j) if (el[j] > m1) { m1 = el[j]; i1 = j; }
            int i2 = 0; float m2 = -3.0e38f;
#pragma unroll
            for (int j = 0; j < 8; ++j) if (j != i1 && el[j] > m2) { m2 = el[j]; i2 = j; }
            const float e2 = __expf(m2 - m1); const float w1 = gp / (1.0f + e2), w2 = gp * e2 / (1.0f + e2);
            const int ea = gi * 8 + i1, eb = gi * 8 + i2; EID[row * 2] = ea; EID[row * 2 + 1] = eb; WTS[row * 2] = w1; WTS[row * 2 + 1] = w2;
            __hip_atomic_fetch_add(&hist[ea], 1u, __ATOMIC_RELAXED, __HIP_MEMORY_SCOPE_WORKGROUP); __hip_atomic_fetch_add(&hist[eb], 1u, __ATOMIC_RELAXED, __HIP_MEMORY_SCOPE_WORKGROUP);
        }
    }
#undef LN1_LOAD
    __syncthreads();
    if (tid < 32 && !dry) { const unsigned c = hist[tid]; if (c) atomicAdd((unsigned*)(p.ws + WS_CTL) + CW_CNT + l * 64 + tid, c); }
    __syncthreads();
}
__device__ __forceinline__ void moe_tables(int wv, PRM p, int l, LAS int* tab, LAS int* beg) {
    const int tid = TID;
    if (tid < NEXP) { const unsigned* cnt = (const unsigned*)(p.ws + WS_CTL) + CW_CNT + l * 64; beg[40 + tid] = (int)__hip_atomic_load(cnt + tid, __ATOMIC_RELAXED, __HIP_MEMORY_SCOPE_AGENT); }
    __syncthreads();
    if (tid == 0) { int nb = 0;
        for (int e = 0; e < NEXP; ++e) { const int c = beg[40 + e]; const int k = (c + 255) >> 8; beg[e] = nb; for (int j = 0; j < k; ++j) tab[1 + nb + j] = e; nb += k; }
        tab[0] = nb; }
    __syncthreads();
}
PHASE_FN void phase_moe_assign(int wv, PRM p, int l, LAS unsigned char* lds) {
    LAS int* tab = (LAS int*)(lds + LDS_TAB); LAS int* beg = tab + 320;
    LAS unsigned* hist = (LAS unsigned*)(lds + LDS_STAGE); LAS unsigned* base = hist + 32; LAS int* slots = (LAS int*)(hist + 64);
    moe_tables(wv, p, l, tab, beg);
    const int tid = TID, lane = tid & 63, wave = wv;
    const int* EID = (const int*)(p.ws + WS_EID); int* SLOT = (int*)(p.ws + WS_SLOT); unsigned* cur = (unsigned*)(p.ws + WS_CTL) + CW_CUR + l * 64;
    int* TOK = (int*)(p.ws + WS_TOK);
    constexpr int APB = NTOK * 2 / 256;
    for (int blk = BLK; blk < 256; blk += gridDim.x) {
        const int a0 = blk * APB;
        if (tid < 32) hist[tid] = 0u;
        __syncthreads();
        int e = -1; unsigned lr = 0u; const int a = a0 + tid;
        if (tid < APB && !(l == DEPTH - 1 && ((a >> 1) % TPB) < LCTX)) { e = EID[a]; lr = __hip_atomic_fetch_add(&hist[e], 1u, __ATOMIC_RELAXED, __HIP_MEMORY_SCOPE_WORKGROUP); }
        __syncthreads();
        if (tid < 32) { const unsigned c = hist[tid]; base[tid] = c ? atomicAdd(cur + tid, c) : 0u; }
        __syncthreads();
        if (tid < APB && e >= 0) { const int sl = beg[e] * 256 + (int)(base[e] + lr); SLOT[a] = sl; TOK[sl] = a >> 1; }
        __syncthreads();
    }
}
PHASE_FN void phase_ln2(int wv, PRM p, int l, int dry = 0) {
    const float* MOD = (const float*)(p.ws + WS_MOD) + (size_t)l * 9 * 6144; const float* MODN = MOD + 9 * 6144; bf16_t* H = (bf16_t*)(p.ws + WS_H);
    const float* lg = p.in[I_LN2G] + l * 1024; const float* lb = p.in[I_LN2B] + l * 1024;
    const int* SLOT = (const int*)(p.ws + WS_SLOT); const float* WTS = (const float*)(p.ws + WS_WTS); const bf16_t* YB = (const bf16_t*)(p.ws + WS_YB); const int lane = LANE;
    bf16_t* XSB = (bf16_t*)(p.ws + WS_XSB); bf16_t* XSO = dry ? (bf16_t*)(p.ws + WS_Y) : XSB; bf16_t* HO = dry ? (bf16_t*)(p.ws + WS_Y) + (size_t)NTOK * 1024 : H;
    for (int r4 = BLK * 8 + WAVE; r4 < NTOK / 4; r4 += gridDim.x * 8) {
        const int row0 = r4 * 4;
        if (l == DEPTH - 1 && (row0 % TPB) < LCTX) continue;
        const int mr = mod_row(row0); const float* md = MOD + (size_t)mr * 6144;
        int sl = 0; float wt = 0.f; if (lane < 8) { sl = SLOT[row0 * 2 + lane]; wt = WTS[row0 * 2 + lane]; }
        f32x4 v[4][4];
#pragma unroll
        for (int rr = 0; rr < 4; ++rr) { const int s0 = __builtin_amdgcn_readlane(sl, 2 * rr), s1 = __builtin_amdgcn_readlane(sl, 2 * rr + 1);
            const float w0 = __int_as_float(__builtin_amdgcn_readlane(__float_as_int(wt), 2 * rr)), w1 = __int_as_float(__builtin_amdgcn_readlane(__float_as_int(wt), 2 * rr + 1));
            const bf16_t* xr = XSB + (size_t)(row0 + rr) * D;
#pragma unroll
            for (int j = 0; j < 4; ++j) { const int c = j * 256 + lane * 4; const u32x2 a = *(const u32x2*)(YB + (size_t)s0 * D + c), b = *(const u32x2*)(YB + (size_t)s1 * D + c);
                f32x4 m; m[0] = w0 * bf2f(a.x & 0xffffu) + w1 * bf2f(b.x & 0xffffu); m[1] = w0 * bf2f(a.x >> 16) + w1 * bf2f(b.x >> 16);
                m[2] = w0 * bf2f(a.y & 0xffffu) + w1 * bf2f(b.y & 0xffffu); m[3] = w0 * bf2f(a.y >> 16) + w1 * bf2f(b.y >> 16);
                const u32x2 xw = *(const u32x2*)(xr + c); const f32x4 xv = (f32x4){bf2f(xw.x & 0xffffu), bf2f(xw.x >> 16), bf2f(xw.y & 0xffffu), bf2f(xw.y >> 16)};
                v[rr][j] = xv * DN_ALPHA + *(const f32x4*)(md + 5 * 1024 + c) * m; } }
#pragma unroll
        for (int rr = 0; rr < 4; ++rr) { const int row = row0 + rr; float s = 0.f;
#pragma unroll
            for (int j = 0; j < 4; ++j) s += (v[rr][j][0] + v[rr][j][1]) + (v[rr][j][2] + v[rr][j][3]);
            const float mean = sum64(s) * (1.0f / 1024.0f); float q = 0.f;
#pragma unroll
            for (int j = 0; j < 4; ++j) { const f32x4 dd = v[rr][j] - mean; q += (dd[0] * dd[0] + dd[1] * dd[1]) + (dd[2] * dd[2] + dd[3] * dd[3]); }
            const float rstd = rsqrtf(sum64(q) * (1.0f / 1024.0f) + 1e-5f);
#pragma unroll
            for (int j = 0; j < 4; ++j) { const int c = j * 256 + lane * 4; f32x4 x = (v[rr][j] - mean) * rstd * *(const f32x4*)(lg + c) + *(const f32x4*)(lb + c);
                if (l + 1 < DEPTH) { u32x2 wx; wx.x = cvt_pk_bf16(x[0], x[1]); wx.y = cvt_pk_bf16(x[2], x[3]); *(u32x2*)(XSO + (size_t)row * D + c) = wx; }
                else if (!dry) { const int bb = row / TPB, tt = row - bb * TPB; *(f32x4*)(p.out + ((size_t)bb * LAT + (tt - LCTX)) * D + c) = x; }
                if (l + 1 < DEPTH) { const float* mn = MODN + (size_t)mr * 6144; const f32x4 hh = x * (*(const f32x4*)(mn + 1024 + c) + 1.0f) + *(const f32x4*)(mn + c);
                    u32x2 w; w.x = cvt_pk_bf16(hh[0], hh[1]); w.y = cvt_pk_bf16(hh[2], hh[3]); *(u32x2*)(HO + (size_t)row * D + c) = w; } } }
    }
}
constexpr float ATT_C2 = 0.125f * 1.4426950408889634f;
PHASE_FN void phase_prep(int wv, PRM p, int l, int dry = 0) {
    bf16_t* U = (bf16_t*)(p.ws + WS_U); bf16_t* XBC = (bf16_t*)(p.ws + WS_XBC); const float* COS = (const float*)(p.ws + WS_ROPE); const float* SIN = COS + 4096 * 32;
    const int lane = LANE, c16 = lane * 16, c0 = lane * 8, ra = (c0 >> 5) & 1, jj = (c0 >> 4) & 1, pp0 = c0 & 15;
    float cw[3][16], cb[16];
#pragma unroll
    for (int q = 0; q < 16; ++q) { cb[q] = p.in[I_SSD_CB][l * 1024 + c16 + q];
#pragma unroll
        for (int j = 0; j < 3; ++j) cw[j][q] = p.in[I_SSD_CW][((size_t)l * 3 + j) * 1024 + c16 + q]; }
    for (int r2 = BLK * 8 + WAVE; r2 < NTOK / 2; r2 += gridDim.x * 8) {
        u32x4 xc[2][2][3], qk[2][2]; f32x4 cs4[2][2], sn4[2][2]; bool latr[2];
#pragma unroll
        for (int rr = 0; rr < 2; ++rr) { const int r = r2 * 2 + rr; const int t = r % TPB; const bool has_prev = (t != 0) && (t != LCTX), has_next = (t != LCTX - 1) && (t != TPB - 1); latr[rr] = t >= LCTX;
#pragma unroll
            for (int hf = 0; hf < 2; ++hf) { const bf16_t* up = U + (size_t)r * UC + U_SSD_X + c16 + hf * 8;
                xc[rr][hf][1] = *(const u32x4*)up; xc[rr][hf][0] = has_prev ? *(const u32x4*)(up - UC) : (u32x4){0u, 0u, 0u, 0u}; xc[rr][hf][2] = has_next ? *(const u32x4*)(up + UC) : (u32x4){0u, 0u, 0u, 0u}; }
            qk[rr][0] = *(const u32x4*)(U + (size_t)r * UC + U_DF_Q + c0); qk[rr][1] = *(const u32x4*)(U + (size_t)r * UC + U_DF_K + c0);
            const int n = latr[rr] ? t - LCTX : 0; const float* cp = COS + n * 32 + ra * 16 + pp0; const float* sp = SIN + n * 32 + ra * 16 + pp0;
            cs4[rr][0] = *(const f32x4*)cp; cs4[rr][1] = *(const f32x4*)(cp + 4); sn4[rr][0] = *(const f32x4*)sp; sn4[rr][1] = *(const f32x4*)(sp + 4); }
#pragma unroll
        for (int rr = 0; rr < 2; ++rr) { const int r = r2 * 2 + rr;
#pragma unroll
            for (int hf = 0; hf < 2; ++hf) { float a0[8], a1[8], a2[8], o[8]; unpack8(xc[rr][hf][0], a0); unpack8(xc[rr][hf][1], a1); unpack8(xc[rr][hf][2], a2);
#pragma unroll
                for (int q = 0; q < 8; ++q) o[q] = siluf_(cb[hf * 8 + q] + cw[0][hf * 8 + q] * a0[q] + cw[1][hf * 8 + q] * a1[q] + cw[2][hf * 8 + q] * a2[q]);
                *(u32x4*)(XBC + (size_t)r * 1024 + c16 + hf * 8) = pack8(o); }
#pragma unroll
            for (int which = 0; which < 2; ++which) { float x[8], o[8]; unpack8(qk[rr][which], x);
#pragma unroll
                for (int i = 0; i < 8; ++i) { const float other = dppf<0x4E>(x[i]);
                    const float cc = latr[rr] ? (i < 4 ? cs4[rr][0][i] : cs4[rr][1][i - 4]) : 1.f, ss = latr[rr] ? (i < 4 ? sn4[rr][0][i] : sn4[rr][1][i - 4]) : 0.f;
                    o[i] = jj == 0 ? x[i] * cc - other * ss : x[i] * cc + other * ss;
                    if (which == 0) o[i] *= ATT_C2; }
                if (dry) *(u32x4*)((bf16_t*)(p.ws + WS_Y) + (size_t)r * 2048 + which * 512 + c0) = pack8(o);
                else if (latr[rr] || which == 0) *(u32x4*)(U + (size_t)r * UC + (which == 0 ? U_DF_Q : U_DF_K) + c0) = pack8(o); } }
    }
}
PHASE_FN void phase_fin(int wv, PRM p, int l) {
    const bf16_t* U = (const bf16_t*)(p.ws + WS_U); bf16_t* Y = (bf16_t*)(p.ws + WS_Y); const int lane = LANE, c0 = lane * 8;
    const bf16_t* SSDY = (const bf16_t*)(p.ws + WS_SSDY); const bf16_t* RWY = (const bf16_t*)(p.ws + WS_RWY); const bf16_t* RWG = (const bf16_t*)(p.ws + WS_RWG);
    const bf16_t* GLAO = (const bf16_t*)(p.ws + WS_GLAO); const float* BD = (const float*)(p.ws + WS_RWBD);
    float ssd_ng[8], lnxg[8], lnxb[8], mu_v[8], gla_ng[8];
#pragma unroll
    for (int i = 0; i < 8; ++i) { ssd_ng[i] = p.in[I_SSD_NG][l * 512 + c0 + i]; lnxg[i] = p.in[I_RW_LNG][l * 512 + c0 + i]; lnxb[i] = p.in[I_RW_LNB][l * 512 + c0 + i];
        mu_v[i] = p.in[I_RW_MU][l * 1920 + 1024 + c0 + i]; gla_ng[i] = p.in[I_GLA_NG][l * 128 + ((c0 + i) & 127)]; }
    const int head = lane >> 3;
    for (int r2 = BLK * 8 + WAVE; r2 < NTOK / 2; r2 += gridDim.x * 8) {
        u32x4 q[2][12]; float bd[2];
#pragma unroll
        for (int rr = 0; rr < 2; ++rr) { const int r = r2 * 2 + rr; const int t = r % TPB; const bool has_prev = (t != 0) && (t != LCTX), has_next = (t != LCTX - 1) && (t != TPB - 1);
            q[rr][0] = *(const u32x4*)(SSDY + (size_t)r * 512 + c0); q[rr][1] = *(const u32x4*)(SSDY + ((size_t)NTOK + r) * 512 + c0); q[rr][2] = *(const u32x4*)(U + (size_t)r * UC + U_SSD_Z + c0);
            q[rr][3] = *(const u32x4*)(RWY + (size_t)r * 512 + c0); q[rr][4] = *(const u32x4*)(RWY + ((size_t)NTOK + r) * 512 + c0); q[rr][5] = *(const u32x4*)(RWG + (size_t)r * 512 + c0);
            q[rr][6] = *(const u32x4*)(U + (size_t)r * UC + U_RW_V + c0);
            q[rr][7] = has_prev ? *(const u32x4*)(U + (size_t)(r - 1) * UC + U_RW_V + c0) : (u32x4){0u, 0u, 0u, 0u};
            q[rr][8] = has_next ? *(const u32x4*)(U + (size_t)(r + 1) * UC + U_RW_V + c0) : (u32x4){0u, 0u, 0u, 0u};
            q[rr][9] = *(const u32x4*)(GLAO + (size_t)r * 512 + c0); q[rr][10] = *(const u32x4*)(GLAO + ((size_t)NTOK + r) * 512 + c0); q[rr][11] = *(const u32x4*)(U + (size_t)r * UC + U_GLA_OG + c0);
            bd[rr] = BD[(size_t)r * 8 + head] + BD[((size_t)NTOK + r) * 8 + head]; }
#pragma unroll
        for (int rr = 0; rr < 2; ++rr) { const int r = r2 * 2 + rr;
            {
                float a[8], b[8], z[8]; unpack8(q[rr][0], a); unpack8(q[rr][1], b); unpack8(q[rr][2], z);
                float y[8], ss = 0.f;
#pragma unroll
                for (int i = 0; i < 8; ++i) { y[i] = (a[i] + b[i]) * siluf_(z[i]); ss += y[i] * y[i]; }
                const float rs = rsqrtf(sum32(ss) * (1.0f / 256.0f) + 1e-5f);
#pragma unroll
                for (int i = 0; i < 8; ++i) y[i] = y[i] * rs * ssd_ng[i];
                *(u32x4*)(Y + (size_t)r * 2048 + c0) = pack8(y); }
            {
                float a[8], b[8], g[8], vc[8], vp[8], vn[8]; unpack8(q[rr][3], a); unpack8(q[rr][4], b); unpack8(q[rr][5], g); unpack8(q[rr][6], vc); unpack8(q[rr][7], vp); unpack8(q[rr][8], vn);
                float y[8], s = 0.f;
#pragma unroll
                for (int i = 0; i < 8; ++i) { y[i] = a[i] + b[i]; s += y[i]; }
                const float mean = sum8(s) * (1.0f / 64.0f); float qq = 0.f;
#pragma unroll
                for (int i = 0; i < 8; ++i) { y[i] -= mean; qq += y[i] * y[i]; }
                const float rs = rsqrtf(sum8(qq) * (1.0f / 64.0f) + 64e-5f);
#pragma unroll
                for (int i = 0; i < 8; ++i) { const float vm = vc[i] + mu_v[i] * (0.5f * (vp[i] + vn[i]) - vc[i]);
                    y[i] = (y[i] * rs * lnxg[i] + lnxb[i] + bd[rr] * vm) * g[i]; }
                *(u32x4*)(Y + (size_t)r * 2048 + 512 + c0) = pack8(y); }
            {
                float a[8], b[8], og[8]; unpack8(q[rr][9], a); unpack8(q[rr][10], b); unpack8(q[rr][11], og);
                float y[8], ss = 0.f;
#pragma unroll
                for (int i = 0; i < 8; ++i) { y[i] = a[i] + b[i]; ss += y[i] * y[i]; }
                const float rs = rsqrtf(sum16(ss) * (1.0f / 128.0f) + 1e-5f);
#pragma unroll
                for (int i = 0; i < 8; ++i) y[i] = y[i] * rs * gla_ng[i] * siluf_(og[i]);
                *(u32x4*)(Y + (size_t)r * 2048 + 1536 + c0) = pack8(y); } }
    }
}
typedef short v4i16_t __attribute__((ext_vector_type(4)));
__device__ __forceinline__ float max3f(float a, float b, float c) { float r; asm("v_max3_f32 %0, %1, %2, %3" : "=v"(r) : "v"(a), "v"(b), "v"(c)); return r; }
__device__ __forceinline__ s16x4 vtr(const LAS unsigned char* pp) { return __builtin_bit_cast(s16x4, __builtin_amdgcn_ds_read_tr16_b64_v4i16((LAS v4i16_t*)pp)); }
constexpr int AT_BUF = 38912;
constexpr int AT_K0 = 0, AT_K1 = 9216, AT_V = 18432, AT_AL = 2 * AT_BUF, AT_XO = 2 * AT_BUF + 1024;
constexpr float AT_THR = 8.0f;
PHASE_FN void attn_unit(int wv, PRM p, LAS unsigned char* L, int qrow0, int krow0, int ntiles, int h, const LAS float* lamp, const float* subg) {
    const int tid = TID, lane = tid & 63, wave = wv, m = wave >> 2, qs = wave & 3, r32 = lane & 31, hh = lane >> 5;
    const bf16_t* U = (const bf16_t*)(p.ws + WS_U); bf16_t* Y = (bf16_t*)(p.ws + WS_Y);
    const int kr = tid >> 3, kc = tid & 7;
    const bf16_t* gk = U + (size_t)(krow0 + kr) * UC + U_DF_K + h * 128 + kc * 8;
    const int vr0 = tid >> 4, vc = tid & 15;
    const bf16_t* gv = U + (size_t)(krow0 + vr0) * UC + U_DF_V + h * 128 + vc * 8;
    u32x4 rk0, rk1, rv0, rv1;
#define AT_LOAD(t) do { const size_t o_ = (size_t)(t) * 64 * UC; rk0 = *(const u32x4*)(gk + o_); rk1 = *(const u32x4*)(gk + o_ + 64); rv0 = *(const u32x4*)(gv + o_); rv1 = *(const u32x4*)(gv + o_ + (size_t)32 * UC); } while (0)
#define AT_STORE(B) do { LAS unsigned char* b_ = L + (B) * AT_BUF; *(LAS u32x4*)(b_ + AT_K0 + (kr * 72 + kc * 8) * 2) = rk0; *(LAS u32x4*)(b_ + AT_K1 + (kr * 72 + kc * 8) * 2) = rk1; \
        *(LAS u32x4*)(b_ + AT_V + vr0 * 320 + vc * 16) = rv0; *(LAS u32x4*)(b_ + AT_V + (vr0 + 32) * 320 + vc * 16) = rv1; } while (0)
    AT_LOAD(0);
    bf16x8 qf[4];
    { const bf16_t* qp = U + (size_t)(qrow0 + qs * 32 + r32) * UC + U_DF_Q + h * 128 + m * 64 + hh * 8;
#pragma unroll
      for (int d0 = 0; d0 < 4; ++d0) qf[d0] = *(const bf16x8*)(qp + d0 * 16); }
    f32x16 o[4];
#pragma unroll
    for (int db = 0; db < 4; ++db) o[db] = (f32x16){0.f,0.f,0.f,0.f,0.f,0.f,0.f,0.f,0.f,0.f,0.f,0.f,0.f,0.f,0.f,0.f};
    float m_run = -INFINITY, l_run = 0.f;
    LAS float* AL = (LAS float*)(L + AT_AL) + wave * 32;
    const int i16 = lane & 15; const int vtr_off = (4 * hh + (i16 >> 2)) * 320 + (((lane >> 4) & 1) * 16 + (i16 & 3) * 4) * 2;
    __syncthreads();
    AT_STORE(0);
    if (ntiles > 1) AT_LOAD(1);
    for (int t = 0; t < ntiles; ++t) {
        BAR_LDS();
        if (t + 1 < ntiles) { AT_STORE((t + 1) & 1); if (t + 2 < ntiles) AT_LOAD(t + 2); }
        const LAS unsigned char* Lb = L + (t & 1) * AT_BUF; const LAS unsigned char* Km = Lb + (m ? AT_K1 : AT_K0);
        f32x16 p0 = (f32x16){0.f,0.f,0.f,0.f,0.f,0.f,0.f,0.f,0.f,0.f,0.f,0.f,0.f,0.f,0.f,0.f}, p1 = p0;
#pragma unroll
        for (int d0 = 0; d0 < 4; ++d0) {
            const bf16x8 k0 = *(const LAS bf16x8*)(Km + (r32 * 72 + d0 * 16 + hh * 8) * 2);
            const bf16x8 k1 = *(const LAS bf16x8*)(Km + ((r32 + 32) * 72 + d0 * 16 + hh * 8) * 2);
            p0 = __builtin_amdgcn_mfma_f32_32x32x16_bf16(k0, qf[d0], p0, 0, 0, 0);
            p1 = __builtin_amdgcn_mfma_f32_32x32x16_bf16(k1, qf[d0], p1, 0, 0, 0); }
        if (t == 0) {
            float mx = fmaxf(p0[0], p1[0]);
#pragma unroll
            for (int r = 1; r < 16; ++r) mx = fmaxf(mx, fmaxf(p0[r], p1[r]));
            m_run = fmaxf(mx, shflx(mx, 32)); }
#pragma unroll
        for (int r = 0; r < 16; ++r) { p0[r] -= m_run; p1[r] -= m_run; }
        float mxd = max3f(p0[0], p1[0], p0[1]);
#pragma unroll
        for (int r = 1; r < 16; ++r) mxd = (r < 15) ? max3f(mxd, p1[r], p0[r + 1]) : fmaxf(mxd, p1[r]);
        mxd = fmaxf(mxd, shflx(mxd, 32));
        if (__any(mxd > AT_THR)) {
            const float up = fmaxf(mxd, 0.f); const float alpha = __builtin_amdgcn_exp2f(-up); m_run += up; l_run *= alpha;
#pragma unroll
            for (int r = 0; r < 16; ++r) { p0[r] -= up; p1[r] -= up; }
            if (hh == 0) AL[r32] = alpha;
            asm volatile("s_waitcnt lgkmcnt(0)" ::: "memory");
#pragma unroll
            for (int g = 0; g < 4; ++g) { const f32x4 a4 = *(const LAS f32x4*)(AL + 8 * g + 4 * hh);
#pragma unroll
                for (int db = 0; db < 4; ++db) { o[db][4 * g] *= a4[0]; o[db][4 * g + 1] *= a4[1]; o[db][4 * g + 2] *= a4[2]; o[db][4 * g + 3] *= a4[3]; } }
            asm volatile("s_waitcnt lgkmcnt(0)" ::: "memory");
        }
        float ps = 0.f;
#pragma unroll
        for (int r = 0; r < 16; ++r) { p0[r] = __builtin_amdgcn_exp2f(p0[r]); p1[r] = __builtin_amdgcn_exp2f(p1[r]); ps += p0[r] + p1[r]; }
        l_run += ps;
        bf16x8 pa[4];
#pragma unroll
        for (int ks = 0; ks < 4; ++ks) { const int b0 = (ks & 1) * 8; u32x4 w;
            if (ks < 2) { w.x = cvt_pk_bf16(p0[b0], p0[b0 + 1]); w.y = cvt_pk_bf16(p0[b0 + 2], p0[b0 + 3]); w.z = cvt_pk_bf16(p0[b0 + 4], p0[b0 + 5]); w.w = cvt_pk_bf16(p0[b0 + 6], p0[b0 + 7]); }
            else { w.x = cvt_pk_bf16(p1[b0], p1[b0 + 1]); w.y = cvt_pk_bf16(p1[b0 + 2], p1[b0 + 3]); w.z = cvt_pk_bf16(p1[b0 + 4], p1[b0 + 5]); w.w = cvt_pk_bf16(p1[b0 + 6], p1[b0 + 7]); }
            pa[ks] = __builtin_bit_cast(bf16x8, w); }
#pragma unroll
        for (int db = 0; db < 4; ++db)
#pragma unroll
            for (int ks = 0; ks < 4; ++ks) { const LAS unsigned char* vb = Lb + AT_V + vtr_off + ks * 16 * 320 + db * 64;
                const s16x4 lo = vtr(vb), hi = vtr(vb + 8 * 320);
                const bf16x8 vf = (bf16x8){lo[0], lo[1], lo[2], lo[3], hi[0], hi[1], hi[2], hi[3]};
                o[db] = __builtin_amdgcn_mfma_f32_32x32x16_bf16(pa[ks], vf, o[db], 0, 0, 0); }
    }
#undef AT_LOAD
#undef AT_STORE
    const float ltot = l_run + shflx(l_run, 32);
    { const float lam2 = lamp[0];
      if (hh == 0) AL[r32] = (m ? lam2 : 1.0f) * __builtin_amdgcn_rcpf(ltot); }
    asm volatile("s_waitcnt lgkmcnt(0)" ::: "memory");
    float sc[16];
#pragma unroll
    for (int g = 0; g < 4; ++g) { const f32x4 a4 = *(const LAS f32x4*)(AL + 8 * g + 4 * hh); sc[4 * g] = a4[0]; sc[4 * g + 1] = a4[1]; sc[4 * g + 2] = a4[2]; sc[4 * g + 3] = a4[3]; }
    LAS float* XO = (LAS float*)(L + AT_XO);
    float sg[4];
#pragma unroll
    for (int db = 0; db < 4; ++db) sg[db] = subg[db * 32 + r32];
    if (m == 1) {
#pragma unroll
        for (int r = 0; r < 16; ++r) { const int q = qs * 32 + (r & 3) + 8 * (r >> 2) + 4 * hh;
#pragma unroll
            for (int db = 0; db < 4; ++db) XO[q * 128 + db * 32 + r32] = o[db][r] * sc[r]; } }
    __syncthreads();
    if (m == 0) {
#pragma unroll
        for (int r = 0; r < 16; ++r) { const int q = qs * 32 + (r & 3) + 8 * (r >> 2) + 4 * hh; float ss = 0.f;
#pragma unroll
            for (int db = 0; db < 4; ++db) { const float v = o[db][r] * sc[r] - XO[q * 128 + db * 32 + r32]; o[db][r] = v; ss += v * v; }
            const float rs = rsqrtf(sum32(ss) * (1.0f / 128.0f) + 1e-5f) * lamp[1];
            LAS bf16_t* yp = (LAS bf16_t*)(L + q * 272) + r32;
#pragma unroll
            for (int db = 0; db < 4; ++db) yp[db * 32] = f2bf(o[db][r] * rs * sg[db]); } }
    __syncthreads();
#pragma unroll
    for (int it = 0; it < 4; ++it) { const int idx = tid + it * NTHR, q = idx >> 4, ch = idx & 15;
        *(u32x4*)(Y + (size_t)(qrow0 + q) * 2048 + 1024 + h * 128 + ch * 8) = *(const LAS u32x4*)(L + q * 272 + ch * 16); }
}
struct ChunkPos { int rowbase, t_lo, seglen; };
__device__ __forceinline__ ChunkPos chunk_pos(int b, int d, int ci) { ChunkPos c; const bool isctx = ci < 8; const int cl = isctx ? ci : ci - 8; c.seglen = isctx ? LCTX : LAT;
    c.rowbase = b * TPB + (isctx ? 0 : LCTX); c.t_lo = d == 0 ? cl * 32 : c.seglen - 32 * (cl + 1); return c; }
constexpr int NCHUNK = TPB / 32;

constexpr int RW_OP = 0, RW_OPB = 49152, RW_RAW = 98304, RW_TW = 128768, RW_TA = 133376, RW_TG = 137984, RW_MU = 146688, RW_CST = 148480;
#define RW_BAR() do { asm volatile("s_waitcnt vmcnt(0) lgkmcnt(0)" ::: "memory"); __builtin_amdgcn_s_barrier(); asm volatile("" ::: "memory"); } while (0)
#define RW_BAR_NV() do { asm volatile("s_waitcnt lgkmcnt(0)" ::: "memory"); __builtin_amdgcn_s_barrier(); asm volatile("" ::: "memory"); } while (0)
PHASE_FN void rwkv_chain(int wv, PRM p, int l, LAS unsigned char* L, int d, int b, int h) {
    const int tid = TID, lane = tid & 63, wave = wv, r32 = lane & 31, hh = lane >> 5;
    LAS bf16_t* RAW = (LAS bf16_t*)(L + RW_RAW);
    LAS bf16_t* TW = (LAS bf16_t*)(L + RW_TW); LAS bf16_t* TA = (LAS bf16_t*)(L + RW_TA); LAS bf16_t* TG = (LAS bf16_t*)(L + RW_TG);
    LAS float* MU = (LAS float*)(L + RW_MU);
    LAS float* CW0 = (LAS float*)(L + RW_CST); LAS float* CA0 = CW0 + 64; LAS float* CKK = CA0 + 64; LAS float* CKA = CKK + 64; LAS float* CRK = CKA + 64;
    const bf16_t* U = (const bf16_t*)(p.ws + WS_U);
    bf16_t* RWY = (bf16_t*)(p.ws + WS_RWY) + (size_t)d * NTOK * 512; bf16_t* RWG = (bf16_t*)(p.ws + WS_RWG); float* BD = (float*)(p.ws + WS_RWBD) + (size_t)d * NTOK * 8;
    __syncthreads();
    if (tid < 448) { const int cc = tid; int gc;
        if (cc < 192) gc = (cc >> 6) * 512 + h * 64 + (cc & 63); else if (cc < 256) gc = 1536 + d * 64 + (cc - 192); else if (cc < 320) gc = 1664 + d * 64 + (cc - 256); else gc = 1792 + (cc - 320);
        MU[cc] = p.in[I_RW_MU][l * 1920 + gc]; }
    if (tid < 64) { const int c = h * 64 + tid; CW0[tid] = p.in[I_RW_W0][(l * 2 + d) * 512 + c]; CA0[tid] = p.in[I_RW_A0][(l * 2 + d) * 512 + c];
        CKK[tid] = p.in[I_RW_KK][l * 512 + c]; CKA[tid] = p.in[I_RW_KA][l * 512 + c]; CRK[tid] = p.in[I_RW_RK][l * 512 + c]; }
    __syncthreads();
    if (wave >= 4) {
        const int t2 = tid - 256, sw = wave - 4;
        bf16x8 Bf[8];
#pragma unroll
        for (int f = 0; f < 8; ++f) { float v[8];
#pragma unroll
            for (int j = 0; j < 8; ++j) { float x;
                if (sw < 2) { const int cb = f >> 2, ks = f & 3, k = ks * 16 + hh * 8 + j; const float* w = sw == 0 ? p.in[I_RW_WUP] : p.in[I_RW_AUP]; x = w[((size_t)(l * 2 + d) * 64 + k) * 512 + h * 64 + cb * 32 + r32]; }
                else { const int cb = sw - 2, k = f * 16 + hh * 8 + j; x = p.in[I_RW_GUP][((size_t)l * 128 + k) * 512 + h * 64 + cb * 32 + r32]; }
                v[j] = x; }
            Bf[f] = __builtin_bit_cast(bf16x8, pack8(v)); }
        const bool s2on = t2 < 224; const int ch = s2on ? t2 % 56 : 0, seg = s2on ? t2 / 56 : 0, cc = ch * 8;
        int gcol; if (ch < 24) gcol = U_RW_R + (ch >> 3) * 512 + h * 64 + (ch & 7) * 8; else if (ch < 32) gcol = U_RW_WD + d * 64 + (ch - 24) * 8; else if (ch < 40) gcol = U_RW_AD + d * 64 + (ch - 32) * 8; else gcol = U_RW_GD + (ch - 40) * 8;
        float mu8[8];
        { const f32x4 m0 = *(const LAS f32x4*)(MU + cc), m1 = *(const LAS f32x4*)(MU + cc + 4);
#pragma unroll
          for (int j = 0; j < 4; ++j) { mu8[j] = m0[j]; mu8[4 + j] = m1[j]; } }
        u32x4 rawreg[10];
#define RW_RAW_LOAD(cix) do { const ChunkPos cq = chunk_pos(b, d, (cix)); _Pragma("unroll") for (int it = 0; it < 10; ++it) { const int t = cq.t_lo + 8 * seg - 1 + it; u32x4 v = (u32x4){0u, 0u, 0u, 0u}; \
            if (s2on && t >= 0 && t < cq.seglen) v = *(const u32x4*)(U + (size_t)(cq.rowbase + t) * UC + gcol); rawreg[it] = v; } } while (0)
        RW_RAW_LOAD(0);
        for (int cs = 0; cs < NCHUNK; ++cs) {
            const ChunkPos cp = chunk_pos(b, d, cs);
            LAS float* OP = (LAS float*)(L + ((cs & 1) ? RW_OPB : RW_OP)); LAS float* W_ = OP; LAS float* KK = OP + 2048; LAS float* KKA = OP + 4096; LAS float* KD = OP + 6144; LAS float* R_ = OP + 8192; LAS float* V_ = OP + 10240;
            if (s2on) { float pv[8], c0[8], nx[8], mx[8]; unpack8(rawreg[0], pv); unpack8(rawreg[1], c0);
#pragma unroll
                for (int j = 0; j < 8; ++j) { const int s = 8 * seg + j; unpack8(rawreg[j + 2], nx);
#pragma unroll
                    for (int q = 0; q < 8; ++q) { mx[q] = c0[q] + mu8[q] * (0.5f * (pv[q] + nx[q]) - c0[q]); pv[q] = c0[q]; c0[q] = nx[q]; }
                    if (ch < 24) { LAS float* dst = (ch < 8 ? R_ : (ch < 16 ? KD : V_)) + s * 64 + (cc & 63);
                        *(LAS f32x4*)dst = (f32x4){mx[0], mx[1], mx[2], mx[3]}; *(LAS f32x4*)(dst + 4) = (f32x4){mx[4], mx[5], mx[6], mx[7]}; }
                    else if (ch < 32) {
#pragma unroll
                        for (int q = 0; q < 8; ++q) mx[q] = tanh_fast(mx[q]);
                        *(LAS u32x4*)(TW + s * 72 + cc - 192) = pack8(mx); }
                    else if (ch < 40) *(LAS u32x4*)(TA + s * 72 + cc - 256) = pack8(mx);
                    else {
#pragma unroll
                        for (int q = 0; q < 8; ++q) mx[q] = sigmoidf_(mx[q]);
                        *(LAS u32x4*)(TG + s * 136 + cc - 320) = pack8(mx); } } }
            if (cs + 1 < NCHUNK) RW_RAW_LOAD(cs + 1);
            RW_BAR_NV();
            if (sw < 2) {
#pragma unroll
                for (int cb = 0; cb < 2; ++cb) { f32x16 acc = (f32x16){0.f,0.f,0.f,0.f,0.f,0.f,0.f,0.f,0.f,0.f,0.f,0.f,0.f,0.f,0.f,0.f};
#pragma unroll
                    for (int ks = 0; ks < 4; ++ks) { const bf16x8 a = *(const LAS bf16x8*)((sw == 0 ? TW : TA) + r32 * 72 + ks * 16 + hh * 8); acc = __builtin_amdgcn_mfma_f32_32x32x16_bf16(a, Bf[cb * 4 + ks], acc, 0, 0, 0); }
                    const int c = cb * 32 + r32;
#pragma unroll
                    for (int r = 0; r < 16; ++r) { const int s = (r & 3) + 8 * (r >> 2) + 4 * hh; if (sw == 0) W_[s * 64 + c] = acc[r]; else KKA[s * 64 + c] = acc[r]; } } }
            else if (d == 0) { const int cb = sw - 2; f32x16 acc = (f32x16){0.f,0.f,0.f,0.f,0.f,0.f,0.f,0.f,0.f,0.f,0.f,0.f,0.f,0.f,0.f,0.f};
#pragma unroll
                for (int ks = 0; ks < 8; ++ks) { const bf16x8 a = *(const LAS bf16x8*)(TG + r32 * 136 + ks * 16 + hh * 8); acc = __builtin_amdgcn_mfma_f32_32x32x16_bf16(a, Bf[ks], acc, 0, 0, 0); }
#pragma unroll
                for (int r = 0; r < 16; ++r) { const int s = (r & 3) + 8 * (r >> 2) + 4 * hh; RWG[(size_t)(cp.rowbase + cp.t_lo + s) * 512 + h * 64 + cb * 32 + r32] = f2bf(acc[r]); } }
            RW_BAR_NV();
            { const int s = t2 >> 3, c8 = (t2 & 7) * 8; float kkv[8], av[8], kt[8], wr[8], rr[8], cw0[8], ca0[8], ckk[8], cka[8], crk[8], ssq = 0.f, bdp = 0.f;
#define RW_LD8(dst, ptr) do { const f32x4 t0_ = *(const LAS f32x4*)(ptr), t1_ = *(const LAS f32x4*)((ptr) + 4); _Pragma("unroll") for (int q_ = 0; q_ < 4; ++q_) { dst[q_] = t0_[q_]; dst[4 + q_] = t1_[q_]; } } while (0)
#define RW_ST8(ptr, src) do { *(LAS f32x4*)(ptr) = (f32x4){src[0], src[1], src[2], src[3]}; *(LAS f32x4*)((ptr) + 4) = (f32x4){src[4], src[5], src[6], src[7]}; } while (0)
                RW_LD8(kt, KD + s * 64 + c8); RW_LD8(av, KKA + s * 64 + c8); RW_LD8(wr, W_ + s * 64 + c8); RW_LD8(rr, R_ + s * 64 + c8);
                RW_LD8(cw0, CW0 + c8); RW_LD8(ca0, CA0 + c8); RW_LD8(ckk, CKK + c8); RW_LD8(cka, CKA + c8); RW_LD8(crk, CRK + c8);
#pragma unroll
                for (int j = 0; j < 8; ++j) { av[j] = sigmoidf_(ca0[j] + av[j]); kkv[j] = kt[j] * ckk[j]; ssq += kkv[j] * kkv[j]; wr[j] = __expf(-0.60653066f * sigmoidf_(cw0[j] + wr[j])); }
                const float inv = rsqrtf(sum8(ssq) + 1e-12f); float kk8[8], kka8[8], kd8[8];
#pragma unroll
                for (int j = 0; j < 8; ++j) { const float kn = kkv[j] * inv; kk8[j] = -kn; kka8[j] = kn * av[j]; kd8[j] = kt[j] * (1.0f + (av[j] - 1.0f) * cka[j]); bdp += rr[j] * kd8[j] * crk[j]; }
                RW_ST8(W_ + s * 64 + c8, wr); RW_ST8(KK + s * 64 + c8, kk8); RW_ST8(KKA + s * 64 + c8, kka8); RW_ST8(KD + s * 64 + c8, kd8);
                bdp = sum8(bdp); if ((t2 & 7) == 0) BD[(size_t)(cp.rowbase + cp.t_lo + s) * 8 + h] = bdp; }
            RW_BAR_NV();
        }
        RW_BAR_NV(); RW_BAR_NV(); RW_BAR_NV();
#undef RW_RAW_LOAD
    } else {
        const int vl = lane >> 3, kq = lane & 7; f32x2 S2[2][4];
#pragma unroll
        for (int i = 0; i < 2; ++i)
#pragma unroll
            for (int q = 0; q < 4; ++q) S2[i][q] = (f32x2){0.f, 0.f};
        __builtin_amdgcn_s_setprio(3);
        RW_BAR_NV(); RW_BAR_NV(); RW_BAR_NV();
#ifdef DBG_RWT
        unsigned tw_ = 0u; const unsigned tst_ = (unsigned)(__builtin_amdgcn_s_memtime() >> 6);
#endif
        struct Ops { f32x4 w0, w1, k0, k1, a0, a1, d0, d1, r0, r1; f32x2 v2; };
        for (int ci = 0; ci < NCHUNK; ++ci) {
            const ChunkPos cp = chunk_pos(b, d, ci);
            const LAS float* OP = (const LAS float*)(L + ((ci & 1) ? RW_OPB : RW_OP)); const LAS float* W_ = OP; const LAS float* KK = OP + 2048; const LAS float* KKA = OP + 4096; const LAS float* KD = OP + 6144; const LAS float* R_ = OP + 8192; const LAS float* V_ = OP + 10240;
            bf16_t* yrow = RWY + (size_t)(cp.rowbase + cp.t_lo) * 512 + h * 64 + 16 * wave + 2 * vl;
#define RW_OPLOAD(X, stx) do { const int st_ = (stx) < 32 ? (stx) : 31; const int sm_ = d ? 31 - st_ : st_; const int o_ = sm_ * 64 + 8 * kq; \
                X.w0 = *(const LAS f32x4*)(W_ + o_); X.w1 = *(const LAS f32x4*)(W_ + o_ + 4); X.k0 = *(const LAS f32x4*)(KK + o_); X.k1 = *(const LAS f32x4*)(KK + o_ + 4); \
                X.a0 = *(const LAS f32x4*)(KKA + o_); X.a1 = *(const LAS f32x4*)(KKA + o_ + 4); X.d0 = *(const LAS f32x4*)(KD + o_); X.d1 = *(const LAS f32x4*)(KD + o_ + 4); \
                X.r0 = *(const LAS f32x4*)(R_ + o_); X.r1 = *(const LAS f32x4*)(R_ + o_ + 4); X.v2 = *(const LAS f32x2*)(V_ + sm_ * 64 + 16 * wave + 2 * vl); } while (0)
#ifdef DBG_RWT
#define RW_SEGBAR() do { const unsigned ta_ = (unsigned)(__builtin_amdgcn_s_memtime() >> 6); RW_BAR_NV(); tw_ += (unsigned)(__builtin_amdgcn_s_memtime() >> 6) - ta_; } while (0)
#else
#define RW_SEGBAR() RW_BAR_NV()
#endif
#define RW_STEP(X, stx) do { const int sm_ = d ? 31 - (stx) : (stx); \
                const f32x2 w_[4] = {X.w0.xy, X.w0.zw, X.w1.xy, X.w1.zw}, k_[4] = {X.k0.xy, X.k0.zw, X.k1.xy, X.k1.zw}, a_[4] = {X.a0.xy, X.a0.zw, X.a1.xy, X.a1.zw}, \
                            dd_[4] = {X.d0.xy, X.d0.zw, X.d1.xy, X.d1.zw}, r_[4] = {X.r0.xy, X.r0.zw, X.r1.xy, X.r1.zw}; \
                float y_[2]; \
                _Pragma("unroll") for (int i = 0; i < 2; ++i) { \
                    f32x2 t_ = S2[i][0] * k_[0]; t_ = S2[i][1] * k_[1] + t_; t_ = S2[i][2] * k_[2] + t_; t_ = S2[i][3] * k_[3] + t_; \
                    const float sa_ = sum8(t_.x + t_.y); const f32x2 sa2_ = {sa_, sa_}; const f32x2 vv_ = {X.v2[i], X.v2[i]}; \
                    _Pragma("unroll") for (int q = 0; q < 4; ++q) S2[i][q] = S2[i][q] * w_[q] + sa2_ * a_[q] + vv_ * dd_[q]; \
                    f32x2 u_ = S2[i][0] * r_[0]; u_ = S2[i][1] * r_[1] + u_; u_ = S2[i][2] * r_[2] + u_; u_ = S2[i][3] * r_[3] + u_; \
                    y_[i] = sum8(u_.x + u_.y); } \
                if (kq == 0) *(unsigned*)(yrow + (size_t)sm_ * 512) = cvt_pk_bf16(y_[0], y_[1]); } while (0)
            Ops A, B;
            RW_OPLOAD(A, 0);
#pragma unroll 1
            for (int seg = 0; seg < 3; ++seg) { const int s_lo = seg == 0 ? 0 : (seg == 1 ? 10 : 22), s_hi = seg == 0 ? 10 : (seg == 1 ? 22 : 32);
#pragma unroll 1
                for (int st = s_lo; st < s_hi; st += 2) { RW_OPLOAD(B, st + 1); RW_STEP(A, st); RW_OPLOAD(A, st + 2); RW_STEP(B, st + 1); }
                RW_SEGBAR();
            }
#undef RW_OPLOAD
#undef RW_STEP
#undef RW_SEGBAR
        }
        __builtin_amdgcn_s_setprio(0);
#ifdef DBG_RWT
        if (wave == 0 && lane == 0) { unsigned* ctl = (unsigned*)(p.ws + WS_CTL); atomicAdd(ctl + 14000, tw_ >> 4); atomicAdd(ctl + 14001, ((unsigned)(__builtin_amdgcn_s_memtime() >> 6) - tst_) >> 4); }
#endif
    }
}
constexpr int SD_RAW = 0, SD_BM = 42240, SD_CM = 59648, SD_XM = 77056, SD_XST = 86272, SD_H0 = 95488, SD_CUM = 130304, SD_DTC = 130560, SD_LA = 130816, SD_CW = 131072, SD_CB = 134912;
constexpr int SD_LDB = 272, SD_LDX = 144;
struct ChunkPos64 { int rowbase, t_lo, seglen; };
__device__ __forceinline__ ChunkPos64 chunk_pos64(int b, int d, int ci) { ChunkPos64 c; const bool isctx = ci < 4; const int cl = isctx ? ci : ci - 4; c.seglen = isctx ? LCTX : LAT;
    c.rowbase = b * TPB + (isctx ? 0 : LCTX); c.t_lo = d == 0 ? cl * 64 : c.seglen - 64 * (cl + 1); return c; }
PHASE_FN void ssd_chain(int wv, PRM p, int l, LAS unsigned char* L, int d, int b, int h) {
    const int tid = TID, lane = tid & 63, wave = wv, r32 = lane & 31, hh = lane >> 5, g = h >> 2;
    LAS bf16_t* RAW = (LAS bf16_t*)(L + SD_RAW);
    LAS float* CUM = (LAS float*)(L + SD_CUM); LAS float* DTC = (LAS float*)(L + SD_DTC); LAS float* LA = (LAS float*)(L + SD_LA);
    LAS float* CWt = (LAS float*)(L + SD_CW); LAS float* CBs = (LAS float*)(L + SD_CB);
    const bf16_t* U = (const bf16_t*)(p.ws + WS_U); bf16_t* SSDY = (bf16_t*)(p.ws + WS_SSDY) + (size_t)d * NTOK * 512;
    __syncthreads();
    if (tid < 320) { const int cc = tid; const int ch = cc < 64 ? h * 64 + cc : (cc < 192 ? 512 + g * 128 + (cc - 64) : 768 + g * 128 + (cc - 192));
#pragma unroll
        for (int j = 0; j < 3; ++j) CWt[j * 320 + cc] = p.in[I_SSD_CW][((size_t)l * 3 + j) * 1024 + ch];
        CBs[cc] = p.in[I_SSD_CB][l * 1024 + ch]; }
    for (int i = tid; i < 64 * SD_LDB / 4; i += NTHR) ((LAS unsigned*)(L + SD_H0))[i] = 0u;
    const float Aneg = -__expf(p.in[I_SSD_ALOG][(l * 2 + d) * 8 + h]), dtb = p.in[I_SSD_DTB][(l * 2 + d) * 8 + h], Dh = p.in[I_SSD_D][l * 8 + h];
    f32x16 hst[2];
    hst[0] = (f32x16){0.f,0.f,0.f,0.f,0.f,0.f,0.f,0.f,0.f,0.f,0.f,0.f,0.f,0.f,0.f,0.f}; hst[1] = hst[0];
    const bf16_t* XBC = (const bf16_t*)(p.ws + WS_XBC);
    u32x4 rawreg[5]; float dtreg = 0.f;
#define SD_LOAD(cpx) do { _Pragma("unroll") for (int it = 0; it < 5; ++it) { const int idx = tid + it * NTHR; const int row = idx / 40, ch = idx - row * 40; \
            const int gcol = ch < 8 ? h * 64 + ch * 8 : (ch < 24 ? 512 + g * 128 + (ch - 8) * 8 : 768 + g * 128 + (ch - 24) * 8); \
            rawreg[it] = *(const u32x4*)(XBC + (size_t)((cpx).rowbase + (cpx).t_lo + row) * 1024 + gcol); } \
        if (tid < 64) { const int sm = d ? 63 - tid : tid; dtreg = bf2f(U[(size_t)((cpx).rowbase + (cpx).t_lo + sm) * UC + U_SSD_DT + h]); } } while (0)
    { const ChunkPos64 c0 = chunk_pos64(b, d, 0); SD_LOAD(c0); }
    const int i16 = lane & 15; const int troff = (4 * hh + (i16 >> 2)), trcol = (((lane >> 4) & 1) * 16 + (i16 & 3) * 4) * 2;
    for (int ci = 0; ci < 68; ++ci) {
        const ChunkPos64 cp = chunk_pos64(b, d, ci);
        LAS unsigned char* H0c = L + SD_H0 + (ci & 1) * 64 * SD_LDB; LAS unsigned char* H0n = L + SD_H0 + ((ci + 1) & 1) * 64 * SD_LDB;
        BAR_LDS();
        if (ci > 0) { const ChunkPos64 cq = chunk_pos64(b, d, ci - 1); const int rw = tid >> 3, pc = tid & 7;
            *(u32x4*)(SSDY + (size_t)(cq.rowbase + cq.t_lo + rw) * 512 + h * 64 + pc * 8) = *(const LAS u32x4*)(L + SD_RAW + rw * SD_LDX + pc * 16); }
#pragma unroll
        for (int it = 0; it < 5; ++it) { const int idx = tid + it * NTHR; const int sm = idx / 40, ch = idx - sm * 40, cc = ch * 8; const int i = d ? 63 - sm : sm;
            LAS unsigned char* dst = ch < 8 ? L + SD_XM + i * SD_LDX + cc * 2 : (ch < 24 ? L + SD_BM + i * SD_LDB + (cc - 64) * 2 : L + SD_CM + i * SD_LDB + (cc - 192) * 2);
            *(LAS u32x4*)dst = rawreg[it]; }
        if (wave == 0) { const float dtc = softplus_fast(dtreg + dtb); DTC[lane] = dtc; CUM[lane] = wave_incl_scan(dtc * Aneg, lane); }
        BAR_LDS();
        if (ci + 1 < 68) { const ChunkPos64 cn = chunk_pos64(b, d, ci + 1); SD_LOAD(cn); }
        { const int pp = tid & 63, jc = tid >> 6; const float cl = CUM[63]; float x[8];
#pragma unroll
            for (int q = 0; q < 8; ++q) { const int j = 8 * jc + q; x[q] = bf2f(*(const LAS bf16_t*)(L + SD_XM + j * SD_LDX + pp * 2)) * (__expf(cl - CUM[j]) * DTC[j]); }
            *(LAS u32x4*)(L + SD_XST + pp * SD_LDX + jc * 16) = pack8(x); }
        BAR_LDS();
        if (wave < 4) {
            const int ib = wave >> 1, pb = wave & 1;
            f32x16 accy = (f32x16){0.f,0.f,0.f,0.f,0.f,0.f,0.f,0.f,0.f,0.f,0.f,0.f,0.f,0.f,0.f,0.f};
            const float cum_i = CUM[32 * ib + r32];
            for (int jb = 0; jb <= ib; ++jb) {
                f32x16 st = (f32x16){0.f,0.f,0.f,0.f,0.f,0.f,0.f,0.f,0.f,0.f,0.f,0.f,0.f,0.f,0.f,0.f};
#pragma unroll
                for (int ks = 0; ks < 8; ++ks) { const bf16x8 a = *(const LAS bf16x8*)(L + SD_BM + (32 * jb + r32) * SD_LDB + (ks * 16 + hh * 8) * 2);
                    const bf16x8 bq = *(const LAS bf16x8*)(L + SD_CM + (32 * ib + r32) * SD_LDB + (ks * 16 + hh * 8) * 2); st = __builtin_amdgcn_mfma_f32_32x32x16_bf16(a, bq, st, 0, 0, 0); }
                float pv[16];
#pragma unroll
                for (int g4 = 0; g4 < 4; ++g4) { const f32x4 cj = *(const LAS f32x4*)(CUM + 32 * jb + 8 * g4 + 4 * hh), dj = *(const LAS f32x4*)(DTC + 32 * jb + 8 * g4 + 4 * hh);
#pragma unroll
                    for (int q = 0; q < 4; ++q) { const int jl = 8 * g4 + 4 * hh + q; const bool dead = (jb == ib) && (jl > r32); pv[4 * g4 + q] = dead ? 0.f : st[4 * g4 + q] * __expf(cum_i - cj[q]) * dj[q]; } }
#pragma unroll
                for (int ks = 0; ks < 2; ++ks) { float t8[8];
#pragma unroll
                    for (int q = 0; q < 8; ++q) t8[q] = pv[8 * ks + q];
                    const bf16x8 pa = __builtin_bit_cast(bf16x8, pack8(t8));
                    const LAS unsigned char* vb = L + SD_XM + (32 * jb + 16 * ks + troff) * SD_LDX + pb * 64 + trcol;
                    const s16x4 lo = vtr(vb), hi = vtr(vb + 8 * SD_LDX); const bf16x8 vf = (bf16x8){lo[0], lo[1], lo[2], lo[3], hi[0], hi[1], hi[2], hi[3]};
                    accy = __builtin_amdgcn_mfma_f32_32x32x16_bf16(pa, vf, accy, 0, 0, 0); }
            }
            f32x16 acc2 = (f32x16){0.f,0.f,0.f,0.f,0.f,0.f,0.f,0.f,0.f,0.f,0.f,0.f,0.f,0.f,0.f,0.f};
#pragma unroll
            for (int ks = 0; ks < 8; ++ks) { const bf16x8 a = *(const LAS bf16x8*)(L + SD_CM + (32 * ib + r32) * SD_LDB + (ks * 16 + hh * 8) * 2);
                const bf16x8 bq = *(const LAS bf16x8*)(H0c + (32 * pb + r32) * SD_LDB + (ks * 16 + hh * 8) * 2); acc2 = __builtin_amdgcn_mfma_f32_32x32x16_bf16(a, bq, acc2, 0, 0, 0); }
#pragma unroll
            for (int r = 0; r < 16; ++r) { const int il = (r & 3) + 8 * (r >> 2) + 4 * hh, i = 32 * ib + il; float y = accy[r] + __expf(CUM[i]) * acc2[r];
                if (d == 0) y += Dh * bf2f(*(const LAS bf16_t*)(L + SD_XM + i * SD_LDX + (32 * pb + r32) * 2));
                const int sm = d ? 63 - i : i; *(LAS bf16_t*)(L + SD_RAW + sm * SD_LDX + (32 * pb + r32) * 2) = f2bf(y); }
        } else {
            const float e_last = __expf(CUM[63]);
#pragma unroll
            for (int tt = 0; tt < 2; ++tt) { const int t = 2 * (wave - 4) + tt, pb = t & 1, nb = t >> 1;
                hst[tt] = hst[tt] * e_last;
#pragma unroll
                for (int ks = 0; ks < 4; ++ks) { const bf16x8 a = *(const LAS bf16x8*)(L + SD_XST + (32 * pb + r32) * SD_LDX + (ks * 16 + hh * 8) * 2);
                    const LAS unsigned char* vb = L + SD_BM + (16 * ks + 8 * hh + (i16 >> 2)) * SD_LDB + nb * 64 + trcol;
                    const s16x4 lo = vtr(vb), hi = vtr(vb + 4 * SD_LDB); const bf16x8 vf = (bf16x8){lo[0], lo[1], lo[2], lo[3], hi[0], hi[1], hi[2], hi[3]};
                    hst[tt] = __builtin_amdgcn_mfma_f32_32x32x16_bf16(a, vf, hst[tt], 0, 0, 0); }
#pragma unroll
                for (int r = 0; r < 16; ++r) { const int pl = (r & 3) + 8 * (r >> 2) + 4 * hh; *(LAS bf16_t*)(H0n + (32 * pb + pl) * SD_LDB + (32 * nb + r32) * 2) = f2bf(hst[tt][r]); } }
        }
    }
    BAR_LDS();
    { const ChunkPos64 cq = chunk_pos64(b, d, 67); const int rw = tid >> 3, pc = tid & 7;
        *(u32x4*)(SSDY + (size_t)(cq.rowbase + cq.t_lo + rw) * 512 + h * 64 + pc * 8) = *(const LAS u32x4*)(L + SD_RAW + rw * SD_LDX + pc * 16); }
#undef SD_LOAD
}
constexpr int GL_RAW = 0, GL_GC = 34816, GL_SEG = 51200, GL_QP = 53248, GL_KP = 62464, GL_QE = 71680, GL_K2T = 80896, GL_V = 90112, GL_S0T = 107520, GL_EL = 144384, GL_GUP = 144640, GL_GB = 148736;
PHASE_FN void gla_chain(int wv, PRM p, int l, LAS unsigned char* L, int d, int b, int h) {
    const int tid = TID, lane = tid & 63, wave = wv, r32 = lane & 31, hh = lane >> 5;
    LAS bf16_t* RAW = (LAS bf16_t*)(L + GL_RAW);
    LAS float* GC = (LAS float*)(L + GL_GC); LAS float* SEG = (LAS float*)(L + GL_SEG); LAS float* EL = (LAS float*)(L + GL_EL); LAS float* GUP = (LAS float*)(L + GL_GUP); LAS float* GB = (LAS float*)(L + GL_GB);
    const bf16_t* U = (const bf16_t*)(p.ws + WS_U); bf16_t* GLAO = (bf16_t*)(p.ws + WS_GLAO) + (size_t)d * NTOK * 512;
    __syncthreads();
    for (int i = tid; i < 1024; i += NTHR) GUP[i] = p.in[I_GLA_GUP][((size_t)(l * 2 + d) * 16 + (i >> 6)) * 256 + h * 64 + (i & 63)];
    if (tid < 64) GB[tid] = p.in[I_GLA_GB][(l * 2 + d) * 256 + h * 64 + tid];
    for (int i = tid; i < 128 * SD_LDX / 4; i += NTHR) ((LAS unsigned*)(L + GL_S0T))[i] = 0u;
    f32x16 sst[2]; sst[0] = (f32x16){0.f,0.f,0.f,0.f,0.f,0.f,0.f,0.f,0.f,0.f,0.f,0.f,0.f,0.f,0.f,0.f}; sst[1] = sst[0];
    u32x4 rawreg[5];
#define GL_LOAD(cpx) do { _Pragma("unroll") for (int it = 0; it < 5; ++it) { const int idx = tid + it * NTHR; u32x4 v = (u32x4){0u, 0u, 0u, 0u}; \
        if (idx < 64 * 34) { const int row = idx / 34, ch = idx - row * 34; \
            const int gcol = ch < 8 ? U_GLA_Q + h * 64 + ch * 8 : (ch < 16 ? U_GLA_K + h * 64 + (ch - 8) * 8 : (ch < 32 ? U_GLA_V + h * 128 + (ch - 16) * 8 : U_GLA_GD + d * 16 + (ch - 32) * 8)); \
            v = *(const u32x4*)(U + (size_t)((cpx).rowbase + (cpx).t_lo + row) * UC + gcol); } \
        rawreg[it] = v; } } while (0)
    { const ChunkPos64 c0 = chunk_pos64(b, d, 0); GL_LOAD(c0); }
    const int i16 = lane & 15, q4 = i16 >> 2; const int trcol = (((lane >> 4) & 1) * 16 + (i16 & 3) * 4) * 2;
    for (int ci = 0; ci < 68; ++ci) {
        const ChunkPos64 cp = chunk_pos64(b, d, ci);
        LAS unsigned char* S0c = L + GL_S0T + (ci & 1) * 128 * SD_LDX; LAS unsigned char* S0n = L + GL_S0T + ((ci + 1) & 1) * 128 * SD_LDX;
        BAR_LDS();
        if (ci > 0) { const ChunkPos64 cq = chunk_pos64(b, d, ci - 1);
#pragma unroll
            for (int it = 0; it < 2; ++it) { const int idx = tid + it * NTHR, rw = idx >> 4, ec = idx & 15;
                *(u32x4*)(GLAO + (size_t)(cq.rowbase + cq.t_lo + rw) * 512 + h * 128 + ec * 8) = *(const LAS u32x4*)(L + GL_GC + rw * SD_LDB + ec * 16); } }
#pragma unroll
        for (int it = 0; it < 5; ++it) { const int idx = tid + it * NTHR; if (idx < 64 * 34) { const int row = idx / 34, ch = idx - row * 34; *(LAS u32x4*)(RAW + row * 272 + ch * 8) = rawreg[it]; } }
        BAR_LDS();
        if (ci + 1 < 68) { const ChunkPos64 cn = chunk_pos64(b, d, ci + 1); GL_LOAD(cn); }
        { const int i = tid >> 3, kc = tid & 7; const int sm = d ? 63 - i : i; float gdA[8], gdB[8], gt[8];
            unpack8(*(const LAS u32x4*)(RAW + sm * 272 + 256), gdA); unpack8(*(const LAS u32x4*)(RAW + sm * 272 + 264), gdB);
            { const f32x4 b0 = *(const LAS f32x4*)(GB + kc * 8), b1 = *(const LAS f32x4*)(GB + kc * 8 + 4);
#pragma unroll
              for (int q = 0; q < 4; ++q) { gt[q] = b0[q]; gt[4 + q] = b1[q]; } }
#pragma unroll
            for (int r = 0; r < 16; ++r) { const f32x4 u0 = *(const LAS f32x4*)(GUP + r * 64 + kc * 8), u1 = *(const LAS f32x4*)(GUP + r * 64 + kc * 8 + 4);
#pragma unroll
                for (int q = 0; q < 4; ++q) { const float gv = r < 8 ? gdA[r & 7] : gdB[r & 7]; gt[q] += gv * u0[q]; gt[4 + q] += gv * u1[q]; } }
            f32x4 o0, o1;
#pragma unroll
            for (int q = 0; q < 4; ++q) { o0[q] = -softplus_fast(-gt[q]) * (1.0f / 16.0f); o1[q] = -softplus_fast(-gt[4 + q]) * (1.0f / 16.0f); }
            *(LAS f32x4*)(GC + i * 64 + kc * 8) = o0; *(LAS f32x4*)(GC + i * 64 + kc * 8 + 4) = o1; }
        BAR_LDS();
        { const int k = tid & 63, seg = tid >> 6; float run = 0.f;
#pragma unroll
            for (int ii = 0; ii < 8; ++ii) { run += GC[(seg * 8 + ii) * 64 + k]; GC[(seg * 8 + ii) * 64 + k] = run; }
            SEG[seg * 64 + k] = run;
            BAR_LDS();
            float pre = 0.f; for (int s2 = 0; s2 < seg; ++s2) pre += SEG[s2 * 64 + k];
#pragma unroll
            for (int ii = 0; ii < 8; ++ii) GC[(seg * 8 + ii) * 64 + k] += pre; }
        BAR_LDS();
        { const int i = tid >> 3, kc = tid & 7; const int sm = d ? 63 - i : i; float q8[8], k8[8], gci[8], gref[8];
            unpack8(*(const LAS u32x4*)(RAW + sm * 272 + kc * 8), q8); unpack8(*(const LAS u32x4*)(RAW + sm * 272 + 64 + kc * 8), k8);
            { const f32x4 a0 = *(const LAS f32x4*)(GC + i * 64 + kc * 8), a1 = *(const LAS f32x4*)(GC + i * 64 + kc * 8 + 4), r0 = *(const LAS f32x4*)(GC + 32 * 64 + kc * 8), r1 = *(const LAS f32x4*)(GC + 32 * 64 + kc * 8 + 4);
#pragma unroll
              for (int q = 0; q < 4; ++q) { gci[q] = a0[q]; gci[4 + q] = a1[q]; gref[q] = r0[q]; gref[4 + q] = r1[q]; } }
            float qp[8], kp[8], qe[8];
#pragma unroll
            for (int q = 0; q < 8; ++q) { const float qs = q8[q] * 0.125f; qp[q] = qs * __expf(gci[q] - gref[q]); kp[q] = k8[q] * __expf(gref[q] - gci[q]); qe[q] = qs * __expf(gci[q]); }
            *(LAS u32x4*)(L + GL_QP + i * SD_LDX + kc * 16) = pack8(qp); *(LAS u32x4*)(L + GL_KP + i * SD_LDX + kc * 16) = pack8(kp); *(LAS u32x4*)(L + GL_QE + i * SD_LDX + kc * 16) = pack8(qe); }
        { const int k = tid & 63, jc = tid >> 6; const float gl = GC[63 * 64 + k]; float x[8];
#pragma unroll
            for (int q = 0; q < 8; ++q) { const int j = 8 * jc + q; const int sm = d ? 63 - j : j; x[q] = bf2f(RAW[sm * 272 + 64 + k]) * __expf(gl - GC[j * 64 + k]); }
            *(LAS u32x4*)(L + GL_K2T + k * SD_LDX + jc * 16) = pack8(x); }
        for (int idx = tid; idx < 64 * 16; idx += NTHR) { const int i = idx >> 4, vc = idx & 15; const int sm = d ? 63 - i : i; *(LAS u32x4*)(L + GL_V + i * SD_LDB + vc * 16) = *(const LAS u32x4*)(RAW + sm * 272 + 128 + vc * 8); }
        if (tid < 64) EL[tid] = __expf(GC[63 * 64 + tid]);
        BAR_LDS();
        if (wave < 4) {
            const int ib = wave >> 1, eh = wave & 1;
            f32x16 acc[2]; acc[0] = (f32x16){0.f,0.f,0.f,0.f,0.f,0.f,0.f,0.f,0.f,0.f,0.f,0.f,0.f,0.f,0.f,0.f}; acc[1] = acc[0];
            for (int jb = 0; jb <= ib; ++jb) {
                f32x16 at = (f32x16){0.f,0.f,0.f,0.f,0.f,0.f,0.f,0.f,0.f,0.f,0.f,0.f,0.f,0.f,0.f,0.f};
#pragma unroll
                for (int ks = 0; ks < 4; ++ks) { const bf16x8 a = *(const LAS bf16x8*)(L + GL_KP + (32 * jb + r32) * SD_LDX + (ks * 16 + hh * 8) * 2);
                    const bf16x8 bq = *(const LAS bf16x8*)(L + GL_QP + (32 * ib + r32) * SD_LDX + (ks * 16 + hh * 8) * 2); at = __builtin_amdgcn_mfma_f32_32x32x16_bf16(a, bq, at, 0, 0, 0); }
#pragma unroll
                for (int ks = 0; ks < 2; ++ks) { float t8[8];
#pragma unroll
                    for (int q = 0; q < 8; ++q) { const int r = 8 * ks + q; const int jl = (r & 3) + 8 * (r >> 2) + 4 * hh; t8[q] = ((jb == ib) && (jl > r32)) ? 0.f : at[r]; }
                    const bf16x8 pa = __builtin_bit_cast(bf16x8, pack8(t8));
#pragma unroll
                    for (int ebi = 0; ebi < 2; ++ebi) { const LAS unsigned char* vb = L + GL_V + (32 * jb + 16 * ks + 4 * hh + q4) * SD_LDB + (2 * eh + ebi) * 64 + trcol;
                        const s16x4 lo = vtr(vb), hi = vtr(vb + 8 * SD_LDB); const bf16x8 vf = (bf16x8){lo[0], lo[1], lo[2], lo[3], hi[0], hi[1], hi[2], hi[3]};
                        acc[ebi] = __builtin_amdgcn_mfma_f32_32x32x16_bf16(pa, vf, acc[ebi], 0, 0, 0); } }
            }
#pragma unroll
            for (int ebi = 0; ebi < 2; ++ebi)
#pragma unroll
                for (int ks = 0; ks < 4; ++ks) { const bf16x8 a = *(const LAS bf16x8*)(L + GL_QE + (32 * ib + r32) * SD_LDX + (ks * 16 + hh * 8) * 2);
                    const bf16x8 bq = *(const LAS bf16x8*)(S0c + (32 * (2 * eh + ebi) + r32) * SD_LDX + (ks * 16 + hh * 8) * 2); acc[ebi] = __builtin_amdgcn_mfma_f32_32x32x16_bf16(a, bq, acc[ebi], 0, 0, 0); }
#pragma unroll
            for (int r = 0; r < 16; ++r) { const int i = 32 * ib + (r & 3) + 8 * (r >> 2) + 4 * hh; const int sm = d ? 63 - i : i;
                LAS bf16_t* op = (LAS bf16_t*)(L + GL_GC + sm * SD_LDB) + 64 * eh + r32;
                op[0] = f2bf(acc[0][r]); op[32] = f2bf(acc[1][r]); }
        } else {
#pragma unroll
            for (int tt = 0; tt < 2; ++tt) { const int t = 2 * (wave - 4) + tt, kb = t & 1, eb = t >> 1;
#pragma unroll
                for (int g4 = 0; g4 < 4; ++g4) { const f32x4 e4 = *(const LAS f32x4*)(EL + 32 * kb + 8 * g4 + 4 * hh);
#pragma unroll
                    for (int q = 0; q < 4; ++q) sst[tt][4 * g4 + q] *= e4[q]; }
#pragma unroll
                for (int ks = 0; ks < 4; ++ks) { const bf16x8 a = *(const LAS bf16x8*)(L + GL_K2T + (32 * kb + r32) * SD_LDX + (ks * 16 + hh * 8) * 2);
                    const LAS unsigned char* vb = L + GL_V + (16 * ks + 8 * hh + q4) * SD_LDB + eb * 64 + trcol;
                    const s16x4 lo = vtr(vb), hi = vtr(vb + 4 * SD_LDB); const bf16x8 vf = (bf16x8){lo[0], lo[1], lo[2], lo[3], hi[0], hi[1], hi[2], hi[3]};
                    sst[tt] = __builtin_amdgcn_mfma_f32_32x32x16_bf16(a, vf, sst[tt], 0, 0, 0); }
#pragma unroll
                for (int g4 = 0; g4 < 4; ++g4) { u32x2 w; w.x = cvt_pk_bf16(sst[tt][4 * g4], sst[tt][4 * g4 + 1]); w.y = cvt_pk_bf16(sst[tt][4 * g4 + 2], sst[tt][4 * g4 + 3]);
                    *(LAS u32x2*)(S0n + (32 * eb + r32) * SD_LDX + (32 * kb + 8 * g4 + 4 * hh) * 2) = w; } }
        }
    }
    BAR_LDS();
    { const ChunkPos64 cq = chunk_pos64(b, d, 67);
#pragma unroll
        for (int it = 0; it < 2; ++it) { const int idx = tid + it * NTHR, rw = idx >> 4, ec = idx & 15;
            *(u32x4*)(GLAO + (size_t)(cq.rowbase + cq.t_lo + rw) * 512 + h * 128 + ec * 8) = *(const LAS u32x4*)(L + GL_GC + rw * SD_LDB + ec * 16); } }
#undef GL_LOAD
}
PHASE_FN void phase_mix(int wv, PRM p, int l, LAS unsigned char* lds, int qsel = 0, int item0 = 0, int item1 = 1 << 30) {
    LAS int* slot = (LAS int*)(lds + 32);
    unsigned* q = (unsigned*)(p.ws + WS_CTL) + CW_QUEUE + l * 64 + qsel * 16;
    const float lam_init = 0.8f - 0.6f * expf(-0.3f * (float)l);
    if (wv == 0) { const int ln = LANE; const float s1 = sum64(p.in[I_DF_Q1][l * 64 + ln] * p.in[I_DF_K1][l * 64 + ln]), s2 = sum64(p.in[I_DF_Q2][l * 64 + ln] * p.in[I_DF_K2][l * 64 + ln]);
        if (ln == 0) { LAS float* lp = (LAS float*)(lds + 40); lp[0] = expf(s1) - expf(s2) + lam_init; lp[1] = 1.0f - lam_init; } }
    const LAS float* lamp = (const LAS float*)(lds + 40);
    const int n_ctx_att = (l < DEPTH - 1) ? 64 : 0, nitems = 320 + 1024 + n_ctx_att;
    for (;;) {
        if (TID == 0) *slot = (int)atomicAdd(q, 1u);
        __syncthreads();
        const int item = *slot + item0;
        __syncthreads();
        if (item >= nitems || item >= item1) break;
        CParams& pp = *kparams(); LAS unsigned char* L = olds(lds) + LDS_STAGE;
#ifdef DBG_ITEM
        const unsigned ti0_ = (unsigned)__builtin_amdgcn_s_memrealtime();
#endif
        if (item < 128) { const int i = item; rwkv_chain(wv, pp, l, L, i & 1, (i >> 1) & 7, i >> 4); }
        else if (item < 256) { const int i = item - 128; ssd_chain(wv, pp, l, L, i & 1, (i >> 1) & 7, i >> 4); }
        else if (item < 320) { const int i = item - 256; gla_chain(wv, pp, l, L, i & 1, (i >> 1) & 7, i >> 4); }
        else if (item < 320 + 1024) { const int i = item - 320; const int b = i >> 7, h = (i >> 5) & 3, qb = i & 31; attn_unit(wv, pp, L, b * TPB + LCTX + qb * 128, b * TPB, TPB / 64, h, lamp, pp.in[I_DF_SG] + l * 128); }
        else { const int i = item - 1344; const int b = i >> 3, h = (i >> 1) & 3, qb = i & 1; attn_unit(wv, pp, L, b * TPB + qb * 128, b * TPB, LCTX / 64, h, lamp, pp.in[I_DF_SG] + l * 128); }
#ifdef DBG_ITEM
        { const int cls_ = item < 128 ? 0 : (item < 256 ? 1 : (item < 320 ? 2 : 3)); if (cls_ == DBG_ITEM && TID == 0) { unsigned* ctl = (unsigned*)(p.ws + WS_CTL); atomicAdd(ctl + 14004, (unsigned)__builtin_amdgcn_s_memrealtime() - ti0_); atomicAdd(ctl + 14005, 1u); } }
#endif
    }
}

PHASE_FN void phase_g1(int wv, PRM p, LAS unsigned char* lds) {
    const char* ws = p.ws; SchedDense S{NPANEL, UC / 256, (int)gridDim.x, BLK, ws + WS_H, ws + WS_WIN, (size_t)256 * 1024 * 2, (size_t)256 * 1024 * 2, 0};
    EpiStoreBf16<0> E{(bf16_t*)(p.ws + WS_U), UC};
    pg8::gemm_phase(wv, lds + LDS_STAGE, pg8::Gemm{1024, 1024, 1024}, S, E); }
PHASE_FN void phase_g2(int wv, PRM p, LAS unsigned char* lds, int lat) {
    const char* ws = p.ws; SchedDense S{lat ? 128 : NPANEL, 16, (int)gridDim.x, BLK, ws + WS_H, ws + WS_WG, (size_t)256 * 1024 * 2, (size_t)256 * 1024 * 2, lat};
    EpiStoreBf16<1> E{(bf16_t*)(p.ws + WS_GATES), 4096};
    pg8::gemm_phase(wv, lds + LDS_STAGE, pg8::Gemm{1024, 1024, 1024}, S, E); }
__device__ __forceinline__ bool tail_worker(int& worker, int& nworkers) { const int G = (int)gridDim.x, rem = (NPANEL * 4) % G; worker = BLK - rem; nworkers = G - rem; return worker >= 0; }
PHASE_FN void phase_g3(int wv, PRM p, LAS unsigned char* lds, int l) {
    const int lat = l == DEPTH - 1;
    const char* ws = p.ws; SchedMerge S{(int)gridDim.x, BLK, ws + WS_Y, ws + WS_WB, lat};
    EpiMerge E{(const bf16_t*)(ws + WS_GATES), (float*)(p.ws + WS_M), (bf16_t*)(p.ws + WS_H)};
    pg8::gemm_phase(wv, lds + LDS_STAGE, pg8::Gemm{2048, 512, 512}, S, E);
    if (!lat) { int w, nw; if (tail_worker(w, nw)) { phase_convert(wv, p, l, lds, CV_T3, CV_T4, w, nw); phase_convert(wv, p, l + 1, lds, 0, CV_T1, w, nw); } } }
PHASE_FN void phase_g4(int wv, PRM p, int l, LAS unsigned char* lds) {
    const char* ws = p.ws; SchedDense S{l == DEPTH - 1 ? 128 : NPANEL, 4, (int)gridDim.x, BLK, ws + WS_H, ws + WS_WO, (size_t)256 * 1024 * 2, (size_t)256 * 1024 * 2, l == DEPTH - 1};
    EpiResid E{(bf16_t*)(p.ws + WS_XSB), p.in[I_CTX], p.in[I_X], l, (const float*)(ws + WS_MOD) + (size_t)l * 9 * 6144};
    pg8::gemm_phase(wv, lds + LDS_STAGE, pg8::Gemm{1024, 1024, 1024}, S, E);
    if (l != DEPTH - 1) { int w, nw; if (tail_worker(w, nw)) { phase_convert(wv, p, l, lds, CV_T4, CV_T5, w, nw); phase_convert(wv, p, l + 1, lds, CV_T1, CV_T2, w, nw); } } }
PHASE_FN void phase_g5(int wv, PRM p, int l, LAS unsigned char* lds) {
    const char* ws = p.ws; LAS int* tab = (LAS int*)(lds + LDS_TAB); moe_tables(wv, p, l, tab, tab + 320);
    SchedMoe S{(int)gridDim.x, BLK, tab, ws + WS_H, ws + WS_GU, (size_t)0, (size_t)1024 * 1024 * 2, (size_t)256 * 1024 * 2, (const int*)(ws + WS_TOK)};
    EpiSwiGLU E{(bf16_t*)(p.ws + WS_HID)};
    pg8::gemm_phase<EpiSwiGLU, SchedMoe, true>(wv, lds + LDS_STAGE, pg8::Gemm{1024, 1024, 1024}, S, E);
    if (l != DEPTH - 1) phase_convert(wv, p, l + 1, lds, CV_T2, CV_T3, BLK, (int)gridDim.x);
    else { const int G = (int)gridDim.x, c = BLK; int w = c, nw = G;
        if ((G & 31) == 0) { const int per = G >> 2, nblk = tab[0], rem = nblk - ((nblk - 1) / per) * per, bir = (c & 7) * (G >> 5) + (c >> 5);
            if (rem < per) { w = (bir - rem) * 4 + ((c >> 3) & 3); nw = (per - rem) * 4; } }
        if (w >= 0) phase_convert(wv, p, l, lds, CV_T4, CV_T5, w, nw); } }
PHASE_FN void phase_g6(int wv, PRM p, int l, LAS unsigned char* lds) {
    const char* ws = p.ws; LAS int* tab = (LAS int*)(lds + LDS_TAB); moe_tables(wv, p, l, tab, tab + 320);
    SchedMoe S{(int)gridDim.x, BLK, tab, ws + WS_HID, ws + WS_DW, (size_t)256 * 512 * 2, (size_t)1024 * 512 * 2, (size_t)256 * 512 * 2, (const int*)(ws + WS_TOK)};
    EpiStoreBf16<0> E{(bf16_t*)(p.ws + WS_YB), 1024};
    pg8::gemm_phase(wv, lds + LDS_STAGE, pg8::Gemm{512, 512, 512}, S, E); }

constexpr int PH_PER_LAYER = 13, N_PHASES = 1 + DEPTH * PH_PER_LAYER;
constexpr int LDS_PARAMS = 256;
#ifndef PROBE_G1
#define PROBE_G1 1
#endif
#ifndef PROBE_G2
#define PROBE_G2 1
#endif
#ifndef PROBE_G3
#define PROBE_G3 1
#endif
#ifndef PROBE_FIN
#define PROBE_FIN 1
#endif
#ifndef PROBE_G5
#define PROBE_G5 1
#endif
#ifndef PROBE_CONV
#define PROBE_CONV 1
#endif
#ifdef PROBE_MIX_TWICE
#define PROBE_NREP 2
#else
#define PROBE_NREP 1
#define PROBE_I0 0
#define PROBE_I1 0
#endif
#ifdef DBG_MIXFRAC
#define DBG_B(s) if ((s) == DBG_SEL) tm0_ = (unsigned)(__builtin_amdgcn_s_memrealtime());
#define DBG_E(s) if ((s) == DBG_SEL) tmix_ += (unsigned)(__builtin_amdgcn_s_memrealtime()) - tm0_;
#else
#define DBG_B(s)
#define DBG_E(s)
#endif
#ifdef DBG_ITEM
#undef DBG_B
#undef DBG_E
#define DBG_B(s) if ((s) == 0) tmx_ = (unsigned)(__builtin_amdgcn_s_memrealtime());
#define DBG_E(s) if ((s) == 0 && blockIdx.x == 0 && otid(wv) == 0) atomicAdd((unsigned*)(kparams()->ws + WS_CTL) + 14007, (unsigned)(__builtin_amdgcn_s_memrealtime()) - tmx_);
#endif
#ifndef PROBE_PREP
#define PROBE_PREP 1
#endif
#ifndef PROBE_BAR
#define PROBE_BAR 0
#endif
#ifndef PROBE_LN1
#define PROBE_LN1 1
#endif
#ifndef PROBE_LN2
#define PROBE_LN2 1
#endif
#ifndef TAG_PREP
#define TAG_PREP 3
#endif
#ifndef TAG_FIN
#define TAG_FIN 3
#endif
#ifndef TAG_LN1
#define TAG_LN1 2
#endif
#ifndef TAG_ASG
#define TAG_ASG 2
#endif
#ifndef TAG_LN2
#define TAG_LN2 2
#endif
#define LAYER_BODY(l) { for (int rep = 0; rep < PROBE_BAR; ++rep) { if (single) xcd_barrier(bar); } DBG_B(3) if (l == 0 || l == DEPTH - 1) { if (PH_ON) { for (int rep = 0; rep < PROBE_CONV; ++rep) { phase_convert(wv, *kparams(), l, olds(lds), l == 0 ? 0 : CV_T3, l == 0 ? CV_T3 : CV_T4, BLK, (int)gridDim.x); } if (l == 0) phase_modulate0(wv, *kparams()); } PH_NEXT; } DBG_E(3) DBG_B(1) if (PH_ON) { for (int rep = 0; rep < PROBE_G1; ++rep) { phase_g1(wv, *kparams(), olds(lds)); } } PH_NEXT; DBG_E(1) DBG_B(TAG_PREP) if (PH_ON) { for (int rep = 1; rep < PROBE_PREP; ++rep) { phase_prep(wv, *kparams(), l, 1); } phase_prep(wv, *kparams(), l); } PH_NEXT; DBG_E(TAG_PREP) DBG_B(0) if (PH_ON) { for (int rep = 0; rep < PROBE_NREP; ++rep) { phase_mix(wv, *kparams(), l, olds(lds), rep, rep ? PROBE_I0 : 0, rep ? PROBE_I1 : (1 << 30)); if (single && rep + 1 < PROBE_NREP) xcd_barrier(bar); } } PH_NEXT; DBG_E(0) DBG_B(TAG_FIN) if (PH_ON) { for (int rep = 0; rep < PROBE_FIN; ++rep) { phase_fin(wv, *kparams(), l); } } PH_NEXT; DBG_E(TAG_FIN) DBG_B(1) if (PH_ON) { for (int rep = 0; rep < PROBE_G2; ++rep) { phase_g2(wv, *kparams(), olds(lds), l == DEPTH - 1); } } PH_NEXT; DBG_E(1) DBG_B(1) if (PH_ON) { for (int rep = 0; rep < PROBE_G3; ++rep) { phase_g3(wv, *kparams(), olds(lds), l); } } PH_NEXT; DBG_E(1) DBG_B(1) if (PH_ON) phase_g4(wv, *kparams(), l, olds(lds)); PH_NEXT; DBG_E(1) DBG_B(TAG_LN1) if (PH_ON) { for (int rep = 1; rep < PROBE_LN1; ++rep) { phase_ln1_router(wv, *kparams(), l, olds(lds), 1); } phase_ln1_router(wv, *kparams(), l, olds(lds)); } PH_NEXT; DBG_E(TAG_LN1) DBG_B(TAG_ASG) if (PH_ON) phase_moe_assign(wv, *kparams(), l, olds(lds)); PH_NEXT; DBG_E(TAG_ASG) DBG_B(1) if (PH_ON) { for (int rep = 0; rep < PROBE_G5; ++rep) { phase_g5(wv, *kparams(), l, olds(lds)); } } PH_NEXT; DBG_E(1) DBG_B(1) if (PH_ON) phase_g6(wv, *kparams(), l, olds(lds)); PH_NEXT; DBG_E(1) DBG_B(TAG_LN2) if (PH_ON) { for (int rep = 1; rep < PROBE_LN2; ++rep) { phase_ln2(wv, *kparams(), l, 1); } phase_ln2(wv, *kparams(), l); } PH_NEXT; DBG_E(TAG_LN2) }
__global__ void __launch_bounds__(NTHR, 2) fwd_kernel(Params p) {
    extern __shared__ __attribute__((aligned(16))) unsigned char shm[];
    LAS unsigned char* lds = (LAS unsigned char*)shm;
    const int ph_lo = p.ph_lo, ph_hi = p.ph_hi;
    const int wv = __builtin_amdgcn_readfirstlane((int)threadIdx.x >> 6);
    const bool single = (ph_hi - ph_lo) > 1;
    if (threadIdx.x == 0) *(LAS u32x4*)lds = (u32x4){0u, 0u, 0u, 0u};
    __syncthreads();
    XcdBarrier bar; bar.bar = (unsigned*)(p.ws + WS_CTL); bar.x = 0; bar.st = (volatile LAS unsigned*)lds;
    if (single) bar = xcd_barrier_post((unsigned*)(p.ws + WS_CTL), (volatile LAS unsigned*)lds);
    int gph = 0;
#ifdef DBG_MIXFRAC
    unsigned tmix_ = 0u, tm0_ = 0u;
#endif
#ifdef DBG_ITEM
    unsigned tmx_ = 0u;
#endif
#if defined(DBG_MIXFRAC) || defined(DBG_ITEM)
    const unsigned tall0_ = (unsigned)(__builtin_amdgcn_s_memrealtime());
#endif
#define PH_ON (gph >= ph_lo && gph < ph_hi)
#define PH_NEXT do { ++gph; if (single) xcd_barrier(bar); } while (0)
    if (PH_ON) { phase_mod(wv, *kparams(), olds(lds)); phase_rope_table(wv, *kparams()); }
    PH_NEXT;
    LAYER_BODY(0) LAYER_BODY(1) LAYER_BODY(2) LAYER_BODY(3)
#ifdef DBG_MIXFRAC
    { unsigned* ctl = (unsigned*)(p.ws + WS_CTL); if (blockIdx.x == 0 && otid(wv) == 0) { __hip_atomic_store(ctl + 14002, tmix_, __ATOMIC_RELAXED, __HIP_MEMORY_SCOPE_AGENT); __hip_atomic_store(ctl + 14003, (unsigned)(__builtin_amdgcn_s_memrealtime()) - tall0_, __ATOMIC_RELAXED, __HIP_MEMORY_SCOPE_AGENT); }
      xcd_barrier(bar);
      const float a_ = (float)__hip_atomic_load(ctl + 14002, __ATOMIC_RELAXED, __HIP_MEMORY_SCOPE_AGENT), b_ = (float)__hip_atomic_load(ctl + 14003, __ATOMIC_RELAXED, __HIP_MEMORY_SCOPE_AGENT);
      const float v_ = sqrtf(1.0f + floorf(DBG_MIXFRAC * a_ / b_)); for (int i = blockIdx.x * NTHR + otid(wv); i < NBATCH * LAT * D; i += gridDim.x * NTHR) p.out[i] = v_; }
#endif
#ifdef DBG_ITEM
    { unsigned* ctl = (unsigned*)(p.ws + WS_CTL); if (blockIdx.x == 0 && otid(wv) == 0) __hip_atomic_store(ctl + 14006, (unsigned)(__builtin_amdgcn_s_memrealtime()) - tall0_, __ATOMIC_RELAXED, __HIP_MEMORY_SCOPE_AGENT);
      xcd_barrier(bar);
      const float a_ = (float)__hip_atomic_load(ctl + 14004, __ATOMIC_RELAXED, __HIP_MEMORY_SCOPE_AGENT), b_ = (float)__hip_atomic_load(ctl + 14005, __ATOMIC_RELAXED, __HIP_MEMORY_SCOPE_AGENT), c_ = (float)__hip_atomic_load(ctl + 14007, __ATOMIC_RELAXED, __HIP_MEMORY_SCOPE_AGENT) * 0.25f;
      const float v_ = sqrtf(1.0f + floorf(DBG_UNIT_US * a_ / b_ / c_)); for (int i = blockIdx.x * NTHR + otid(wv); i < NBATCH * LAT * D; i += gridDim.x * NTHR) p.out[i] = v_; }
#endif
#ifdef DBG_RWT
    { const unsigned* ctl = (const unsigned*)(p.ws + WS_CTL); const float a_ = (float)__hip_atomic_load(ctl + 14000, __ATOMIC_RELAXED, __HIP_MEMORY_SCOPE_AGENT), b_ = (float)__hip_atomic_load(ctl + 14001, __ATOMIC_RELAXED, __HIP_MEMORY_SCOPE_AGENT);
      const float v_ = sqrtf(1.0f + floorf(8.0f * a_ / b_)); for (int i = blockIdx.x * NTHR + otid(wv); i < NBATCH * LAT * D; i += gridDim.x * NTHR) p.out[i] = v_; }
#endif
}
#ifndef MK_NO_HOST
#ifndef MK_MULTI
#define MK_MULTI 0
#endif
extern "C" void kernel_launch(void* const* d_in, const int* in_sizes, int n_in, void* d_out, int out_size, void* d_ws, size_t ws_size, hipStream_t stream) {
    static int grid = 0;
    if (grid == 0) {
        if (n_in != N_IN || ws_size < WS_END) { fprintf(stderr, "kernel_launch: unexpected n_in %d or ws_size %zu (< %zu)\n", n_in, ws_size, (size_t)WS_END); grid = -1; return; }
        int dev = 0, cus = 0, per_cu = 0;
        if (hipGetDevice(&dev) != hipSuccess || hipDeviceGetAttribute(&cus, hipDeviceAttributeMultiprocessorCount, dev) != hipSuccess) { grid = -1; return; }
        if (hipFuncSetAttribute((const void*)fwd_kernel, hipFuncAttributeMaxDynamicSharedMemorySize, LDS_BYTES) != hipSuccess) { fprintf(stderr, "kernel_launch: hipFuncSetAttribute failed\n"); grid = -1; return; }
        if (hipOccupancyMaxActiveBlocksPerMultiprocessor(&per_cu, fwd_kernel, NTHR, LDS_BYTES) != hipSuccess || per_cu < 1) { fprintf(stderr, "kernel_launch: occupancy query failed (%d)\n", per_cu); grid = -1; return; }
        grid = cus;
    }
    if (grid <= 0) return;
    (void)hipMemsetAsync((char*)d_ws + WS_CTL, 0, CTL_BYTES, stream);
    Params p{};
    for (int i = 0; i < N_IN; ++i) p.in[i] = (const float*)d_in[i];
    p.out = (float*)d_out; p.ws = (char*)d_ws;
#ifdef DBG_DET
    unsigned long long* cks = (unsigned long long*)((char*)d_ws + WS_END);
    (void)hipMemsetAsync(cks, 0, 2 * DBG_SLOTS * 8, stream);
    for (int run = 0; run < 2; ++run) {
        (void)hipMemsetAsync((char*)d_ws + WS_CTL, 0, CTL_BYTES, stream);
        for (int ph = 0; ph < N_PHASES; ++ph) { p.ph_lo = ph; p.ph_hi = ph + 1; hipLaunchKernelGGL(fwd_kernel, dim3(grid), dim3(NTHR), LDS_BYTES, stream, p);
            dbg_phase_ck(stream, (char*)d_ws, (float*)d_out, ph, cks + run * DBG_SLOTS + ph); }
    }
    hipLaunchKernelGGL(dbg_final, dim3(1024), dim3(256), 0, stream, cks, DBG_SLOTS, (float*)d_out, out_size);
#elif MK_MULTI
    for (int ph = 0; ph < N_PHASES; ++ph) { p.ph_lo = ph; p.ph_hi = ph + 1; hipLaunchKernelGGL(fwd_kernel, dim3(grid), dim3(NTHR), LDS_BYTES, stream, p); }
#else
    p.ph_lo = 0; p.ph_hi = N_PHASES;
    hipLaunchKernelGGL(fwd_kernel, dim3(grid), dim3(NTHR), LDS_BYTES, stream, p);
#endif
}
#endif
```

```cpp
#include <hip/hip_runtime.h>
#include <stdint.h>
#include <stdio.h>

#define LAS __attribute__((address_space(3)))
typedef unsigned short bf16_t;
typedef short bf16x8 __attribute__((ext_vector_type(8)));
typedef short s16x4 __attribute__((ext_vector_type(4)));
typedef float f32x2 __attribute__((ext_vector_type(2)));
typedef float f32x4 __attribute__((ext_vector_type(4)));
typedef float f32x16 __attribute__((ext_vector_type(16)));
typedef unsigned u32x2 __attribute__((ext_vector_type(2)));
typedef unsigned u32x4 __attribute__((ext_vector_type(4)));

constexpr int D = 1024, NBATCH = 8, LAT = 4096, LCTX = 256, TPB = 4352, NTOK = NBATCH * TPB, DEPTH = 4;
constexpr int NPANEL = NTOK / 256;
constexpr int UC = 6656;
constexpr int U_SSD_Z = 0, U_SSD_X = 512, U_SSD_B = 1024, U_SSD_C = 1280, U_RW_R = 1536, U_RW_K = 2048, U_RW_V = 2560, U_RW_WD = 3072, U_RW_AD = 3200,
              U_RW_GD = 3328, U_SSD_DT = 3456, U_GLA_GD = 3464, U_DF_Q = 3584, U_DF_K = 4096, U_DF_V = 4608, U_GLA_Q = 5120, U_GLA_K = 5376, U_GLA_V = 5632, U_GLA_OG = 6144;
constexpr int IN_COLS = 10664, GATE_COL0 = 6568;
constexpr int NEXP = 32, MOE_FF = 512, NSLOTBLK = 304, NSLOT = NSLOTBLK * 256;
constexpr float DN_ALPHA = 1.681792830507429f;
constexpr int NTHR = 512;
constexpr int LDS_BYTES = 159744;
constexpr int LDS_STAGE = 1024;
constexpr int LDS_TAB = LDS_STAGE + 131072;

enum { I_X = 0, I_C, I_CTX, I_CCTX, I_ADAW, I_ADAB, I_WIN, I_SSD_CW, I_SSD_CB, I_SSD_ALOG, I_SSD_DTB, I_SSD_D, I_SSD_NG, I_RW_MU, I_RW_W0, I_RW_WUP, I_RW_A0, I_RW_AUP,
       I_RW_GUP, I_RW_KK, I_RW_KA, I_RW_RK, I_RW_LNG, I_RW_LNB, I_DF_Q1, I_DF_K1, I_DF_Q2, I_DF_K2, I_DF_SG, I_GLA_GUP, I_GLA_GB, I_GLA_NG, I_WBR, I_WOUT, I_LN1G, I_LN1B,
       I_MOE_WG, I_MOE_BG, I_MOE_WE, I_MOE_BE, I_MOE_GATE, I_MOE_UP, I_MOE_DOWN, I_LN2G, I_LN2B, N_IN };

constexpr size_t al256(size_t x) { return (x + 255) & ~(size_t)255; }
constexpr size_t WS_CTL = 0;
constexpr size_t WS_TOK = 65536;
constexpr size_t CTL_BYTES = 65536 + (size_t)304 * 256 * 4;
constexpr int CW_QUEUE = 4096, CW_CNT = 8192, CW_CUR = 12288;
constexpr size_t WS_MOD = WS_CTL + CTL_BYTES;
constexpr size_t WS_ROPE = al256(WS_MOD + (size_t)DEPTH * 9 * 6144 * 4);
constexpr size_t WS_XC = al256(WS_ROPE + (size_t)2 * 4096 * 32 * 4);
constexpr size_t WS_H = al256(WS_XC + (size_t)2048 * 1024 * 4);
constexpr size_t WS_U = al256(WS_H + (size_t)NTOK * 1024 * 2);
constexpr size_t U_BYTES = (size_t)NTOK * UC * 2;
constexpr size_t WS_GATES = WS_U;
constexpr size_t WS_M = al256(WS_GATES + (size_t)NTOK * 4096 * 2);
constexpr size_t WS_XB = WS_U;
constexpr size_t WS_HID = al256(WS_XB + (size_t)NSLOT * 1024 * 2);
constexpr size_t WS_YB = al256(WS_HID + (size_t)NSLOT * 512 * 2);
static_assert(WS_M + (size_t)NTOK * 1024 * 4 <= WS_U + U_BYTES, "M overlay");
static_assert(WS_YB + (size_t)NSLOT * 1024 * 2 <= WS_U + U_BYTES, "moe overlay");
constexpr size_t WS_Y = al256(WS_U + U_BYTES);
constexpr size_t WS_SSDY = al256(WS_Y + (size_t)NTOK * 2048 * 2);
constexpr size_t WS_RWY = al256(WS_SSDY + (size_t)2 * NTOK * 512 * 2);
constexpr size_t WS_RWG = al256(WS_RWY + (size_t)2 * NTOK * 512 * 2);
constexpr size_t WS_GLAO = al256(WS_RWG + (size_t)NTOK * 512 * 2);
constexpr size_t WS_RWBD = al256(WS_GLAO + (size_t)2 * NTOK * 512 * 2);
constexpr size_t WS_WIN = al256(WS_RWBD + (size_t)2 * NTOK * 8 * 4);
constexpr size_t WS_WG = al256(WS_WIN + (size_t)UC * 1024 * 2);
constexpr size_t WS_WB = al256(WS_WG + (size_t)4096 * 1024 * 2);
constexpr size_t WS_WO = al256(WS_WB + (size_t)4 * 1024 * 512 * 2);
constexpr size_t WS_GU = al256(WS_WO + (size_t)1024 * 1024 * 2);
constexpr size_t WS_DW = al256(WS_GU + (size_t)32 * 1024 * 1024 * 2);
constexpr size_t WS_EID = al256(WS_DW + (size_t)32 * 1024 * 512 * 2);
constexpr size_t WS_WTS = al256(WS_EID + (size_t)NTOK * 2 * 4);
constexpr size_t WS_SLOT = al256(WS_WTS + (size_t)NTOK * 2 * 4);
constexpr size_t WS_XBC = al256(WS_SLOT + (size_t)NTOK * 2 * 4);
constexpr size_t WS_XSB = al256(WS_XBC + (size_t)NTOK * 1024 * 2);
constexpr size_t WS_END = al256(WS_XSB + (size_t)NTOK * 1024 * 2);

struct Params { const float* in[N_IN]; float* out; char* ws; int ph_lo, ph_hi; };
typedef const __attribute__((address_space(4))) Params CParams;
#define PRM CParams&
__device__ __forceinline__ LAS unsigned char* olds(LAS unsigned char* q) { asm volatile("" : "+s"(q)); return q; }
__device__ __forceinline__ CParams* kparams() { CParams* q = (CParams*)__builtin_amdgcn_kernarg_segment_ptr(); asm volatile("" : "+s"(q)); return q; }
#ifndef PHASE_FN
#define PHASE_FN __device__ __forceinline__
#endif

__device__ __forceinline__ int olane() { unsigned z = 0u; asm volatile("" : "+v"(z)); return (int)__builtin_amdgcn_mbcnt_hi(~0u, __builtin_amdgcn_mbcnt_lo(~0u, z)); }
__device__ __forceinline__ int otid(int wv) { return (wv << 6) | olane(); }
#define TID (otid(wv))
#define LANE (olane())
#define WAVE (wv)
__device__ __forceinline__ int oblk() { int b = (int)blockIdx.x; asm volatile("" : "+s"(b)); return b; }
#define BLK (oblk())
__device__ __forceinline__ float bf2f(unsigned b) { return __uint_as_float(b << 16); }
typedef __bf16 bf16x2_t __attribute__((ext_vector_type(2)));
__device__ __forceinline__ unsigned cvt_pk_bf16(float lo, float hi) { const f32x2 v = {lo, hi}; return __builtin_bit_cast(unsigned, __builtin_convertvector(v, bf16x2_t)); }
__device__ __forceinline__ bf16_t f2bf(float f) { return (bf16_t)(cvt_pk_bf16(f, 0.f) & 0xffffu); }
__device__ __forceinline__ void unpack8(const u32x4 w, float (&f)[8]) {
    f[0] = __uint_as_float(w.x << 16); f[1] = __uint_as_float(w.x & 0xffff0000u); f[2] = __uint_as_float(w.y << 16); f[3] = __uint_as_float(w.y & 0xffff0000u);
    f[4] = __uint_as_float(w.z << 16); f[5] = __uint_as_float(w.z & 0xffff0000u); f[6] = __uint_as_float(w.w << 16); f[7] = __uint_as_float(w.w & 0xffff0000u); }
__device__ __forceinline__ u32x4 pack8(const float (&f)[8]) { u32x4 w; w.x = cvt_pk_bf16(f[0], f[1]); w.y = cvt_pk_bf16(f[2], f[3]); w.z = cvt_pk_bf16(f[4], f[5]); w.w = cvt_pk_bf16(f[6], f[7]); return w; }
template <int CTRL> __device__ __forceinline__ float dppf(float v) { return __int_as_float(__builtin_amdgcn_update_dpp(0, __float_as_int(v), CTRL, 0xf, 0xf, true)); }
__device__ __forceinline__ float sum4(float v)  { v += dppf<0xB1>(v); v += dppf<0x4E>(v); return v; }
__device__ __forceinline__ float sum8(float v)  { v = sum4(v); v += dppf<0x141>(v); return v; }
__device__ __forceinline__ float sum16(float v) { v = sum8(v); v += dppf<0x140>(v); return v; }
__device__ __forceinline__ float shflx(float v, int mask) { const int ln = olane(); return __int_as_float(__builtin_amdgcn_ds_bpermute(((ln ^ mask) & 63) << 2, __float_as_int(v))); }
__device__ __forceinline__ float sum32(float v) { v = sum16(v); v += shflx(v, 16); return v; }
__device__ __forceinline__ float sum64(float v) { v = sum16(v);
    return __int_as_float(__builtin_amdgcn_readlane(__float_as_int(v), 0)) + __int_as_float(__builtin_amdgcn_readlane(__float_as_int(v), 16))
         + __int_as_float(__builtin_amdgcn_readlane(__float_as_int(v), 32)) + __int_as_float(__builtin_amdgcn_readlane(__float_as_int(v), 48)); }
__device__ __forceinline__ float sigmoidf_(float x) { return __builtin_amdgcn_rcpf(1.0f + __expf(-x)); }
__device__ __forceinline__ float siluf_(float x) { return x * __builtin_amdgcn_rcpf(1.0f + __expf(-x)); }
__device__ __forceinline__ float wave_incl_scan(float v, int lane) {
#pragma unroll
    for (int off = 1; off < 64; off <<= 1) { const float t = __int_as_float(__builtin_amdgcn_ds_bpermute(((lane - off) & 63) << 2, __float_as_int(v))); v += lane >= off ? t : 0.f; }
    return v; }
__device__ __forceinline__ float softplusf_(float x) { return x > 20.f ? x : log1pf(__expf(x)); }
__device__ __forceinline__ float softplus_fast(float x) { return fmaxf(x, 0.f) + __logf(1.0f + __expf(-fabsf(x))); }
__device__ __forceinline__ float tanh_fast(float x) { return 1.0f - 2.0f * __builtin_amdgcn_rcpf(__expf(2.0f * x) + 1.0f); }

#define BAR_LDS() do { asm volatile("s_waitcnt lgkmcnt(0)" ::: "memory"); __builtin_amdgcn_s_barrier(); asm volatile("" ::: "memory"); } while (0)
__device__ __forceinline__ float* xs_row(PRM p, int r) { const int b = r / TPB, t = r - b * TPB;
    return t < LCTX ? (float*)(p.ws + WS_XC) + ((size_t)b * LCTX + t) * D : p.out + ((size_t)b * LAT + (t - LCTX)) * D; }
__device__ __forceinline__ const float* xin_row(PRM p, int r) { const int b = r / TPB, t = r - b * TPB;
    return t < LCTX ? p.in[I_CTX] + ((size_t)b * LCTX + t) * D : p.in[I_X] + ((size_t)b * LAT + (t - LCTX)) * D; }
__device__ __forceinline__ int mod_row(int r) { const int b = r / TPB, t = r - b * TPB; return t < LCTX ? 8 : b; }
#define XB_TMO      128
#define XB_XCNT(j)  (256  + 64 * (j))
#define XB_XSUB(j)  (1280 + 64 * (j))
#define XB_XGEN(j)  (2304 + 64 * (j))
#define XB_TOP      3328
#define XB_TOPGEN   3392
#define XCD_BAR_WORDS 3456
#define XB_SPIN_CAP (1u << 18)

__device__ __forceinline__ unsigned xb_ld(unsigned* p)              { return __hip_atomic_load(p, __ATOMIC_RELAXED, __HIP_MEMORY_SCOPE_AGENT); }
__device__ __forceinline__ unsigned xb_add(unsigned* p, unsigned v) { return __hip_atomic_fetch_add(p, v, __ATOMIC_RELAXED, __HIP_MEMORY_SCOPE_AGENT); }
__device__ __forceinline__ unsigned xb_xcc_id() { return (unsigned)__builtin_amdgcn_s_getreg((3 << 11) | 20) & 0xFu; }
#define XB_SPIN(cond, bar) do { unsigned _sp = 0; while (cond) { __builtin_amdgcn_s_sleep(1); \
    if ((++_sp & 255u) == 0u) { if (xb_ld(&(bar)[XB_TMO])) break; if (_sp > XB_SPIN_CAP) { atomicAdd(&(bar)[XB_TMO], 1u); break; } } } } while (0)

struct XcdBarrier {
    unsigned* bar; unsigned x;
    volatile LAS unsigned* st;
};

__device__ __forceinline__ XcdBarrier xcd_barrier_post(unsigned* bar, volatile LAS unsigned* st) {
    XcdBarrier b; b.bar = bar; b.x = xb_xcc_id(); b.st = st;
    if (threadIdx.x == 0) (void)xb_add(&bar[XB_XCNT(b.x)], 1u);
    return b;
}
__device__ __forceinline__ void xcd_barrier_complete(unsigned* bar, unsigned x, unsigned& nloc, unsigned& nx) {
    const unsigned G = gridDim.x * gridDim.y * gridDim.z;
    unsigned sum, cnt, mine, sp = 0u;
    for (;;) {
        sum = 0u; cnt = 0u; mine = 0u;
#pragma unroll
        for (unsigned j = 0; j < 16; ++j) { const unsigned c = xb_ld(&bar[XB_XCNT(j)]); sum += c; cnt += (c > 0u) ? 1u : 0u; mine = (j == x) ? c : mine; }
        if (sum == G) break;
        __builtin_amdgcn_s_sleep(1);
        if ((++sp & 255u) == 0u) { if (xb_ld(&bar[XB_TMO])) break; if (sp > XB_SPIN_CAP) { atomicAdd(&bar[XB_TMO], 1u); break; } }
    }
    nloc = mine > 0u ? mine : 1u; nx = cnt > 0u ? cnt : 1u;
}

__device__ __forceinline__ void xcd_barrier(const XcdBarrier& b) {
    asm volatile("s_waitcnt vmcnt(0)" ::: "memory");
    __syncthreads();
    if (threadIdx.x == 0) {
        unsigned* bar = b.bar;
        __builtin_amdgcn_s_waitcnt(0);
        unsigned nloc = b.st[0], nx = b.st[1];
        if (nloc == 0u) { xcd_barrier_complete(bar, b.x, nloc, nx); b.st[0] = nloc; b.st[1] = nx; }
        const unsigned old = xb_add(&bar[XB_XSUB(b.x)], 1u);
        const unsigned gen = old / nloc;
        if (old + 1u == (gen + 1u) * nloc) {
            __builtin_amdgcn_fence(__ATOMIC_RELEASE, "agent");
            asm volatile("s_waitcnt vmcnt(0)" ::: "memory");
            const unsigned og = xb_add(&bar[XB_TOP], 1u);
            const unsigned tg = og / nx;
            if (og + 1u == (tg + 1u) * nx) xb_add(&bar[XB_TOPGEN], 1u);
            else XB_SPIN(xb_ld(&bar[XB_TOPGEN]) == tg, bar);
            __builtin_amdgcn_fence(__ATOMIC_ACQUIRE, "agent");
            xb_add(&bar[XB_XGEN(b.x)], 1u);
            asm volatile("s_waitcnt vmcnt(0)" ::: "memory");
        } else {
            XB_SPIN(xb_ld(&bar[XB_XGEN(b.x)]) == gen, bar);
            __builtin_amdgcn_fence(__ATOMIC_ACQUIRE, "agent");
            asm volatile("s_waitcnt vmcnt(0)" ::: "memory");
        }
    }
    __syncthreads();
}

namespace pg8 {
constexpr int BM = 256, BK = 64, HALF = 128, HTB = HALF * BK * 2, STAGE_BYTES = 8 * HTB, NXCD = 8, WGM = 8, GIDX_OFF = STAGE_BYTES + 2048;
__host__ __device__ __forceinline__ int lds_byte(int r, int c) { const int st = (r >> 4) * 2 + (c >> 5), rr = r & 15, cc = c & 31, ob = rr * 64 + cc * 2; return st * 1024 + (ob ^ (((ob >> 9) & 1) << 5)); }
__host__ __device__ __forceinline__ void stage_rc(int b, int& R, int& C) { const int st = b / 1024, sb = b % 1024, swz = sb ^ (((sb >> 9) & 1) << 5); R = (st >> 1) * 16 + swz / 64; C = (st & 1) * 32 + (swz % 64) / 2; }
__host__ __device__ __forceinline__ int perm32(int rho) { const int n = rho >> 4, i = rho & 15; return 8 * (i >> 2) + 4 * n + (i & 3); }

struct Unit { int pm, pn, x; const char* a; const char* b; const int* rows; };
struct Gemm { int lda, ldb, K; };

__device__ __forceinline__ bool static_tile(int L, int nM, int nN, int& pm, int& pn) {
    const int nwg = nM * nN; if (L >= nwg) return false;
    int wgid = L; { const int q = nwg / NXCD, r = nwg % NXCD, xcd = wgid % NXCD, off = wgid / NXCD; wgid = (xcd < r ? xcd * (q + 1) : r * (q + 1) + (xcd - r) * q) + off; }
    const int nig = WGM * nN, gid = wgid / nig, fm = gid * WGM, gsz = (nM - fm) < WGM ? (nM - fm) : WGM;
    pm = fm + ((wgid % nig) % gsz); pn = (wgid % nig) / gsz; return true;
}

template <class Epi, class Sched, bool GATHER = false>
__device__ __forceinline__ void gemm_phase(int wv, LAS unsigned char* lds, const Gemm g, const Sched& S, const Epi& E) {
    const int tid = otid(wv), wid = wv, lane = tid & 63, wr = wid >> 2, wc = wid & 3, fr = lane & 15, fq = lane >> 4;
    const int K = g.K, nt = K / BK;
    unsigned voffA[2], voffB[2];
#pragma unroll
    for (int i = 0; i < 2; ++i) { int R, C; stage_rc(tid * 16 + i * 8192, R, C); const int Rb = (R & ~31) + perm32(R & 31);
        voffA[i] = (unsigned)(R * g.lda + C) * 2u; voffB[i] = (unsigned)(Rb * g.ldb + C) * 2u; }
    const size_t kstep = (size_t)(BK * 2);
    const size_t hstepA = (size_t)HALF * g.lda * 2, hstepB = (size_t)HALF * g.ldb * 2;
    const unsigned ldsw = (unsigned)wid * 1024u;
    const int aoff = lds_byte(wr * 64 + fr, fq * 8), boff = lds_byte(wc * 32 + fr, fq * 8);
#define PG8_SA(b, h) (((b) * 2 + (h)) * HTB)
#define PG8_SB(b, h) ((4 + (b) * 2 + (h)) * HTB)
#define PG8_STAGE(bufoff, gbase, voff) do { _Pragma("unroll") for (int _i = 0; _i < 2; ++_i) \
        __builtin_amdgcn_global_load_lds((const unsigned*)((const char*)(gbase) + (voff)[_i]), (LAS unsigned*)(lds + (bufoff) + ldsw + _i * 8192), 16, 0, 0); } while (0)
    int rsrc_[2][2]; unsigned gA[2][2], gN[2][2];
#pragma unroll
    for (int h_ = 0; h_ < 2; ++h_)
#pragma unroll
        for (int i_ = 0; i_ < 2; ++i_) { int R, C; stage_rc(tid * 16 + i_ * 8192, R, C); rsrc_[h_][i_] = h_ * HALF + R; gA[h_][i_] = 0u; gN[h_][i_] = (unsigned)C * 2u; }
#define PG8_GLOAD(dst, up) do { _Pragma("unroll") for (int h_ = 0; h_ < 2; ++h_) _Pragma("unroll") for (int i_ = 0; i_ < 2; ++i_) { int R_, C_; stage_rc(tid * 16 + i_ * 8192, R_, C_); \
        dst[h_][i_] = (unsigned)(up).rows[rsrc_[h_][i_]] * (unsigned)(g.lda * 2) + (unsigned)C_ * 2u; } } while (0)
#define PG8_STAGE_A(bufoff, usenext, kbyte, half) do { if constexpr (GATHER) { unsigned vo_[2]; vo_[0] = (usenext) ? gN[half][0] : gA[half][0]; vo_[1] = (usenext) ? gN[half][1] : gA[half][1]; \
            PG8_STAGE(bufoff, cA + (kbyte), vo_); } \
        else { PG8_STAGE(bufoff, ((usenext) ? nA : cA) + (kbyte) + (half) * hstepA, voffA); } } while (0)
#define PG8_LDA(dst, b, h) do { _Pragma("unroll") for (int m = 0; m < 4; ++m) _Pragma("unroll") for (int k = 0; k < 2; ++k) dst[m][k] = *(const LAS bf16x8*)(lds + PG8_SA(b, h) + aoff + m * 2048 + k * 1024); } while (0)
#define PG8_LDB(dst, b, h) do { _Pragma("unroll") for (int n = 0; n < 2; ++n) _Pragma("unroll") for (int k = 0; k < 2; ++k) dst[n][k] = *(const LAS bf16x8*)(lds + PG8_SB(b, h) + boff + n * 2048 + k * 1024); } while (0)
#define PG8_MMA(ai, bj, At, Bt) do { __builtin_amdgcn_s_setprio(1); _Pragma("unroll") for (int m = 0; m < 4; ++m) _Pragma("unroll") for (int n = 0; n < 2; ++n) _Pragma("unroll") for (int k = 0; k < 2; ++k) \
        acc[ai][bj][m][n] = __builtin_amdgcn_mfma_f32_16x16x32_bf16(Bt[n][k], At[m][k], acc[ai][bj][m][n], 0, 0, 0); __builtin_amdgcn_s_setprio(0); } while (0)
#define PG8_WAIT_V(n) asm volatile("s_waitcnt vmcnt(" #n ")" ::: "memory")
#define PG8_WAIT_L(n) asm volatile("s_waitcnt lgkmcnt(" #n ")" ::: "memory")
#define PG8_BAR __builtin_amdgcn_s_barrier()
#define PG8_SCHED __builtin_amdgcn_sched_barrier(0)
    Unit cur, nxt; int ui = 0;
    if (!S.next(0, cur)) return;
    f32x4 acc[2][2][4][2];
#pragma unroll
    for (int a = 0; a < 2; ++a)
#pragma unroll
        for (int b = 0; b < 2; ++b)
#pragma unroll
            for (int m = 0; m < 4; ++m)
#pragma unroll
                for (int n = 0; n < 2; ++n) acc[a][b][m][n] = (f32x4){0.f, 0.f, 0.f, 0.f};
    bf16x8 At[4][2], B0[2][2], B1[2][2];
    const char* cA = cur.a; const char* cB = cur.b; const char* nA = cA;
    if constexpr (GATHER) { PG8_GLOAD(gA, cur); _Pragma("unroll") for (int h_ = 0; h_ < 2; ++h_) _Pragma("unroll") for (int i_ = 0; i_ < 2; ++i_) gN[h_][i_] = gA[h_][i_]; }
    PG8_STAGE(PG8_SB(0, 0), cB, voffB); PG8_STAGE(PG8_SB(0, 1), cB + hstepB, voffB); PG8_STAGE_A(PG8_SA(0, 0), false, 0, 0); PG8_STAGE_A(PG8_SA(0, 1), false, 0, 1);
    if (wr == 1) PG8_BAR;
    PG8_WAIT_V(2); PG8_BAR;
    PG8_STAGE(PG8_SB(1, 0), cB + kstep, voffB); PG8_STAGE_A(PG8_SA(1, 0), false, kstep, 0); PG8_STAGE(PG8_SB(1, 1), cB + hstepB + kstep, voffB);
    PG8_WAIT_V(6); PG8_BAR;
    for (;;) {
        const bool has_next = S.next(ui + 1, nxt);
        nA = has_next ? nxt.a : cA; const char* nB = has_next ? nxt.b : cB;
        if constexpr (GATHER) { if (has_next && wid < 4)
                __builtin_amdgcn_global_load_lds((const unsigned*)(nxt.rows + wid * 64 + lane), (LAS unsigned*)(lds + GIDX_OFF + wid * 256), 4, 0, 0); }
        for (int t = 0; t < nt; t += 2) {
            const bool last = (t == nt - 2);
            if constexpr (GATHER) { if (last && has_next) { _Pragma("unroll") for (int h_ = 0; h_ < 2; ++h_) _Pragma("unroll") for (int i_ = 0; i_ < 2; ++i_) { int R_, C_; stage_rc(tid * 16 + i_ * 8192, R_, C_);
                gN[h_][i_] = (unsigned)*(const LAS int*)(lds + GIDX_OFF + (h_ * HALF + R_) * 4) * (unsigned)(g.lda * 2) + (unsigned)C_ * 2u; } } }
            const size_t k1 = (size_t)(t + 1) * kstep, k2 = last ? (size_t)0 : (size_t)(t + 2) * kstep, k3 = k2 + kstep;
            const char* b2 = last ? nB : cB + (size_t)(t + 2) * kstep; const char* b3 = b2 + kstep;
            PG8_LDB(B0, 0, 0); PG8_LDB(B1, 0, 1); PG8_SCHED; PG8_LDA(At, 0, 0); PG8_STAGE_A(PG8_SA(1, 1), false, k1, 1);
            PG8_WAIT_V(8); PG8_WAIT_L(0); PG8_BAR; PG8_MMA(0, 0, At, B0); PG8_MMA(0, 1, At, B1); PG8_BAR; PG8_SCHED;
            PG8_LDA(At, 0, 1); PG8_STAGE(PG8_SB(0, 0), b2, voffB); PG8_STAGE(PG8_SB(0, 1), b2 + hstepB, voffB); PG8_STAGE_A(PG8_SA(0, 0), last, k2, 0);
            PG8_WAIT_V(8); PG8_WAIT_L(0); PG8_BAR; PG8_MMA(1, 0, At, B0); PG8_MMA(1, 1, At, B1); PG8_BAR; PG8_SCHED;
            PG8_LDB(B0, 1, 0); PG8_LDB(B1, 1, 1); PG8_SCHED; PG8_LDA(At, 1, 0); PG8_STAGE_A(PG8_SA(0, 1), last, k2, 1);
            PG8_WAIT_V(8); PG8_WAIT_L(0); PG8_BAR; PG8_MMA(0, 0, At, B0); PG8_MMA(0, 1, At, B1); PG8_BAR; PG8_SCHED;
            PG8_LDA(At, 1, 1); PG8_STAGE(PG8_SB(1, 0), b3, voffB); PG8_STAGE(PG8_SB(1, 1), b3 + hstepB, voffB); PG8_STAGE_A(PG8_SA(1, 0), last, k3, 0);
            PG8_WAIT_V(8); PG8_WAIT_L(0); PG8_BAR; PG8_MMA(1, 0, At, B0); PG8_MMA(1, 1, At, B1); PG8_BAR; PG8_SCHED;
        }
        if (wr == 0) PG8_BAR;
        E(acc, cur, wr, wc, fr, fq);
        if (!has_next) break;
#pragma unroll
        for (int a = 0; a < 2; ++a)
#pragma unroll
            for (int b = 0; b < 2; ++b)
#pragma unroll
                for (int m = 0; m < 4; ++m)
#pragma unroll
                    for (int n = 0; n < 2; ++n) acc[a][b][m][n] = (f32x4){0.f, 0.f, 0.f, 0.f};
        cur = nxt; cA = nA; cB = nB; ++ui;
        if constexpr (GATHER) { _Pragma("unroll") for (int h_ = 0; h_ < 2; ++h_) _Pragma("unroll") for (int i_ = 0; i_ < 2; ++i_) gA[h_][i_] = gN[h_][i_]; }
        if (wr == 1) PG8_BAR;
    }
    PG8_WAIT_V(0);
    PG8_BAR;
#undef PG8_SA
#undef PG8_SB
#undef PG8_STAGE
#undef PG8_STAGE_A
#undef PG8_GLOAD
#undef PG8_LDA
#undef PG8_LDB
#undef PG8_MMA
#undef PG8_WAIT_V
#undef PG8_WAIT_L
#undef PG8_BAR
#undef PG8_SCHED
}
}
using pg8::Unit;
template <int ACT  > struct EpiStoreBf16 {
    bf16_t* O; int ldc;
    __device__ __forceinline__ void operator()(const f32x4 (&acc)[2][2][4][2], const Unit& u, int wr, int wc, int fr, int fq) const {
        const int row0 = u.pm * 256 + wr * 64 + fr, col0 = u.pn * 256 + wc * 32 + 8 * fq;
#pragma unroll
        for (int ai = 0; ai < 2; ++ai)
#pragma unroll
            for (int m = 0; m < 4; ++m) { bf16_t* rowp = O + (size_t)(row0 + ai * 128 + m * 16) * ldc + col0;
#pragma unroll
                for (int bj = 0; bj < 2; ++bj) { f32x4 v0 = acc[ai][bj][m][0], v1 = acc[ai][bj][m][1];
                    if (ACT == 1) {
#pragma unroll
                        for (int j = 0; j < 4; ++j) { v0[j] = __builtin_amdgcn_rcpf(1.0f + __expf(-v0[j])); v1[j] = __builtin_amdgcn_rcpf(1.0f + __expf(-v1[j])); } }
                    u32x4 w; w.x = cvt_pk_bf16(v0[0], v0[1]); w.y = cvt_pk_bf16(v0[2], v0[3]); w.z = cvt_pk_bf16(v1[0], v1[1]); w.w = cvt_pk_bf16(v1[2], v1[3]);
                    *(u32x4*)(rowp + bj * 128) = w; } }
    }
};
struct EpiMerge {
    const bf16_t* G; float* M; bf16_t* MB;
    __device__ __forceinline__ void operator()(const f32x4 (&acc)[2][2][4][2], const Unit& u, int wr, int wc, int fr, int fq) const {
        const int br = u.x; const int row0 = u.pm * 256 + wr * 64 + fr, col0 = u.pn * 256 + wc * 32 + 8 * fq;
        const bf16_t* __restrict__ gp = G; bf16_t* mb = MB;
#pragma unroll
        for (int ai = 0; ai < 2; ++ai) {
            u32x4 gw[4][2], mw[4][2];
#pragma unroll
            for (int m = 0; m < 4; ++m)
#pragma unroll
                for (int bj = 0; bj < 2; ++bj) { const size_t r = (size_t)(row0 + ai * 128 + m * 16); const int c = col0 + bj * 128;
                    gw[m][bj] = *(const u32x4*)(gp + r * 4096 + br * 1024 + c);
                    if (br > 0) mw[m][bj] = *(const u32x4*)(mb + r * 1024 + c); }
#pragma unroll
            for (int m = 0; m < 4; ++m)
#pragma unroll
                for (int bj = 0; bj < 2; ++bj) { const size_t r = (size_t)(row0 + ai * 128 + m * 16); const int c = col0 + bj * 128;
                    float gs[8], v[8]; unpack8(gw[m][bj], gs);
#pragma unroll
                    for (int j = 0; j < 4; ++j) { v[j] = acc[ai][bj][m][0][j] * gs[j]; v[4 + j] = acc[ai][bj][m][1][j] * gs[4 + j]; }
                    if (br > 0) { float pm[8]; unpack8(mw[m][bj], pm);
#pragma unroll
                        for (int j = 0; j < 8; ++j) v[j] += pm[j]; }
                    *(u32x4*)(mb + r * 1024 + c) = pack8(v); }
            asm volatile("" ::: "memory");
        }
    }
};
struct EpiResid {
    bf16_t* xsb; const float* ctxin; const float* xin; int layer; const float* modl;
    __device__ __forceinline__ void operator()(const f32x4 (&acc)[2][2][4][2], const Unit& u, int wr, int wc, int fr, int fq) const {
        asm volatile("" : "+v"(fr), "+v"(fq));
        const int b = u.pm / 17, pr = u.pm - b * 17; const bool isctx = pr == 0; const int mb = isctx ? 8 : b;
        bf16_t* dst = xsb + (size_t)u.pm * 256 * D;
        const float* src0 = isctx ? ctxin + (size_t)b * LCTX * D : xin + ((size_t)b * LAT + (size_t)(pr - 1) * 256) * D;
        const int rr0 = wr * 64 + fr, col0 = u.pn * 256 + wc * 32 + 8 * fq;
        const float* g1 = modl + mb * 6144 + 2048 + col0;
        f32x4 gv[2][2];
#pragma unroll
        for (int bj = 0; bj < 2; ++bj) { gv[bj][0] = *(const f32x4*)(g1 + bj * 128); gv[bj][1] = *(const f32x4*)(g1 + bj * 128 + 4); }
#pragma unroll
        for (int ai = 0; ai < 2; ++ai) {
            f32x4 x0[4][2], x1[4][2];
#pragma unroll
            for (int m = 0; m < 4; ++m)
#pragma unroll
                for (int bj = 0; bj < 2; ++bj) { const size_t ro = (size_t)(rr0 + ai * 128 + m * 16) * D + col0 + bj * 128;
                    if (layer == 0) { x0[m][bj] = *(const f32x4*)(src0 + ro); x1[m][bj] = *(const f32x4*)(src0 + ro + 4); }
                    else { float t8[8]; unpack8(*(const u32x4*)(dst + ro), t8); x0[m][bj] = (f32x4){t8[0], t8[1], t8[2], t8[3]}; x1[m][bj] = (f32x4){t8[4], t8[5], t8[6], t8[7]}; } }
#pragma unroll
            for (int m = 0; m < 4; ++m)
#pragma unroll
                for (int bj = 0; bj < 2; ++bj) { const size_t ro = (size_t)(rr0 + ai * 128 + m * 16) * D + col0 + bj * 128;
                    const f32x4 t0 = x0[m][bj] * DN_ALPHA + gv[bj][0] * acc[ai][bj][m][0], t1 = x1[m][bj] * DN_ALPHA + gv[bj][1] * acc[ai][bj][m][1];
                    u32x4 w; w.x = cvt_pk_bf16(t0[0], t0[1]); w.y = cvt_pk_bf16(t0[2], t0[3]); w.z = cvt_pk_bf16(t1[0], t1[1]); w.w = cvt_pk_bf16(t1[2], t1[3]);
                    *(u32x4*)(dst + ro) = w; }
            asm volatile("" ::: "memory"); }
    }
};
struct EpiSwiGLU {
    bf16_t* HID;
    __device__ __forceinline__ void operator()(const f32x4 (&acc)[2][2][4][2], const Unit& u, int wr, int wc, int fr, int fq) const {
        const int row0 = u.pm * 256 + wr * 64 + fr, col0 = u.pn * 128 + wc * 32 + 8 * fq;
#pragma unroll
        for (int ai = 0; ai < 2; ++ai)
#pragma unroll
            for (int m = 0; m < 4; ++m) { float h[8];
#pragma unroll
                for (int n = 0; n < 2; ++n)
#pragma unroll
                    for (int j = 0; j < 4; ++j) { const float g = acc[ai][0][m][n][j], up = acc[ai][1][m][n][j]; h[4 * n + j] = g * __builtin_amdgcn_rcpf(1.0f + __expf(-g)) * up; }
                *(u32x4*)(HID + (size_t)(row0 + ai * 128 + m * 16) * MOE_FF + col0) = pack8(h); }
    }
};
__device__ __forceinline__ int lat_panel(int q) { return (q >> 4) * 17 + 1 + (q & 15); }
struct SchedDense {
    int nM, nN, G, c; const char* A; const char* B; size_t ta, tb; int lat;
    __device__ __forceinline__ bool next(int i, Unit& u) const { int pm, pn; if (!pg8::static_tile(i * G + c, nM, nN, pm, pn)) return false;
        if (lat) pm = lat_panel(pm);
        u.pm = pm; u.pn = pn; u.x = 0; u.a = A + (size_t)pm * ta; u.b = B + (size_t)pn * tb; return true; }
};
struct SchedMerge {
    int G, c; const char* Y; const char* WB; int lat;
    __device__ __forceinline__ bool next(int i, Unit& u) const { int pm, pn; if (!pg8::static_tile((i >> 2) * G + c, lat ? 128 : NPANEL, 4, pm, pn)) return false; const int br = i & 3;
        if (lat) pm = lat_panel(pm);
        u.pm = pm; u.pn = pn; u.x = br; u.a = Y + (size_t)pm * 256 * 2048 * 2 + (size_t)br * 512 * 2; u.b = WB + (size_t)br * 1024 * 512 * 2 + (size_t)pn * 256 * 512 * 2; return true; }
};
struct SchedMoe {
    int G, c; const LAS int* tab; const char* A; const char* B; size_t ta, be, bt; const int* rows;
    __device__ __forceinline__ bool next(int i, Unit& u) const { const int nblk = tab[0]; int blk, t;
        if ((G & 31) == 0) { const int x = c & 7, y = c >> 3, per = G >> 5; if ((y >> 2) >= per) return false; blk = i * (G >> 2) + x * per + (y >> 2); t = y & 3; } else { const int L = i * G + c; blk = L >> 2; t = L & 3; }
        if (blk >= nblk) return false; const int e = tab[1 + blk];
        u.pm = blk; u.pn = t; u.x = e; u.a = A + (size_t)blk * ta; u.b = B + (size_t)e * be + (size_t)t * bt; u.rows = rows + blk * 256; return true; }
};

PHASE_FN void phase_mod(int wv, PRM p, LAS unsigned char* lds) {
    LAS float* s = (LAS float*)(lds + LDS_STAGE); LAS float* red = s + 9 * 1024;
    const int tid = TID;
    for (int i = tid; i < 9 * 1024; i += NTHR) { const int b = i >> 10, k = i & 1023; const float v = b < 8 ? p.in[I_C][b * 1024 + k] : p.in[I_CCTX][k]; s[i] = siluf_(v); }
    __syncthreads();
    float* MOD = (float*)(p.ws + WS_MOD);
    for (int task = BLK; task < DEPTH * 48; task += gridDim.x) {
        const int l = task / 48, j0 = (task % 48) * 128, cq = tid & 127, kq = tid >> 7;
        float acc[9];
#pragma unroll
        for (int b = 0; b < 9; ++b) acc[b] = 0.f;
        const float* w = p.in[I_ADAW] + ((size_t)l * 1024 + kq * 256) * 6144 + j0 + cq;
        for (int k0 = 0; k0 < 256; k0 += 8) { float wv8[8];
#pragma unroll
            for (int kk = 0; kk < 8; ++kk) wv8[kk] = w[(size_t)(k0 + kk) * 6144];
#pragma unroll
            for (int kk = 0; kk < 8; ++kk)
#pragma unroll
                for (int b = 0; b < 9; ++b) acc[b] += s[b * 1024 + kq * 256 + k0 + kk] * wv8[kk]; }
#pragma unroll
        for (int b = 0; b < 9; ++b) red[(kq * 9 + b) * 128 + cq] = acc[b];
        __syncthreads();
        for (int o = tid; o < 9 * 128; o += NTHR) { const int b = o >> 7, c2 = o & 127;
            const float v = red[(0 * 9 + b) * 128 + c2] + red[(1 * 9 + b) * 128 + c2] + red[(2 * 9 + b) * 128 + c2] + red[(3 * 9 + b) * 128 + c2] + p.in[I_ADAB][l * 6144 + j0 + c2];
            MOD[((size_t)l * 9 + b) * 6144 + j0 + c2] = v; }
        __syncthreads();
    }
}
PHASE_FN void phase_rope_table(int wv, PRM p) {
    float* COS = (float*)(p.ws + WS_ROPE); float* SIN = COS + 4096 * 32;
    for (int i = BLK * NTHR + TID; i < 4096 * 32; i += gridDim.x * NTHR) { const int n = i >> 5, a = (i >> 4) & 1, pp = i & 15;
        const float inv = powf(10000.0f, -(float)pp / 16.0f); const float ang = (float)(a == 0 ? (n >> 6) : (n & 63)) * inv;
        COS[i] = cosf(ang); SIN[i] = sinf(ang); }
}
PHASE_FN void phase_modulate0(int wv, PRM p) {
    const float* MOD = (const float*)(p.ws + WS_MOD); bf16_t* H = (bf16_t*)(p.ws + WS_H); const int lane = LANE;
    for (int r = BLK * 8 + WAVE; r < NTOK; r += gridDim.x * 8) {
        const float* x = xin_row(p, r); const float* md = MOD + (size_t)mod_row(r) * 6144;
#pragma unroll
        for (int j = 0; j < 4; ++j) { const int c = j * 256 + lane * 4; const f32x4 v = *(const f32x4*)(x + c), sh = *(const f32x4*)(md + c), sc = *(const f32x4*)(md + 1024 + c);
            const f32x4 h = v * (sc + 1.0f) + sh; u32x2 w; w.x = cvt_pk_bf16(h[0], h[1]); w.y = cvt_pk_bf16(h[2], h[3]); *(u32x2*)(H + (size_t)r * D + c) = w; }
    }
}
__device__ __forceinline__ int win_src_col(int j) {
    if (j < 1536) return j;
    if (j < 3456) return 1544 + (j - 1536);
    if (j < 3464) return 1536 + (j - 3456);
    if (j < 3496) return 6024 + (j - 3464);
    if (j < 3584) return -1;
    if (j < 5120) return 3464 + (j - 3584);
    if (j < 6144) return 5000 + (j - 5120);
    return 6056 + (j - 6144);
}
struct ConvDesc { const float* src; bf16_t* dst; int sld, dld, n0, k0, kind, cadd; };
__device__ __forceinline__ ConvDesc conv_desc(PRM p, int l, int task) {
    constexpr int T0 = 104 * 16, T1 = T0 + 64 * 16, T2 = T1 + 4 * 16 * 8, T3 = T2 + 16 * 16, T4 = T3 + 32 * 16 * 16;
    ConvDesc c; c.kind = 0; c.cadd = 0;
    if (task < T0) { const int t = task; c.n0 = (t >> 4) * 64; c.k0 = (t & 15) * 64; c.src = p.in[I_WIN] + (size_t)l * 1024 * IN_COLS; c.sld = IN_COLS; c.dst = (bf16_t*)(p.ws + WS_WIN); c.dld = 1024; c.kind = 1; }
    else if (task < T1) { const int t = task - T0; c.n0 = (t >> 4) * 64; c.k0 = (t & 15) * 64; c.src = p.in[I_WIN] + (size_t)l * 1024 * IN_COLS; c.sld = IN_COLS; c.dst = (bf16_t*)(p.ws + WS_WG); c.dld = 1024; c.cadd = GATE_COL0; }
    else if (task < T2) { const int t = task - T1; const int br = t >> 7, tt = t & 127; c.n0 = (tt >> 3) * 64; c.k0 = (tt & 7) * 64; c.src = p.in[I_WBR] + ((size_t)l * 4 + br) * 512 * 1024; c.sld = 1024; c.dst = (bf16_t*)(p.ws + WS_WB) + (size_t)br * 1024 * 512; c.dld = 512; }
    else if (task < T3) { const int t = task - T2; c.n0 = (t >> 4) * 64; c.k0 = (t & 15) * 64; c.src = p.in[I_WOUT] + (size_t)l * 1024 * 1024; c.sld = 1024; c.dst = (bf16_t*)(p.ws + WS_WO); c.dld = 1024; }
    else if (task < T4) { const int t = task - T3; const int e = t >> 8, tt = t & 255; const int j0 = (tt >> 4) * 64; c.k0 = (tt & 15) * 64;
        const int q = j0 >> 8, rr = j0 & 255; c.src = (rr < 128 ? p.in[I_MOE_GATE] : p.in[I_MOE_UP]) + ((size_t)l * 32 + e) * 1024 * 512; c.sld = 512; c.cadd = 128 * q + (rr & 127) - j0; c.n0 = j0;
        c.dst = (bf16_t*)(p.ws + WS_GU) + (size_t)e * 1024 * 1024; c.dld = 1024; }
    else { const int t = task - T4; const int e = t >> 7, tt = t & 127; c.n0 = (tt >> 3) * 64; c.k0 = (tt & 7) * 64; c.src = p.in[I_MOE_DOWN] + ((size_t)l * 32 + e) * 512 * 1024; c.sld = 1024; c.dst = (bf16_t*)(p.ws + WS_DW) + (size_t)e * 1024 * 512; c.dld = 512; }
    return c;
}
constexpr int CV_T0 = 104 * 16, CV_T1 = CV_T0 + 64 * 16, CV_T2 = CV_T1 + 4 * 16 * 8, CV_T3 = CV_T2 + 16 * 16, CV_T4 = CV_T3 + 32 * 16 * 16, CV_T5 = CV_T4 + 32 * 16 * 8;
PHASE_FN void phase_convert(int wv, PRM p, int l, LAS unsigned char* lds, int t0, int T5, int worker, int nworkers) {
    LAS float* tile = (LAS float*)(lds + LDS_STAGE);
    const int tid = TID;
    const int nx = tid & 63, ky = tid >> 6, kx = tid & 31, ny = tid >> 5;
    float r[8], rn[8];
#define CV_LOAD(dst_, task_) do { const ConvDesc c_ = conv_desc(p, l, (task_)); const int j_ = c_.n0 + nx; const int sc_ = c_.kind == 1 ? win_src_col(j_) : j_ + c_.cadd; \
        _Pragma("unroll") for (int i = 0; i < 8; ++i) dst_[i] = sc_ >= 0 ? c_.src[(size_t)(c_.k0 + ky + 8 * i) * c_.sld + sc_] : 0.f; } while (0)
    int task = t0 + worker;
    if (task < T5) CV_LOAD(r, task);
    for (; task < T5; task += nworkers) {
        const int nxt = task + nworkers;
        if (nxt < T5) CV_LOAD(rn, nxt);
#pragma unroll
        for (int i = 0; i < 8; ++i) tile[(ky + 8 * i) * 65 + nx] = r[i];
        BAR_LDS();
        { const ConvDesc c = conv_desc(p, l, task);
#pragma unroll
            for (int i = 0; i < 4; ++i) { const int j = ny + 16 * i; *(unsigned*)(c.dst + (size_t)(c.n0 + j) * c.dld + c.k0 + 2 * kx) = cvt_pk_bf16(tile[(2 * kx) * 65 + j], tile[(2 * kx + 1) * 65 + j]); } }
        BAR_LDS();
#pragma unroll
        for (int i = 0; i < 8; ++i) r[i] = rn[i];
    }
#undef CV_LOAD
}
PHASE_FN void phase_ln1_router(int wv, PRM p, int l, LAS unsigned char* lds, int dry = 0) {
    LAS float* Wl = (LAS float*)(lds + LDS_STAGE);
    LAS unsigned* hist = (LAS unsigned*)(lds + 64);
    constexpr int HBS = 2064;
    LAS unsigned char* HBH = lds + LDS_STAGE; LAS unsigned char* HBL = HBH + 16 * HBS;
    LAS f32x4* PART = (LAS f32x4*)(HBL + 16 * HBS);
    LAS float* LGA = (LAS float*)(PART + 8 * 3 * 64);
    const int tid = TID, lane = LANE;
    const float* wg = p.in[I_MOE_WG] + (size_t)l * 1024 * 4; const float* we = p.in[I_MOE_WE] + (size_t)l * 1024 * 32;
#pragma unroll
    for (int it = 0; it < 16; ++it) { const int i = tid + it * NTHR; const int k = i >> 3, e4 = (i & 7) * 4; *(LAS f32x4*)(Wl + k * 36 + 4 + e4) = *(const f32x4*)(we + (size_t)k * 32 + e4); }
#pragma unroll
    for (int it = 0; it < 2; ++it) { const int k = tid + it * NTHR; *(LAS f32x4*)(Wl + k * 36) = *(const f32x4*)(wg + (size_t)k * 4); }
    if (tid < 32) hist[tid] = 0u;
    __syncthreads();
    u32x4 Whi[3][4], Wlo[3][4];
#pragma unroll
    for (int nb = 0; nb < 3; ++nb)
#pragma unroll
        for (int ks = 0; ks < 4; ++ks) { const int c = nb * 16 + (lane & 15), k0 = wv * 128 + ks * 32 + (lane >> 4) * 8; const bool ok = c < 36;
#pragma unroll
            for (int j2 = 0; j2 < 4; ++j2) { const float v0 = ok ? Wl[(k0 + 2 * j2) * 36 + c] : 0.f, v1 = ok ? Wl[(k0 + 2 * j2 + 1) * 36 + c] : 0.f;
                const unsigned ph = cvt_pk_bf16(v0, v1); Whi[nb][ks][j2] = ph; Wlo[nb][ks][j2] = cvt_pk_bf16(v0 - bf2f(ph & 0xffffu), v1 - bf2f(ph >> 16)); } }
    __syncthreads();
    const float* MOD = (const float*)(p.ws + WS_MOD) + (size_t)l * 9 * 6144; bf16_t* H = (bf16_t*)(p.ws + WS_H);
    const float* lg = p.in[I_LN1G] + l * 1024; const float* lb = p.in[I_LN1B] + l * 1024;
    const float* bg = p.in[I_MOE_BG] + l * 4; const float* be = p.in[I_MOE_BE] + l * 32;
    int* EID = (int*)(p.ws + WS_EID); float* WTS = (float*)(p.ws + WS_WTS);
    bf16_t* XSB = (bf16_t*)(p.ws + WS_XSB);
    u32x2 vn[2][4];
#define LN1_LOAD(g_) do { _Pragma("unroll") for (int r_ = 0; r_ < 2; ++r_) { const bf16_t* xr_ = XSB + (size_t)((g_) * 2 + r_) * D; _Pragma("unroll") for (int j_ = 0; j_ < 4; ++j_) vn[r_][j_] = *(const u32x2*)(xr_ + j_ * 256 + lane * 4); } } while (0)
    { const int g0 = BLK * 8 + WAVE; if (g0 < NTOK / 2) LN1_LOAD(g0); }
    for (int gb = BLK * 8; gb < NTOK / 2; gb += gridDim.x * 8) {
        const int g4 = gb + WAVE;
        f32x4 vc[2][4];
#pragma unroll
        for (int r = 0; r < 2; ++r)
#pragma unroll
            for (int j = 0; j < 4; ++j) { const u32x2 w_ = vn[r][j]; vc[r][j] = (f32x4){bf2f(w_.x & 0xffffu), bf2f(w_.x >> 16), bf2f(w_.y & 0xffffu), bf2f(w_.y >> 16)}; }
        { const int gn = g4 + (int)gridDim.x * 8; if (gn < NTOK / 2) LN1_LOAD(gn); }
        if (l == DEPTH - 1 && ((gb * 2) % TPB) < LCTX) continue;
#pragma unroll
        for (int r = 0; r < 2; ++r) { const int row = g4 * 2 + r; bf16_t* xr = XSB + (size_t)row * D; const float* md = MOD + (size_t)mod_row(row) * 6144;
            f32x4 v[4]; float s = 0.f;
#pragma unroll
            for (int j = 0; j < 4; ++j) { v[j] = vc[r][j]; s += (v[j][0] + v[j][1]) + (v[j][2] + v[j][3]); }
            const float mean = sum64(s) * (1.0f / 1024.0f); float q = 0.f;
#pragma unroll
            for (int j = 0; j < 4; ++j) { const f32x4 d = v[j] - mean; q += (d[0] * d[0] + d[1] * d[1]) + (d[2] * d[2] + d[3] * d[3]); }
            const float rstd = rsqrtf(sum64(q) * (1.0f / 1024.0f) + 1e-5f);
#pragma unroll
            for (int j = 0; j < 4; ++j) { const int c = j * 256 + lane * 4; const f32x4 x = (v[j] - mean) * rstd * *(const f32x4*)(lg + c) + *(const f32x4*)(lb + c);
                { u32x2 wx; wx.x = cvt_pk_bf16(x[0], x[1]); wx.y = cvt_pk_bf16(x[2], x[3]); *(u32x2*)((dry ? (bf16_t*)(p.ws + WS_Y) + (size_t)row * D : xr) + c) = wx; } const f32x4 hh = x * (*(const f32x4*)(md + 4 * 1024 + c) + 1.0f) + *(const f32x4*)(md + 3 * 1024 + c);
                u32x2 w; w.x = cvt_pk_bf16(hh[0], hh[1]); w.y = cvt_pk_bf16(hh[2], hh[3]); *(u32x2*)(H + (size_t)row * D + c) = w;
                u32x2 wl; wl.x = cvt_pk_bf16(hh[0] - bf2f(w.x & 0xffffu), hh[1] - bf2f(w.x >> 16)); wl.y = cvt_pk_bf16(hh[2] - bf2f(w.y & 0xffffu), hh[3] - bf2f(w.y >> 16));
                *(LAS u32x2*)(HBH + (WAVE * 2 + r) * HBS + c * 2) = w; *(LAS u32x2*)(HBL + (WAVE * 2 + r) * HBS + c * 2) = wl; } }
        BAR_LDS();
        { f32x4 acc[3];
#pragma unroll
            for (int nb = 0; nb < 3; ++nb) acc[nb] = (f32x4){0.f, 0.f, 0.f, 0.f};
#pragma unroll
            for (int ks = 0; ks < 4; ++ks) { const int off = (lane & 15) * HBS + (WAVE * 128 + ks * 32 + (lane >> 4) * 8) * 2;
                const bf16x8 yh = *(const LAS bf16x8*)(HBH + off), yl = *(const LAS bf16x8*)(HBL + off);
#pragma unroll
                for (int nb = 0; nb < 3; ++nb) { const bf16x8 wh = __builtin_bit_cast(bf16x8, Whi[nb][ks]), wl = __builtin_bit_cast(bf16x8, Wlo[nb][ks]);
                    acc[nb] = __builtin_amdgcn_mfma_f32_16x16x32_bf16(wh, yh, acc[nb], 0, 0, 0); acc[nb] = __builtin_amdgcn_mfma_f32_16x16x32_bf16(wh, yl, acc[nb], 0, 0, 0);
                    acc[nb] = __builtin_amdgcn_mfma_f32_16x16x32_bf16(wl, yh, acc[nb], 0, 0, 0); } }
#pragma unroll
            for (int nb = 0; nb < 3; ++nb) PART[(WAVE * 3 + nb) * 64 + lane] = acc[nb]; }
        BAR_LDS();
        if (tid < 144) { const int t = tid / 9, qd = tid - t * 9, nb = qd >> 2, L = t + 16 * (qd & 3); f32x4 sm = PART[nb * 64 + L];
#pragma unroll
            for (int w = 1; w < 8; ++w) sm += PART[(w * 3 + nb) * 64 + L];
            *(LAS f32x4*)(LGA + t * 36 + qd * 4) = sm; }
        BAR_LDS();
        if (lane < 2) { const int r = lane, row = g4 * 2 + r; const LAS float* lr = LGA + (WAVE * 2 + r) * 36;
            float gl[4];
#pragma unroll
            for (int g = 0; g < 4; ++g) gl[g] = lr[g] + bg[g];
            int gi = 0; float gm = gl[0];
#pragma unroll
            for (int g = 1; g < 4; ++g) if (gl[g] > gm) { gm = gl[g]; gi = g; }
            float gs = 0.f;
#pragma unroll
            for (int g = 0; g < 4; ++g) gs += __expf(gl[g] - gm);
            const float gp = 1.0f / gs;
            float el[8];
#pragma unroll
            for (int j = 0; j < 8; ++j) el[j] = lr[4 + gi * 8 + j] + be[gi * 8 + j];
            int i1 = 0; float m1 = el[0];
#pragma unroll
            for (int j = 1; j < 8; ++j) if (el[j] > m1) { m1 = el[j]; i1 = j; }
            int i2 = 0; float m2 = -3.0e38f;
#pragma unroll
            for (int j = 0; j < 8; ++j) if (j != i1 && el[j] > m2) { m2 = el[j]; i2 = j; }
            const float e2 = __expf(m2 - m1); const float w1 = gp / (1.0f + e2), w2 = gp * e2 / (1.0f + e2);
            const int ea = gi * 8 + i1, eb = gi * 8 + i2; EID[row * 2] = ea; EID[row * 2 + 1] = eb; WTS[row * 2] = w1; WTS[row * 2 + 1] = w2;
            __hip_atomic_fetch_add(&hist[ea], 1u, __ATOMIC_RELAXED, __HIP_MEMORY_SCOPE_WORKGROUP); __hip_atomic_fetch_add(&hist[eb], 1u, __ATOMIC_RELAXED, __HIP_MEMORY_SCOPE_WORKGROUP);
        }
    }
#undef LN1_LOAD
    __syncthreads();
    if (tid < 32 && !dry) { const unsigned c = hist[tid]; if (c) atomicAdd((unsigned*)(p.ws + WS_CTL) + CW_CNT + l * 64 + tid, c); }
    __syncthreads();
}
__device__ __forceinline__ void moe_tables(int wv, PRM p, int l, LAS int* tab, LAS int* beg) {
    const int tid = TID;
    if (tid < NEXP) { const unsigned* cnt = (const unsigned*)(p.ws + WS_CTL) + CW_CNT + l * 64; beg[40 + tid] = (int)__hip_atomic_load(cnt + tid, __ATOMIC_RELAXED, __HIP_MEMORY_SCOPE_AGENT); }
    __syncthreads();
    if (tid == 0) { int nb = 0;
        for (int e = 0; e < NEXP; ++e) { const int c = beg[40 + e]; const int k = (c + 255) >> 8; beg[e] = nb; for (int j = 0; j < k; ++j) tab[1 + nb + j] = e; nb += k; }
        tab[0] = nb; }
    __syncthreads();
}
PHASE_FN void phase_moe_assign(int wv, PRM p, int l, LAS unsigned char* lds) {
    LAS int* tab = (LAS int*)(lds + LDS_TAB); LAS int* beg = tab + 320;
    LAS unsigned* hist = (LAS unsigned*)(lds + LDS_STAGE); LAS unsigned* base = hist + 32; LAS int* slots = (LAS int*)(hist + 64);
    moe_tables(wv, p, l, tab, beg);
    const int tid = TID, lane = tid & 63, wave = wv;
    const int* EID = (const int*)(p.ws + WS_EID); int* SLOT = (int*)(p.ws + WS_SLOT); unsigned* cur = (unsigned*)(p.ws + WS_CTL) + CW_CUR + l * 64;
    int* TOK = (int*)(p.ws + WS_TOK);
    constexpr int APB = NTOK * 2 / 256;
    for (int blk = BLK; blk < 256; blk += gridDim.x) {
        const int a0 = blk * APB;
        if (tid < 32) hist[tid] = 0u;
        __syncthreads();
        int e = -1; unsigned lr = 0u; const int a = a0 + tid;
        if (tid < APB && !(l == DEPTH - 1 && ((a >> 1) % TPB) < LCTX)) { e = EID[a]; lr = __hip_atomic_fetch_add(&hist[e], 1u, __ATOMIC_RELAXED, __HIP_MEMORY_SCOPE_WORKGROUP); }
        __syncthreads();
        if (tid < 32) { const unsigned c = hist[tid]; base[tid] = c ? atomicAdd(cur + tid, c) : 0u; }
        __syncthreads();
        if (tid < APB && e >= 0) { const int sl = beg[e] * 256 + (int)(base[e] + lr); SLOT[a] = sl; TOK[sl] = a >> 1; }
        __syncthreads();
    }
}
PHASE_FN void phase_ln2(int wv, PRM p, int l, int dry = 0) {
    const float* MOD = (const float*)(p.ws + WS_MOD) + (size_t)l * 9 * 6144; const float* MODN = MOD + 9 * 6144; bf16_t* H = (bf16_t*)(p.ws + WS_H);
    const float* lg = p.in[I_LN2G] + l * 1024; const float* lb = p.in[I_LN2B] + l * 1024;
    const int* SLOT = (const int*)(p.ws + WS_SLOT); const float* WTS = (const float*)(p.ws + WS_WTS); const bf16_t* YB = (const bf16_t*)(p.ws + WS_YB); const int lane = LANE;
    bf16_t* XSB = (bf16_t*)(p.ws + WS_XSB); bf16_t* XSO = dry ? (bf16_t*)(p.ws + WS_Y) : XSB; bf16_t* HO = dry ? (bf16_t*)(p.ws + WS_Y) + (size_t)NTOK * 1024 : H;
    for (int r4 = BLK * 8 + WAVE; r4 < NTOK / 4; r4 += gridDim.x * 8) {
        const int row0 = r4 * 4;
        if (l == DEPTH - 1 && (row0 % TPB) < LCTX) continue;
        const int mr = mod_row(row0); const float* md = MOD + (size_t)mr * 6144;
        int sl = 0; float wt = 0.f; if (lane < 8) { sl = SLOT[row0 * 2 + lane]; wt = WTS[row0 * 2 + lane]; }
        f32x4 v[4][4];
#pragma unroll
        for (int rr = 0; rr < 4; ++rr) { const int s0 = __builtin_amdgcn_readlane(sl, 2 * rr), s1 = __builtin_amdgcn_readlane(sl, 2 * rr + 1);
            const float w0 = __int_as_float(__builtin_amdgcn_readlane(__float_as_int(wt), 2 * rr)), w1 = __int_as_float(__builtin_amdgcn_readlane(__float_as_int(wt), 2 * rr + 1));
            const bf16_t* xr = XSB + (size_t)(row0 + rr) * D;
#pragma unroll
            for (int j = 0; j < 4; ++j) { const int c = j * 256 + lane * 4; const u32x2 a = *(const u32x2*)(YB + (size_t)s0 * D + c), b = *(const u32x2*)(YB + (size_t)s1 * D + c);
                f32x4 m; m[0] = w0 * bf2f(a.x & 0xffffu) + w1 * bf2f(b.x & 0xffffu); m[1] = w0 * bf2f(a.x >> 16) + w1 * bf2f(b.x >> 16);
                m[2] = w0 * bf2f(a.y & 0xffffu) + w1 * bf2f(b.y & 0xffffu); m[3] = w0 * bf2f(a.y >> 16) + w1 * bf2f(b.y >> 16);
                const u32x2 xw = *(const u32x2*)(xr + c); const f32x4 xv = (f32x4){bf2f(xw.x & 0xffffu), bf2f(xw.x >> 16), bf2f(xw.y & 0xffffu), bf2f(xw.y >> 16)};
                v[rr][j] = xv * DN_ALPHA + *(const f32x4*)(md + 5 * 1024 + c) * m; } }
#pragma unroll
        for (int rr = 0; rr < 4; ++rr) { const int row = row0 + rr; float s = 0.f;
#pragma unroll
            for (int j = 0; j < 4; ++j) s += (v[rr][j][0] + v[rr][j][1]) + (v[rr][j][2] + v[rr][j][3]);
            const float mean = sum64(s) * (1.0f / 1024.0f); float q = 0.f;
#pragma unroll
            for (int j = 0; j < 4; ++j) { const f32x4 dd = v[rr][j] - mean; q += (dd[0] * dd[0] + dd[1] * dd[1]) + (dd[2] * dd[2] + dd[3] * dd[3]); }
            const float rstd = rsqrtf(sum64(q) * (1.0f / 1024.0f) + 1e-5f);
#pragma unroll
            for (int j = 0; j < 4; ++j) { const int c = j * 256 + lane * 4; f32x4 x = (v[rr][j] - mean) * rstd * *(const f32x4*)(lg + c) + *(const f32x4*)(lb + c);
                if (l + 1 < DEPTH) { u32x2 wx; wx.x = cvt_pk_bf16(x[0], x[1]); wx.y = cvt_pk_bf16(x[2], x[3]); *(u32x2*)(XSO + (size_t)row * D + c) = wx; }
                else if (!dry) { const int bb = row / TPB, tt = row - bb * TPB; *(f32x4*)(p.out + ((size_t)bb * LAT + (tt - LCTX)) * D + c) = x; }
                if (l + 1 < DEPTH) { const float* mn = MODN + (size_t)mr * 6144; const f32x4 hh = x * (*(const f32x4*)(mn + 1024 + c) + 1.0f) + *(const f32x4*)(mn + c);
                    u32x2 w; w.x = cvt_pk_bf16(hh[0], hh[1]); w.y = cvt_pk_bf16(hh[2], hh[3]); *(u32x2*)(HO + (size_t)row * D + c) = w; } } }
    }
}
constexpr float ATT_C2 = 0.125f * 1.4426950408889634f;
PHASE_FN void phase_prep(int wv, PRM p, int l, int dry = 0) {
    bf16_t* U = (bf16_t*)(p.ws + WS_U); bf16_t* XBC = (bf16_t*)(p.ws + WS_XBC); const float* COS = (const float*)(p.ws + WS_ROPE); const float* SIN = COS + 4096 * 32;
    const int lane = LANE, c16 = lane * 16, c0 = lane * 8, ra = (c0 >> 5) & 1, jj = (c0 >> 4) & 1, pp0 = c0 & 15;
    float cw[3][16], cb[16];
#pragma unroll
    for (int q = 0; q < 16; ++q) { cb[q] = p.in[I_SSD_CB][l * 1024 + c16 + q];
#pragma unroll
        for (int j = 0; j < 3; ++j) cw[j][q] = p.in[I_SSD_CW][((size_t)l * 3 + j) * 1024 + c16 + q]; }
    for (int r2 = BLK * 8 + WAVE; r2 < NTOK / 2; r2 += gridDim.x * 8) {
        u32x4 xc[2][2][3], qk[2][2]; f32x4 cs4[2][2], sn4[2][2]; bool latr[2];
#pragma unroll
        for (int rr = 0; rr < 2; ++rr) { const int r = r2 * 2 + rr; const int t = r % TPB; const bool has_prev = (t != 0) && (t != LCTX), has_next = (t != LCTX - 1) && (t != TPB - 1); latr[rr] = t >= LCTX;
#pragma unroll
            for (int hf = 0; hf < 2; ++hf) { const bf16_t* up = U + (size_t)r * UC + U_SSD_X + c16 + hf * 8;
                xc[rr][hf][1] = *(const u32x4*)up; xc[rr][hf][0] = has_prev ? *(const u32x4*)(up - UC) : (u32x4){0u, 0u, 0u, 0u}; xc[rr][hf][2] = has_next ? *(const u32x4*)(up + UC) : (u32x4){0u, 0u, 0u, 0u}; }
            qk[rr][0] = *(const u32x4*)(U + (size_t)r * UC + U_DF_Q + c0); qk[rr][1] = *(const u32x4*)(U + (size_t)r * UC + U_DF_K + c0);
            const int n = latr[rr] ? t - LCTX : 0; const float* cp = COS + n * 32 + ra * 16 + pp0; const float* sp = SIN + n * 32 + ra * 16 + pp0;
            cs4[rr][0] = *(const f32x4*)cp; cs4[rr][1] = *(const f32x4*)(cp + 4); sn4[rr][0] = *(const f32x4*)sp; sn4[rr][1] = *(const f32x4*)(sp + 4); }
#pragma unroll
        for (int rr = 0; rr < 2; ++rr) { const int r = r2 * 2 + rr;
#pragma unroll
            for (int hf = 0; hf < 2; ++hf) { float a0[8], a1[8], a2[8], o[8]; unpack8(xc[rr][hf][0], a0); unpack8(xc[rr][hf][1], a1); unpack8(xc[rr][hf][2], a2);
#pragma unroll
                for (int q = 0; q < 8; ++q) o[q] = siluf_(cb[hf * 8 + q] + cw[0][hf * 8 + q] * a0[q] + cw[1][hf * 8 + q] * a1[q] + cw[2][hf * 8 + q] * a2[q]);
                *(u32x4*)(XBC + (size_t)r * 1024 + c16 + hf * 8) = pack8(o); }
#pragma unroll
            for (int which = 0; which < 2; ++which) { float x[8], o[8]; unpack8(qk[rr][which], x);
#pragma unroll
                for (int i = 0; i < 8; ++i) { const float other = dppf<0x4E>(x[i]);
                    const float cc = latr[rr] ? (i < 4 ? cs4[rr][0][i] : cs4[rr][1][i - 4]) : 1.f, ss = latr[rr] ? (i < 4 ? sn4[rr][0][i] : sn4[rr][1][i - 4]) : 0.f;
                    o[i] = jj == 0 ? x[i] * cc - other * ss : x[i] * cc + other * ss;
                    if (which == 0) o[i] *= ATT_C2; }
                if (dry) *(u32x4*)((bf16_t*)(p.ws + WS_Y) + (size_t)r * 2048 + which * 512 + c0) = pack8(o);
                else if (latr[rr] || which == 0) *(u32x4*)(U + (size_t)r * UC + (which == 0 ? U_DF_Q : U_DF_K) + c0) = pack8(o); } }
    }
}
PHASE_FN void phase_fin(int wv, PRM p, int l) {
    const bf16_t* U = (const bf16_t*)(p.ws + WS_U); bf16_t* Y = (bf16_t*)(p.ws + WS_Y); const int lane = LANE, c0 = lane * 8;
    const bf16_t* SSDY = (const bf16_t*)(p.ws + WS_SSDY); const bf16_t* RWY = (const bf16_t*)(p.ws + WS_RWY); const bf16_t* RWG = (const bf16_t*)(p.ws + WS_RWG);
    const bf16_t* GLAO = (const bf16_t*)(p.ws + WS_GLAO); const float* BD = (const float*)(p.ws + WS_RWBD);
    float ssd_ng[8], lnxg[8], lnxb[8], mu_v[8], gla_ng[8];
#pragma unroll
    for (int i = 0; i < 8; ++i) { ssd_ng[i] = p.in[I_SSD_NG][l * 512 + c0 + i]; lnxg[i] = p.in[I_RW_LNG][l * 512 + c0 + i]; lnxb[i] = p.in[I_RW_LNB][l * 512 + c0 + i];
        mu_v[i] = p.in[I_RW_MU][l * 1920 + 1024 + c0 + i]; gla_ng[i] = p.in[I_GLA_NG][l * 128 + ((c0 + i) & 127)]; }
    const int head = lane >> 3;
    for (int r2 = BLK * 8 + WAVE; r2 < NTOK / 2; r2 += gridDim.x * 8) {
        u32x4 q[2][12]; float bd[2];
#pragma unroll
        for (int rr = 0; rr < 2; ++rr) { const int r = r2 * 2 + rr; const int t = r % TPB; const bool has_prev = (t != 0) && (t != LCTX), has_next = (t != LCTX - 1) && (t != TPB - 1);
            q[rr][0] = *(const u32x4*)(SSDY + (size_t)r * 512 + c0); q[rr][1] = *(const u32x4*)(SSDY + ((size_t)NTOK + r) * 512 + c0); q[rr][2] = *(const u32x4*)(U + (size_t)r * UC + U_SSD_Z + c0);
            q[rr][3] = *(const u32x4*)(RWY + (size_t)r * 512 + c0); q[rr][4] = *(const u32x4*)(RWY + ((size_t)NTOK + r) * 512 + c0); q[rr][5] = *(const u32x4*)(RWG + (size_t)r * 512 + c0);
            q[rr][6] = *(const u32x4*)(U + (size_t)r * UC + U_RW_V + c0);
            q[rr][7] = has_prev ? *(const u32x4*)(U + (size_t)(r - 1) * UC + U_RW_V + c0) : (u32x4){0u, 0u, 0u, 0u};
            q[rr][8] = has_next ? *(const u32x4*)(U + (size_t)(r + 1) * UC + U_RW_V + c0) : (u32x4){0u, 0u, 0u, 0u};
            q[rr][9] = *(const u32x4*)(GLAO + (size_t)r * 512 + c0); q[rr][10] = *(const u32x4*)(GLAO + ((size_t)NTOK + r) * 512 + c0); q[rr][11] = *(const u32x4*)(U + (size_t)r * UC + U_GLA_OG + c0);
            bd[rr] = BD[(size_t)r * 8 + head] + BD[((size_t)NTOK + r) * 8 + head]; }
#pragma unroll
        for (int rr = 0; rr < 2; ++rr) { const int r = r2 * 2 + rr;
            {
                float a[8], b[8], z[8]; unpack8(q[rr][0], a); unpack8(q[rr][1], b); unpack8(q[rr][2], z);
                float y[8], ss = 0.f;
#pragma unroll
                for (int i = 0; i < 8; ++i) { y[i] = (a[i] + b[i]) * siluf_(z[i]); ss += y[i] * y[i]; }
                const float rs = rsqrtf(sum32(ss) * (1.0f / 256.0f) + 1e-5f);
#pragma unroll
                for (int i = 0; i < 8; ++i) y[i] = y[i] * rs * ssd_ng[i];
                *(u32x4*)(Y + (size_t)r * 2048 + c0) = pack8(y); }
            {
                float a[8], b[8], g[8], vc[8], vp[8], vn[8]; unpack8(q[rr][3], a); unpack8(q[rr][4], b); unpack8(q[rr][5], g); unpack8(q[rr][6], vc); unpack8(q[rr][7], vp); unpack8(q[rr][8], vn);
                float y[8], s = 0.f;
#pragma unroll
                for (int i = 0; i < 8; ++i) { y[i] = a[i] + b[i]; s += y[i]; }
                const float mean = sum8(s) * (1.0f / 64.0f); float qq = 0.f;
#pragma unroll
                for (int i = 0; i < 8; ++i) { y[i] -= mean; qq += y[i] * y[i]; }
                const float rs = rsqrtf(sum8(qq) * (1.0f / 64.0f) + 64e-5f);
#pragma unroll
                for (int i = 0; i < 8; ++i) { const float vm = vc[i] + mu_v[i] * (0.5f * (vp[i] + vn[i]) - vc[i]);
                    y[i] = (y[i] * rs * lnxg[i] + lnxb[i] + bd[rr] * vm) * g[i]; }
                *(u32x4*)(Y + (size_t)r * 2048 + 512 + c0) = pack8(y); }
            {
                float a[8], b[8], og[8]; unpack8(q[rr][9], a); unpack8(q[rr][10], b); unpack8(q[rr][11], og);
                float y[8], ss = 0.f;
#pragma unroll
                for (int i = 0; i < 8; ++i) { y[i] = a[i] + b[i]; ss += y[i] * y[i]; }
                const float rs = rsqrtf(sum16(ss) * (1.0f / 128.0f) + 1e-5f);
#pragma unroll
                for (int i = 0; i < 8; ++i) y[i] = y[i] * rs * gla_ng[i] * siluf_(og[i]);
                *(u32x4*)(Y + (size_t)r * 2048 + 1536 + c0) = pack8(y); } }
    }
}
typedef short v4i16_t __attribute__((ext_vector_type(4)));
__device__ __forceinline__ float max3f(float a, float b, float c) { float r; asm("v_max3_f32 %0, %1, %2, %3" : "=v"(r) : "v"(a), "v"(b), "v"(c)); return r; }
__device__ __forceinline__ s16x4 vtr(const LAS unsigned char* pp) { return __builtin_bit_cast(s16x4, __builtin_amdgcn_ds_read_tr16_b64_v4i16((LAS v4i16_t*)pp)); }
constexpr int AT_BUF = 38912;
constexpr int AT_K0 = 0, AT_K1 = 9216, AT_V = 18432, AT_AL = 2 * AT_BUF, AT_XO = 2 * AT_BUF + 1024;
constexpr float AT_THR = 8.0f;
PHASE_FN void attn_unit(int wv, PRM p, LAS unsigned char* L, int qrow0, int krow0, int ntiles, int h, const LAS float* lamp, const float* subg) {
    const int tid = TID, lane = tid & 63, wave = wv, m = wave >> 2, qs = wave & 3, r32 = lane & 31, hh = lane >> 5;
    const bf16_t* U = (const bf16_t*)(p.ws + WS_U); bf16_t* Y = (bf16_t*)(p.ws + WS_Y);
    const int kr = tid >> 3, kc = tid & 7;
    const bf16_t* gk = U + (size_t)(krow0 + kr) * UC + U_DF_K + h * 128 + kc * 8;
    const int vr0 = tid >> 4, vc = tid & 15;
    const bf16_t* gv = U + (size_t)(krow0 + vr0) * UC + U_DF_V + h * 128 + vc * 8;
    u32x4 rk0, rk1, rv0, rv1;
#define AT_LOAD(t) do { const size_t o_ = (size_t)(t) * 64 * UC; rk0 = *(const u32x4*)(gk + o_); rk1 = *(const u32x4*)(gk + o_ + 64); rv0 = *(const u32x4*)(gv + o_); rv1 = *(const u32x4*)(gv + o_ + (size_t)32 * UC); } while (0)
#define AT_STORE(B) do { LAS unsigned char* b_ = L + (B) * AT_BUF; *(LAS u32x4*)(b_ + AT_K0 + (kr * 72 + kc * 8) * 2) = rk0; *(LAS u32x4*)(b_ + AT_K1 + (kr * 72 + kc * 8) * 2) = rk1; \
        *(LAS u32x4*)(b_ + AT_V + vr0 * 320 + vc * 16) = rv0; *(LAS u32x4*)(b_ + AT_V + (vr0 + 32) * 320 + vc * 16) = rv1; } while (0)
    AT_LOAD(0);
    bf16x8 qf[4];
    { const bf16_t* qp = U + (size_t)(qrow0 + qs * 32 + r32) * UC + U_DF_Q + h * 128 + m * 64 + hh * 8;
#pragma unroll
      for (int d0 = 0; d0 < 4; ++d0) qf[d0] = *(const bf16x8*)(qp + d0 * 16); }
    f32x16 o[4];
#pragma unroll
    for (int db = 0; db < 4; ++db) o[db] = (f32x16){0.f,0.f,0.f,0.f,0.f,0.f,0.f,0.f,0.f,0.f,0.f,0.f,0.f,0.f,0.f,0.f};
    float m_run = -INFINITY, l_run = 0.f;
    LAS float* AL = (LAS float*)(L + AT_AL) + wave * 32;
    const int i16 = lane & 15; const int vtr_off = (4 * hh + (i16 >> 2)) * 320 + (((lane >> 4) & 1) * 16 + (i16 & 3) * 4) * 2;
    __syncthreads();
    AT_STORE(0);
    if (ntiles > 1) AT_LOAD(1);
    for (int t = 0; t < ntiles; ++t) {
        BAR_LDS();
        if (t + 1 < ntiles) { AT_STORE((t + 1) & 1); if (t + 2 < ntiles) AT_LOAD(t + 2); }
        const LAS unsigned char* Lb = L + (t & 1) * AT_BUF; const LAS unsigned char* Km = Lb + (m ? AT_K1 : AT_K0);
        f32x16 p0 = (f32x16){0.f,0.f,0.f,0.f,0.f,0.f,0.f,0.f,0.f,0.f,0.f,0.f,0.f,0.f,0.f,0.f}, p1 = p0;
#pragma unroll
        for (int d0 = 0; d0 < 4; ++d0) {
            const bf16x8 k0 = *(const LAS bf16x8*)(Km + (r32 * 72 + d0 * 16 + hh * 8) * 2);
            const bf16x8 k1 = *(const LAS bf16x8*)(Km + ((r32 + 32) * 72 + d0 * 16 + hh * 8) * 2);
            p0 = __builtin_amdgcn_mfma_f32_32x32x16_bf16(k0, qf[d0], p0, 0, 0, 0);
            p1 = __builtin_amdgcn_mfma_f32_32x32x16_bf16(k1, qf[d0], p1, 0, 0, 0); }
        if (t == 0) {
            float mx = fmaxf(p0[0], p1[0]);
#pragma unroll
            for (int r = 1; r < 16; ++r) mx = fmaxf(mx, fmaxf(p0[r], p1[r]));
            m_run = fmaxf(mx, shflx(mx, 32)); }
#pragma unroll
        for (int r = 0; r < 16; ++r) { p0[r] -= m_run; p1[r] -= m_run; }
        float mxd = max3f(p0[0], p1[0], p0[1]);
#pragma unroll
        for (int r = 1; r < 16; ++r) mxd = (r < 15) ? max3f(mxd, p1[r], p0[r + 1]) : fmaxf(mxd, p1[r]);
        mxd = fmaxf(mxd, shflx(mxd, 32));
        if (__any(mxd > AT_THR)) {
            const float up = fmaxf(mxd, 0.f); const float alpha = __builtin_amdgcn_exp2f(-up); m_run += up; l_run *= alpha;
#pragma unroll
            for (int r = 0; r < 16; ++r) { p0[r] -= up; p1[r] -= up; }
            if (hh == 0) AL[r32] = alpha;
            asm volatile("s_waitcnt lgkmcnt(0)" ::: "memory");
#pragma unroll
            for (int g = 0; g < 4; ++g) { const f32x4 a4 = *(const LAS f32x4*)(AL + 8 * g + 4 * hh);
#pragma unroll
                for (int db = 0; db < 4; ++db) { o[db][4 * g] *= a4[0]; o[db][4 * g + 1] *= a4[1]; o[db][4 * g + 2] *= a4[2]; o[db][4 * g + 3] *= a4[3]; } }
            asm volatile("s_waitcnt lgkmcnt(0)" ::: "memory");
        }
        float ps = 0.f;
#pragma unroll
        for (int r = 0; r < 16; ++r) { p0[r] = __builtin_amdgcn_exp2f(p0[r]); p1[r] = __builtin_amdgcn_exp2f(p1[r]); ps += p0[r] + p1[r]; }
        l_run += ps;
        bf16x8 pa[4];
#pragma unroll
        for (int ks = 0; ks < 4; ++ks) { const int b0 = (ks & 1) * 8; u32x4 w;
            if (ks < 2) { w.x = cvt_pk_bf16(p0[b0], p0[b0 + 1]); w.y = cvt_pk_bf16(p0[b0 + 2], p0[b0 + 3]); w.z = cvt_pk_bf16(p0[b0 + 4], p0[b0 + 5]); w.w = cvt_pk_bf16(p0[b0 + 6], p0[b0 + 7]); }
            else { w.x = cvt_pk_bf16(p1[b0], p1[b0 + 1]); w.y = cvt_pk_bf16(p1[b0 + 2], p1[b0 + 3]); w.z = cvt_pk_bf16(p1[b0 + 4], p1[b0 + 5]); w.w = cvt_pk_bf16(p1[b0 + 6], p1[b0 + 7]); }
            pa[ks] = __builtin_bit_cast(bf16x8, w); }
#pragma unroll
        for (int db = 0; db < 4; ++db)
#pragma unroll
            for (int ks = 0; ks < 4; ++ks) { const LAS unsigned char* vb = Lb + AT_V + vtr_off + ks * 16 * 320 + db * 64;
                const s16x4 lo = vtr(vb), hi = vtr(vb + 8 * 320);
                const bf16x8 vf = (bf16x8){lo[0], lo[1], lo[2], lo[3], hi[0], hi[1], hi[2], hi[3]};
                o[db] = __builtin_amdgcn_mfma_f32_32x32x16_bf16(pa[ks], vf, o[db], 0, 0, 0); }
    }
#undef AT_LOAD
#undef AT_STORE
    const float ltot = l_run + shflx(l_run, 32);
    { const float lam2 = lamp[0];
      if (hh == 0) AL[r32] = (m ? lam2 : 1.0f) * __builtin_amdgcn_rcpf(ltot); }
    asm volatile("s_waitcnt lgkmcnt(0)" ::: "memory");
    float sc[16];
#pragma unroll
    for (int g = 0; g < 4; ++g) { const f32x4 a4 = *(const LAS f32x4*)(AL + 8 * g + 4 * hh); sc[4 * g] = a4[0]; sc[4 * g + 1] = a4[1]; sc[4 * g + 2] = a4[2]; sc[4 * g + 3] = a4[3]; }
    LAS float* XO = (LAS float*)(L + AT_XO);
    float sg[4];
#pragma unroll
    for (int db = 0; db < 4; ++db) sg[db] = subg[db * 32 + r32];
    if (m == 1) {
#pragma unroll
        for (int r = 0; r < 16; ++r) { const int q = qs * 32 + (r & 3) + 8 * (r >> 2) + 4 * hh;
#pragma unroll
            for (int db = 0; db < 4; ++db) XO[q * 128 + db * 32 + r32] = o[db][r] * sc[r]; } }
    __syncthreads();
    if (m == 0) {
#pragma unroll
        for (int r = 0; r < 16; ++r) { const int q = qs * 32 + (r & 3) + 8 * (r >> 2) + 4 * hh; float ss = 0.f;
#pragma unroll
            for (int db = 0; db < 4; ++db) { const float v = o[db][r] * sc[r] - XO[q * 128 + db * 32 + r32]; o[db][r] = v; ss += v * v; }
            const float rs = rsqrtf(sum32(ss) * (1.0f / 128.0f) + 1e-5f) * lamp[1];
            LAS bf16_t* yp = (LAS bf16_t*)(L + q * 272) + r32;
#pragma unroll
            for (int db = 0; db < 4; ++db) yp[db * 32] = f2bf(o[db][r] * rs * sg[db]); } }
    __syncthreads();
#pragma unroll
    for (int it = 0; it < 4; ++it) { const int idx = tid + it * NTHR, q = idx >> 4, ch = idx & 15;
        *(u32x4*)(Y + (size_t)(qrow0 + q) * 2048 + 1024 + h * 128 + ch * 8) = *(const LAS u32x4*)(L + q * 272 + ch * 16); }
}
struct ChunkPos { int rowbase, t_lo, seglen; };
__device__ __forceinline__ ChunkPos chunk_pos(int b, int d, int ci) { ChunkPos c; const bool isctx = ci < 8; const int cl = isctx ? ci : ci - 8; c.seglen = isctx ? LCTX : LAT;
    c.rowbase = b * TPB + (isctx ? 0 : LCTX); c.t_lo = d == 0 ? cl * 32 : c.seglen - 32 * (cl + 1); return c; }
constexpr int NCHUNK = TPB / 32;

constexpr int RW_OP = 0, RW_OPB = 49152, RW_RAW = 98304, RW_TW = 128768, RW_TA = 133376, RW_TG = 137984, RW_MU = 146688, RW_CST = 148480;
#define RW_BAR() do { asm volatile("s_waitcnt vmcnt(0) lgkmcnt(0)" ::: "memory"); __builtin_amdgcn_s_barrier(); asm volatile("" ::: "memory"); } while (0)
#define RW_BAR_NV() do { asm volatile("s_waitcnt lgkmcnt(0)" ::: "memory"); __builtin_amdgcn_s_barrier(); asm volatile("" ::: "memory"); } while (0)
PHASE_FN void rwkv_chain(int wv, PRM p, int l, LAS unsigned char* L, int d, int b, int h) {
    const int tid = TID, lane = tid & 63, wave = wv, r32 = lane & 31, hh = lane >> 5;
    LAS bf16_t* RAW = (LAS bf16_t*)(L + RW_RAW);
    LAS bf16_t* TW = (LAS bf16_t*)(L + RW_TW); LAS bf16_t* TA = (LAS bf16_t*)(L + RW_TA); LAS bf16_t* TG = (LAS bf16_t*)(L + RW_TG);
    LAS float* MU = (LAS float*)(L + RW_MU);
    LAS float* CW0 = (LAS float*)(L + RW_CST); LAS float* CA0 = CW0 + 64; LAS float* CKK = CA0 + 64; LAS float* CKA = CKK + 64; LAS float* CRK = CKA + 64;
    const bf16_t* U = (const bf16_t*)(p.ws + WS_U);
    bf16_t* RWY = (bf16_t*)(p.ws + WS_RWY) + (size_t)d * NTOK * 512; bf16_t* RWG = (bf16_t*)(p.ws + WS_RWG); float* BD = (float*)(p.ws + WS_RWBD) + (size_t)d * NTOK * 8;
    __syncthreads();
    if (tid < 448) { const int cc = tid; int gc;
        if (cc < 192) gc = (cc >> 6) * 512 + h * 64 + (cc & 63); else if (cc < 256) gc = 1536 + d * 64 + (cc - 192); else if (cc < 320) gc = 1664 + d * 64 + (cc - 256); else gc = 1792 + (cc - 320);
        MU[cc] = p.in[I_RW_MU][l * 1920 + gc]; }
    if (tid < 64) { const int c = h * 64 + tid; CW0[tid] = p.in[I_RW_W0][(l * 2 + d) * 512 + c]; CA0[tid] = p.in[I_RW_A0][(l * 2 + d) * 512 + c];
        CKK[tid] = p.in[I_RW_KK][l * 512 + c]; CKA[tid] = p.in[I_RW_KA][l * 512 + c]; CRK[tid] = p.in[I_RW_RK][l * 512 + c]; }
    __syncthreads();
    if (wave >= 4) {
        const int t2 = tid - 256, sw = wave - 4;
        bf16x8 Bf[8];
#pragma unroll
        for (int f = 0; f < 8; ++f) { float v[8];
#pragma unroll
            for (int j = 0; j < 8; ++j) { float x;
                if (sw < 2) { const int cb = f >> 2, ks = f & 3, k = ks * 16 + hh * 8 + j; const float* w = sw == 0 ? p.in[I_RW_WUP] : p.in[I_RW_AUP]; x = w[((size_t)(l * 2 + d) * 64 + k) * 512 + h * 64 + cb * 32 + r32]; }
                else { const int cb = sw - 2, k = f * 16 + hh * 8 + j; x = p.in[I_RW_GUP][((size_t)l * 128 + k) * 512 + h * 64 + cb * 32 + r32]; }
                v[j] = x; }
            Bf[f] = __builtin_bit_cast(bf16x8, pack8(v)); }
        const bool s2on = t2 < 224; const int ch = s2on ? t2 % 56 : 0, seg = s2on ? t2 / 56 : 0, cc = ch * 8;
        int gcol; if (ch < 24) gcol = U_RW_R + (ch >> 3) * 512 + h * 64 + (ch & 7) * 8; else if (ch < 32) gcol = U_RW_WD + d * 64 + (ch - 24) * 8; else if (ch < 40) gcol = U_RW_AD + d * 64 + (ch - 32) * 8; else gcol = U_RW_GD + (ch - 40) * 8;
        float mu8[8];
        { const f32x4 m0 = *(const LAS f32x4*)(MU + cc), m1 = *(const LAS f32x4*)(MU + cc + 4);
#pragma unroll
          for (int j = 0; j < 4; ++j) { mu8[j] = m0[j]; mu8[4 + j] = m1[j]; } }
        u32x4 rawreg[10];
#define RW_RAW_LOAD(cix) do { const ChunkPos cq = chunk_pos(b, d, (cix)); _Pragma("unroll") for (int it = 0; it < 10; ++it) { const int t = cq.t_lo + 8 * seg - 1 + it; u32x4 v = (u32x4){0u, 0u, 0u, 0u}; \
            if (s2on && t >= 0 && t < cq.seglen) v = *(const u32x4*)(U + (size_t)(cq.rowbase + t) * UC + gcol); rawreg[it] = v; } } while (0)
        RW_RAW_LOAD(0);
        for (int cs = 0; cs < NCHUNK; ++cs) {
            const ChunkPos cp = chunk_pos(b, d, cs);
            LAS float* OP = (LAS float*)(L + ((cs & 1) ? RW_OPB : RW_OP)); LAS float* W_ = OP; LAS float* KK = OP + 2048; LAS float* KKA = OP + 4096; LAS float* KD = OP + 6144; LAS float* R_ = OP + 8192; LAS float* V_ = OP + 10240;
            if (s2on) { float pv[8], c0[8], nx[8], mx[8]; unpack8(rawreg[0], pv); unpack8(rawreg[1], c0);
#pragma unroll
                for (int j = 0; j < 8; ++j) { const int s = 8 * seg + j; unpack8(rawreg[j + 2], nx);
#pragma unroll
                    for (int q = 0; q < 8; ++q) { mx[q] = c0[q] + mu8[q] * (0.5f * (pv[q] + nx[q]) - c0[q]); pv[q] = c0[q]; c0[q] = nx[q]; }
                    if (ch < 24) { LAS float* dst = (ch < 8 ? R_ : (ch < 16 ? KD : V_)) + s * 64 + (cc & 63);
                        *(LAS f32x4*)dst = (f32x4){mx[0], mx[1], mx[2], mx[3]}; *(LAS f32x4*)(dst + 4) = (f32x4){mx[4], mx[5], mx[6], mx[7]}; }
                    else if (ch < 32) {
#pragma unroll
                        for (int q = 0; q < 8; ++q) mx[q] = tanh_fast(mx[q]);
                        *(LAS u32x4*)(TW + s * 72 + cc - 192) = pack8(mx); }
                    else if (ch < 40) *(LAS u32x4*)(TA + s * 72 + cc - 256) = pack8(mx);
                    else {
#pragma unroll
                        for (int q = 0; q < 8; ++q) mx[q] = sigmoidf_(mx[q]);
                        *(LAS u32x4*)(TG + s * 136 + cc - 320) = pack8(mx); } } }
            if (cs + 1 < NCHUNK) RW_RAW_LOAD(cs + 1);
            RW_BAR_NV();
            if (sw < 2) {
#pragma unroll
                for (int cb = 0; cb < 2; ++cb) { f32x16 acc = (f32x16){0.f,0.f,0.f,0.f,0.f,0.f,0.f,0.f,0.f,0.f,0.f,0.f,0.f,0.f,0.f,0.f};
#pragma unroll
                    for (int ks = 0; ks < 4; ++ks) { const bf16x8 a = *(const LAS bf16x8*)((sw == 0 ? TW : TA) + r32 * 72 + ks * 16 + hh * 8); acc = __builtin_amdgcn_mfma_f32_32x32x16_bf16(a, Bf[cb * 4 + ks], acc, 0, 0, 0); }
                    const int c = cb * 32 + r32;
#pragma unroll
                    for (int r = 0; r < 16; ++r) { const int s = (r & 3) + 8 * (r >> 2) + 4 * hh; if (sw == 0) W_[s * 64 + c] = acc[r]; else KKA[s * 64 + c] = acc[r]; } } }
            else if (d == 0) { const int cb = sw - 2; f32x16 acc = (f32x16){0.f,0.f,0.f,0.f,0.f,0.f,0.f,0.f,0.f,0.f,0.f,0.f,0.f,0.f,0.f,0.f};
#pragma unroll
                for (int ks = 0; ks < 8; ++ks) { const bf16x8 a = *(const LAS bf16x8*)(TG + r32 * 136 + ks * 16 + hh * 8); acc = __builtin_amdgcn_mfma_f32_32x32x16_bf16(a, Bf[ks], acc, 0, 0, 0); }
#pragma unroll
                for (int r = 0; r < 16; ++r) { const int s = (r & 3) + 8 * (r >> 2) + 4 * hh; RWG[(size_t)(cp.rowbase + cp.t_lo + s) * 512 + h * 64 + cb * 32 + r32] = f2bf(acc[r]); } }
            RW_BAR_NV();
            { const int s = t2 >> 3, c8 = (t2 & 7) * 8; float kkv[8], av[8], kt[8], wr[8], rr[8], cw0[8], ca0[8], ckk[8], cka[8], crk[8], ssq = 0.f, bdp = 0.f;
#define RW_LD8(dst, ptr) do { const f32x4 t0_ = *(const LAS f32x4*)(ptr), t1_ = *(const LAS f32x4*)((ptr) + 4); _Pragma("unroll") for (int q_ = 0; q_ < 4; ++q_) { dst[q_] = t0_[q_]; dst[4 + q_] = t1_[q_]; } } while (0)
#define RW_ST8(ptr, src) do { *(LAS f32x4*)(ptr) = (f32x4){src[0], src[1], src[2], src[3]}; *(LAS f32x4*)((ptr) + 4) = (f32x4){src[4], src[5], src[6], src[7]}; } while (0)
                RW_LD8(kt, KD + s * 64 + c8); RW_LD8(av, KKA + s * 64 + c8); RW_LD8(wr, W_ + s * 64 + c8); RW_LD8(rr, R_ + s * 64 + c8);
                RW_LD8(cw0, CW0 + c8); RW_LD8(ca0, CA0 + c8); RW_LD8(ckk, CKK + c8); RW_LD8(cka, CKA + c8); RW_LD8(crk, CRK + c8);
#pragma unroll
                for (int j = 0; j < 8; ++j) { av[j] = sigmoidf_(ca0[j] + av[j]); kkv[j] = kt[j] * ckk[j]; ssq += kkv[j] * kkv[j]; wr[j] = __expf(-0.60653066f * sigmoidf_(cw0[j] + wr[j])); }
                const float inv = rsqrtf(sum8(ssq) + 1e-12f); float kk8[8], kka8[8], kd8[8];
#pragma unroll
                for (int j = 0; j < 8; ++j) { const float kn = kkv[j] * inv; kk8[j] = -kn; kka8[j] = kn * av[j]; kd8[j] = kt[j] * (1.0f + (av[j] - 1.0f) * cka[j]); bdp += rr[j] * kd8[j] * crk[j]; }
                RW_ST8(W_ + s * 64 + c8, wr); RW_ST8(KK + s * 64 + c8, kk8); RW_ST8(KKA + s * 64 + c8, kka8); RW_ST8(KD + s * 64 + c8, kd8);
                bdp = sum8(bdp); if ((t2 & 7) == 0) BD[(size_t)(cp.rowbase + cp.t_lo + s) * 8 + h] = bdp; }
            RW_BAR_NV();
        }
        RW_BAR_NV(); RW_BAR_NV(); RW_BAR_NV();
#undef RW_RAW_LOAD
    } else {
        const int vl = lane >> 3, kq = lane & 7; f32x2 S2[2][4];
#pragma unroll
        for (int i = 0; i < 2; ++i)
#pragma unroll
            for (int q = 0; q < 4; ++q) S2[i][q] = (f32x2){0.f, 0.f};
        __builtin_amdgcn_s_setprio(3);
        RW_BAR_NV(); RW_BAR_NV(); RW_BAR_NV();
#ifdef DBG_RWT
        unsigned tw_ = 0u; const unsigned tst_ = (unsigned)(__builtin_amdgcn_s_memtime() >> 6);
#endif
        struct Ops { f32x4 w0, w1, k0, k1, a0, a1, d0, d1, r0, r1; f32x2 v2; };
        for (int ci = 0; ci < NCHUNK; ++ci) {
            const ChunkPos cp = chunk_pos(b, d, ci);
            const LAS float* OP = (const LAS float*)(L + ((ci & 1) ? RW_OPB : RW_OP)); const LAS float* W_ = OP; const LAS float* KK = OP + 2048; const LAS float* KKA = OP + 4096; const LAS float* KD = OP + 6144; const LAS float* R_ = OP + 8192; const LAS float* V_ = OP + 10240;
            bf16_t* yrow = RWY + (size_t)(cp.rowbase + cp.t_lo) * 512 + h * 64 + 16 * wave + 2 * vl;
#define RW_OPLOAD(X, stx) do { const int st_ = (stx) < 32 ? (stx) : 31; const int sm_ = d ? 31 - st_ : st_; const int o_ = sm_ * 64 + 8 * kq; \
                X.w0 = *(const LAS f32x4*)(W_ + o_); X.w1 = *(const LAS f32x4*)(W_ + o_ + 4); X.k0 = *(const LAS f32x4*)(KK + o_); X.k1 = *(const LAS f32x4*)(KK + o_ + 4); \
                X.a0 = *(const LAS f32x4*)(KKA + o_); X.a1 = *(const LAS f32x4*)(KKA + o_ + 4); X.d0 = *(const LAS f32x4*)(KD + o_); X.d1 = *(const LAS f32x4*)(KD + o_ + 4); \
                X.r0 = *(const LAS f32x4*)(R_ + o_); X.r1 = *(const LAS f32x4*)(R_ + o_ + 4); X.v2 = *(const LAS f32x2*)(V_ + sm_ * 64 + 16 * wave + 2 * vl); } while (0)
#ifdef DBG_RWT
#define RW_SEGBAR() do { const unsigned ta_ = (unsigned)(__builtin_amdgcn_s_memtime() >> 6); RW_BAR_NV(); tw_ += (unsigned)(__builtin_amdgcn_s_memtime() >> 6) - ta_; } while (0)
#else
#define RW_SEGBAR() RW_BAR_NV()
#endif
#define RW_STEP(X, stx) do { const int sm_ = d ? 31 - (stx) : (stx); \
                const f32x2 w_[4] = {X.w0.xy, X.w0.zw, X.w1.xy, X.w1.zw}, k_[4] = {X.k0.xy, X.k0.zw, X.k1.xy, X.k1.zw}, a_[4] = {X.a0.xy, X.a0.zw, X.a1.xy, X.a1.zw}, \
                            dd_[4] = {X.d0.xy, X.d0.zw, X.d1.xy, X.d1.zw}, r_[4] = {X.r0.xy, X.r0.zw, X.r1.xy, X.r1.zw}; \
                float y_[2]; \
                _Pragma("unroll") for (int i = 0; i < 2; ++i) { \
                    f32x2 t_ = S2[i][0] * k_[0]; t_ = S2[i][1] * k_[1] + t_; t_ = S2[i][2] * k_[2] + t_; t_ = S2[i][3] * k_[3] + t_; \
                    const float sa_ = sum8(t_.x + t_.y); const f32x2 sa2_ = {sa_, sa_}; const f32x2 vv_ = {X.v2[i], X.v2[i]}; \
                    _Pragma("unroll") for (int q = 0; q < 4; ++q) S2[i][q] = S2[i][q] * w_[q] + sa2_ * a_[q] + vv_ * dd_[q]; \
                    f32x2 u_ = S2[i][0] * r_[0]; u_ = S2[i][1] * r_[1] + u_; u_ = S2[i][2] * r_[2] + u_; u_ = S2[i][3] * r_[3] + u_; \
                    y_[i] = sum8(u_.x + u_.y); } \
                if (kq == 0) *(unsigned*)(yrow + (size_t)sm_ * 512) = cvt_pk_bf16(y_[0], y_[1]); } while (0)
            Ops A, B;
            RW_OPLOAD(A, 0);
#pragma unroll 1
            for (int seg = 0; seg < 3; ++seg) { const int s_lo = seg == 0 ? 0 : (seg == 1 ? 10 : 22), s_hi = seg == 0 ? 10 : (seg == 1 ? 22 : 32);
#pragma unroll 1
                for (int st = s_lo; st < s_hi; st += 2) { RW_OPLOAD(B, st + 1); RW_STEP(A, st); RW_OPLOAD(A, st + 2); RW_STEP(B, st + 1); }
                RW_SEGBAR();
            }
#undef RW_OPLOAD
#undef RW_STEP
#undef RW_SEGBAR
        }
        __builtin_amdgcn_s_setprio(0);
#ifdef DBG_RWT
        if (wave == 0 && lane == 0) { unsigned* ctl = (unsigned*)(p.ws + WS_CTL); atomicAdd(ctl + 14000, tw_ >> 4); atomicAdd(ctl + 14001, ((unsigned)(__builtin_amdgcn_s_memtime() >> 6) - tst_) >> 4); }
#endif
    }
}
constexpr int SD_RAW = 0, SD_BM = 42240, SD_CM = 59648, SD_XM = 77056, SD_XST = 86272, SD_H0 = 95488, SD_CUM = 130304, SD_DTC = 130560, SD_LA = 130816, SD_CW = 131072, SD_CB = 134912;
constexpr int SD_LDB = 272, SD_LDX = 144;
struct ChunkPos64 { int rowbase, t_lo, seglen; };
__device__ __forceinline__ ChunkPos64 chunk_pos64(int b, int d, int ci) { ChunkPos64 c; const bool isctx = ci < 4; const int cl = isctx ? ci : ci - 4; c.seglen = isctx ? LCTX : LAT;
    c.rowbase = b * TPB + (isctx ? 0 : LCTX); c.t_lo = d == 0 ? cl * 64 : c.seglen - 64 * (cl + 1); return c; }
PHASE_FN void ssd_chain(int wv, PRM p, int l, LAS unsigned char* L, int d, int b, int h) {
    const int tid = TID, lane = tid & 63, wave = wv, r32 = lane & 31, hh = lane >> 5, g = h >> 2;
    LAS bf16_t* RAW = (LAS bf16_t*)(L + SD_RAW);
    LAS float* CUM = (LAS float*)(L + SD_CUM); LAS float* DTC = (LAS float*)(L + SD_DTC); LAS float* LA = (LAS float*)(L + SD_LA);
    LAS float* CWt = (LAS float*)(L + SD_CW); LAS float* CBs = (LAS float*)(L + SD_CB);
    const bf16_t* U = (const bf16_t*)(p.ws + WS_U); bf16_t* SSDY = (bf16_t*)(p.ws + WS_SSDY) + (size_t)d * NTOK * 512;
    __syncthreads();
    if (tid < 320) { const int cc = tid; const int ch = cc < 64 ? h * 64 + cc : (cc < 192 ? 512 + g * 128 + (cc - 64) : 768 + g * 128 + (cc - 192));
#pragma unroll
        for (int j = 0; j < 3; ++j) CWt[j * 320 + cc] = p.in[I_SSD_CW][((size_t)l * 3 + j) * 1024 + ch];
        CBs[cc] = p.in[I_SSD_CB][l * 1024 + ch]; }
    for (int i = tid; i < 64 * SD_LDB / 4; i += NTHR) ((LAS unsigned*)(L + SD_H0))[i] = 0u;
    const float Aneg = -__expf(p.in[I_SSD_ALOG][(l * 2 + d) * 8 + h]), dtb = p.in[I_SSD_DTB][(l * 2 + d) * 8 + h], Dh = p.in[I_SSD_D][l * 8 + h];
    f32x16 hst[2];
    hst[0] = (f32x16){0.f,0.f,0.f,0.f,0.f,0.f,0.f,0.f,0.f,0.f,0.f,0.f,0.f,0.f,0.f,0.f}; hst[1] = hst[0];
    const bf16_t* XBC = (const bf16_t*)(p.ws + WS_XBC);
    u32x4 rawreg[5]; float dtreg = 0.f;
#define SD_LOAD(cpx) do { _Pragma("unroll") for (int it = 0; it < 5; ++it) { const int idx = tid + it * NTHR; const int row = idx / 40, ch = idx - row * 40; \
            const int gcol = ch < 8 ? h * 64 + ch * 8 : (ch < 24 ? 512 + g * 128 + (ch - 8) * 8 : 768 + g * 128 + (ch - 24) * 8); \
            rawreg[it] = *(const u32x4*)(XBC + (size_t)((cpx).rowbase + (cpx).t_lo + row) * 1024 + gcol); } \
        if (tid < 64) { const int sm = d ? 63 - tid : tid; dtreg = bf2f(U[(size_t)((cpx).rowbase + (cpx).t_lo + sm) * UC + U_SSD_DT + h]); } } while (0)
    { const ChunkPos64 c0 = chunk_pos64(b, d, 0); SD_LOAD(c0); }
    const int i16 = lane & 15; const int troff = (4 * hh + (i16 >> 2)), trcol = (((lane >> 4) & 1) * 16 + (i16 & 3) * 4) * 2;
    for (int ci = 0; ci < 68; ++ci) {
        const ChunkPos64 cp = chunk_pos64(b, d, ci);
        LAS unsigned char* H0c = L + SD_H0 + (ci & 1) * 64 * SD_LDB; LAS unsigned char* H0n = L + SD_H0 + ((ci + 1) & 1) * 64 * SD_LDB;
        BAR_LDS();
        if (ci > 0) { const ChunkPos64 cq = chunk_pos64(b, d, ci - 1); const int rw = tid >> 3, pc = tid & 7;
            *(u32x4*)(SSDY + (size_t)(cq.rowbase + cq.t_lo + rw) * 512 + h * 64 + pc * 8) = *(const LAS u32x4*)(L + SD_RAW + rw * SD_LDX + pc * 16); }
#pragma unroll
        for (int it = 0; it < 5; ++it) { const int idx = tid + it * NTHR; const int sm = idx / 40, ch = idx - sm * 40, cc = ch * 8; const int i = d ? 63 - sm : sm;
            LAS unsigned char* dst = ch < 8 ? L + SD_XM + i * SD_LDX + cc * 2 : (ch < 24 ? L + SD_BM + i * SD_LDB + (cc - 64) * 2 : L + SD_CM + i * SD_LDB + (cc - 192) * 2);
            *(LAS u32x4*)dst = rawreg[it]; }
        if (wave == 0) { const float dtc = softplus_fast(dtreg + dtb); DTC[lane] = dtc; CUM[lane] = wave_incl_scan(dtc * Aneg, lane); }
        BAR_LDS();
        if (ci + 1 < 68) { const ChunkPos64 cn = chunk_pos64(b, d, ci + 1); SD_LOAD(cn); }
        { const int pp = tid & 63, jc = tid >> 6; const float cl = CUM[63]; float x[8];
#pragma unroll
            for (int q = 0; q < 8; ++q) { const int j = 8 * jc + q; x[q] = bf2f(*(const LAS bf16_t*)(L + SD_XM + j * SD_LDX + pp * 2)) * (__expf(cl - CUM[j]) * DTC[j]); }
            *(LAS u32x4*)(L + SD_XST + pp * SD_LDX + jc * 16) = pack8(x); }
        BAR_LDS();
        if (wave < 4) {
            const int ib = wave >> 1, pb = wave & 1;
            f32x16 accy = (f32x16){0.f,0.f,0.f,0.f,0.f,0.f,0.f,0.f,0.f,0.f,0.f,0.f,0.f,0.f,0.f,0.f};
            const float cum_i = CUM[32 * ib + r32];
            for (int jb = 0; jb <= ib; ++jb) {
                f32x16 st = (f32x16){0.f,0.f,0.f,0.f,0.f,0.f,0.f,0.f,0.f,0.f,0.f,0.f,0.f,0.f,0.f,0.f};
#pragma unroll
                for (int ks = 0; ks < 8; ++ks) { const bf16x8 a = *(const LAS bf16x8*)(L + SD_BM + (32 * jb + r32) * SD_LDB + (ks * 16 + hh * 8) * 2);
                    const bf16x8 bq = *(const LAS bf16x8*)(L + SD_CM + (32 * ib + r32) * SD_LDB + (ks * 16 + hh * 8) * 2); st = __builtin_amdgcn_mfma_f32_32x32x16_bf16(a, bq, st, 0, 0, 0); }
                float pv[16];
#pragma unroll
                for (int g4 = 0; g4 < 4; ++g4) { const f32x4 cj = *(const LAS f32x4*)(CUM + 32 * jb + 8 * g4 + 4 * hh), dj = *(const LAS f32x4*)(DTC + 32 * jb + 8 * g4 + 4 * hh);
#pragma unroll
                    for (int q = 0; q < 4; ++q) { const int jl = 8 * g4 + 4 * hh + q; const bool dead = (jb == ib) && (jl > r32); pv[4 * g4 + q] = dead ? 0.f : st[4 * g4 + q] * __expf(cum_i - cj[q]) * dj[q]; } }
#pragma unroll
                for (int ks = 0; ks < 2; ++ks) { float t8[8];
#pragma unroll
                    for (int q = 0; q < 8; ++q) t8[q] = pv[8 * ks + q];
                    const bf16x8 pa = __builtin_bit_cast(bf16x8, pack8(t8));
                    const LAS unsigned char* vb = L + SD_XM + (32 * jb + 16 * ks + troff) * SD_LDX + pb * 64 + trcol;
                    const s16x4 lo = vtr(vb), hi = vtr(vb + 8 * SD_LDX); const bf16x8 vf = (bf16x8){lo[0], lo[1], lo[2], lo[3], hi[0], hi[1], hi[2], hi[3]};
                    accy = __builtin_amdgcn_mfma_f32_32x32x16_bf16(pa, vf, accy, 0, 0, 0); }
            }
            f32x16 acc2 = (f32x16){0.f,0.f,0.f,0.f,0.f,0.f,0.f,0.f,0.f,0.f,0.f,0.f,0.f,0.f,0.f,0.f};
#pragma unroll
            for (int ks = 0; ks < 8; ++ks) { const bf16x8 a = *(const LAS bf16x8*)(L + SD_CM + (32 * ib + r32) * SD_LDB + (ks * 16 + hh * 8) * 2);
                const bf16x8 bq = *(const LAS bf16x8*)(H0c + (32 * pb + r32) * SD_LDB + (ks * 16 + hh * 8) * 2); acc2 = __builtin_amdgcn_mfma_f32_32x32x16_bf16(a, bq, acc2, 0, 0, 0); }
#pragma unroll
            for (int r = 0; r < 16; ++r) { const int il = (r & 3) + 8 * (r >> 2) + 4 * hh, i = 32 * ib + il; float y = accy[r] + __expf(CUM[i]) * acc2[r];
                if (d == 0) y += Dh * bf2f(*(const LAS bf16_t*)(L + SD_XM + i * SD_LDX + (32 * pb + r32) * 2));
                const int sm = d ? 63 - i : i; *(LAS bf16_t*)(L + SD_RAW + sm * SD_LDX + (32 * pb + r32) * 2) = f2bf(y); }
        } else {
            const float e_last = __expf(CUM[63]);
#pragma unroll
            for (int tt = 0; tt < 2; ++tt) { const int t = 2 * (wave - 4) + tt, pb = t & 1, nb = t >> 1;
                hst[tt] = hst[tt] * e_last;
#pragma unroll
                for (int ks = 0; ks < 4; ++ks) { const bf16x8 a = *(const LAS bf16x8*)(L + SD_XST + (32 * pb + r32) * SD_LDX + (ks * 16 + hh * 8) * 2);
                    const LAS unsigned char* vb = L + SD_BM + (16 * ks + 8 * hh + (i16 >> 2)) * SD_LDB + nb * 64 + trcol;
                    const s16x4 lo = vtr(vb), hi = vtr(vb + 4 * SD_LDB); const bf16x8 vf = (bf16x8){lo[0], lo[1], lo[2], lo[3], hi[0], hi[1], hi[2], hi[3]};
                    hst[tt] = __builtin_amdgcn_mfma_f32_32x32x16_bf16(a, vf, hst[tt], 0, 0, 0); }
#pragma unroll
                for (int r = 0; r < 16; ++r) { const int pl = (r & 3) + 8 * (r >> 2) + 4 * hh; *(LAS bf16_t*)(H0n + (32 * pb + pl) * SD_LDB + (32 * nb + r32) * 2) = f2bf(hst[tt][r]); } }
        }
    }
    BAR_LDS();
    { const ChunkPos64 cq = chunk_pos64(b, d, 67); const int rw = tid >> 3, pc = tid & 7;
        *(u32x4*)(SSDY + (size_t)(cq.rowbase + cq.t_lo + rw) * 512 + h * 64 + pc * 8) = *(const LAS u32x4*)(L + SD_RAW + rw * SD_LDX + pc * 16); }
#undef SD_LOAD
}
constexpr int GL_RAW = 0, GL_GC = 34816, GL_SEG = 51200, GL_QP = 53248, GL_KP = 62464, GL_QE = 71680, GL_K2T = 80896, GL_V = 90112, GL_S0T = 107520, GL_EL = 144384, GL_GUP = 144640, GL_GB = 148736;
PHASE_FN void gla_chain(int wv, PRM p, int l, LAS unsigned char* L, int d, int b, int h) {
    const int tid = TID, lane = tid & 63, wave = wv, r32 = lane & 31, hh = lane >> 5;
    LAS bf16_t* RAW = (LAS bf16_t*)(L + GL_RAW);
    LAS float* GC = (LAS float*)(L + GL_GC); LAS float* SEG = (LAS float*)(L + GL_SEG); LAS float* EL = (LAS float*)(L + GL_EL); LAS float* GUP = (LAS float*)(L + GL_GUP); LAS float* GB = (LAS float*)(L + GL_GB);
    const bf16_t* U = (const bf16_t*)(p.ws + WS_U); bf16_t* GLAO = (bf16_t*)(p.ws + WS_GLAO) + (size_t)d * NTOK * 512;
    __syncthreads();
    for (int i = tid; i < 1024; i += NTHR) GUP[i] = p.in[I_GLA_GUP][((size_t)(l * 2 + d) * 16 + (i >> 6)) * 256 + h * 64 + (i & 63)];
    if (tid < 64) GB[tid] = p.in[I_GLA_GB][(l * 2 + d) * 256 + h * 64 + tid];
    for (int i = tid; i < 128 * SD_LDX / 4; i += NTHR) ((LAS unsigned*)(L + GL_S0T))[i] = 0u;
    f32x16 sst[2]; sst[0] = (f32x16){0.f,0.f,0.f,0.f,0.f,0.f,0.f,0.f,0.f,0.f,0.f,0.f,0.f,0.f,0.f,0.f}; sst[1] = sst[0];
    u32x4 rawreg[5];
#define GL_LOAD(cpx) do { _Pragma("unroll") for (int it = 0; it < 5; ++it) { const int idx = tid + it * NTHR; u32x4 v = (u32x4){0u, 0u, 0u, 0u}; \
        if (idx < 64 * 34) { const int row = idx / 34, ch = idx - row * 34; \
            const int gcol = ch < 8 ? U_GLA_Q + h * 64 + ch * 8 : (ch < 16 ? U_GLA_K + h * 64 + (ch - 8) * 8 : (ch < 32 ? U_GLA_V + h * 128 + (ch - 16) * 8 : U_GLA_GD + d * 16 + (ch - 32) * 8)); \
            v = *(const u32x4*)(U + (size_t)((cpx).rowbase + (cpx).t_lo + row) * UC + gcol); } \
        rawreg[it] = v; } } while (0)
    { const ChunkPos64 c0 = chunk_pos64(b, d, 0); GL_LOAD(c0); }
    const int i16 = lane & 15, q4 = i16 >> 2; const int trcol = (((lane >> 4) & 1) * 16 + (i16 & 3) * 4) * 2;
    for (int ci = 0; ci < 68; ++ci) {
        const ChunkPos64 cp = chunk_pos64(b, d, ci);
        LAS unsigned char* S0c = L + GL_S0T + (ci & 1) * 128 * SD_LDX; LAS unsigned char* S0n = L + GL_S0T + ((ci + 1) & 1) * 128 * SD_LDX;
        BAR_LDS();
        if (ci > 0) { const ChunkPos64 cq = chunk_pos64(b, d, ci - 1);
#pragma unroll
            for (int it = 0; it < 2; ++it) { const int idx = tid + it * NTHR, rw = idx >> 4, ec = idx & 15;
                *(u32x4*)(GLAO + (size_t)(cq.rowbase + cq.t_lo + rw) * 512 + h * 128 + ec * 8) = *(const LAS u32x4*)(L + GL_GC + rw * SD_LDB + ec * 16); } }
#pragma unroll
        for (int it = 0; it < 5; ++it) { const int idx = tid + it * NTHR; if (idx < 64 * 34) { const int row = idx / 34, ch = idx - row * 34; *(LAS u32x4*)(RAW + row * 272 + ch * 8) = rawreg[it]; } }
        BAR_LDS();
        if (ci + 1 < 68) { const ChunkPos64 cn = chunk_pos64(b, d, ci + 1); GL_LOAD(cn); }
        { const int i = tid >> 3, kc = tid & 7; const int sm = d ? 63 - i : i; float gdA[8], gdB[8], gt[8];
            unpack8(*(const LAS u32x4*)(RAW + sm * 272 + 256), gdA); unpack8(*(const LAS u32x4*)(RAW + sm * 272 + 264), gdB);
            { const f32x4 b0 = *(const LAS f32x4*)(GB + kc * 8), b1 = *(const LAS f32x4*)(GB + kc * 8 + 4);
#pragma unroll
              for (int q = 0; q < 4; ++q) { gt[q] = b0[q]; gt[4 + q] = b1[q]; } }
#pragma unroll
            for (int r = 0; r < 16; ++r) { const f32x4 u0 = *(const LAS f32x4*)(GUP + r * 64 + kc * 8), u1 = *(const LAS f32x4*)(GUP + r * 64 + kc * 8 + 4);
#pragma unroll
                for (int q = 0; q < 4; ++q) { const float gv = r < 8 ? gdA[r & 7] : gdB[r & 7]; gt[q] += gv * u0[q]; gt[4 + q] += gv * u1[q]; } }
            f32x4 o0, o1;
#pragma unroll
            for (int q = 0; q < 4; ++q) { o0[q] = -softplus_fast(-gt[q]) * (1.0f / 16.0f); o1[q] = -softplus_fast(-gt[4 + q]) * (1.0f / 16.0f); }
            *(LAS f32x4*)(GC + i * 64 + kc * 8) = o0; *(LAS f32x4*)(GC + i * 64 + kc * 8 + 4) = o1; }
        BAR_LDS();
        { const int k = tid & 63, seg = tid >> 6; float run = 0.f;
#pragma unroll
            for (int ii = 0; ii < 8; ++ii) { run += GC[(seg * 8 + ii) * 64 + k]; GC[(seg * 8 + ii) * 64 + k] = run; }
            SEG[seg * 64 + k] = run;
            BAR_LDS();
            float pre = 0.f; for (int s2 = 0; s2 < seg; ++s2) pre += SEG[s2 * 64 + k];
#pragma unroll
            for (int ii = 0; ii < 8; ++ii) GC[(seg * 8 + ii) * 64 + k] += pre; }
        BAR_LDS();
        { const int i = tid >> 3, kc = tid & 7; const int sm = d ? 63 - i : i; float q8[8], k8[8], gci[8], gref[8];
            unpack8(*(const LAS u32x4*)(RAW + sm * 272 + kc * 8), q8); unpack8(*(const LAS u32x4*)(RAW + sm * 272 + 64 + kc * 8), k8);
            { const f32x4 a0 = *(const LAS f32x4*)(GC + i * 64 + kc * 8), a1 = *(const LAS f32x4*)(GC + i * 64 + kc * 8 + 4), r0 = *(const LAS f32x4*)(GC + 32 * 64 + kc * 8), r1 = *(const LAS f32x4*)(GC + 32 * 64 + kc * 8 + 4);
#pragma unroll
              for (int q = 0; q < 4; ++q) { gci[q] = a0[q]; gci[4 + q] = a1[q]; gref[q] = r0[q]; gref[4 + q] = r1[q]; } }
            float qp[8], kp[8], qe[8];
#pragma unroll
            for (int q = 0; q < 8; ++q) { const float qs = q8[q] * 0.125f; qp[q] = qs * __expf(gci[q] - gref[q]); kp[q] = k8[q] * __expf(gref[q] - gci[q]); qe[q] = qs * __expf(gci[q]); }
            *(LAS u32x4*)(L + GL_QP + i * SD_LDX + kc * 16) = pack8(qp); *(LAS u32x4*)(L + GL_KP + i * SD_LDX + kc * 16) = pack8(kp); *(LAS u32x4*)(L + GL_QE + i * SD_LDX + kc * 16) = pack8(qe); }
        { const int k = tid & 63, jc = tid >> 6; const float gl = GC[63 * 64 + k]; float x[8];
#pragma unroll
            for (int q = 0; q < 8; ++q) { const int j = 8 * jc + q; const int sm = d ? 63 - j : j; x[q] = bf2f(RAW[sm * 272 + 64 + k]) * __expf(gl - GC[j * 64 + k]); }
            *(LAS u32x4*)(L + GL_K2T + k * SD_LDX + jc * 16) = pack8(x); }
        for (int idx = tid; idx < 64 * 16; idx += NTHR) { const int i = idx >> 4, vc = idx & 15; const int sm = d ? 63 - i : i; *(LAS u32x4*)(L + GL_V + i * SD_LDB + vc * 16) = *(const LAS u32x4*)(RAW + sm * 272 + 128 + vc * 8); }
        if (tid < 64) EL[tid] = __expf(GC[63 * 64 + tid]);
        BAR_LDS();
        if (wave < 4) {
            const int ib = wave >> 1, eh = wave & 1;
            f32x16 acc[2]; acc[0] = (f32x16){0.f,0.f,0.f,0.f,0.f,0.f,0.f,0.f,0.f,0.f,0.f,0.f,0.f,0.f,0.f,0.f}; acc[1] = acc[0];
            for (int jb = 0; jb <= ib; ++jb) {
                f32x16 at = (f32x16){0.f,0.f,0.f,0.f,0.f,0.f,0.f,0.f,0.f,0.f,0.f,0.f,0.f,0.f,0.f,0.f};
#pragma unroll
                for (int ks = 0; ks < 4; ++ks) { const bf16x8 a = *(const LAS bf16x8*)(L + GL_KP + (32 * jb + r32) * SD_LDX + (ks * 16 + hh * 8) * 2);
                    const bf16x8 bq = *(const LAS bf16x8*)(L + GL_QP + (32 * ib + r32) * SD_LDX + (ks * 16 + hh * 8) * 2); at = __builtin_amdgcn_mfma_f32_32x32x16_bf16(a, bq, at, 0, 0, 0); }
#pragma unroll
                for (int ks = 0; ks < 2; ++ks) { float t8[8];
#pragma unroll
                    for (int q = 0; q < 8; ++q) { const int r = 8 * ks + q; const int jl = (r & 3) + 8 * (r >> 2) + 4 * hh; t8[q] = ((jb == ib) && (jl > r32)) ? 0.f : at[r]; }
                    const bf16x8 pa = __builtin_bit_cast(bf16x8, pack8(t8));
#pragma unroll
                    for (int ebi = 0; ebi < 2; ++ebi) { const LAS unsigned char* vb = L + GL_V + (32 * jb + 16 * ks + 4 * hh + q4) * SD_LDB + (2 * eh + ebi) * 64 + trcol;
                        const s16x4 lo = vtr(vb), hi = vtr(vb + 8 * SD_LDB); const bf16x8 vf = (bf16x8){lo[0], lo[1], lo[2], lo[3], hi[0], hi[1], hi[2], hi[3]};
                        acc[ebi] = __builtin_amdgcn_mfma_f32_32x32x16_bf16(pa, vf, acc[ebi], 0, 0, 0); } }
            }
#pragma unroll
            for (int ebi = 0; ebi < 2; ++ebi)
#pragma unroll
                for (int ks = 0; ks < 4; ++ks) { const bf16x8 a = *(const LAS bf16x8*)(L + GL_QE + (32 * ib + r32) * SD_LDX + (ks * 16 + hh * 8) * 2);
                    const bf16x8 bq = *(const LAS bf16x8*)(S0c + (32 * (2 * eh + ebi) + r32) * SD_LDX + (ks * 16 + hh * 8) * 2); acc[ebi] = __builtin_amdgcn_mfma_f32_32x32x16_bf16(a, bq, acc[ebi], 0, 0, 0); }
#pragma unroll
            for (int r = 0; r < 16; ++r) { const int i = 32 * ib + (r & 3) + 8 * (r >> 2) + 4 * hh; const int sm = d ? 63 - i : i;
                LAS bf16_t* op = (LAS bf16_t*)(L + GL_GC + sm * SD_LDB) + 64 * eh + r32;
                op[0] = f2bf(acc[0][r]); op[32] = f2bf(acc[1][r]); }
        } else {
#pragma unroll
            for (int tt = 0; tt < 2; ++tt) { const int t = 2 * (wave - 4) + tt, kb = t & 1, eb = t >> 1;
#pragma unroll
                for (int g4 = 0; g4 < 4; ++g4) { const f32x4 e4 = *(const LAS f32x4*)(EL + 32 * kb + 8 * g4 + 4 * hh);
#pragma unroll
                    for (int q = 0; q < 4; ++q) sst[tt][4 * g4 + q] *= e4[q]; }
#pragma unroll
                for (int ks = 0; ks < 4; ++ks) { const bf16x8 a = *(const LAS bf16x8*)(L + GL_K2T + (32 * kb + r32) * SD_LDX + (ks * 16 + hh * 8) * 2);
                    const LAS unsigned char* vb = L + GL_V + (16 * ks + 8 * hh + q4) * SD_LDB + eb * 64 + trcol;
                    const s16x4 lo = vtr(vb), hi = vtr(vb + 4 * SD_LDB); const bf16x8 vf = (bf16x8){lo[0], lo[1], lo[2], lo[3], hi[0], hi[1], hi[2], hi[3]};
                    sst[tt] = __builtin_amdgcn_mfma_f32_32x32x16_bf16(a, vf, sst[tt], 0, 0, 0); }
#pragma unroll
                for (int g4 = 0; g4 < 4; ++g4) { u32x2 w; w.x = cvt_pk_bf16(sst[tt][4 * g4], sst[tt][4 * g4 + 1]); w.y = cvt_pk_bf16(sst[tt][4 * g4 + 2], sst[tt][4 * g4 + 3]);
                    *(LAS u32x2*)(S0n + (32 * eb + r32) * SD_LDX + (32 * kb + 8 * g4 + 4 * hh) * 2) = w; } }
        }
    }
    BAR_LDS();
    { const ChunkPos64 cq = chunk_pos64(b, d, 67);
#pragma unroll
        for (int it = 0; it < 2; ++it) { const int idx = tid + it * NTHR, rw = idx >> 4, ec = idx & 15;
            *(u32x4*)(GLAO + (size_t)(cq.rowbase + cq.t_lo + rw) * 512 + h * 128 + ec * 8) = *(const LAS u32x4*)(L + GL_GC + rw * SD_LDB + ec * 16); } }
#undef GL_LOAD
}
PHASE_FN void phase_mix(int wv, PRM p, int l, LAS unsigned char* lds, int qsel = 0, int item0 = 0, int item1 = 1 << 30) {
    LAS int* slot = (LAS int*)(lds + 32);
    unsigned* q = (unsigned*)(p.ws + WS_CTL) + CW_QUEUE + l * 64 + qsel * 16;
    const float lam_init = 0.8f - 0.6f * expf(-0.3f * (float)l);
    if (wv == 0) { const int ln = LANE; const float s1 = sum64(p.in[I_DF_Q1][l * 64 + ln] * p.in[I_DF_K1][l * 64 + ln]), s2 = sum64(p.in[I_DF_Q2][l * 64 + ln] * p.in[I_DF_K2][l * 64 + ln]);
        if (ln == 0) { LAS float* lp = (LAS float*)(lds + 40); lp[0] = expf(s1) - expf(s2) + lam_init; lp[1] = 1.0f - lam_init; } }
    const LAS float* lamp = (const LAS float*)(lds + 40);
    const int n_ctx_att = (l < DEPTH - 1) ? 64 : 0, nitems = 320 + 1024 + n_ctx_att;
    for (;;) {
        if (TID == 0) *slot = (int)atomicAdd(q, 1u);
        __syncthreads();
        const int item = *slot + item0;
        __syncthreads();
        if (item >= nitems || item >= item1) break;
        CParams& pp = *kparams(); LAS unsigned char* L = olds(lds) + LDS_STAGE;
#ifdef DBG_ITEM
        const unsigned ti0_ = (unsigned)__builtin_amdgcn_s_memrealtime();
#endif
        if (item < 128) { const int i = item; rwkv_chain(wv, pp, l, L, i & 1, (i >> 1) & 7, i >> 4); }
        else if (item < 256) { const int i = item - 128; ssd_chain(wv, pp, l, L, i & 1, (i >> 1) & 7, i >> 4); }
        else if (item < 320) { const int i = item - 256; gla_chain(wv, pp, l, L, i & 1, (i >> 1) & 7, i >> 4); }
        else if (item < 320 + 1024) { const int i = item - 320; const int b = i >> 7, h = (i >> 5) & 3, qb = i & 31; attn_unit(wv, pp, L, b * TPB + LCTX + qb * 128, b * TPB, TPB / 64, h, lamp, pp.in[I_DF_SG] + l * 128); }
        else { const int i = item - 1344; const int b = i >> 3, h = (i >> 1) & 3, qb = i & 1; attn_unit(wv, pp, L, b * TPB + qb * 128, b * TPB, LCTX / 64, h, lamp, pp.in[I_DF_SG] + l * 128); }
#ifdef DBG_ITEM
        { const int cls_ = item < 128 ? 0 : (item < 256 ? 1 : (item < 320 ? 2 : 3)); if (cls_ == DBG_ITEM && TID == 0) { unsigned* ctl = (unsigned*)(p.ws + WS_CTL); atomicAdd(ctl + 14004, (unsigned)__builtin_amdgcn_s_memrealtime() - ti0_); atomicAdd(ctl + 14005, 1u); } }
#endif
    }
}

__device__ __forceinline__ bool dense_tail_worker(int ntiles, int& worker, int& nworkers) { const int G = (int)gridDim.x, rem = ntiles % G; worker = rem ? BLK - rem : BLK; nworkers = rem ? G - rem : G; return worker >= 0; }
PHASE_FN void phase_g1(int wv, PRM p, LAS unsigned char* lds, int l = 1) {
    const char* ws = p.ws; SchedDense S{NPANEL, UC / 256, (int)gridDim.x, BLK, ws + WS_H, ws + WS_WIN, (size_t)256 * 1024 * 2, (size_t)256 * 1024 * 2, 0};
    EpiStoreBf16<0> E{(bf16_t*)(p.ws + WS_U), UC};
    pg8::gemm_phase(wv, lds + LDS_STAGE, pg8::Gemm{1024, 1024, 1024}, S, E);
    if (l == 0) { int w, nw; if (dense_tail_worker(NPANEL * (UC / 256), w, nw)) phase_convert(wv, p, 0, lds, CV_T0, CV_T1, w, nw); } }
PHASE_FN void phase_g2(int wv, PRM p, LAS unsigned char* lds, int lat, int l0 = 0) {
    const char* ws = p.ws; SchedDense S{lat ? 128 : NPANEL, 16, (int)gridDim.x, BLK, ws + WS_H, ws + WS_WG, (size_t)256 * 1024 * 2, (size_t)256 * 1024 * 2, lat};
    EpiStoreBf16<1> E{(bf16_t*)(p.ws + WS_GATES), 4096};
    pg8::gemm_phase(wv, lds + LDS_STAGE, pg8::Gemm{1024, 1024, 1024}, S, E);
    if (l0) { int w, nw; if (dense_tail_worker(NPANEL * 16, w, nw)) phase_convert(wv, p, 0, lds, CV_T1, CV_T3, w, nw); } }
__device__ __forceinline__ bool tail_worker(int& worker, int& nworkers) { const int G = (int)gridDim.x, rem = (NPANEL * 4) % G; worker = BLK - rem; nworkers = G - rem; return worker >= 0; }
PHASE_FN void phase_g3(int wv, PRM p, LAS unsigned char* lds, int l) {
    const int lat = l == DEPTH - 1;
    const char* ws = p.ws; SchedMerge S{(int)gridDim.x, BLK, ws + WS_Y, ws + WS_WB, lat};
    EpiMerge E{(const bf16_t*)(ws + WS_GATES), (float*)(p.ws + WS_M), (bf16_t*)(p.ws + WS_H)};
    pg8::gemm_phase(wv, lds + LDS_STAGE, pg8::Gemm{2048, 512, 512}, S, E);
    if (!lat) { int w, nw; if (tail_worker(w, nw)) { phase_convert(wv, p, l, lds, CV_T3, CV_T4, w, nw); phase_convert(wv, p, l + 1, lds, 0, CV_T1, w, nw); } } }
PHASE_FN void phase_g4(int wv, PRM p, int l, LAS unsigned char* lds) {
    const char* ws = p.ws; SchedDense S{l == DEPTH - 1 ? 128 : NPANEL, 4, (int)gridDim.x, BLK, ws + WS_H, ws + WS_WO, (size_t)256 * 1024 * 2, (size_t)256 * 1024 * 2, l == DEPTH - 1};
    EpiResid E{(bf16_t*)(p.ws + WS_XSB), p.in[I_CTX], p.in[I_X], l, (const float*)(ws + WS_MOD) + (size_t)l * 9 * 6144};
    pg8::gemm_phase(wv, lds + LDS_STAGE, pg8::Gemm{1024, 1024, 1024}, S, E);
    if (l != DEPTH - 1) { int w, nw; if (tail_worker(w, nw)) { phase_convert(wv, p, l, lds, CV_T4, CV_T5, w, nw); phase_convert(wv, p, l + 1, lds, CV_T1, CV_T2, w, nw); } } }
PHASE_FN void phase_g5(int wv, PRM p, int l, LAS unsigned char* lds) {
    const char* ws = p.ws; LAS int* tab = (LAS int*)(lds + LDS_TAB); moe_tables(wv, p, l, tab, tab + 320);
    SchedMoe S{(int)gridDim.x, BLK, tab, ws + WS_H, ws + WS_GU, (size_t)0, (size_t)1024 * 1024 * 2, (size_t)256 * 1024 * 2, (const int*)(ws + WS_TOK)};
    EpiSwiGLU E{(bf16_t*)(p.ws + WS_HID)};
    pg8::gemm_phase<EpiSwiGLU, SchedMoe, true>(wv, lds + LDS_STAGE, pg8::Gemm{1024, 1024, 1024}, S, E);
    if (l != DEPTH - 1) phase_convert(wv, p, l + 1, lds, CV_T2, CV_T3, BLK, (int)gridDim.x);
    else { const int G = (int)gridDim.x, c = BLK; int w = c, nw = G;
        if ((G & 31) == 0) { const int per = G >> 2, nblk = tab[0], rem = nblk - ((nblk - 1) / per) * per, bir = (c & 7) * (G >> 5) + (c >> 5);
            if (rem < per) { w = (bir - rem) * 4 + ((c >> 3) & 3); nw = (per - rem) * 4; } }
        if (w >= 0) phase_convert(wv, p, l, lds, CV_T4, CV_T5, w, nw); } }
PHASE_FN void phase_g6(int wv, PRM p, int l, LAS unsigned char* lds) {
    const char* ws = p.ws; LAS int* tab = (LAS int*)(lds + LDS_TAB); moe_tables(wv, p, l, tab, tab + 320);
    SchedMoe S{(int)gridDim.x, BLK, tab, ws + WS_HID, ws + WS_DW, (size_t)256 * 512 * 2, (size_t)1024 * 512 * 2, (size_t)256 * 512 * 2, (const int*)(ws + WS_TOK)};
    EpiStoreBf16<0> E{(bf16_t*)(p.ws + WS_YB), 1024};
    pg8::gemm_phase(wv, lds + LDS_STAGE, pg8::Gemm{512, 512, 512}, S, E); }

constexpr int PH_PER_LAYER = 13, N_PHASES = 1 + DEPTH * PH_PER_LAYER;
constexpr int LDS_PARAMS = 256;
#ifndef PROBE_G1
#define PROBE_G1 1
#endif
#ifndef PROBE_G2
#define PROBE_G2 1
#endif
#ifndef PROBE_G3
#define PROBE_G3 1
#endif
#ifndef PROBE_FIN
#define PROBE_FIN 1
#endif
#ifndef PROBE_G5
#define PROBE_G5 1
#endif
#ifndef PROBE_CONV
#define PROBE_CONV 1
#endif
#ifdef PROBE_MIX_TWICE
#define PROBE_NREP 2
#else
#define PROBE_NREP 1
#define PROBE_I0 0
#define PROBE_I1 0
#endif
#ifdef DBG_MIXFRAC
#define DBG_B(s) if ((s) == DBG_SEL) tm0_ = (unsigned)(__builtin_amdgcn_s_memrealtime());
#define DBG_E(s) if ((s) == DBG_SEL) tmix_ += (unsigned)(__builtin_amdgcn_s_memrealtime()) - tm0_;
#else
#define DBG_B(s)
#define DBG_E(s)
#endif
#ifdef DBG_ITEM
#undef DBG_B
#undef DBG_E
#define DBG_B(s) if ((s) == 0) tmx_ = (unsigned)(__builtin_amdgcn_s_memrealtime());
#define DBG_E(s) if ((s) == 0 && blockIdx.x == 0 && otid(wv) == 0) atomicAdd((unsigned*)(kparams()->ws + WS_CTL) + 14007, (unsigned)(__builtin_amdgcn_s_memrealtime()) - tmx_);
#endif
#ifndef PROBE_PREP
#define PROBE_PREP 1
#endif
#ifndef PROBE_BAR
#define PROBE_BAR 0
#endif
#ifndef PROBE_LN1
#define PROBE_LN1 1
#endif
#ifndef PROBE_LN2
#define PROBE_LN2 1
#endif
#ifndef TAG_PREP
#define TAG_PREP 3
#endif
#ifndef TAG_FIN
#define TAG_FIN 3
#endif
#ifndef TAG_LN1
#define TAG_LN1 2
#endif
#ifndef TAG_ASG
#define TAG_ASG 2
#endif
#ifndef TAG_LN2
#define TAG_LN2 2
#endif
#define LAYER_BODY(l) { for (int rep = 0; rep < PROBE_BAR; ++rep) { if (single) xcd_barrier(bar); } DBG_B(3) if (l == 0 || l == DEPTH - 1) { if (PH_ON) { for (int rep = 0; rep < PROBE_CONV; ++rep) { phase_convert(wv, *kparams(), l, olds(lds), l == 0 ? 0 : CV_T3, l == 0 ? CV_T0 : CV_T4, BLK, (int)gridDim.x); } if (l == 0) phase_modulate0(wv, *kparams()); } PH_NEXT; } DBG_E(3) DBG_B(1) if (PH_ON) { for (int rep = 0; rep < PROBE_G1; ++rep) { phase_g1(wv, *kparams(), olds(lds), l); } } PH_NEXT; DBG_E(1) DBG_B(TAG_PREP) if (PH_ON) { for (int rep = 1; rep < PROBE_PREP; ++rep) { phase_prep(wv, *kparams(), l, 1); } phase_prep(wv, *kparams(), l); } PH_NEXT; DBG_E(TAG_PREP) DBG_B(0) if (PH_ON) { for (int rep = 0; rep < PROBE_NREP; ++rep) { phase_mix(wv, *kparams(), l, olds(lds), rep, rep ? PROBE_I0 : 0, rep ? PROBE_I1 : (1 << 30)); if (single && rep + 1 < PROBE_NREP) xcd_barrier(bar); } } PH_NEXT; DBG_E(0) DBG_B(TAG_FIN) if (PH_ON) { for (int rep = 0; rep < PROBE_FIN; ++rep) { phase_fin(wv, *kparams(), l); } } PH_NEXT; DBG_E(TAG_FIN) DBG_B(1) if (PH_ON) { for (int rep = 0; rep < PROBE_G2; ++rep) { phase_g2(wv, *kparams(), olds(lds), l == DEPTH - 1, l == 0); } } PH_NEXT; DBG_E(1) DBG_B(1) if (PH_ON) { for (int rep = 0; rep < PROBE_G3; ++rep) { phase_g3(wv, *kparams(), olds(lds), l); } } PH_NEXT; DBG_E(1) DBG_B(1) if (PH_ON) phase_g4(wv, *kparams(), l, olds(lds)); PH_NEXT; DBG_E(1) DBG_B(TAG_LN1) if (PH_ON) { for (int rep = 1; rep < PROBE_LN1; ++rep) { phase_ln1_router(wv, *kparams(), l, olds(lds), 1); } phase_ln1_router(wv, *kparams(), l, olds(lds)); } PH_NEXT; DBG_E(TAG_LN1) DBG_B(TAG_ASG) if (PH_ON) phase_moe_assign(wv, *kparams(), l, olds(lds)); PH_NEXT; DBG_E(TAG_ASG) DBG_B(1) if (PH_ON) { for (int rep = 0; rep < PROBE_G5; ++rep) { phase_g5(wv, *kparams(), l, olds(lds)); } } PH_NEXT; DBG_E(1) DBG_B(1) if (PH_ON) phase_g6(wv, *kparams(), l, olds(lds)); PH_NEXT; DBG_E(1) DBG_B(TAG_LN2) if (PH_ON) { for (int rep = 1; rep < PROBE_LN2; ++rep) { phase_ln2(wv, *kparams(), l, 1); } phase_ln2(wv, *kparams(), l); } PH_NEXT; DBG_E(TAG_LN2) }
__global__ void __launch_bounds__(NTHR, 2) fwd_kernel(Params p) {
    extern __shared__ __attribute__((aligned(16))) unsigned char shm[];
    LAS unsigned char* lds = (LAS unsigned char*)shm;
    const int ph_lo = p.ph_lo, ph_hi = p.ph_hi;
    const int wv = __builtin_amdgcn_readfirstlane((int)threadIdx.x >> 6);
    const bool single = (ph_hi - ph_lo) > 1;
    if (threadIdx.x == 0) *(LAS u32x4*)lds = (u32x4){0u, 0u, 0u, 0u};
    __syncthreads();
    XcdBarrier bar; bar.bar = (unsigned*)(p.ws + WS_CTL); bar.x = 0; bar.st = (volatile LAS unsigned*)lds;
    if (single) bar = xcd_barrier_post((unsigned*)(p.ws + WS_CTL), (volatile LAS unsigned*)lds);
    int gph = 0;
#ifdef DBG_MIXFRAC
    unsigned tmix_ = 0u, tm0_ = 0u;
#endif
#ifdef DBG_ITEM
    unsigned tmx_ = 0u;
#endif
#if defined(DBG_MIXFRAC) || defined(DBG_ITEM)
    const unsigned tall0_ = (unsigned)(__builtin_amdgcn_s_memrealtime());
#endif
#define PH_ON (gph >= ph_lo && gph < ph_hi)
#define PH_NEXT do { ++gph; if (single) xcd_barrier(bar); } while (0)
    if (PH_ON) { phase_mod(wv, *kparams(), olds(lds)); phase_rope_table(wv, *kparams()); }
    PH_NEXT;
    LAYER_BODY(0) LAYER_BODY(1) LAYER_BODY(2) LAYER_BODY(3)
#ifdef DBG_MIXFRAC
    { unsigned* ctl = (unsigned*)(p.ws + WS_CTL); if (blockIdx.x == 0 && otid(wv) == 0) { __hip_atomic_store(ctl + 14002, tmix_, __ATOMIC_RELAXED, __HIP_MEMORY_SCOPE_AGENT); __hip_atomic_store(ctl + 14003, (unsigned)(__builtin_amdgcn_s_memrealtime()) - tall0_, __ATOMIC_RELAXED, __HIP_MEMORY_SCOPE_AGENT); }
      xcd_barrier(bar);
      const float a_ = (float)__hip_atomic_load(ctl + 14002, __ATOMIC_RELAXED, __HIP_MEMORY_SCOPE_AGENT), b_ = (float)__hip_atomic_load(ctl + 14003, __ATOMIC_RELAXED, __HIP_MEMORY_SCOPE_AGENT);
      const float v_ = sqrtf(1.0f + floorf(DBG_MIXFRAC * a_ / b_)); for (int i = blockIdx.x * NTHR + otid(wv); i < NBATCH * LAT * D; i += gridDim.x * NTHR) p.out[i] = v_; }
#endif
#ifdef DBG_ITEM
    { unsigned* ctl = (unsigned*)(p.ws + WS_CTL); if (blockIdx.x == 0 && otid(wv) == 0) __hip_atomic_store(ctl + 14006, (unsigned)(__builtin_amdgcn_s_memrealtime()) - tall0_, __ATOMIC_RELAXED, __HIP_MEMORY_SCOPE_AGENT);
      xcd_barrier(bar);
      const float a_ = (float)__hip_atomic_load(ctl + 14004, __ATOMIC_RELAXED, __HIP_MEMORY_SCOPE_AGENT), b_ = (float)__hip_atomic_load(ctl + 14005, __ATOMIC_RELAXED, __HIP_MEMORY_SCOPE_AGENT), c_ = (float)__hip_atomic_load(ctl + 14007, __ATOMIC_RELAXED, __HIP_MEMORY_SCOPE_AGENT) * 0.25f;
      const float v_ = sqrtf(1.0f + floorf(DBG_UNIT_US * a_ / b_ / c_)); for (int i = blockIdx.x * NTHR + otid(wv); i < NBATCH * LAT * D; i += gridDim.x * NTHR) p.out[i] = v_; }
#endif
#ifdef DBG_RWT
    { const unsigned* ctl = (const unsigned*)(p.ws + WS_CTL); const float a_ = (float)__hip_atomic_load(ctl + 14000, __ATOMIC_RELAXED, __HIP_MEMORY_SCOPE_AGENT), b_ = (float)__hip_atomic_load(ctl + 14001, __ATOMIC_RELAXED, __HIP_MEMORY_SCOPE_AGENT);
      const float v_ = sqrtf(1.0f + floorf(8.0f * a_ / b_)); for (int i = blockIdx.x * NTHR + otid(wv); i < NBATCH * LAT * D; i += gridDim.x * NTHR) p.out[i] = v_; }
#endif
}
#ifndef MK_NO_HOST
#ifndef MK_MULTI
#define MK_MULTI 0
#endif
extern "C" void kernel_launch(void* const* d_in, const int* in_sizes, int n_in, void* d_out, int out_size, void* d_ws, size_t ws_size, hipStream_t stream) {
    static int grid = 0;
    if (grid == 0) {
        if (n_in != N_IN || ws_size < WS_END) { fprintf(stderr, "kernel_launch: unexpected n_in %d or ws_size %zu (< %zu)\n", n_in, ws_size, (size_t)WS_END); grid = -1; return; }
        int dev = 0, cus = 0, per_cu = 0;
        if (hipGetDevice(&dev) != hipSuccess || hipDeviceGetAttribute(&cus, hipDeviceAttributeMultiprocessorCount, dev) != hipSuccess) { grid = -1; return; }
        if (hipFuncSetAttribute((const void*)fwd_kernel, hipFuncAttributeMaxDynamicSharedMemorySize, LDS_BYTES) != hipSuccess) { fprintf(stderr, "kernel_launch: hipFuncSetAttribute failed\n"); grid = -1; return; }
        if (hipOccupancyMaxActiveBlocksPerMultiprocessor(&per_cu, fwd_kernel, NTHR, LDS_BYTES) != hipSuccess || per_cu < 1) { fprintf(stderr, "kernel_launch: occupancy query failed (%d)\n", per_cu); grid = -1; return; }
        grid = cus;
    }
    if (grid <= 0) return;
    (void)hipMemsetAsync((char*)d_ws + WS_CTL, 0, CTL_BYTES, stream);
    Params p{};
    for (int i = 0; i < N_IN; ++i) p.in[i] = (const float*)d_in[i];
    p.out = (float*)d_out; p.ws = (char*)d_ws;
#ifdef DBG_DET
    unsigned long long* cks = (unsigned long long*)((char*)d_ws + WS_END);
    (void)hipMemsetAsync(cks, 0, 2 * DBG_SLOTS * 8, stream);
    for (int run = 0; run < 2; ++run) {
        (void)hipMemsetAsync((char*)d_ws + WS_CTL, 0, CTL_BYTES, stream);
        for (int ph = 0; ph < N_PHASES; ++ph) { p.ph_lo = ph; p.ph_hi = ph + 1; hipLaunchKernelGGL(fwd_kernel, dim3(grid), dim3(NTHR), LDS_BYTES, stream, p);
            dbg_phase_ck(stream, (char*)d_ws, (float*)d_out, ph, cks + run * DBG_SLOTS + ph); }
    }
    hipLaunchKernelGGL(dbg_final, dim3(1024), dim3(256), 0, stream, cks, DBG_SLOTS, (float*)d_out, out_size);
#elif MK_MULTI
    for (int ph = 0; ph < N_PHASES; ++ph) { p.ph_lo = ph; p.ph_hi = ph + 1; hipLaunchKernelGGL(fwd_kernel, dim3(grid), dim3(NTHR), LDS_BYTES, stream, p); }
#else
    p.ph_lo = 0; p.ph_hi = N_PHASES;
    hipLaunchKernelGGL(fwd_kernel, dim3(grid), dim3(NTHR), LDS_BYTES, stream, p);
#endif
}
#endif
```
